# Optimizing an MI355X kernel written in HIP

```python
import jax, jax.numpy as jnp
from jax import lax
import numpy as np

D_MODEL = 1024
BATCH = 4
SEQ = 4096
DEPTH = 1

EPS = 1e-6
ROPE_THETA = 10000.0
BLOCK = 128
NEG = -1e30

SWA_HEADS = 8
SWA_KV_HEADS = 2
SWA_HEAD_DIM = D_MODEL // 16
SWA_WINDOW = 128
SWA_WIDTH = SWA_HEADS * SWA_HEAD_DIM

MLA_HEADS = 8
MLA_NOPE_DIM = D_MODEL // 16
MLA_ROPE_DIM = D_MODEL // 32
MLA_V_DIM = D_MODEL // 16
MLA_Q_RANK = 3 * D_MODEL // 16
MLA_KV_RANK = D_MODEL // 8
MLA_WIDTH = MLA_HEADS * MLA_V_DIM

MIX_WIDTH = SWA_WIDTH + MLA_WIDTH
IN_SIZES = (SWA_WIDTH, SWA_KV_HEADS * SWA_HEAD_DIM, SWA_KV_HEADS * SWA_HEAD_DIM,
            MLA_Q_RANK, MLA_KV_RANK, MLA_ROPE_DIM)
IN_WIDTH = sum(IN_SIZES)
IN_SPLITS = [int(v) for v in np.cumsum(IN_SIZES)[:-1]]

N_GROUPS = 4
EXPERTS_PER_GROUP = 8
N_EXPERTS = N_GROUPS * EXPERTS_PER_GROUP
TOP_K = 2
D_EXPERT = D_MODEL // 4

N_MOD = 6

kernel_name = "hymba_swa_mla_hiermoe_adaln_encoder"


def rmsnorm(x, g):
    xf = x.astype(jnp.float32)
    y = xf * lax.rsqrt(jnp.mean(xf * xf, axis=-1, keepdims=True) + EPS)
    return (y * g.astype(jnp.float32)).astype(x.dtype)


def rope_tables(seq, dim):
    inv = 1.0 / (ROPE_THETA ** (jnp.arange(0, dim, 2, dtype=jnp.float32) / dim))
    ang = jnp.arange(seq, dtype=jnp.float32)[:, None] * inv[None, :]
    return jnp.cos(ang), jnp.sin(ang)


def apply_rope(x, cos, sin):
    half = x.shape[-1] // 2
    xf = x.astype(jnp.float32)
    x1, x2 = xf[..., :half], xf[..., half:]
    return jnp.concatenate([x1 * cos - x2 * sin, x2 * cos + x1 * sin], axis=-1).astype(x.dtype)


def windowed_gqa(q, k, v, sink, cos, sin):
    B, S = q.shape[0], q.shape[1]
    nb = S // BLOCK
    G = SWA_HEADS // SWA_KV_HEADS
    q = apply_rope(q, cos[:, None, :], sin[:, None, :])
    k = apply_rope(k, cos[:, None, :], sin[:, None, :])
    qb = q.reshape(B, nb, BLOCK, SWA_KV_HEADS, G, SWA_HEAD_DIM)
    pad = ((0, 0), (BLOCK, BLOCK), (0, 0), (0, 0))
    kp = jnp.pad(k, pad).reshape(B, nb + 2, BLOCK, SWA_KV_HEADS, SWA_HEAD_DIM)
    vp = jnp.pad(v, pad).reshape(B, nb + 2, BLOCK, SWA_KV_HEADS, SWA_HEAD_DIM)
    kb = jnp.concatenate([kp[:, :-2], kp[:, 1:-1], kp[:, 2:]], axis=2)
    vb = jnp.concatenate([vp[:, :-2], vp[:, 1:-1], vp[:, 2:]], axis=2)
    r = jnp.arange(BLOCK)[:, None]
    j = jnp.arange(3 * BLOCK)[None, :]
    in_win = jnp.abs(j - BLOCK - r) <= SWA_WINDOW
    kpos = jnp.arange(nb)[:, None] * BLOCK - BLOCK + jnp.arange(3 * BLOCK)[None, :]
    valid = (kpos >= 0) & (kpos < S)
    mask = in_win[None, :, :] & valid[:, None, :]
    scale = SWA_HEAD_DIM ** -0.5
    s = jnp.einsum('bnqkgd,bnjkd->bnkgqj', qb, kb).astype(jnp.float32) * scale
    s = jnp.where(mask[None, :, None, None, :, :], s, NEG)
    sink_f = sink.astype(jnp.float32).reshape(SWA_KV_HEADS, G)[None, None, :, :, None]
    m = jnp.maximum(jnp.max(s, axis=-1), sink_f)
    p = jnp.exp(s - m[..., None])
    denom = jnp.sum(p, axis=-1) + jnp.exp(sink_f - m)
    p = (p / denom[..., None]).astype(v.dtype)
    o = jnp.einsum('bnkgqj,bnjkd->bnqkgd', p, vb)
    return o.reshape(B, S, SWA_HEADS * SWA_HEAD_DIM)


def latent_attention(c_q, c_kv, k_rope, g_q, w_uq, g_kv, w_ukv, cos, sin):
    B, S = c_q.shape[0], c_q.shape[1]
    nb = S // BLOCK
    q = (rmsnorm(c_q, g_q) @ w_uq).reshape(B, S, MLA_HEADS, MLA_NOPE_DIM + MLA_ROPE_DIM)
    qn, qr = q[..., :MLA_NOPE_DIM], q[..., MLA_NOPE_DIM:]
    qr = apply_rope(qr, cos[:, None, :], sin[:, None, :])
    kr = apply_rope(k_rope, cos, sin)
    kv = (rmsnorm(c_kv, g_kv) @ w_ukv).reshape(B, S, MLA_HEADS, MLA_NOPE_DIM + MLA_V_DIM)
    kn, v = kv[..., :MLA_NOPE_DIM], kv[..., MLA_NOPE_DIM:]
    scale = (MLA_NOPE_DIM + MLA_ROPE_DIM) ** -0.5
    qn_b = qn.reshape(B, nb, BLOCK, MLA_HEADS, MLA_NOPE_DIM).transpose(1, 0, 2, 3, 4)
    qr_b = qr.reshape(B, nb, BLOCK, MLA_HEADS, MLA_ROPE_DIM).transpose(1, 0, 2, 3, 4)

    def attend(blk):
        qn_i, qr_i = blk
        s = (jnp.einsum('bqhd,bkhd->bhqk', qn_i, kn)
             + jnp.einsum('bqhr,bkr->bhqk', qr_i, kr)).astype(jnp.float32) * scale
        p = jax.nn.softmax(s, axis=-1).astype(v.dtype)
        return jnp.einsum('bhqk,bkhd->bqhd', p, v)

    o = lax.map(attend, (qn_b, qr_b))
    return o.transpose(1, 0, 2, 3, 4).reshape(B, S, MLA_HEADS * MLA_V_DIM)


def hierarchical_moe(h, w_rg, b_rg, w_re, b_re, w_gate, w_up, w_down):
    B, S, Dm = h.shape
    t = h.reshape(B * S, Dm)
    g_prob = jax.nn.softmax((t @ w_rg + b_rg).astype(jnp.float32), axis=-1)
    g_w, g_idx = lax.top_k(g_prob, 1)
    e_logit = (t @ w_re + b_re).astype(jnp.float32).reshape(-1, N_GROUPS, EXPERTS_PER_GROUP)
    g_onehot = jax.nn.one_hot(g_idx[:, 0], N_GROUPS, dtype=jnp.float32)
    e_logit = jnp.einsum('tge,tg->te', e_logit, g_onehot)
    e_prob = jax.nn.softmax(e_logit, axis=-1)
    e_w, e_idx = lax.top_k(e_prob, TOP_K)
    e_w = e_w / jnp.sum(e_w, axis=-1, keepdims=True)
    weights = g_w * e_w
    expert_id = g_idx * EXPERTS_PER_GROUP + e_idx
    combine = jnp.sum(jax.nn.one_hot(expert_id, N_EXPERTS, dtype=jnp.float32)
                      * weights[..., None], axis=1)
    hidden = (jax.nn.silu(jnp.einsum('td,edf->tef', t, w_gate))
              * jnp.einsum('td,edf->tef', t, w_up) * combine[..., None].astype(t.dtype))
    out = jnp.einsum('tef,efd->td', hidden, w_down)
    return out.reshape(B, S, Dm)


def setup_inputs(seed: int = 0) -> dict:
    key = jax.random.key(seed)
    ks = jax.random.split(key, 24)
    f32 = jnp.float32
    L = DEPTH

    def nrm(k, shape, fan_in, mult=1.0):
        return jax.random.normal(k, shape, f32) * (mult * fan_in ** -0.5)

    def gain(k, shape):
        return 1.0 + 0.02 * jax.random.normal(k, shape, f32)

    return {
        "x": jax.random.normal(ks[0], (BATCH, SEQ, D_MODEL), f32),
        "c": jax.random.normal(ks[1], (BATCH, D_MODEL), f32),
        "w_ada": nrm(ks[2], (L, D_MODEL, N_MOD * D_MODEL), D_MODEL, 0.5),
        "b_ada": 0.01 * jax.random.normal(ks[3], (L, N_MOD * D_MODEL), f32),
        "g_norm1": gain(ks[4], (L, D_MODEL)),
        "w_in": nrm(ks[5], (L, D_MODEL, IN_WIDTH), D_MODEL),
        "g_q_lora": gain(ks[6], (L, MLA_Q_RANK)),
        "w_uq": nrm(ks[7], (L, MLA_Q_RANK, MLA_HEADS * (MLA_NOPE_DIM + MLA_ROPE_DIM)), MLA_Q_RANK),
        "g_kv_lora": gain(ks[8], (L, MLA_KV_RANK)),
        "w_ukv": nrm(ks[9], (L, MLA_KV_RANK, MLA_HEADS * (MLA_NOPE_DIM + MLA_V_DIM)), MLA_KV_RANK),
        "sink": jax.random.normal(ks[10], (L, SWA_HEADS), f32),
        "g_out_swa": gain(ks[11], (L, SWA_WIDTH)),
        "g_out_mla": gain(ks[12], (L, MLA_WIDTH)),
        "w_out": nrm(ks[13], (L, MIX_WIDTH, D_MODEL), MIX_WIDTH),
        "g_norm2": gain(ks[14], (L, D_MODEL)),
        "w_router_group": nrm(ks[15], (L, D_MODEL, N_GROUPS), D_MODEL),
        "b_router_group": 0.01 * jax.random.normal(ks[16], (L, N_GROUPS), f32),
        "w_router_expert": nrm(ks[17], (L, D_MODEL, N_EXPERTS), D_MODEL),
        "b_router_expert": 0.01 * jax.random.normal(ks[18], (L, N_EXPERTS), f32),
        "w_exp_gate": nrm(ks[19], (L, N_EXPERTS, D_MODEL, D_EXPERT), D_MODEL),
        "w_exp_up": nrm(ks[20], (L, N_EXPERTS, D_MODEL, D_EXPERT), D_MODEL),
        "w_exp_down": nrm(ks[21], (L, N_EXPERTS, D_EXPERT, D_MODEL), D_EXPERT),
        "g_final": gain(ks[22], (D_MODEL,)),
    }


def reference(x, c, w_ada, b_ada, g_norm1, w_in, g_q_lora, w_uq, g_kv_lora, w_ukv, sink,
              g_out_swa, g_out_mla, w_out, g_norm2, w_router_group, b_router_group,
              w_router_expert, b_router_expert, w_exp_gate, w_exp_up, w_exp_down, g_final):
    B, S, _ = x.shape
    cos_a, sin_a = rope_tables(S, SWA_HEAD_DIM)
    cos_b, sin_b = rope_tables(S, MLA_ROPE_DIM)
    for l in range(DEPTH):
        mod = jax.nn.silu(c) @ w_ada[l] + b_ada[l]
        sh1, sc1, gt1, sh2, sc2, gt2 = [m[:, None, :] for m in jnp.split(mod, N_MOD, axis=-1)]

        h = rmsnorm(x, g_norm1[l]) * (1.0 + sc1) + sh1
        proj = h @ w_in[l]
        qa, ka, va, cq, ckv, kr = jnp.split(proj, IN_SPLITS, axis=-1)
        qa = qa.reshape(B, S, SWA_HEADS, SWA_HEAD_DIM)
        ka = ka.reshape(B, S, SWA_KV_HEADS, SWA_HEAD_DIM)
        va = va.reshape(B, S, SWA_KV_HEADS, SWA_HEAD_DIM)
        o_a = windowed_gqa(qa, ka, va, sink[l], cos_a, sin_a)
        o_b = latent_attention(cq, ckv, kr, g_q_lora[l], w_uq[l], g_kv_lora[l], w_ukv[l],
                               cos_b, sin_b)
        mix = jnp.concatenate([rmsnorm(o_a, g_out_swa[l]), rmsnorm(o_b, g_out_mla[l])], axis=-1)
        x = x + gt1 * (mix @ w_out[l])

        h = rmsnorm(x, g_norm2[l]) * (1.0 + sc2) + sh2
        x = x + gt2 * hierarchical_moe(h, w_router_group[l], b_router_group[l],
                                       w_router_expert[l], b_router_expert[l],
                                       w_exp_gate[l], w_exp_up[l], w_exp_down[l])
    return rmsnorm(x, g_final)
```

```cpp
#include <hip/hip_runtime.h>
#include <cstdio>
#include <cstdint>
constexpr int DM = 1024, NB = 4, SEQ = 4096, T = NB * SEQ;
constexpr int INW = 1120, NMOD = 6;
constexpr float EPS = 1e-6f;
#define LAS __attribute__((address_space(3)))
typedef unsigned short bf16_t;
typedef short bf16x8 __attribute__((ext_vector_type(8)));
typedef float f32x16 __attribute__((ext_vector_type(16)));
typedef float f32x4 __attribute__((ext_vector_type(4)));
typedef unsigned u32x4 __attribute__((ext_vector_type(4)));
typedef unsigned u32x2 __attribute__((ext_vector_type(2)));
typedef unsigned char uchar;

constexpr int NTHR = 512, NWAVE = 8;
constexpr int LDS_A = 0, LDS_MISC = 131072, LDS_BYTES = 163840;
constexpr float LOG2E = 1.4426950408889634f;
constexpr float QSCALE_A = 0.125f * LOG2E;
constexpr float QSCALE_B = 0.10206207261596575f * LOG2E;
constexpr float THR2 = 10.f;
constexpr float WIN_SCALE = 64.f, WIN_DESCALE = 1.0f / 64.f;
constexpr float H2_SCALE = 8.f, WGU_SCALE = 64.f, WD_SCALE = 32.f, HID_SCALE = 8.f;

constexpr size_t WS_CTL   = 0;
constexpr size_t WS_CNT   = 16384;
constexpr size_t WS_MOD   = 32768;
constexpr size_t WS_TABA  = WS_MOD + 98304;
constexpr size_t WS_TABB  = WS_TABA + 4096 * 32 * 8;
constexpr size_t WS_WIN   = WS_TABB + 4096 * 16 * 8;
constexpr size_t WS_WUQ   = WS_WIN + 35 * 64 * 1024;
constexpr size_t WS_WUKV  = WS_WUQ + 24 * 12 * 1024;
constexpr size_t WS_WOUT  = WS_WUKV + 32 * 8 * 1024;
constexpr size_t WS_WR    = WS_WOUT + 32 * 64 * 1024;
constexpr size_t WS_WG    = WS_WR + 2 * 64 * 1024;
constexpr size_t WS_WU    = WS_WG + (size_t)32 * 8 * 32 * 1024;
constexpr size_t WS_WD    = WS_WU + (size_t)32 * 8 * 32 * 1024;
constexpr size_t WS_LIST  = WS_WD + (size_t)32 * 32 * 8 * 1024;
constexpr size_t WS_WT    = WS_LIST + (size_t)32 * 16384 * 4;
constexpr size_t WS_QA    = WS_WT + (size_t)T * 2 * 4;
constexpr size_t WS_KVA   = WS_QA + (size_t)NB * 8 * 64 * 8192;
constexpr size_t WS_QB    = WS_KVA + (size_t)NB * 2 * 64 * 16384;
constexpr size_t WS_KVB   = WS_QB + (size_t)NB * 8 * 64 * 12288;
constexpr size_t WS_O     = WS_KVB + (size_t)NB * 8 * 64 * 20480;
constexpr size_t WS_H2    = WS_O + (size_t)T * DM * 2;
constexpr size_t WS_X1    = WS_H2 + (size_t)T * DM * 2;
constexpr size_t WS_END   = WS_X1 + (size_t)T * DM * 2;
constexpr size_t WS_Y     = WS_QA;
static_assert((size_t)T * 2 * DM * 2 <= WS_O - WS_QA, "Y overlay");

struct Params { const float* in[23]; float* out; unsigned char* ws; int ph_lo, ph_hi, variant, pad; };
struct KP { const float* const* in; float* out; unsigned char* ws; int ph_lo, ph_hi, wave, variant; };
__device__ __forceinline__ int mk_lane() { return (int)__builtin_amdgcn_mbcnt_hi(~0u, __builtin_amdgcn_mbcnt_lo(~0u, 0u)); }

__device__ __forceinline__ unsigned pk2(float lo, float hi) { unsigned r; asm("v_cvt_pk_bf16_f32 %0, %1, %2" : "=v"(r) : "v"(lo), "v"(hi)); return r; }
__device__ __forceinline__ float bf2f(unsigned short v) { return __uint_as_float((unsigned)v << 16); }
__host__ __device__ __forceinline__ constexpr int crow(int r, int hi) { return (r & 3) + 8 * (r >> 2) + 4 * hi; }
__device__ __forceinline__ f32x16 mfma(bf16x8 a, bf16x8 b, f32x16 c) { return __builtin_amdgcn_mfma_f32_32x32x16_bf16(a, b, c, 0, 0, 0); }
__device__ __forceinline__ float wave_sum(float v) {
#pragma unroll
  for (int o = 32; o; o >>= 1) v += __shfl_xor(v, o);
  return v;
}
__device__ __forceinline__ float half_swap_max(float x) { auto rr = __builtin_amdgcn_permlane32_swap(__float_as_uint(x), __float_as_uint(x), false, false); return fmaxf(__uint_as_float(rr[0]), __uint_as_float(rr[1])); }
__device__ __forceinline__ float half_swap_sum(float x) { auto rr = __builtin_amdgcn_permlane32_swap(__float_as_uint(x), __float_as_uint(x), false, false); return __uint_as_float(rr[0]) + __uint_as_float(rr[1]); }
__host__ __device__ __forceinline__ constexpr int a_off(int row, int kbyte, int pitch) { return row * pitch + (kbyte ^ ((row & 15) << 4)); }
__host__ __device__ __forceinline__ constexpr int img_qk(int rr, int d, int NS) { return ((((rr >> 5) * NS + (d >> 4)) * 64) + ((d >> 3) & 1) * 32 + (rr & 31)) * 16 + (d & 7) * 2; }
__host__ __device__ __forceinline__ constexpr int img_v(int kk, int d) {
  const int kb = kk >> 5, k32 = kk & 31, s = k32 >> 4, k16 = k32 & 15, h = (k16 >> 2) & 1, j = ((k16 >> 3) << 2) | (k16 & 3), db = d >> 5, r = d & 31;
  return (((((kb * 2 + db) * 2 + s) * 64) + h * 32 + r) * 8 + j) * 2;
}

#define XB_TMO      128
#define XB_XCNT(j)  (256  + 64 * (j))
#define XB_XSUB(j)  (1280 + 64 * (j))
#define XB_XGEN(j)  (2304 + 64 * (j))
#define XB_TOP      3328
#define XB_TOPGEN   3392
#define XCD_BAR_WORDS 3456
#define XB_SPIN_CAP (1u << 20)
__device__ __forceinline__ unsigned xb_ld(unsigned* p)              { return __hip_atomic_load(p, __ATOMIC_RELAXED, __HIP_MEMORY_SCOPE_AGENT); }
__device__ __forceinline__ unsigned xb_add(unsigned* p, unsigned v) { return __hip_atomic_fetch_add(p, v, __ATOMIC_RELAXED, __HIP_MEMORY_SCOPE_AGENT); }
__device__ __forceinline__ unsigned xb_xcc_id() { return (unsigned)__builtin_amdgcn_s_getreg((3 << 11) | 20) & 0xFu; }
#define XB_SPIN(cond, bar) do { unsigned _sp = 0; while (cond) { __builtin_amdgcn_s_sleep(1); \
    if ((++_sp & 255u) == 0u) { if (xb_ld(&(bar)[XB_TMO])) break; if (_sp > XB_SPIN_CAP) { atomicAdd(&(bar)[XB_TMO], 1u); break; } } } } while (0)
struct XcdBarrier { unsigned* bar; unsigned x; volatile LAS unsigned* st; };
__device__ __forceinline__ XcdBarrier xcd_barrier_post(unsigned* bar, volatile LAS unsigned* st, bool leader) {
  XcdBarrier b; b.bar = bar; b.x = xb_xcc_id(); b.st = st;
  if (leader) (void)xb_add(&bar[XB_XCNT(b.x)], 1u);
  return b;
}
__device__ __forceinline__ void xcd_barrier_complete(unsigned* bar, unsigned x, unsigned& nloc, unsigned& nx) {
  const unsigned G = gridDim.x * gridDim.y * gridDim.z;
  unsigned sum, cnt, mine, sp = 0u;
  for (;;) {
    sum = 0u; cnt = 0u; mine = 0u;
#pragma unroll
    for (unsigned j = 0; j < 16; ++j) { const unsigned c = xb_ld(&bar[XB_XCNT(j)]); sum += c; cnt += (c > 0u) ? 1u : 0u; mine = (j == x) ? c : mine; }
    if (sum == G) break;
    __builtin_amdgcn_s_sleep(1);
    if ((++sp & 255u) == 0u) { if (xb_ld(&bar[XB_TMO])) break; if (sp > XB_SPIN_CAP) { atomicAdd(&bar[XB_TMO], 1u); break; } }
  }
  nloc = mine > 0u ? mine : 1u; nx = cnt > 0u ? cnt : 1u;
}
__device__ __forceinline__ void xcd_barrier(const XcdBarrier& b, bool leader) {
  asm volatile("s_waitcnt vmcnt(0)" ::: "memory");
  __syncthreads();
  if (leader) {
    unsigned* bar = b.bar;
    __builtin_amdgcn_s_waitcnt(0);
    unsigned nloc = b.st[0], nx = b.st[1];
    if (nloc == 0u) { xcd_barrier_complete(bar, b.x, nloc, nx); b.st[0] = nloc; b.st[1] = nx; }
    const unsigned old = xb_add(&bar[XB_XSUB(b.x)], 1u);
    const unsigned gen = old / nloc;
    if (old + 1u == (gen + 1u) * nloc) {
      __builtin_amdgcn_fence(__ATOMIC_RELEASE, "agent");
      asm volatile("s_waitcnt vmcnt(0)" ::: "memory");
      const unsigned og = xb_add(&bar[XB_TOP], 1u);
      const unsigned tg = og / nx;
      if (og + 1u == (tg + 1u) * nx) xb_add(&bar[XB_TOPGEN], 1u);
      else XB_SPIN(xb_ld(&bar[XB_TOPGEN]) == tg, bar);
      __builtin_amdgcn_fence(__ATOMIC_ACQUIRE, "agent");
      xb_add(&bar[XB_XGEN(b.x)], 1u);
      asm volatile("s_waitcnt vmcnt(0)" ::: "memory");
    } else {
      XB_SPIN(xb_ld(&bar[XB_XGEN(b.x)]) == gen, bar);
      __builtin_amdgcn_fence(__ATOMIC_ACQUIRE, "agent");
      asm volatile("s_waitcnt vmcnt(0)" ::: "memory");
    }
  }
  __syncthreads();
}

template <int NBLK, int NS, bool TR, int D = (NBLK >= 3 ? 4 : 8)>
__device__ __forceinline__ void gemm_tile(f32x16 (&acc)[NBLK][2], const LAS uchar* A, const int pitch, const bf16x8* const (&wp)[NBLK], const int lane) {
  constexpr int NSM = (NS / D) * D;
  const int r = lane & 31, h = lane >> 5;
  const LAS uchar* a0p = A + r * pitch; const LAS uchar* a1p = A + (32 + r) * pitch;
  const int swz = (lane & 15) << 4, kb0 = 16 * h;
  bf16x8 ring[D][NBLK];
#pragma unroll
  for (int d = 0; d < D; ++d)
#pragma unroll
    for (int i = 0; i < NBLK; ++i) ring[d][i] = wp[i][d * 64];
#pragma unroll 1
  for (int s0 = 0; s0 < NSM; s0 += D) {
#pragma unroll
    for (int d = 0; d < D; ++d) {
      const int s = s0 + d;
      const int ko = ((s * 32) + kb0) ^ swz; const bf16x8 fa0 = *(const LAS bf16x8*)(a0p + ko), fa1 = *(const LAS bf16x8*)(a1p + ko);
#pragma unroll
      for (int i = 0; i < NBLK; ++i) {
        if (TR) { acc[i][0] = mfma(ring[d][i], fa0, acc[i][0]); acc[i][1] = mfma(ring[d][i], fa1, acc[i][1]); }
        else    { acc[i][0] = mfma(fa0, ring[d][i], acc[i][0]); acc[i][1] = mfma(fa1, ring[d][i], acc[i][1]); }
      }
      if (s + D < NS) {
#pragma unroll
        for (int i = 0; i < NBLK; ++i) ring[d][i] = wp[i][(s + D) * 64];
      }
    }
  }
#pragma unroll
  for (int d = 0; d < NS - NSM; ++d) {
    const int s = NSM + d;
    const int ko = ((s * 32) + kb0) ^ swz; const bf16x8 fa0 = *(const LAS bf16x8*)(a0p + ko), fa1 = *(const LAS bf16x8*)(a1p + ko);
#pragma unroll
    for (int i = 0; i < NBLK; ++i) {
      if (TR) { acc[i][0] = mfma(ring[d][i], fa0, acc[i][0]); acc[i][1] = mfma(ring[d][i], fa1, acc[i][1]); }
      else    { acc[i][0] = mfma(fa0, ring[d][i], acc[i][0]); acc[i][1] = mfma(fa1, ring[d][i], acc[i][1]); }
    }
  }
}
typedef long l64x2 __attribute__((ext_vector_type(2)));
__device__ __forceinline__ f32x16 mfma8(long a, long b, f32x16 c) { return __builtin_amdgcn_mfma_f32_32x32x16_fp8_fp8(a, b, c, 0, 0, 0); }
__device__ __forceinline__ unsigned pk4_fp8(float a, float b, float c, float d) { int w = 0; w = __builtin_amdgcn_cvt_pk_fp8_f32(a, b, w, false); w = __builtin_amdgcn_cvt_pk_fp8_f32(c, d, w, true); return (unsigned)w; }
typedef int i32x8 __attribute__((ext_vector_type(8)));
typedef int i32x4 __attribute__((ext_vector_type(4)));
#ifndef MK_MX
#define MK_MX 1
#endif
__device__ __forceinline__ f32x16 mfma_mx(i32x4 a0, i32x4 a1, i32x4 b0, i32x4 b1, f32x16 c) {
  const i32x8 a = __builtin_shufflevector(a0, a1, 0, 1, 2, 3, 4, 5, 6, 7), b = __builtin_shufflevector(b0, b1, 0, 1, 2, 3, 4, 5, 6, 7);
  return __builtin_amdgcn_mfma_scale_f32_32x32x64_f8f6f4(a, b, c, 0, 0, 0, 0x7f7f7f7f, 0, 0x7f7f7f7f);
}
__device__ __forceinline__ f32x16 mfma_mx8(i32x8 a, i32x8 b, f32x16 c) { return __builtin_amdgcn_mfma_scale_f32_32x32x64_f8f6f4(a, b, c, 0, 0, 0, 0x7f7f7f7f, 0, 0x7f7f7f7f); }
__device__ __forceinline__ i32x8 ld_pair(const i32x4* p0, const i32x4* p1) { const i32x4 x = *p0, y = *p1; return __builtin_shufflevector(x, y, 0, 1, 2, 3, 4, 5, 6, 7); }
template <int NBLK, int NS, bool TR, int D, bool FULL, int NRB>
__device__ __forceinline__ void gemm_tile_f8(f32x16 (&acc)[NBLK][NRB], const LAS uchar* A, const int pitch, const l64x2* const (&wp)[NBLK], const int lane, const int nrb) {
  constexpr int NP = NS / 2;
  static_assert(NS % 2 == 0 && NP % D == 0, "NS even, NP % D");
  const int r = lane & 31, h = lane >> 5;
  const LAS uchar* ap = A + r * pitch;
  const int swz = (lane & 15) << 4, kb0 = 16 * h;
  i32x8 ring[D][NBLK];
#pragma unroll
  for (int d = 0; d < D; ++d)
#pragma unroll
    for (int i = 0; i < NBLK; ++i) ring[d][i] = ld_pair((const i32x4*)(wp[i] + (2 * d) * 64), (const i32x4*)(wp[i] + (2 * d + 1) * 64));
#pragma unroll 1
  for (int p0 = 0; p0 < NP; p0 += D) {
#pragma unroll
    for (int d = 0; d < D; ++d) {
      const int s = 2 * (p0 + d);
      const int ko0 = ((s * 32) + kb0) ^ swz, ko1 = (((s + 1) * 32) + kb0) ^ swz;
#pragma unroll
      for (int rb = 0; rb < NRB; ++rb) {
        if (FULL || rb < nrb) {
          const i32x4 f0 = *(const LAS i32x4*)(ap + rb * 32 * pitch + ko0), f1 = *(const LAS i32x4*)(ap + rb * 32 * pitch + ko1);
          const i32x8 fa = __builtin_shufflevector(f0, f1, 0, 1, 2, 3, 4, 5, 6, 7);
#pragma unroll
          for (int i = 0; i < NBLK; ++i) acc[i][rb] = TR ? mfma_mx8(ring[d][i], fa, acc[i][rb]) : mfma_mx8(fa, ring[d][i], acc[i][rb]);
        }
      }
      if (p0 + d + D < NP) {
#pragma unroll
        for (int i = 0; i < NBLK; ++i) ring[d][i] = ld_pair((const i32x4*)(wp[i] + (2 * (p0 + d + D)) * 64), (const i32x4*)(wp[i] + (2 * (p0 + d + D) + 1) * 64));
      }
    }
  }
}
template <int NSLOT, int NACC, int NS, bool TR, int D, int MAP>
__device__ __forceinline__ void gemm_slots_f8(f32x16 (&acc)[NACC][2], const LAS uchar* A, const int pitch, const l64x2* const (&wp)[NSLOT], const int lane) {
  constexpr int NP = NS / 2;
  static_assert(NS % 2 == 0 && NP % D == 0, "NS even, NP % D");
  const int r = lane & 31, h = lane >> 5;
  const LAS uchar* ap = A + r * pitch;
  const int swz = (lane & 15) << 4, kb0 = 16 * h;
  i32x8 ring[D][NSLOT];
#pragma unroll
  for (int d = 0; d < D; ++d)
#pragma unroll
    for (int i = 0; i < NSLOT; ++i) ring[d][i] = ld_pair((const i32x4*)(wp[i] + (2 * d) * 64), (const i32x4*)(wp[i] + (2 * d + 1) * 64));
#pragma unroll 1
  for (int p0 = 0; p0 < NP; p0 += D) {
#pragma unroll
    for (int d = 0; d < D; ++d) {
      const int s = 2 * (p0 + d);
      const int ko0 = ((s * 32) + kb0) ^ swz, ko1 = (((s + 1) * 32) + kb0) ^ swz;
#pragma unroll
      for (int rb = 0; rb < 2; ++rb) {
        const i32x4 f0 = *(const LAS i32x4*)(ap + rb * 32 * pitch + ko0), f1 = *(const LAS i32x4*)(ap + rb * 32 * pitch + ko1);
        const i32x8 fa = __builtin_shufflevector(f0, f1, 0, 1, 2, 3, 4, 5, 6, 7);
#pragma unroll
        for (int i = 0; i < NSLOT; ++i) { constexpr int dummy = 0; (void)dummy; const int ai = (MAP >> (4 * i)) & 15;
          acc[ai][rb] = TR ? mfma_mx8(ring[d][i], fa, acc[ai][rb]) : mfma_mx8(fa, ring[d][i], acc[ai][rb]); }
      }
      if (p0 + d + D < NP) {
#pragma unroll
        for (int i = 0; i < NSLOT; ++i) ring[d][i] = ld_pair((const i32x4*)(wp[i] + (2 * (p0 + d + D)) * 64), (const i32x4*)(wp[i] + (2 * (p0 + d + D) + 1) * 64));
      }
    }
  }
}
template <int NBLK> __device__ __forceinline__ void acc_zero(f32x16 (&acc)[NBLK][2]) {
#pragma unroll
  for (int i = 0; i < NBLK; ++i) { acc[i][0] = f32x16{}; acc[i][1] = f32x16{}; }
}

__device__ __forceinline__ void store_img_qk(uchar* img, const f32x16& v, int rr, int f0, int NS, int hi) {
#pragma unroll
  for (int g = 0; g < 4; ++g) { u32x2 w; w.x = pk2(v[4 * g], v[4 * g + 1]); w.y = pk2(v[4 * g + 2], v[4 * g + 3]);
    *(u32x2*)(img + img_qk(rr, f0 + 8 * g + 4 * hi, NS)) = w; }
}
__device__ __forceinline__ void store_img_v(uchar* img, const f32x16& v, int kb, int d, int hi) {
#pragma unroll
  for (int g = 0; g < 4; ++g) { u32x2 w; w.x = pk2(v[4 * g], v[4 * g + 1]); w.y = pk2(v[4 * g + 2], v[4 * g + 3]);
    *(u32x2*)(img + img_v(32 * kb + 8 * g + 4 * hi, d)) = w; }
}
__device__ __forceinline__ void pack_frag(const float* __restrict__ W, int ldw, int k0, int n0, const float* __restrict__ rowscale, u32x4* __restrict__ dst, int lane) {
  const int r = lane & 31, h = lane >> 5;
  const float* p = W + (size_t)(k0 + 8 * h) * ldw + n0 + r;
  float v[8];
#pragma unroll
  for (int j = 0; j < 8; ++j) v[j] = p[(size_t)j * ldw];
  if (rowscale) {
#pragma unroll
    for (int j = 0; j < 8; ++j) v[j] *= rowscale[k0 + 8 * h + j];
  }
  u32x4 w; w.x = pk2(v[0], v[1]); w.y = pk2(v[2], v[3]); w.z = pk2(v[4], v[5]); w.w = pk2(v[6], v[7]);
  dst[lane] = w;
}
__device__ __forceinline__ void pack_frag8(const float* __restrict__ W, int ldw, int k0, int n0, float scale, u32x4* __restrict__ dst, int lane) {
  const int r = lane & 31, h = lane >> 5;
  const float* p = W + (size_t)(k0 + 16 * h) * ldw + n0 + r;
  float v[16];
#pragma unroll
  for (int j = 0; j < 16; ++j) v[j] = p[(size_t)j * ldw] * scale;
  u32x4 w; w.x = pk4_fp8(v[0], v[1], v[2], v[3]); w.y = pk4_fp8(v[4], v[5], v[6], v[7]); w.z = pk4_fp8(v[8], v[9], v[10], v[11]); w.w = pk4_fp8(v[12], v[13], v[14], v[15]);
  dst[lane] = w;
}
__device__ __forceinline__ void pack_frag8_lo(const float* __restrict__ W, int ldw, int k0, int n0, float scale, u32x4* __restrict__ dst, int lane) {
  const int r = lane & 31, h = lane >> 5;
  const float* p = W + (size_t)(k0 + 16 * h) * ldw + n0 + r;
  float v[16];
#pragma unroll
  for (int j = 0; j < 16; ++j) { const float x = p[(size_t)j * ldw] * scale; const int q = __builtin_amdgcn_cvt_pk_fp8_f32(x, 0.f, 0, false); v[j] = x - __builtin_amdgcn_cvt_f32_fp8(q, 0); }
  u32x4 w; w.x = pk4_fp8(v[0], v[1], v[2], v[3]); w.y = pk4_fp8(v[4], v[5], v[6], v[7]); w.z = pk4_fp8(v[8], v[9], v[10], v[11]); w.w = pk4_fp8(v[12], v[13], v[14], v[15]);
  dst[lane] = w;
}
__device__ __forceinline__ void phase0(const KP& P, LAS uchar* lds) {
  int lane_ = mk_lane(); asm volatile("" : "+v"(lane_)); const int lane = lane_ & 63, wave = P.wave, tid = wave * 64 + lane, bid = blockIdx.x, G = gridDim.x;
  uchar* ws = P.ws;
  if (bid == 0 && tid < 64) ((int*)(ws + WS_CNT))[tid] = 0;
  for (int idx = bid * NTHR + tid; idx < SEQ * 48; idx += G * NTHR) {
    int pos, i, half; float2* dst;
    if (idx < SEQ * 32) { pos = idx >> 5; i = idx & 31; half = 32; dst = (float2*)(ws + WS_TABA) + idx; }
    else { const int i2 = idx - SEQ * 32; pos = i2 >> 4; i = i2 & 15; half = 16; dst = (float2*)(ws + WS_TABB) + i2; }
    const float inv = 1.0f / powf(10000.0f, (float)(2 * i) / (float)(2 * half));
    const float ang = (float)pos * inv;
    *dst = make_float2(cosf(ang), sinf(ang));
  }
  if (bid < 192) {
    const float* c = P.in[1]; const float* w_ada = P.in[2]; const float* b_ada = P.in[3];
    LAS float* sl = (LAS float*)lds; LAS float* part = (LAS float*)(lds + 16384);
    for (int i = tid; i < NB * DM; i += NTHR) { const float v = c[i]; sl[i] = v / (1.f + __expf(-v)); }
    __syncthreads();
    const int n0 = bid * 32, rowl = lane >> 3, c4 = lane & 7;
    f32x4 a0 = {0, 0, 0, 0}, a1 = a0, a2 = a0, a3 = a0;
#pragma unroll 4
    for (int it = 0; it < 16; ++it) {
      const int k = wave * 128 + it * 8 + rowl;
      const f32x4 wv = *(const f32x4*)(w_ada + (size_t)k * (NMOD * DM) + n0 + 4 * c4);
      a0 += wv * sl[k]; a1 += wv * sl[DM + k]; a2 += wv * sl[2 * DM + k]; a3 += wv * sl[3 * DM + k];
    }
#pragma unroll
    for (int e = 0; e < 4; ++e) {
#pragma unroll
      for (int o = 8; o < 64; o <<= 1) { a0[e] += __shfl_xor(a0[e], o); a1[e] += __shfl_xor(a1[e], o); a2[e] += __shfl_xor(a2[e], o); a3[e] += __shfl_xor(a3[e], o); }
    }
    if (rowl == 0) {
#pragma unroll
      for (int e = 0; e < 4; ++e) { part[(wave * 4 + 0) * 32 + 4 * c4 + e] = a0[e]; part[(wave * 4 + 1) * 32 + 4 * c4 + e] = a1[e]; part[(wave * 4 + 2) * 32 + 4 * c4 + e] = a2[e]; part[(wave * 4 + 3) * 32 + 4 * c4 + e] = a3[e]; }
    }
    __syncthreads();
    if (tid < 128) { const int bb = tid >> 5, col = tid & 31; float s = b_ada[n0 + col];
#pragma unroll
      for (int w = 0; w < 8; ++w) s += part[(w * 4 + bb) * 32 + col];
      ((float*)(ws + WS_MOD))[bb * (NMOD * DM) + n0 + col] = s; }
  }
  const int gw = bid * NWAVE + wave, NGW = G * NWAVE;
  for (int f = gw; f < 43 * 32; f += NGW) { const int slot = f >> 5, s = f & 31;
    if (slot < 35) pack_frag8(P.in[5], INW, 32 * s, 32 * slot, WIN_SCALE, (u32x4*)(ws + WS_WIN) + (size_t)f * 64, lane);
    else { const int blk = slot < 39 ? 20 + (slot - 35) : 30 + (slot - 39); pack_frag8_lo(P.in[5], INW, 32 * s, 32 * blk, WIN_SCALE, (u32x4*)(ws + WS_WIN) + (size_t)f * 64, lane); } }
  for (int f = gw; f < 32 * 64; f += NGW) pack_frag(P.in[13], DM, 16 * (f & 63), 32 * (f >> 6), nullptr, (u32x4*)(ws + WS_WOUT) + (size_t)f * 64, lane);
  for (int f = gw; f < 24 * 12; f += NGW) pack_frag(P.in[7], 768, 16 * (f % 12), 32 * (f / 12), P.in[6], (u32x4*)(ws + WS_WUQ) + (size_t)f * 64, lane);
  for (int f = gw; f < 32 * 8; f += NGW) pack_frag(P.in[9], 1024, 16 * (f & 7), 32 * (f >> 3), P.in[8], (u32x4*)(ws + WS_WUKV) + (size_t)f * 64, lane);
  for (int f = gw; f < 2 * 64; f += NGW) {
    const int nb = f >> 6, s = f & 63, r = lane & 31, h = lane >> 5, col = 32 * nb + r;
    float v[8];
#pragma unroll
    for (int j = 0; j < 8; ++j) { const int k = 16 * s + 8 * h + j; v[j] = col < 4 ? P.in[15][k * 4 + col] : (col < 36 ? P.in[17][k * 32 + col - 4] : 0.f); }
    u32x4 w; w.x = pk2(v[0], v[1]); w.y = pk2(v[2], v[3]); w.z = pk2(v[4], v[5]); w.w = pk2(v[6], v[7]);
    ((u32x4*)(ws + WS_WR) + (size_t)f * 64)[lane] = w;
  }
}

__device__ __forceinline__ void rope64(const f32x16& xa, const f32x16& xb, f32x16& ya, f32x16& yb, const float2* __restrict__ trow, int hi, float scale) {
#pragma unroll
  for (int g = 0; g < 4; ++g) {
    const f32x4 t0 = *(const f32x4*)(trow + 8 * g + 4 * hi), t1 = *(const f32x4*)(trow + 8 * g + 4 * hi + 2);
    const float cc[4] = {t0[0], t0[2], t1[0], t1[2]}, sn[4] = {t0[1], t0[3], t1[1], t1[3]};
#pragma unroll
    for (int i = 0; i < 4; ++i) { const int reg = 4 * g + i; ya[reg] = (xa[reg] * cc[i] - xb[reg] * sn[i]) * scale; yb[reg] = (xb[reg] * cc[i] + xa[reg] * sn[i]) * scale; }
  }
}
__device__ __forceinline__ void rope32(const f32x16& x, f32x16& y, const float2* __restrict__ trow, int hi, float scale) {
#pragma unroll
  for (int g = 0; g < 2; ++g) {
    const f32x4 t0 = *(const f32x4*)(trow + 8 * g + 4 * hi), t1 = *(const f32x4*)(trow + 8 * g + 4 * hi + 2);
    const float cc[4] = {t0[0], t0[2], t1[0], t1[2]}, sn[4] = {t0[1], t0[3], t1[1], t1[3]};
#pragma unroll
    for (int i = 0; i < 4; ++i) { const int reg = 4 * g + i; y[reg] = (x[reg] * cc[i] - x[reg + 8] * sn[i]) * scale; y[reg + 8] = (x[reg + 8] * cc[i] + x[reg] * sn[i]) * scale; }
  }
}
__device__ __forceinline__ float write_c_tile(LAS uchar* base, int pitch, const f32x16& vin, int rr, int f0, int hi) {
  const f32x16 v = vin * WIN_DESCALE;
  float ss = 0.f;
#pragma unroll
  for (int g = 0; g < 4; ++g) { u32x2 w; w.x = pk2(v[4 * g], v[4 * g + 1]); w.y = pk2(v[4 * g + 2], v[4 * g + 3]);
    *(LAS u32x2*)(base + a_off(rr, 2 * (f0 + 8 * g + 4 * hi), pitch)) = w;
    ss += v[4 * g] * v[4 * g] + v[4 * g + 1] * v[4 * g + 1] + v[4 * g + 2] * v[4 * g + 2] + v[4 * g + 3] * v[4 * g + 3]; }
  return ss;
}
__device__ __forceinline__ void store_img8_qk(uchar* img, const f32x16& v, int rb, int r32, int blk, int hi) {
#pragma unroll
  for (int g = 0; g < 4; ++g) { const unsigned w = pk4_fp8(v[4 * g], v[4 * g + 1], v[4 * g + 2], v[4 * g + 3]);
    const int off = blk < 2 ? rb * 4096 + (g >> 1) * 1024 + (blk * 32 + r32) * 16 + 8 * (g & 1) + 4 * hi : rb * 4096 + 2048 + ((g >> 1) * 32 + r32) * 16 + 8 * (g & 1) + 4 * hi;
    *(unsigned*)(img + off) = w; }
}
__device__ __forceinline__ void store_img8_v(uchar* img, const f32x16& v, int rb, int db, int r32, int hi) {
#pragma unroll
  for (int g = 0; g < 4; ++g) *(unsigned*)(img + db * 2048 + rb * 1024 + (hi * 32 + r32) * 16 + 4 * g) = pk4_fp8(v[4 * g], v[4 * g + 1], v[4 * g + 2], v[4 * g + 3]);
}
__device__ __forceinline__ void lds_fadd(LAS float* p, float v) { __hip_atomic_fetch_add(p, v, __ATOMIC_RELAXED, __HIP_MEMORY_SCOPE_WORKGROUP); }

__device__ __forceinline__ void phase1_tile(const KP& P, LAS uchar* lds, const int tile) {
  int lane_ = mk_lane(); asm volatile("" : "+v"(lane_)); const int lane = lane_ & 63, wave = P.wave, tid = wave * 64 + lane, r32 = lane & 31, hi = lane >> 5;
  uchar* ws = P.ws;
  const int t0 = tile * 64, b = t0 / SEQ, pos0 = t0 % SEQ, tb = pos0 >> 6;
  const float* __restrict__ x = P.in[0]; const float* __restrict__ mod = (const float*)(ws + WS_MOD) + b * (NMOD * DM); const float* __restrict__ g1 = P.in[4];
  LAS float* ssq = (LAS float*)(lds + LDS_MISC + 64);
  LAS uchar* krt = lds + LDS_MISC + 1024;
  const float2* tabA = (const float2*)(ws + WS_TABA); const float2* tabB = (const float2*)(ws + WS_TABB);
  if (tid < 128) ssq[tid] = 0.f;
  {
    f32x4 av[4], sv[4];
#pragma unroll
    for (int i = 0; i < 4; ++i) { const int k = 4 * (lane + 64 * i); const f32x4 g = *(const f32x4*)(g1 + k), sc = *(const f32x4*)(mod + DM + k); av[i] = g * (sc + 1.0f); sv[i] = *(const f32x4*)(mod + k); }
#pragma unroll
    for (int hf = 0; hf < 2; ++hf) {
      f32x4 xv[4][4];
#pragma unroll
      for (int rr = 0; rr < 4; ++rr)
#pragma unroll
        for (int i = 0; i < 4; ++i) xv[rr][i] = *(const f32x4*)(x + (size_t)(t0 + wave * 8 + hf * 4 + rr) * DM + 4 * (lane + 64 * i));
#pragma unroll
      for (int rr = 0; rr < 4; ++rr) {
        const int row = wave * 8 + hf * 4 + rr; float ss = 0.f;
#pragma unroll
        for (int i = 0; i < 4; ++i) ss += xv[rr][i][0] * xv[rr][i][0] + xv[rr][i][1] * xv[rr][i][1] + xv[rr][i][2] * xv[rr][i][2] + xv[rr][i][3] * xv[rr][i][3];
        ss = wave_sum(ss); const float rs = rsqrtf(ss * (1.0f / DM) + EPS);
#pragma unroll
        for (int i = 0; i < 4; ++i) { const f32x4 v = xv[rr][i] * rs * av[i] + sv[i];
          *(LAS unsigned*)(lds + a_off(row, 4 * (lane + 64 * i), 1024)) = pk4_fp8(v[0], v[1], v[2], v[3]); }
      }
    }
  }
  __syncthreads();
  const l64x2* WIN = (const l64x2*)(ws + WS_WIN);
#define WSLOT(slot) (WIN + (size_t)((slot) * 32) * 64 + lane)
  f32x16 acc[4][2]; acc_zero<4>(acc);
  f32x16 acc2[1][2]; acc_zero<1>(acc2);
  if (wave < 4) {
    { const l64x2* wp[4] = {WSLOT(4 * wave), WSLOT(4 * wave + 1), WSLOT(4 * wave + 2), WSLOT(4 * wave + 3)}; gemm_slots_f8<4, 4, 32, true, 1, 0x3210>(acc, lds, 1024, wp, lane); }
    if (wave < 3) { const l64x2* wp[1] = {WSLOT(wave == 0 ? 34 : 27 + wave)}; gemm_slots_f8<1, 1, 32, true, 2, 0x0>(acc2, lds, 1024, wp, lane); }
  } else if (wave == 4) {
    { const l64x2* wp[4] = {WSLOT(16), WSLOT(17), WSLOT(18), WSLOT(19)}; gemm_slots_f8<4, 4, 32, true, 1, 0x3210>(acc, lds, 1024, wp, lane); }
    { const l64x2* wp[2] = {WSLOT(33), WSLOT(42)}; gemm_slots_f8<2, 1, 32, true, 1, 0x00>(acc2, lds, 1024, wp, lane); }
  } else if (wave == 7) {
    { const l64x2* wp[4] = {WSLOT(30), WSLOT(39), WSLOT(31), WSLOT(40)}; gemm_slots_f8<4, 4, 32, true, 1, 0x1100>(acc, lds, 1024, wp, lane); }
    { const l64x2* wp[2] = {WSLOT(32), WSLOT(41)}; gemm_slots_f8<2, 4, 32, true, 1, 0x22>(acc, lds, 1024, wp, lane); }
  } else {
    const int kv = wave - 5;
    { const l64x2* wp[4] = {WSLOT(20 + 2 * kv), WSLOT(35 + 2 * kv), WSLOT(21 + 2 * kv), WSLOT(36 + 2 * kv)}; gemm_slots_f8<4, 4, 32, false, 1, 0x1100>(acc, lds, 1024, wp, lane); }
    { const l64x2* wp[2] = {WSLOT(24 + 2 * kv), WSLOT(25 + 2 * kv)}; gemm_slots_f8<2, 4, 32, true, 1, 0x32>(acc, lds, 1024, wp, lane); }
  }
#undef WSLOT
  int tid2_ = mk_lane(); asm volatile("" : "+v"(tid2_)); const int lane2 = tid2_ & 63;
#define lane lane2
  const int r32e = lane2 & 31, hie = lane2 >> 5;
#define r32 r32e
#define hi hie
  if (wave < 4) {
#pragma unroll
    for (int p = 0; p < 2; ++p) { uchar* img = ws + WS_QA + ((size_t)(b * 8 + 2 * wave + p) * 64 + tb) * 8192;
#pragma unroll
      for (int rb = 0; rb < 2; ++rb) { const int rr = 32 * rb + r32; f32x16 ya, yb; rope64(acc[2 * p][rb], acc[2 * p + 1][rb], ya, yb, tabA + (size_t)(pos0 + rr) * 32, hi, QSCALE_A * WIN_DESCALE);
        store_img_qk(img, ya, rr, 0, 4, hi); store_img_qk(img, yb, rr, 32, 4, hi); } }
    if (wave == 0) {
#pragma unroll
      for (int rb = 0; rb < 2; ++rb) { const int rr = 32 * rb + r32; f32x16 y; rope32(acc2[0][rb], y, tabB + (size_t)(pos0 + rr) * 16, hi, WIN_DESCALE);
#pragma unroll
        for (int g = 0; g < 4; ++g) { u32x2 w; w.x = pk2(y[4 * g], y[4 * g + 1]); w.y = pk2(y[4 * g + 2], y[4 * g + 3]); *(LAS u32x2*)(krt + rr * 64 + (8 * g + 4 * hi) * 2) = w; } }
    }
  } else if (wave == 4) {
#pragma unroll
    for (int p = 0; p < 2; ++p) { uchar* img = ws + WS_KVA + ((size_t)(b * 2 + p) * 64 + tb) * 16384;
#pragma unroll
      for (int rb = 0; rb < 2; ++rb) { const int rr = 32 * rb + r32; f32x16 ya, yb; rope64(acc[2 * p][rb], acc[2 * p + 1][rb], ya, yb, tabA + (size_t)(pos0 + rr) * 32, hi, WIN_DESCALE);
        store_img_qk(img, ya, rr, 0, 4, hi); store_img_qk(img, yb, rr, 32, 4, hi); } }
  } else if (wave == 5 || wave == 6) {
    uchar* img = ws + WS_KVA + ((size_t)(b * 2 + (wave - 5)) * 64 + tb) * 16384 + 8192;
#pragma unroll
    for (int i = 0; i < 2; ++i)
#pragma unroll
      for (int rb = 0; rb < 2; ++rb) { const f32x16 y = acc[i][rb] * WIN_DESCALE; store_img_v(img, y, rb, 32 * i + r32, hi); }
  }
  __syncthreads();
  if (wave != 0 && wave != 3) {
#pragma unroll
    for (int rb = 0; rb < 2; ++rb) { const int rr = 32 * rb + r32; float sq = 0.f, skv = 0.f;
      if (wave == 5 || wave == 6) { sq += write_c_tile(lds, 512, acc[2][rb], rr, 64 * (wave - 5), hi); sq += write_c_tile(lds, 512, acc[3][rb], rr, 64 * (wave - 5) + 32, hi); }
      else if (wave == 1 || wave == 2) sq += write_c_tile(lds, 512, acc2[0][rb], rr, 96 + 32 * wave, hi);
      else if (wave == 7) { skv += write_c_tile(lds + 32768, 256, acc[0][rb], rr, 0, hi); skv += write_c_tile(lds + 32768, 256, acc[1][rb], rr, 32, hi); skv += write_c_tile(lds + 32768, 256, acc[2][rb], rr, 64, hi); }
      else skv += write_c_tile(lds + 32768, 256, acc2[0][rb], rr, 96, hi);
      if (wave == 4 || wave == 7) lds_fadd(&ssq[64 + rr], skv); else lds_fadd(&ssq[rr], sq); }
  }
  __syncthreads();
  const int head = wave;
  uchar* imgQ = ws + WS_QB + ((size_t)(b * 8 + head) * 64 + tb) * 8192;
  uchar* imgKV = ws + WS_KVB + ((size_t)(b * 8 + head) * 64 + tb) * 12288;
  {
    f32x16 aq[3][2]; acc_zero<3>(aq);
    const bf16x8* wp[3];
#pragma unroll
    for (int i = 0; i < 3; ++i) wp[i] = (const bf16x8*)(ws + WS_WUQ) + (size_t)((3 * head + i) * 12) * 64 + lane;
    gemm_tile<3, 12, true>(aq, lds, 512, wp, lane);
#pragma unroll
    for (int rb = 0; rb < 2; ++rb) { const int rr = 32 * rb + r32; const float sc = rsqrtf(ssq[rr] * (1.0f / 192.0f) + EPS) * (8.0f * QSCALE_B);
      f32x16 y0 = aq[0][rb] * sc, y1 = aq[1][rb] * sc, y2; rope32(aq[2][rb], y2, tabB + (size_t)(pos0 + rr) * 16, hi, sc);
      store_img8_qk(imgQ, y0, rb, r32, 0, hi); store_img8_qk(imgQ, y1, rb, r32, 1, hi); store_img8_qk(imgQ, y2, rb, r32, 2, hi);
      *(u32x4*)(imgQ + rb * 4096 + 3072 + lane * 16) = u32x4{0u, 0u, 0u, 0u}; }
  }
  {
    f32x16 ak[2][2]; acc_zero<2>(ak);
    const bf16x8* wp[2];
#pragma unroll
    for (int i = 0; i < 2; ++i) wp[i] = (const bf16x8*)(ws + WS_WUKV) + (size_t)((4 * head + i) * 8) * 64 + lane;
    gemm_tile<2, 8, true>(ak, lds + 32768, 256, wp, lane);
#pragma unroll
    for (int rb = 0; rb < 2; ++rb) { const int rr = 32 * rb + r32; const float sc = rsqrtf(ssq[64 + rr] * (1.0f / 128.0f) + EPS);
      f32x16 y0 = ak[0][rb] * sc, y1 = ak[1][rb] * sc; store_img8_qk(imgKV, y0, rb, r32, 0, hi); store_img8_qk(imgKV, y1, rb, r32, 1, hi); }
#pragma unroll
    for (int rb = 0; rb < 2; ++rb) {
      const u32x4 c0 = *(const LAS u32x4*)(krt + (32 * rb + r32) * 64 + hi * 32), c1 = *(const LAS u32x4*)(krt + (32 * rb + r32) * 64 + hi * 32 + 16);
      u32x4 w;
      w.x = pk4_fp8(__uint_as_float(c0.x << 16), __uint_as_float(c0.x & 0xffff0000u), __uint_as_float(c0.y << 16), __uint_as_float(c0.y & 0xffff0000u));
      w.y = pk4_fp8(__uint_as_float(c0.z << 16), __uint_as_float(c0.z & 0xffff0000u), __uint_as_float(c0.w << 16), __uint_as_float(c0.w & 0xffff0000u));
      w.z = pk4_fp8(__uint_as_float(c1.x << 16), __uint_as_float(c1.x & 0xffff0000u), __uint_as_float(c1.y << 16), __uint_as_float(c1.y & 0xffff0000u));
      w.w = pk4_fp8(__uint_as_float(c1.z << 16), __uint_as_float(c1.z & 0xffff0000u), __uint_as_float(c1.w << 16), __uint_as_float(c1.w & 0xffff0000u));
      *(u32x4*)(imgKV + rb * 4096 + 2048 + lane * 16) = w;
      *(u32x4*)(imgKV + rb * 4096 + 3072 + lane * 16) = u32x4{hi ? 0u : 0x00003838u, 0u, 0u, 0u}; }
  }
  {
    f32x16 avv[2][2]; acc_zero<2>(avv);
    const bf16x8* wp[2];
#pragma unroll
    for (int i = 0; i < 2; ++i) wp[i] = (const bf16x8*)(ws + WS_WUKV) + (size_t)((4 * head + 2 + i) * 8) * 64 + lane;
    gemm_tile<2, 8, false>(avv, lds + 32768, 256, wp, lane);
#pragma unroll
    for (int rb = 0; rb < 2; ++rb) { f32x16 sc;
#pragma unroll
      for (int reg = 0; reg < 16; ++reg) sc[reg] = rsqrtf(ssq[64 + 32 * rb + crow(reg, hi)] * (1.0f / 128.0f) + EPS);
#pragma unroll
      for (int i = 0; i < 2; ++i) { f32x16 y = avv[i][rb] * sc; store_img8_v(imgKV + 8192, y, rb, i, r32, hi); } }
  }
  __syncthreads();
#undef lane
#undef r32
#undef hi
}
__device__ __forceinline__ float tile_max(const f32x16& p0, const f32x16& p1) {
  float t = __builtin_amdgcn_fmed3f(p0[0], p1[0], __builtin_inff());
  asm("v_max3_f32 %0, %0, %1, %2\n\tv_max3_f32 %0, %0, %3, %4\n\tv_max3_f32 %0, %0, %5, %6\n\tv_max3_f32 %0, %0, %7, %8\n\t"
      "v_max3_f32 %0, %0, %9, %10\n\tv_max3_f32 %0, %0, %11, %12\n\tv_max3_f32 %0, %0, %13, %14\n\tv_max3_f32 %0, %0, %15, %16"
      : "+v"(t) : "v"(p0[1]), "v"(p1[1]), "v"(p0[2]), "v"(p1[2]), "v"(p0[3]), "v"(p1[3]), "v"(p0[4]), "v"(p1[4]), "v"(p0[5]), "v"(p1[5]), "v"(p0[6]), "v"(p1[6]), "v"(p0[7]), "v"(p1[7]), "v"(p0[8]), "v"(p1[8]));
  asm("v_max3_f32 %0, %0, %1, %2\n\tv_max3_f32 %0, %0, %3, %4\n\tv_max3_f32 %0, %0, %5, %6\n\tv_max3_f32 %0, %0, %7, %8\n\t"
      "v_max3_f32 %0, %0, %9, %10\n\tv_max3_f32 %0, %0, %11, %12\n\tv_max3_f32 %0, %0, %13, %14"
      : "+v"(t) : "v"(p0[9]), "v"(p1[9]), "v"(p0[10]), "v"(p1[10]), "v"(p0[11]), "v"(p1[11]), "v"(p0[12]), "v"(p1[12]), "v"(p0[13]), "v"(p1[13]), "v"(p0[14]), "v"(p1[14]), "v"(p0[15]), "v"(p1[15]));
  return t;
}
template <bool FIRST_POSSIBLE>
__device__ __forceinline__ float softmax_tile(f32x16& p0, f32x16& p1, f32x16& negm, float& m, float& l, f32x16& o0, f32x16& o1, bool first, bf16x8 (&pb)[2][2]) {
  float applied = 0.f;
  float tmax = half_swap_max(tile_max(p0, p1));
  const bool fst = FIRST_POSSIBLE && first;
  const float dm = fst ? tmax : fmaxf(tmax, 0.f);
  if (fst || __any(dm > THR2)) {
    const float alpha = fst ? 1.0f : __builtin_amdgcn_exp2f(-dm);
    m += dm; l *= alpha; applied = dm;
#pragma unroll
    for (int r = 0; r < 16; ++r) { o0[r] *= alpha; o1[r] *= alpha; p0[r] -= dm; p1[r] -= dm; negm[r] = -m; }
  }
  float s = 0.f;
#pragma unroll
  for (int r = 0; r < 16; ++r) { p0[r] = __builtin_amdgcn_exp2f(p0[r]); p1[r] = __builtin_amdgcn_exp2f(p1[r]); s += p0[r] + p1[r]; }
  l += s;
#pragma unroll
  for (int ks = 0; ks < 2; ++ks) {
    u32x4 w0, w1;
    w0.x = pk2(p0[8 * ks + 0], p0[8 * ks + 1]); w0.y = pk2(p0[8 * ks + 2], p0[8 * ks + 3]); w0.z = pk2(p0[8 * ks + 4], p0[8 * ks + 5]); w0.w = pk2(p0[8 * ks + 6], p0[8 * ks + 7]);
    w1.x = pk2(p1[8 * ks + 0], p1[8 * ks + 1]); w1.y = pk2(p1[8 * ks + 2], p1[8 * ks + 3]); w1.z = pk2(p1[8 * ks + 4], p1[8 * ks + 5]); w1.w = pk2(p1[8 * ks + 6], p1[8 * ks + 7]);
    pb[0][ks] = *reinterpret_cast<bf16x8*>(&w0); pb[1][ks] = *reinterpret_cast<bf16x8*>(&w1);
  }
  return applied;
}
__device__ __forceinline__ void pv_tile(const LAS uchar* vimg, const bf16x8 (&pb)[2][2], f32x16& o0, f32x16& o1, int lane) {
#pragma unroll
  for (int kb = 0; kb < 2; ++kb)
#pragma unroll
    for (int ks = 0; ks < 2; ++ks) {
      const bf16x8 v0 = *(const LAS bf16x8*)(vimg + ((((kb * 2 + 0) * 2 + ks) * 64) + lane) * 16);
      const bf16x8 v1 = *(const LAS bf16x8*)(vimg + ((((kb * 2 + 1) * 2 + ks) * 64) + lane) * 16);
      o0 = mfma(v0, pb[kb][ks], o0); o1 = mfma(v1, pb[kb][ks], o1);
    }
}
__device__ __forceinline__ void store_o(bf16_t* __restrict__ orow, f32x16& o0, f32x16& o1, float l, int hi) {
  const float inv = 1.0f / half_swap_sum(l);
#pragma unroll
  for (int g = 0; g < 4; ++g) {
    u32x2 w; w.x = pk2(o0[4 * g] * inv, o0[4 * g + 1] * inv); w.y = pk2(o0[4 * g + 2] * inv, o0[4 * g + 3] * inv); *(u32x2*)(orow + 8 * g + 4 * hi) = w;
    u32x2 z; z.x = pk2(o1[4 * g] * inv, o1[4 * g + 1] * inv); z.y = pk2(o1[4 * g + 2] * inv, o1[4 * g + 3] * inv); *(u32x2*)(orow + 32 + 8 * g + 4 * hi) = z;
  }
}

__device__ __forceinline__ void store_o_l(bf16_t* __restrict__ orow, f32x16& o0, f32x16& o1, float ltot, int hi) {
  const float inv = 1.0f / ltot;
#pragma unroll
  for (int g = 0; g < 4; ++g) {
    u32x2 w; w.x = pk2(o0[4 * g] * inv, o0[4 * g + 1] * inv); w.y = pk2(o0[4 * g + 2] * inv, o0[4 * g + 3] * inv); *(u32x2*)(orow + 8 * g + 4 * hi) = w;
    u32x2 z; z.x = pk2(o1[4 * g] * inv, o1[4 * g + 1] * inv); z.y = pk2(o1[4 * g + 2] * inv, o1[4 * g + 3] * inv); *(u32x2*)(orow + 32 + 8 * g + 4 * hi) = z;
  }
}
constexpr int SWA_LDS = 49152;
__device__ __forceinline__ void swa_unit(const KP& P, LAS uchar* lds_all, int u, bool prefetched) {
  LAS uchar* lds = lds_all + SWA_LDS;
  int lane_ = mk_lane(); asm volatile("" : "+v"(lane_)); const int lane = lane_ & 63, wave = P.wave, tid = wave * 64 + lane, r32 = lane & 31, hi = lane >> 5;
  uchar* ws = P.ws;
  const int n = u & 31, kvh = (u >> 5) & 1, b = u >> 6;
  const uchar* kvimg = ws + WS_KVA + (size_t)(b * 2 + kvh) * 64 * 16384;
  if (!prefetched) {
#pragma unroll 1
    for (int jt = 0; jt < 6; ++jt) { const int gt = 2 * n - 2 + jt; if (gt < 0 || gt >= 64) continue;
      const u32x4* src = (const u32x4*)(kvimg + (size_t)gt * 16384); LAS u32x4* dst = (LAS u32x4*)(lds + jt * 16384);
      const u32x4 v0 = src[tid], v1 = src[tid + 512]; dst[tid] = v0; dst[tid + 512] = v1; }
  }
  __syncthreads();
  const int rbq = wave & 3, jlo = rbq >> 1;
  bf16_t* O = (bf16_t*)(ws + WS_O);
#pragma unroll 1
  for (int hh = 0; hh < 2; ++hh) {
    const int head = kvh * 4 + 2 * (wave >> 2) + hh;
    const uchar* qimg = ws + WS_QA + ((size_t)(b * 8 + head) * 64 + 2 * n + (rbq >> 1)) * 8192;
    bf16x8 qf[4];
#pragma unroll
    for (int s = 0; s < 4; ++s) qf[s] = *(const bf16x8*)(qimg + ((((rbq & 1) * 4 + s) * 64) + lane) * 16);
    const float sink2 = P.in[10][head] * LOG2E;
    float m = sink2, l = hi ? 0.f : 1.f; f32x16 negm, o0 = {}, o1 = {};
#pragma unroll
    for (int r = 0; r < 16; ++r) negm[r] = -sink2;
#pragma unroll 1
    for (int jt = jlo; jt < jlo + 5; ++jt) { const int gt = 2 * n - 2 + jt; if (gt < 0 || gt >= 64) continue;
      const LAS uchar* kimg = lds + jt * 16384;
      f32x16 p0 = negm, p1 = negm;
#pragma unroll
      for (int s = 0; s < 4; ++s) { const bf16x8 k0 = *(const LAS bf16x8*)(kimg + (((0 * 4 + s) * 64) + lane) * 16), k1 = *(const LAS bf16x8*)(kimg + (((1 * 4 + s) * 64) + lane) * 16);
        p0 = mfma(k0, qf[s], p0); p1 = mfma(k1, qf[s], p1); }
      const int base = 64 * jt - 32 * rbq - r32;
#pragma unroll
      for (int r = 0; r < 16; ++r) { const int d0 = base + crow(r, hi);
        p0[r] = ((unsigned)d0 <= 256u) ? p0[r] : -1e30f; p1[r] = ((unsigned)(d0 + 32) <= 256u) ? p1[r] : -1e30f; }
      bf16x8 pb[2][2];
      (void)softmax_tile<false>(p0, p1, negm, m, l, o0, o1, false, pb);
      pv_tile(kimg + 8192, pb, o0, o1, lane);
    }
    store_o(O + (size_t)(b * SEQ + n * 128 + 32 * rbq + r32) * DM + head * 64, o0, o1, l, hi);
  }
  __syncthreads();
}

#define MK_LDS_RD(dst, vaddr, imm) asm volatile("ds_read_b128 %0, %1 offset:%2" : "=v"(dst) : "v"(vaddr), "i"(imm))
template <int N> __device__ __forceinline__ void lgkm_wait() { asm volatile("s_waitcnt lgkmcnt(%0)" :: "i"(N) : "memory"); __builtin_amdgcn_sched_barrier(0); }
__device__ __forceinline__ void pv_regs(const bf16x8 (&vf)[8], const bf16x8 (&pb)[2][2], f32x16& o0, f32x16& o1) {
#pragma unroll
  for (int kb = 0; kb < 2; ++kb)
#pragma unroll
    for (int ks = 0; ks < 2; ++ks) { o0 = mfma(vf[(kb * 2 + 0) * 2 + ks], pb[kb][ks], o0); o1 = mfma(vf[(kb * 2 + 1) * 2 + ks], pb[kb][ks], o1); }
}
__device__ __forceinline__ void mla_dma_step(const uchar* kvimg, LAS uchar* lds, int t, int wave, int lane) {
  const uchar* src = kvimg + (size_t)t * 24576 + wave * 3072 + lane * 16;
  LAS uchar* dst = lds + (t & 1) * 24576 + wave * 3072;
#pragma unroll
  for (int i = 0; i < 3; ++i) __builtin_amdgcn_global_load_lds((const unsigned*)(src + i * 1024), (LAS unsigned*)(dst + i * 1024), 16, 0, 0);
}
template <bool FIRST_POSSIBLE>
__device__ __forceinline__ float softmax_tile8(f32x16& p0, f32x16& p1, float& pad, int& qpad, f32x16& lacc, f32x16& o0, f32x16& o1, bool first, int hi, i32x4& pb0, i32x4& pb1) {
  float applied = 0.f;
  float tmax = half_swap_max(tile_max(p0, p1));
  const bool fst = FIRST_POSSIBLE && first;
  if (fst || __any(tmax > 120.5f)) {
    const float want = fst ? tmax - 96.5f : fmaxf(tmax - 96.5f, 0.f);
    const float nt = pad - want;
    const int wa = __builtin_amdgcn_cvt_pk_fp8_f32(nt, 0.f, 0, false); const float fa = __builtin_amdgcn_cvt_f32_fp8(wa, 0);
    const int wb = __builtin_amdgcn_cvt_pk_fp8_f32(nt - fa, 0.f, 0, false); const float fb = __builtin_amdgcn_cvt_f32_fp8(wb, 0);
    const float pnew = fa + fb, dt = pad - pnew;
    const float alpha = fst ? 1.0f : __builtin_amdgcn_exp2f(-0.125f * dt);
    pad = pnew; applied = dt; qpad = hi ? 0 : ((wa & 0xff) | ((wb & 0xff) << 8));
#pragma unroll
    for (int r = 0; r < 16; ++r) { o0[r] *= alpha; o1[r] *= alpha; lacc[r] *= alpha; p0[r] -= dt; p1[r] -= dt; }
  }
#define MK_P8(P, R) __builtin_amdgcn_cvt_pk_u8_f32(P[(R) + 3], 3, __builtin_amdgcn_cvt_pk_u8_f32(P[(R) + 2], 2, __builtin_amdgcn_cvt_pk_u8_f32(P[(R) + 1], 1, __builtin_amdgcn_cvt_pk_u8_f32(P[R], 0, 0u))))
  pb0.x = (int)MK_P8(p0, 0); pb0.y = (int)MK_P8(p0, 4); pb0.z = (int)MK_P8(p0, 8); pb0.w = (int)MK_P8(p0, 12);
  pb1.x = (int)MK_P8(p1, 0); pb1.y = (int)MK_P8(p1, 4); pb1.z = (int)MK_P8(p1, 8); pb1.w = (int)MK_P8(p1, 12);
#undef MK_P8
  return applied;
}
constexpr int N_PACK_JOBS = 3 * 8192;
struct PackJob { const float* p; int ldw; u32x4* dst; float scale; };
__device__ __forceinline__ PackJob pack_job(const KP& P, int f, int lane) {
  const int which = f >> 13, ff = f & 8191, r = lane & 31, h = lane >> 5, e = ff >> 8; PackJob j;
  if (which < 2) { const int nb = (ff >> 5) & 7, s = ff & 31; j.ldw = 256; j.scale = WGU_SCALE;
    j.p = P.in[19 + which] + (size_t)e * DM * 256 + (size_t)(32 * s + 16 * h) * 256 + 32 * nb + r; j.dst = (u32x4*)(P.ws + (which ? WS_WU : WS_WG)) + (size_t)ff * 64 + lane; }
  else { const int nb = (ff >> 3) & 31, s = ff & 7; j.ldw = DM; j.scale = WD_SCALE;
    j.p = P.in[21] + (size_t)e * 256 * DM + (size_t)(32 * s + 16 * h) * DM + 32 * nb + r; j.dst = (u32x4*)(P.ws + WS_WD) + (size_t)ff * 64 + lane; }
  return j;
}
__device__ __forceinline__ u32x4 pack_cvt(const float (&v)[16], float sc) {
  u32x4 w; w.x = pk4_fp8(v[0] * sc, v[1] * sc, v[2] * sc, v[3] * sc); w.y = pk4_fp8(v[4] * sc, v[5] * sc, v[6] * sc, v[7] * sc);
  w.z = pk4_fp8(v[8] * sc, v[9] * sc, v[10] * sc, v[11] * sc); w.w = pk4_fp8(v[12] * sc, v[13] * sc, v[14] * sc, v[15] * sc); return w;
}
__device__ __forceinline__ void mla_unit(const KP& P, LAS uchar* lds, int b, int head, int qblk, int& pk_k, int swa_u) {
  int lane_ = mk_lane(); asm volatile("" : "+v"(lane_)); const int lane = lane_ & 63, wave = P.wave, r32 = lane & 31, hi = lane >> 5;
  uchar* ws = P.ws;
  const uchar* kvimg = ws + WS_KVB + (size_t)(b * 8 + head) * 64 * 12288;
  const uchar* qimg = ws + WS_QB + ((size_t)(b * 8 + head) * 64 + qblk * 4 + (wave >> 1)) * 8192 + (wave & 1) * 4096 + lane * 16;
  const int gw = blockIdx.x * NWAVE + wave, NGW = gridDim.x * NWAVE;
  const i32x4 q00 = *(const i32x4*)(qimg), q01 = *(const i32x4*)(qimg + 1024), q10 = *(const i32x4*)(qimg + 2048);
  float pad = 56.5f; int qpad = hi ? 0 : 0x3066;
  f32x16 o0 = {}, o1 = {}, lacc = {};
  const i32x4 ones = {0x38383838, 0x38383838, 0x38383838, 0x38383838};
  mla_dma_step(kvimg, lds, 0, wave, lane);
#pragma unroll 1
  for (int t = 0; t < 32; ++t) {
    asm volatile("s_waitcnt vmcnt(0)" ::: "memory");
    __syncthreads();
    if (t + 1 < 32 && !(P.variant & 4)) mla_dma_step(kvimg, lds, t + 1, wave, lane);
    if (P.variant & 8) continue;
    u32x4 bandv = {}; int band_off = -1;
    if (swa_u >= 0 && t >= 20) { const int c = (wave * 64 + lane) + 512 * (t - 20), jt = c >> 10, gt = 2 * (swa_u & 31) - 2 + jt;
      if (gt >= 0 && gt < 64) { band_off = c * 16; bandv = *(const u32x4*)(ws + WS_KVA + ((size_t)((swa_u >> 6) * 2 + ((swa_u >> 5) & 1)) * 64 + gt) * 16384 + (c & 1023) * 16); } }
    const int pf = gw + pk_k * NGW; const bool do_pack = pf < N_PACK_JOBS;
    float pv[16]; u32x4* pdst = nullptr; float psc = 0.f;
    if (do_pack) { const PackJob j = pack_job(P, pf, lane); pdst = j.dst; psc = j.scale;
#pragma unroll
      for (int q = 0; q < 16; ++q) pv[q] = j.p[(size_t)q * j.ldw]; }
    f32x16 a0, a1, b0, b1; i32x4 pb0, pb1;
    { const unsigned va = (unsigned)(unsigned long)(lds + (t & 1) * 24576) + lane * 16;
#define MK_KOFF(j) (((j) >> 2) * 12288 + (((j) >> 1) & 1) * 4096 + ((j) & 1) * 2048)
      i32x4 kf[4][2];
#define MK_KRD(j) { MK_LDS_RD(kf[(j) & 3][0], va, MK_KOFF(j)); MK_LDS_RD(kf[(j) & 3][1], va, MK_KOFF(j) + 1024); }
      MK_KRD(0) MK_KRD(1) MK_KRD(2) MK_KRD(3)
      const i32x4 q11 = {qpad, 0, 0, 0};
#define MK_QK_STEP(j, ACC, NW) { lgkm_wait<NW>(); ACC = ((j) & 1) ? mfma_mx(kf[(j) & 3][0], kf[(j) & 3][1], q10, q11, ACC) : mfma_mx(kf[(j) & 3][0], kf[(j) & 3][1], q00, q01, f32x16{}); if ((j) + 4 < 8) MK_KRD(((j) + 4) & 7) }
      MK_QK_STEP(0, a0, 6) MK_QK_STEP(1, a0, 6) MK_QK_STEP(2, a1, 6) MK_QK_STEP(3, a1, 6) MK_QK_STEP(4, b0, 6) MK_QK_STEP(5, b0, 4) MK_QK_STEP(6, b1, 2) MK_QK_STEP(7, b1, 0)
#undef MK_QK_STEP
#undef MK_KRD
#undef MK_KOFF
      i32x4 vf[4];
#define MK_VRD(tile) { MK_LDS_RD(vf[0], va, (tile) * 12288 + 8192); MK_LDS_RD(vf[1], va, (tile) * 12288 + 8192 + 1024); MK_LDS_RD(vf[2], va, (tile) * 12288 + 8192 + 2048); MK_LDS_RD(vf[3], va, (tile) * 12288 + 8192 + 3072); }
      MK_VRD(0)
      const float dA = softmax_tile8<true>(a0, a1, pad, qpad, lacc, o0, o1, t == 0, hi, pb0, pb1);
      lacc = mfma_mx(ones, ones, pb0, pb1, lacc);
      lgkm_wait<0>();
      o0 = mfma_mx(vf[0], vf[1], pb0, pb1, o0); o1 = mfma_mx(vf[2], vf[3], pb0, pb1, o1);
      MK_VRD(1)
#undef MK_VRD
      if (__any(dA != 0.f)) {
#pragma unroll
        for (int r = 0; r < 16; ++r) { b0[r] -= dA; b1[r] -= dA; }
      }
      (void)softmax_tile8<false>(b0, b1, pad, qpad, lacc, o0, o1, false, hi, pb0, pb1);
      lacc = mfma_mx(ones, ones, pb0, pb1, lacc);
      lgkm_wait<0>();
      o0 = mfma_mx(vf[0], vf[1], pb0, pb1, o0); o1 = mfma_mx(vf[2], vf[3], pb0, pb1, o1);
    }
    if (do_pack) { *pdst = pack_cvt(pv, psc); ++pk_k; }
    if (band_off >= 0) *(LAS u32x4*)(lds + SWA_LDS + band_off) = bandv;
  }
  if (!(P.variant & 12)) store_o_l((bf16_t*)(ws + WS_O) + (size_t)(b * SEQ + qblk * 256 + 32 * wave + r32) * DM + 512 + head * 64, o0, o1, lacc[0], hi);
  __syncthreads();
}
__device__ __forceinline__ void phase2(const KP& P, LAS uchar* lds) {
  const int bid = blockIdx.x;
  int pk_k = 0;
  const bool pref = gridDim.x == 256 && !(P.variant & 3);
  if (!(P.variant & 2)) for (int i = bid; i < 512; i += gridDim.x) {
    const int rr = i >> 8, ii = i & 255, xcd = ii & 7, local = ii >> 3, pair = xcd * 4 + rr * 2 + (local >> 4), qblk = local & 15;
    mla_unit(P, lds, pair >> 3, pair & 7, qblk, pk_k, (pref && i >= 256) ? bid : -1);
  }
  if (!(P.variant & 1)) for (int u = bid; u < 256; u += gridDim.x) swa_unit(P, lds, u, pref);
  { const int lane = mk_lane(), wave = P.wave, gw = bid * NWAVE + wave, NGW = gridDim.x * NWAVE;
    for (int f = gw + pk_k * NGW; f < N_PACK_JOBS; f += NGW) { const PackJob j = pack_job(P, f, lane); float v[16];
#pragma unroll
      for (int q = 0; q < 16; ++q) v[q] = j.p[(size_t)q * j.ldw];
      *j.dst = pack_cvt(v, j.scale); } }
}
__device__ __forceinline__ void phase3_tile(const KP& P, LAS uchar* lds, const int tile) {
  int lane_ = mk_lane(); asm volatile("" : "+v"(lane_)); const int lane = lane_ & 63, wave = P.wave, tid = wave * 64 + lane, r32 = lane & 31, hi = lane >> 5;
  uchar* ws = P.ws;
  const int t0 = tile * 64, b = t0 / SEQ;
  const float* __restrict__ x = P.in[0]; const float* __restrict__ mod = (const float*)(ws + WS_MOD) + b * (NMOD * DM);
  LAS float* ssq = (LAS float*)(lds + LDS_MISC + 64);
  LAS int* selE = (LAS int*)(lds + LDS_MISC + 1024);
  LAS float* selW = (LAS float*)(lds + LDS_MISC + 1536);
  LAS int* selP = (LAS int*)(lds + LDS_MISC + 2048);
  LAS int* cntl = (LAS int*)(lds + LDS_MISC + 2560);
  LAS int* basel = (LAS int*)(lds + LDS_MISC + 2688);
  LAS float* logit = (LAS float*)(lds + LDS_MISC + 8192);
  if (tid < 64) ssq[tid] = 0.f;
  if (tid < 32) cntl[tid] = 0;
  {
    const bf16_t* O = (const bf16_t*)(ws + WS_O);
    float ga[8], gb[8];
#pragma unroll
    for (int j = 0; j < 8; ++j) { ga[j] = P.in[11][8 * lane + j]; gb[j] = P.in[12][8 * lane + j]; }
#pragma unroll
    for (int hf = 0; hf < 2; ++hf) {
      u32x4 va[4], vb[4];
#pragma unroll
      for (int rr = 0; rr < 4; ++rr) { const u32x4* src = (const u32x4*)(O + (size_t)(t0 + wave * 8 + hf * 4 + rr) * DM); va[rr] = src[lane]; vb[rr] = src[lane + 64]; }
#pragma unroll
      for (int rr = 0; rr < 4; ++rr) {
        const int row = wave * 8 + hf * 4 + rr; float fa[8], fb[8], sa = 0.f, sb = 0.f;
#pragma unroll
        for (int q = 0; q < 4; ++q) { fa[2 * q] = __uint_as_float(va[rr][q] << 16); fa[2 * q + 1] = __uint_as_float(va[rr][q] & 0xffff0000u);
          fb[2 * q] = __uint_as_float(vb[rr][q] << 16); fb[2 * q + 1] = __uint_as_float(vb[rr][q] & 0xffff0000u); }
#pragma unroll
        for (int j = 0; j < 8; ++j) { sa += fa[j] * fa[j]; sb += fb[j] * fb[j]; }
        sa = wave_sum(sa); sb = wave_sum(sb);
        const float ra = rsqrtf(sa * (1.0f / 512.0f) + EPS), rb_ = rsqrtf(sb * (1.0f / 512.0f) + EPS);
        u32x4 wa, wb;
#pragma unroll
        for (int q = 0; q < 4; ++q) { wa[q] = pk2(fa[2 * q] * ra * ga[2 * q], fa[2 * q + 1] * ra * ga[2 * q + 1]); wb[q] = pk2(fb[2 * q] * rb_ * gb[2 * q], fb[2 * q + 1] * rb_ * gb[2 * q + 1]); }
        *(LAS u32x4*)(lds + a_off(row, 16 * lane, 2048)) = wa; *(LAS u32x4*)(lds + a_off(row, 16 * (lane + 64), 2048)) = wb;
      }
    }
  }
  __syncthreads();
  f32x16 acc[4][2]; acc_zero<4>(acc);
  { const bf16x8* wp[4];
#pragma unroll
    for (int i = 0; i < 4; ++i) wp[i] = (const bf16x8*)(ws + WS_WOUT) + (size_t)((4 * wave + i) * 64) * 64 + lane;
    gemm_tile<4, 64, false, 5>(acc, lds, 2048, wp, lane); }
  if (P.variant & 2) { asm volatile("" :: "v"(acc[0][0][0]), "v"(acc[1][1][3]), "v"(acc[2][0][7]), "v"(acc[3][1][15])); return; }
  bf16_t* X1 = (bf16_t*)(ws + WS_X1);
  float gt[4];
#pragma unroll
  for (int i = 0; i < 4; ++i) gt[i] = mod[2 * DM + 128 * wave + 32 * i + r32];
#pragma unroll
  for (int rb = 0; rb < 2; ++rb) {
    float xr[16][4];
#pragma unroll
    for (int reg = 0; reg < 16; ++reg) { const size_t off = (size_t)(t0 + 32 * rb + crow(reg, hi)) * DM + 128 * wave + r32;
#pragma unroll
      for (int i = 0; i < 4; ++i) xr[reg][i] = x[off + 32 * i]; }
#pragma unroll
    for (int reg = 0; reg < 16; ++reg) { const int row = 32 * rb + crow(reg, hi); const size_t off = (size_t)(t0 + row) * DM + 128 * wave + r32; float ss = 0.f;
#pragma unroll
      for (int i = 0; i < 4; ++i) { const float v = xr[reg][i] + gt[i] * acc[i][rb][reg]; acc[i][rb][reg] = v; X1[off + 32 * i] = (bf16_t)(pk2(v, 0.f) & 0xffffu); ss += v * v; }
#pragma unroll
      for (int o = 16; o; o >>= 1) ss += __shfl_xor(ss, o);
      if (r32 == 0) lds_fadd(&ssq[row], ss); }
  }
  __syncthreads();
  { float a2[4], s2[4];
#pragma unroll
    for (int i = 0; i < 4; ++i) { const int col = 128 * wave + 32 * i + r32; a2[i] = P.in[14][col] * (1.0f + mod[4 * DM + col]); s2[i] = mod[3 * DM + col]; }
#pragma unroll
    for (int rb = 0; rb < 2; ++rb)
#pragma unroll
      for (int reg = 0; reg < 16; ++reg) { const int row = 32 * rb + crow(reg, hi); const float rs = rsqrtf(ssq[row] * (1.0f / DM) + EPS);
#pragma unroll
        for (int i = 0; i < 4; ++i) { const float v = acc[i][rb][reg] * rs * a2[i] + s2[i]; const int col = 128 * wave + 32 * i + r32;
          *(LAS bf16_t*)(lds + a_off(row, 2 * col, 2048)) = (bf16_t)(pk2(v, v) & 0xffffu); } }
  }
  __syncthreads();
  if (P.variant & 1) return;
  if (wave < 4) {
    f32x16 ar[1][2]; acc_zero<1>(ar);
    const bf16x8* wp[1]; wp[0] = (const bf16x8*)(ws + WS_WR) + (size_t)((wave >> 1) * 64) * 64 + lane;
    gemm_tile<1, 64, false>(ar, lds, 2048, wp, lane);
    const int rb = wave & 1, col = 32 * (wave >> 1) + r32;
#pragma unroll
    for (int reg = 0; reg < 16; ++reg) { const float v = rb ? ar[0][1][reg] : ar[0][0][reg]; logit[(32 * rb + crow(reg, hi)) * 64 + col] = v; }
  }
  { uchar* H2 = ws + WS_H2;
#pragma unroll
    for (int rr = 0; rr < 8; ++rr) { const int row = wave * 8 + rr;
      const u32x4 v0 = *(const LAS u32x4*)(lds + a_off(row, 16 * lane, 2048)), v1 = *(const LAS u32x4*)(lds + a_off(row, 16 * (lane + 64), 2048));
      u32x2 w0, w1;
      w0.x = pk4_fp8(__uint_as_float(v0.x << 16) * H2_SCALE, __uint_as_float(v0.x & 0xffff0000u) * H2_SCALE, __uint_as_float(v0.y << 16) * H2_SCALE, __uint_as_float(v0.y & 0xffff0000u) * H2_SCALE);
      w0.y = pk4_fp8(__uint_as_float(v0.z << 16) * H2_SCALE, __uint_as_float(v0.z & 0xffff0000u) * H2_SCALE, __uint_as_float(v0.w << 16) * H2_SCALE, __uint_as_float(v0.w & 0xffff0000u) * H2_SCALE);
      w1.x = pk4_fp8(__uint_as_float(v1.x << 16) * H2_SCALE, __uint_as_float(v1.x & 0xffff0000u) * H2_SCALE, __uint_as_float(v1.y << 16) * H2_SCALE, __uint_as_float(v1.y & 0xffff0000u) * H2_SCALE);
      w1.y = pk4_fp8(__uint_as_float(v1.z << 16) * H2_SCALE, __uint_as_float(v1.z & 0xffff0000u) * H2_SCALE, __uint_as_float(v1.w << 16) * H2_SCALE, __uint_as_float(v1.w & 0xffff0000u) * H2_SCALE);
      u32x2* dst = (u32x2*)(H2 + (size_t)(t0 + row) * DM); dst[lane] = w0; dst[lane + 64] = w1; } }
  __syncthreads();
  if (tid < 64) {
    const float* lg = (const float*)0; (void)lg;
    float gl[4];
#pragma unroll
    for (int i = 0; i < 4; ++i) gl[i] = logit[tid * 64 + i] + P.in[16][i];
    int gi = 0; float gm = gl[0];
#pragma unroll
    for (int i = 1; i < 4; ++i) if (gl[i] > gm) { gm = gl[i]; gi = i; }
    float gs = 0.f;
#pragma unroll
    for (int i = 0; i < 4; ++i) gs += __expf(gl[i] - gm);
    const float gw = 1.0f / gs;
    float el[8];
#pragma unroll
    for (int i = 0; i < 8; ++i) el[i] = logit[tid * 64 + 4 + gi * 8 + i] + P.in[18][gi * 8 + i];
    int i1 = 0; float m1 = el[0];
#pragma unroll
    for (int i = 1; i < 8; ++i) if (el[i] > m1) { m1 = el[i]; i1 = i; }
    int i2 = (i1 + 1) & 7; float m2 = el[i2];
#pragma unroll
    for (int i = 0; i < 8; ++i) if (i != i1 && el[i] > m2) { m2 = el[i]; i2 = i; }
    const float p2 = __expf(m2 - m1), w1 = 1.0f / (1.0f + p2), w2 = p2 * w1;
    const int e1 = gi * 8 + i1, e2 = gi * 8 + i2;
    selE[2 * tid] = e1; selE[2 * tid + 1] = e2; selW[2 * tid] = gw * w1; selW[2 * tid + 1] = gw * w2;
    selP[2 * tid] = __hip_atomic_fetch_add(&cntl[e1], 1, __ATOMIC_RELAXED, __HIP_MEMORY_SCOPE_WORKGROUP);
    selP[2 * tid + 1] = __hip_atomic_fetch_add(&cntl[e2], 1, __ATOMIC_RELAXED, __HIP_MEMORY_SCOPE_WORKGROUP);
  }
  __syncthreads();
  if (tid < 32) { const int c = cntl[tid]; basel[tid] = c ? atomicAdd((int*)(ws + WS_CNT) + tid, c) : 0; }
  __syncthreads();
  if (tid < 128) { const int e = selE[tid], pos = basel[e] + selP[tid];
    ((int*)(ws + WS_LIST))[(size_t)e * 16384 + pos] = (t0 + (tid >> 1)) * 2 + (tid & 1);
    ((float*)(ws + WS_WT))[(size_t)(t0 + (tid >> 1)) * 2 + (tid & 1)] = selW[tid]; }
  __syncthreads();
}

constexpr int P4_ROWS = 144, P4_NRB = 5, P4_MISC = P4_ROWS * 1024;
__device__ __forceinline__ void phase4(const KP& P, LAS uchar* lds) {
  int lane_ = mk_lane(); asm volatile("" : "+v"(lane_)); const int lane = lane_ & 63, wave = P.wave, tid = wave * 64 + lane, r32 = lane & 31, hi = lane >> 5;
  uchar* ws = P.ws;
  LAS int* rinfo = (LAS int*)(lds + P4_MISC + 1024);
  LAS float* rwt = (LAS float*)(lds + P4_MISC + 2048);
  LAS int* ustart = (LAS int*)(lds + P4_MISC + 3072);
  const int* cnt = (const int*)(ws + WS_CNT);
  if (tid == 0) { int acc_ = 0; for (int e = 0; e < 32; ++e) { ustart[e] = acc_; acc_ += (cnt[e] + P4_ROWS - 1) / P4_ROWS; } ustart[32] = acc_; }
  __syncthreads();
  const int total = ustart[32];
  const uchar* H2 = ws + WS_H2; bf16_t* Y = (bf16_t*)(ws + WS_Y);
#pragma unroll 1
  for (int u = blockIdx.x; u < total; u += gridDim.x) {
    int e = 0;
#pragma unroll 1
    for (int k = 1; k < 32; ++k) if (ustart[k] <= u) e = k;
    const int ne = cnt[e], ke = ustart[e + 1] - ustart[e], q = (ne + ke - 1) / ke, j = u - ustart[e], base = j * q, len = min(q, ne - base), nrb = (len + 31) >> 5;
    if (tid < 160) { int info = -1; float w = 0.f;
      if (tid < len) { info = ((const int*)(ws + WS_LIST))[(size_t)e * 16384 + base + tid]; w = ((const float*)(ws + WS_WT))[info]; }
      rinfo[tid] = info; rwt[tid] = w; }
    __syncthreads();
#pragma unroll
    for (int hf = 0; hf < 2; ++hf) {
      u32x4 v[9];
#pragma unroll
      for (int rr = 0; rr < 9; ++rr) { const int info = rinfo[wave * 18 + hf * 9 + rr]; const int tok = info < 0 ? 0 : (info >> 1); v[rr] = ((const u32x4*)(H2 + (size_t)tok * DM))[lane]; }
#pragma unroll
      for (int rr = 0; rr < 9; ++rr) *(LAS u32x4*)(lds + a_off(wave * 18 + hf * 9 + rr, 16 * lane, 1024)) = v[rr];
    }
    __syncthreads();
    f32x16 ag[2][P4_NRB];
#pragma unroll
    for (int i = 0; i < 2; ++i)
#pragma unroll
      for (int rb = 0; rb < P4_NRB; ++rb) ag[i][rb] = f32x16{};
    { const l64x2* wp[2];
      wp[0] = (const l64x2*)(ws + WS_WG) + (size_t)((e * 8 + wave) * 32) * 64 + lane;
      wp[1] = (const l64x2*)(ws + WS_WU) + (size_t)((e * 8 + wave) * 32) * 64 + lane;
      if (!(P.variant & 2)) gemm_tile_f8<2, 32, true, 1, false, P4_NRB>(ag, lds, 1024, wp, lane, nrb); }
    __syncthreads();
    { constexpr float S1 = 1.0f / (H2_SCALE * WGU_SCALE);
#pragma unroll
      for (int rb = 0; rb < P4_NRB; ++rb) if (rb < nrb) { const int rr = 32 * rb + r32; const float w = rwt[rr] * HID_SCALE;
#pragma unroll
        for (int g = 0; g < 4; ++g) { float hv[4];
#pragma unroll
          for (int i = 0; i < 4; ++i) { const float gg = ag[0][rb][4 * g + i] * S1, uu = ag[1][rb][4 * g + i] * S1; hv[i] = gg / (1.0f + __expf(-gg)) * uu * w; }
          *(LAS unsigned*)(lds + a_off(rr, 32 * wave + 8 * g + 4 * hi, 256)) = pk4_fp8(hv[0], hv[1], hv[2], hv[3]); } } }
    __syncthreads();
#pragma unroll 1
    for (int pass = (P.variant & 1) ? 2 : 0; pass < 2; ++pass) {
      f32x16 ad[2][P4_NRB];
#pragma unroll
      for (int i = 0; i < 2; ++i)
#pragma unroll
        for (int rb = 0; rb < P4_NRB; ++rb) ad[i][rb] = f32x16{};
      const l64x2* wp[2];
#pragma unroll
      for (int i = 0; i < 2; ++i) wp[i] = (const l64x2*)(ws + WS_WD) + (size_t)((e * 32 + 4 * wave + 2 * pass + i) * 8) * 64 + lane;
      gemm_tile_f8<2, 8, false, 1, false, P4_NRB>(ad, lds, 256, wp, lane, nrb);
      constexpr float S2 = 1.0f / (HID_SCALE * WD_SCALE);
#pragma unroll
      for (int rb = 0; rb < P4_NRB; ++rb) if (rb < nrb) {
#pragma unroll
        for (int reg = 0; reg < 16; ++reg) { const int info = rinfo[32 * rb + crow(reg, hi)];
          if (info >= 0) { bf16_t* yp = Y + (size_t)info * DM + 128 * wave + 64 * pass + r32;
            yp[0] = (bf16_t)(pk2(ad[0][rb][reg] * S2, 0.f) & 0xffffu); yp[32] = (bf16_t)(pk2(ad[1][rb][reg] * S2, 0.f) & 0xffffu); } } }
    }
    __syncthreads();
  }
}

__device__ __forceinline__ void phase5(const KP& P) {
  int lane_ = mk_lane(); asm volatile("" : "+v"(lane_)); const int lane = lane_ & 63, wave = P.wave;
  uchar* ws = P.ws;
  const bf16_t* Y = (const bf16_t*)(ws + WS_Y);
  const bf16_t* X1 = (const bf16_t*)(ws + WS_X1); float* OUT = P.out;
  f32x4 gf[4];
#pragma unroll
  for (int i = 0; i < 4; ++i) gf[i] = *(const f32x4*)(P.in[22] + 4 * (lane + 64 * i));
  constexpr int RPI = 4;
  const int nwv = gridDim.x * NWAVE, wv = blockIdx.x * NWAVE + wave;
#pragma unroll 1
  for (int t0 = wv * RPI; t0 < T; t0 += nwv * RPI) {
    u32x2 xv[RPI][4]; u32x2 ya[RPI][4], yb[RPI][4];
#pragma unroll
    for (int r = 0; r < RPI; ++r)
#pragma unroll
      for (int i = 0; i < 4; ++i) { const int k = 4 * (lane + 64 * i); const size_t t = t0 + r;
        xv[r][i] = *(const u32x2*)(X1 + t * DM + k); ya[r][i] = *(const u32x2*)(Y + (2 * t) * DM + k); yb[r][i] = *(const u32x2*)(Y + (2 * t + 1) * DM + k); }
    const int b = t0 / SEQ; const float* gt2 = (const float*)(ws + WS_MOD) + b * (NMOD * DM) + 5 * DM;
    f32x4 g2v[4];
#pragma unroll
    for (int i = 0; i < 4; ++i) g2v[i] = *(const f32x4*)(gt2 + 4 * (lane + 64 * i));
#pragma unroll
    for (int r = 0; r < RPI; ++r) {
      f32x4 v[4]; float ss = 0.f;
#pragma unroll
      for (int i = 0; i < 4; ++i) { const u32x2 y0 = ya[r][i], y1 = yb[r][i]; f32x4 ys;
        ys[0] = __uint_as_float(y0.x << 16) + __uint_as_float(y1.x << 16); ys[1] = __uint_as_float(y0.x & 0xffff0000u) + __uint_as_float(y1.x & 0xffff0000u);
        ys[2] = __uint_as_float(y0.y << 16) + __uint_as_float(y1.y << 16); ys[3] = __uint_as_float(y0.y & 0xffff0000u) + __uint_as_float(y1.y & 0xffff0000u);
        f32x4 xf; xf[0] = __uint_as_float(xv[r][i].x << 16); xf[1] = __uint_as_float(xv[r][i].x & 0xffff0000u); xf[2] = __uint_as_float(xv[r][i].y << 16); xf[3] = __uint_as_float(xv[r][i].y & 0xffff0000u);
        v[i] = xf + g2v[i] * ys; ss += v[i][0] * v[i][0] + v[i][1] * v[i][1] + v[i][2] * v[i][2] + v[i][3] * v[i][3]; }
      ss = wave_sum(ss); const float rs = rsqrtf(ss * (1.0f / DM) + EPS);
#pragma unroll
      for (int i = 0; i < 4; ++i) *(f32x4*)(OUT + (size_t)(t0 + r) * DM + 4 * (lane + 64 * i)) = v[i] * rs * gf[i];
    }
  }
}
__global__ void __launch_bounds__(NTHR, 2) mk_fwd(const Params P0) {
  extern __shared__ __attribute__((aligned(16))) uchar lds_raw[];
  LAS uchar* lds = (LAS uchar*)lds_raw;
  KP P; P.in = P0.in; P.out = P0.out; P.ws = P0.ws; P.ph_lo = P0.ph_lo; P.ph_hi = P0.ph_hi; P.variant = P0.variant; P.wave = __builtin_amdgcn_readfirstlane((int)(threadIdx.x >> 6));
  const int bid = blockIdx.x, G = gridDim.x;
  const int lo = P.ph_lo, hi = P.ph_hi;
  volatile LAS unsigned* bst = (volatile LAS unsigned*)(lds + LDS_BYTES - 16);
  if (threadIdx.x < 4) bst[threadIdx.x] = 0u;
  __syncthreads();
  XcdBarrier bar; bar.bar = (unsigned*)(P.ws + WS_CTL); bar.x = 0; bar.st = bst;
  if (hi - lo > 1) bar = xcd_barrier_post((unsigned*)(P.ws + WS_CTL), bst, P.wave == 0 && mk_lane() == 0);
#define IN(k) (lo <= (k) && (k) < hi)
#define BOTH(k) (IN(k) && IN((k) + 1))
  if (IN(0)) { phase0(P, lds); if (BOTH(0)) xcd_barrier(bar, P.wave == 0 && mk_lane() == 0); }
  if (IN(1)) { if (bid < T / 64) phase1_tile(P, lds, bid); if (BOTH(1)) xcd_barrier(bar, P.wave == 0 && mk_lane() == 0); }
  if (IN(2)) { phase2(P, lds); if (BOTH(2)) xcd_barrier(bar, P.wave == 0 && mk_lane() == 0); }
  if (IN(3)) { if (bid < T / 64) phase3_tile(P, lds, bid); if (BOTH(3)) xcd_barrier(bar, P.wave == 0 && mk_lane() == 0); }
  if (IN(4)) { phase4(P, lds); if (BOTH(4)) xcd_barrier(bar, P.wave == 0 && mk_lane() == 0); }
  if (IN(5)) phase5(P);
#undef IN
#undef BOTH
}

extern "C" void kernel_launch(void* const* d_in, const int* in_sizes, int n_in, void* d_out, int out_size, void* d_ws, size_t ws_size, hipStream_t stream) {
  static int ready = 0;
  if (!ready) {
    if (n_in != 23 || out_size != T * DM || ws_size < WS_END) { fprintf(stderr, "kernel_launch: unexpected shapes (n_in %d out %d ws %zu need %zu)\n", n_in, out_size, ws_size, (size_t)WS_END); return; }
    if (hipFuncSetAttribute((const void*)mk_fwd, hipFuncAttributeMaxDynamicSharedMemorySize, LDS_BYTES) != hipSuccess) { fprintf(stderr, "kernel_launch: hipFuncSetAttribute failed\n"); return; }
    ready = 1;
  }
  uchar* ws = (uchar*)d_ws;
  if (hipMemsetAsync(ws + WS_CTL, 0, 32768, stream) != hipSuccess) { fprintf(stderr, "kernel_launch: hipMemsetAsync failed\n"); return; }
  Params p{};
  for (int i = 0; i < 23; ++i) p.in[i] = (const float*)d_in[i];
  p.out = (float*)d_out; p.ws = ws; p.ph_lo = 0; p.ph_hi = 6; p.variant = 0; p.pad = 0;
  hipLaunchKernelGGL(mk_fwd, dim3(T / 64), dim3(NTHR), LDS_BYTES, stream, p);
}
```

```cpp
#include <hip/hip_runtime.h>
#include <cstdio>
#include <cstdint>
constexpr int DM = 1024, NB = 4, SEQ = 4096, T = NB * SEQ;
constexpr int INW = 1120, NMOD = 6;
constexpr float EPS = 1e-6f;
#define LAS __attribute__((address_space(3)))
typedef unsigned short bf16_t;
typedef short bf16x8 __attribute__((ext_vector_type(8)));
typedef float f32x16 __attribute__((ext_vector_type(16)));
typedef float f32x4 __attribute__((ext_vector_type(4)));
typedef unsigned u32x4 __attribute__((ext_vector_type(4)));
typedef unsigned u32x2 __attribute__((ext_vector_type(2)));
typedef unsigned char uchar;

constexpr int NTHR = 512, NWAVE = 8;
constexpr int LDS_A = 0, LDS_MISC = 131072, LDS_BYTES = 163840;
constexpr float LOG2E = 1.4426950408889634f;
constexpr float QSCALE_A = 0.125f * LOG2E;
constexpr float QSCALE_B = 0.10206207261596575f * LOG2E;
constexpr float THR2 = 10.f;
constexpr float WIN_SCALE = 64.f, WIN_DESCALE = 1.0f / 64.f;
constexpr float H2_SCALE = 8.f, WGU_SCALE = 64.f, WD_SCALE = 32.f, HID_SCALE = 8.f;

constexpr size_t WS_CTL   = 0;
constexpr size_t WS_CNT   = 16384;
constexpr size_t WS_MOD   = 32768;
constexpr size_t WS_TABA  = WS_MOD + 98304;
constexpr size_t WS_TABB  = WS_TABA + 4096 * 32 * 8;
constexpr size_t WS_WIN   = WS_TABB + 4096 * 16 * 8;
constexpr size_t WS_WUQ   = WS_WIN + 35 * 64 * 1024;
constexpr size_t WS_WUKV  = WS_WUQ + 24 * 12 * 1024;
constexpr size_t WS_WOUT  = WS_WUKV + 32 * 8 * 1024;
constexpr size_t WS_WR    = WS_WOUT + 32 * 64 * 1024;
constexpr size_t WS_WG    = WS_WR + 2 * 64 * 1024;
constexpr size_t WS_WU    = WS_WG + (size_t)32 * 8 * 32 * 1024;
constexpr size_t WS_WD    = WS_WU + (size_t)32 * 8 * 32 * 1024;
constexpr size_t WS_LIST  = WS_WD + (size_t)32 * 32 * 8 * 1024;
constexpr size_t WS_WT    = WS_LIST + (size_t)32 * 16384 * 4;
constexpr size_t WS_QA    = WS_WT + (size_t)T * 2 * 4;
constexpr size_t WS_KVA   = WS_QA + (size_t)NB * 8 * 64 * 8192;
constexpr size_t WS_QB    = WS_KVA + (size_t)NB * 2 * 64 * 16384;
constexpr size_t WS_KVB   = WS_QB + (size_t)NB * 8 * 64 * 12288;
constexpr size_t WS_O     = WS_KVB + (size_t)NB * 8 * 64 * 20480;
constexpr size_t WS_H2    = WS_O + (size_t)T * DM * 2;
constexpr size_t WS_X1    = WS_H2 + (size_t)T * DM * 2;
constexpr size_t WS_END   = WS_X1 + (size_t)T * DM * 2;
constexpr size_t WS_Y     = WS_QA;
static_assert((size_t)T * 2 * DM * 2 <= WS_O - WS_QA, "Y overlay");

struct Params { const float* in[23]; float* out; unsigned char* ws; int ph_lo, ph_hi, variant, pad; };
struct KP { const float* const* in; float* out; unsigned char* ws; int ph_lo, ph_hi, wave, variant; };
__device__ __forceinline__ int mk_lane() { return (int)__builtin_amdgcn_mbcnt_hi(~0u, __builtin_amdgcn_mbcnt_lo(~0u, 0u)); }

__device__ __forceinline__ unsigned pk2(float lo, float hi) { unsigned r; asm("v_cvt_pk_bf16_f32 %0, %1, %2" : "=v"(r) : "v"(lo), "v"(hi)); return r; }
__device__ __forceinline__ float bf2f(unsigned short v) { return __uint_as_float((unsigned)v << 16); }
__host__ __device__ __forceinline__ constexpr int crow(int r, int hi) { return (r & 3) + 8 * (r >> 2) + 4 * hi; }
__device__ __forceinline__ f32x16 mfma(bf16x8 a, bf16x8 b, f32x16 c) { return __builtin_amdgcn_mfma_f32_32x32x16_bf16(a, b, c, 0, 0, 0); }
__device__ __forceinline__ float wave_sum(float v) {
#pragma unroll
  for (int o = 32; o; o >>= 1) v += __shfl_xor(v, o);
  return v;
}
__device__ __forceinline__ float half_swap_max(float x) { auto rr = __builtin_amdgcn_permlane32_swap(__float_as_uint(x), __float_as_uint(x), false, false); return fmaxf(__uint_as_float(rr[0]), __uint_as_float(rr[1])); }
__device__ __forceinline__ float half_swap_sum(float x) { auto rr = __builtin_amdgcn_permlane32_swap(__float_as_uint(x), __float_as_uint(x), false, false); return __uint_as_float(rr[0]) + __uint_as_float(rr[1]); }
__host__ __device__ __forceinline__ constexpr int a_off(int row, int kbyte, int pitch) { return row * pitch + (kbyte ^ ((row & 15) << 4)); }
__host__ __device__ __forceinline__ constexpr int img_qk(int rr, int d, int NS) { return ((((rr >> 5) * NS + (d >> 4)) * 64) + ((d >> 3) & 1) * 32 + (rr & 31)) * 16 + (d & 7) * 2; }
__host__ __device__ __forceinline__ constexpr int img_v(int kk, int d) {
  const int kb = kk >> 5, k32 = kk & 31, s = k32 >> 4, k16 = k32 & 15, h = (k16 >> 2) & 1, j = ((k16 >> 3) << 2) | (k16 & 3), db = d >> 5, r = d & 31;
  return (((((kb * 2 + db) * 2 + s) * 64) + h * 32 + r) * 8 + j) * 2;
}

#define XB_TMO      128
#define XB_XCNT(j)  (256  + 64 * (j))
#define XB_XSUB(j)  (1280 + 64 * (j))
#define XB_XGEN(j)  (2304 + 64 * (j))
#define XB_TOP      3328
#define XB_TOPGEN   3392
#define XCD_BAR_WORDS 3456
#define XB_SPIN_CAP (1u << 20)
__device__ __forceinline__ unsigned xb_ld(unsigned* p)              { return __hip_atomic_load(p, __ATOMIC_RELAXED, __HIP_MEMORY_SCOPE_AGENT); }
__device__ __forceinline__ unsigned xb_add(unsigned* p, unsigned v) { return __hip_atomic_fetch_add(p, v, __ATOMIC_RELAXED, __HIP_MEMORY_SCOPE_AGENT); }
__device__ __forceinline__ unsigned xb_xcc_id() { return (unsigned)__builtin_amdgcn_s_getreg((3 << 11) | 20) & 0xFu; }
#define XB_SPIN(cond, bar) do { unsigned _sp = 0; while (cond) { __builtin_amdgcn_s_sleep(1); \
    if ((++_sp & 255u) == 0u) { if (xb_ld(&(bar)[XB_TMO])) break; if (_sp > XB_SPIN_CAP) { atomicAdd(&(bar)[XB_TMO], 1u); break; } } } } while (0)
struct XcdBarrier { unsigned* bar; unsigned x; volatile LAS unsigned* st; };
__device__ __forceinline__ XcdBarrier xcd_barrier_post(unsigned* bar, volatile LAS unsigned* st, bool leader) {
  XcdBarrier b; b.bar = bar; b.x = xb_xcc_id(); b.st = st;
  if (leader) (void)xb_add(&bar[XB_XCNT(b.x)], 1u);
  return b;
}
__device__ __forceinline__ void xcd_barrier_complete(unsigned* bar, unsigned x, unsigned& nloc, unsigned& nx) {
  const unsigned G = gridDim.x * gridDim.y * gridDim.z;
  unsigned sum, cnt, mine, sp = 0u;
  for (;;) {
    sum = 0u; cnt = 0u; mine = 0u;
#pragma unroll
    for (unsigned j = 0; j < 16; ++j) { const unsigned c = xb_ld(&bar[XB_XCNT(j)]); sum += c; cnt += (c > 0u) ? 1u : 0u; mine = (j == x) ? c : mine; }
    if (sum == G) break;
    __builtin_amdgcn_s_sleep(1);
    if ((++sp & 255u) == 0u) { if (xb_ld(&bar[XB_TMO])) break; if (sp > XB_SPIN_CAP) { atomicAdd(&bar[XB_TMO], 1u); break; } }
  }
  nloc = mine > 0u ? mine : 1u; nx = cnt > 0u ? cnt : 1u;
}
__device__ __forceinline__ void xcd_barrier(const XcdBarrier& b, bool leader) {
  asm volatile("s_waitcnt vmcnt(0)" ::: "memory");
  __syncthreads();
  if (leader) {
    unsigned* bar = b.bar;
    __builtin_amdgcn_s_waitcnt(0);
    unsigned nloc = b.st[0], nx = b.st[1];
    if (nloc == 0u) { xcd_barrier_complete(bar, b.x, nloc, nx); b.st[0] = nloc; b.st[1] = nx; }
    const unsigned old = xb_add(&bar[XB_XSUB(b.x)], 1u);
    const unsigned gen = old / nloc;
    if (old + 1u == (gen + 1u) * nloc) {
      __builtin_amdgcn_fence(__ATOMIC_RELEASE, "agent");
      asm volatile("s_waitcnt vmcnt(0)" ::: "memory");
      const unsigned og = xb_add(&bar[XB_TOP], 1u);
      const unsigned tg = og / nx;
      if (og + 1u == (tg + 1u) * nx) xb_add(&bar[XB_TOPGEN], 1u);
      else XB_SPIN(xb_ld(&bar[XB_TOPGEN]) == tg, bar);
      __builtin_amdgcn_fence(__ATOMIC_ACQUIRE, "agent");
      xb_add(&bar[XB_XGEN(b.x)], 1u);
      asm volatile("s_waitcnt vmcnt(0)" ::: "memory");
    } else {
      XB_SPIN(xb_ld(&bar[XB_XGEN(b.x)]) == gen, bar);
      __builtin_amdgcn_fence(__ATOMIC_ACQUIRE, "agent");
      asm volatile("s_waitcnt vmcnt(0)" ::: "memory");
    }
  }
  __syncthreads();
}

template <int NBLK, int NS, bool TR, int D = (NBLK >= 3 ? 4 : 8)>
__device__ __forceinline__ void gemm_tile(f32x16 (&acc)[NBLK][2], const LAS uchar* A, const int pitch, const bf16x8* const (&wp)[NBLK], const int lane) {
  constexpr int NSM = (NS / D) * D;
  const int r = lane & 31, h = lane >> 5;
  const LAS uchar* a0p = A + r * pitch; const LAS uchar* a1p = A + (32 + r) * pitch;
  const int swz = (lane & 15) << 4, kb0 = 16 * h;
  bf16x8 ring[D][NBLK];
#pragma unroll
  for (int d = 0; d < D; ++d)
#pragma unroll
    for (int i = 0; i < NBLK; ++i) ring[d][i] = wp[i][d * 64];
#pragma unroll 1
  for (int s0 = 0; s0 < NSM; s0 += D) {
#pragma unroll
    for (int d = 0; d < D; ++d) {
      const int s = s0 + d;
      const int ko = ((s * 32) + kb0) ^ swz; const bf16x8 fa0 = *(const LAS bf16x8*)(a0p + ko), fa1 = *(const LAS bf16x8*)(a1p + ko);
#pragma unroll
      for (int i = 0; i < NBLK; ++i) {
        if (TR) { acc[i][0] = mfma(ring[d][i], fa0, acc[i][0]); acc[i][1] = mfma(ring[d][i], fa1, acc[i][1]); }
        else    { acc[i][0] = mfma(fa0, ring[d][i], acc[i][0]); acc[i][1] = mfma(fa1, ring[d][i], acc[i][1]); }
      }
      if (s + D < NS) {
#pragma unroll
        for (int i = 0; i < NBLK; ++i) ring[d][i] = wp[i][(s + D) * 64];
      }
    }
  }
#pragma unroll
  for (int d = 0; d < NS - NSM; ++d) {
    const int s = NSM + d;
    const int ko = ((s * 32) + kb0) ^ swz; const bf16x8 fa0 = *(const LAS bf16x8*)(a0p + ko), fa1 = *(const LAS bf16x8*)(a1p + ko);
#pragma unroll
    for (int i = 0; i < NBLK; ++i) {
      if (TR) { acc[i][0] = mfma(ring[d][i], fa0, acc[i][0]); acc[i][1] = mfma(ring[d][i], fa1, acc[i][1]); }
      else    { acc[i][0] = mfma(fa0, ring[d][i], acc[i][0]); acc[i][1] = mfma(fa1, ring[d][i], acc[i][1]); }
    }
  }
}
typedef long l64x2 __attribute__((ext_vector_type(2)));
__device__ __forceinline__ f32x16 mfma8(long a, long b, f32x16 c) { return __builtin_amdgcn_mfma_f32_32x32x16_fp8_fp8(a, b, c, 0, 0, 0); }
__device__ __forceinline__ unsigned pk4_fp8(float a, float b, float c, float d) { int w = 0; w = __builtin_amdgcn_cvt_pk_fp8_f32(a, b, w, false); w = __builtin_amdgcn_cvt_pk_fp8_f32(c, d, w, true); return (unsigned)w; }
typedef int i32x8 __attribute__((ext_vector_type(8)));
typedef int i32x4 __attribute__((ext_vector_type(4)));
#ifndef MK_MX
#define MK_MX 1
#endif
__device__ __forceinline__ f32x16 mfma_mx(i32x4 a0, i32x4 a1, i32x4 b0, i32x4 b1, f32x16 c) {
  const i32x8 a = __builtin_shufflevector(a0, a1, 0, 1, 2, 3, 4, 5, 6, 7), b = __builtin_shufflevector(b0, b1, 0, 1, 2, 3, 4, 5, 6, 7);
  return __builtin_amdgcn_mfma_scale_f32_32x32x64_f8f6f4(a, b, c, 0, 0, 0, 0x7f7f7f7f, 0, 0x7f7f7f7f);
}
__device__ __forceinline__ f32x16 mfma_mx_q(i32x4 a0, i32x4 a1, i32x4 b0, i32x4 b1, f32x16 c) {
  const i32x8 a = __builtin_shufflevector(a0, a1, 0, 1, 2, 3, 4, 5, 6, 7), b = __builtin_shufflevector(b0, b1, 0, 1, 2, 3, 4, 5, 6, 7);
  return __builtin_amdgcn_mfma_scale_f32_32x32x64_f8f6f4(a, b, c, 0, 0, 0, 0x7f7f7f7f, 0, 0x77777777);
}
__device__ __forceinline__ unsigned mk_pknorm(float lo, float hi) { typedef unsigned short u16x2 __attribute__((ext_vector_type(2))); const u16x2 v = __builtin_amdgcn_cvt_pknorm_u16(lo, hi); return __builtin_bit_cast(unsigned, v); }
__device__ __forceinline__ f32x16 mfma_mx8(i32x8 a, i32x8 b, f32x16 c) { return __builtin_amdgcn_mfma_scale_f32_32x32x64_f8f6f4(a, b, c, 0, 0, 0, 0x7f7f7f7f, 0, 0x7f7f7f7f); }
__device__ __forceinline__ i32x8 ld_pair(const i32x4* p0, const i32x4* p1) { const i32x4 x = *p0, y = *p1; return __builtin_shufflevector(x, y, 0, 1, 2, 3, 4, 5, 6, 7); }
template <int NBLK, int NS, bool TR, int D, bool FULL, int NRB>
__device__ __forceinline__ void gemm_tile_f8(f32x16 (&acc)[NBLK][NRB], const LAS uchar* A, const int pitch, const l64x2* const (&wp)[NBLK], const int lane, const int nrb) {
  constexpr int NP = NS / 2;
  static_assert(NS % 2 == 0 && NP % D == 0, "NS even, NP % D");
  const int r = lane & 31, h = lane >> 5;
  const LAS uchar* ap = A + r * pitch;
  const int swz = (lane & 15) << 4, kb0 = 16 * h;
  i32x8 ring[D][NBLK];
#pragma unroll
  for (int d = 0; d < D; ++d)
#pragma unroll
    for (int i = 0; i < NBLK; ++i) ring[d][i] = ld_pair((const i32x4*)(wp[i] + (2 * d) * 64), (const i32x4*)(wp[i] + (2 * d + 1) * 64));
#pragma unroll 1
  for (int p0 = 0; p0 < NP; p0 += D) {
#pragma unroll
    for (int d = 0; d < D; ++d) {
      const int s = 2 * (p0 + d);
      const int ko0 = ((s * 32) + kb0) ^ swz, ko1 = (((s + 1) * 32) + kb0) ^ swz;
#pragma unroll
      for (int rb = 0; rb < NRB; ++rb) {
        if (FULL || rb < nrb) {
          const i32x4 f0 = *(const LAS i32x4*)(ap + rb * 32 * pitch + ko0), f1 = *(const LAS i32x4*)(ap + rb * 32 * pitch + ko1);
          const i32x8 fa = __builtin_shufflevector(f0, f1, 0, 1, 2, 3, 4, 5, 6, 7);
#pragma unroll
          for (int i = 0; i < NBLK; ++i) acc[i][rb] = TR ? mfma_mx8(ring[d][i], fa, acc[i][rb]) : mfma_mx8(fa, ring[d][i], acc[i][rb]);
        }
      }
      if (p0 + d + D < NP) {
#pragma unroll
        for (int i = 0; i < NBLK; ++i) ring[d][i] = ld_pair((const i32x4*)(wp[i] + (2 * (p0 + d + D)) * 64), (const i32x4*)(wp[i] + (2 * (p0 + d + D) + 1) * 64));
      }
    }
  }
}
template <int NSLOT, int NACC, int NS, bool TR, int D, int MAP>
__device__ __forceinline__ void gemm_slots_f8(f32x16 (&acc)[NACC][2], const LAS uchar* A, const int pitch, const l64x2* const (&wp)[NSLOT], const int lane) {
  constexpr int NP = NS / 2;
  static_assert(NS % 2 == 0 && NP % D == 0, "NS even, NP % D");
  const int r = lane & 31, h = lane >> 5;
  const LAS uchar* ap = A + r * pitch;
  const int swz = (lane & 15) << 4, kb0 = 16 * h;
  i32x8 ring[D][NSLOT];
#pragma unroll
  for (int d = 0; d < D; ++d)
#pragma unroll
    for (int i = 0; i < NSLOT; ++i) ring[d][i] = ld_pair((const i32x4*)(wp[i] + (2 * d) * 64), (const i32x4*)(wp[i] + (2 * d + 1) * 64));
#pragma unroll 1
  for (int p0 = 0; p0 < NP; p0 += D) {
#pragma unroll
    for (int d = 0; d < D; ++d) {
      const int s = 2 * (p0 + d);
      const int ko0 = ((s * 32) + kb0) ^ swz, ko1 = (((s + 1) * 32) + kb0) ^ swz;
#pragma unroll
      for (int rb = 0; rb < 2; ++rb) {
        const i32x4 f0 = *(const LAS i32x4*)(ap + rb * 32 * pitch + ko0), f1 = *(const LAS i32x4*)(ap + rb * 32 * pitch + ko1);
        const i32x8 fa = __builtin_shufflevector(f0, f1, 0, 1, 2, 3, 4, 5, 6, 7);
#pragma unroll
        for (int i = 0; i < NSLOT; ++i) { constexpr int dummy = 0; (void)dummy; const int ai = (MAP >> (4 * i)) & 15;
          acc[ai][rb] = TR ? mfma_mx8(ring[d][i], fa, acc[ai][rb]) : mfma_mx8(fa, ring[d][i], acc[ai][rb]); }
      }
      if (p0 + d + D < NP) {
#pragma unroll
        for (int i = 0; i < NSLOT; ++i) ring[d][i] = ld_pair((const i32x4*)(wp[i] + (2 * (p0 + d + D)) * 64), (const i32x4*)(wp[i] + (2 * (p0 + d + D) + 1) * 64));
      }
    }
  }
}
template <int NBLK> __device__ __forceinline__ void acc_zero(f32x16 (&acc)[NBLK][2]) {
#pragma unroll
  for (int i = 0; i < NBLK; ++i) { acc[i][0] = f32x16{}; acc[i][1] = f32x16{}; }
}

__device__ __forceinline__ void store_img_qk(uchar* img, const f32x16& v, int rr, int f0, int NS, int hi) {
#pragma unroll
  for (int g = 0; g < 4; ++g) { u32x2 w; w.x = pk2(v[4 * g], v[4 * g + 1]); w.y = pk2(v[4 * g + 2], v[4 * g + 3]);
    *(u32x2*)(img + img_qk(rr, f0 + 8 * g + 4 * hi, NS)) = w; }
}
__device__ __forceinline__ void store_img_v(uchar* img, const f32x16& v, int kb, int d, int hi) {
#pragma unroll
  for (int g = 0; g < 4; ++g) { u32x2 w; w.x = pk2(v[4 * g], v[4 * g + 1]); w.y = pk2(v[4 * g + 2], v[4 * g + 3]);
    *(u32x2*)(img + img_v(32 * kb + 8 * g + 4 * hi, d)) = w; }
}
__device__ __forceinline__ void pack_frag(const float* __restrict__ W, int ldw, int k0, int n0, const float* __restrict__ rowscale, u32x4* __restrict__ dst, int lane) {
  const int r = lane & 31, h = lane >> 5;
  const float* p = W + (size_t)(k0 + 8 * h) * ldw + n0 + r;
  float v[8];
#pragma unroll
  for (int j = 0; j < 8; ++j) v[j] = p[(size_t)j * ldw];
  if (rowscale) {
#pragma unroll
    for (int j = 0; j < 8; ++j) v[j] *= rowscale[k0 + 8 * h + j];
  }
  u32x4 w; w.x = pk2(v[0], v[1]); w.y = pk2(v[2], v[3]); w.z = pk2(v[4], v[5]); w.w = pk2(v[6], v[7]);
  dst[lane] = w;
}
__device__ __forceinline__ void pack_frag8(const float* __restrict__ W, int ldw, int k0, int n0, float scale, u32x4* __restrict__ dst, int lane) {
  const int r = lane & 31, h = lane >> 5;
  const float* p = W + (size_t)(k0 + 16 * h) * ldw + n0 + r;
  float v[16];
#pragma unroll
  for (int j = 0; j < 16; ++j) v[j] = p[(size_t)j * ldw] * scale;
  u32x4 w; w.x = pk4_fp8(v[0], v[1], v[2], v[3]); w.y = pk4_fp8(v[4], v[5], v[6], v[7]); w.z = pk4_fp8(v[8], v[9], v[10], v[11]); w.w = pk4_fp8(v[12], v[13], v[14], v[15]);
  dst[lane] = w;
}
__device__ __forceinline__ void pack_frag8_lo(const float* __restrict__ W, int ldw, int k0, int n0, float scale, u32x4* __restrict__ dst, int lane) {
  const int r = lane & 31, h = lane >> 5;
  const float* p = W + (size_t)(k0 + 16 * h) * ldw + n0 + r;
  float v[16];
#pragma unroll
  for (int j = 0; j < 16; ++j) { const float x = p[(size_t)j * ldw] * scale; const int q = __builtin_amdgcn_cvt_pk_fp8_f32(x, 0.f, 0, false); v[j] = x - __builtin_amdgcn_cvt_f32_fp8(q, 0); }
  u32x4 w; w.x = pk4_fp8(v[0], v[1], v[2], v[3]); w.y = pk4_fp8(v[4], v[5], v[6], v[7]); w.z = pk4_fp8(v[8], v[9], v[10], v[11]); w.w = pk4_fp8(v[12], v[13], v[14], v[15]);
  dst[lane] = w;
}
__device__ __forceinline__ void phase0(const KP& P, LAS uchar* lds) {
  int lane_ = mk_lane(); asm volatile("" : "+v"(lane_)); const int lane = lane_ & 63, wave = P.wave, tid = wave * 64 + lane, bid = blockIdx.x, G = gridDim.x;
  uchar* ws = P.ws;
  if (bid == 0 && tid < 64) ((int*)(ws + WS_CNT))[tid] = 0;
  for (int idx = bid * NTHR + tid; idx < SEQ * 48; idx += G * NTHR) {
    int pos, i, half; float2* dst;
    if (idx < SEQ * 32) { pos = idx >> 5; i = idx & 31; half = 32; dst = (float2*)(ws + WS_TABA) + idx; }
    else { const int i2 = idx - SEQ * 32; pos = i2 >> 4; i = i2 & 15; half = 16; dst = (float2*)(ws + WS_TABB) + i2; }
    const float inv = 1.0f / powf(10000.0f, (float)(2 * i) / (float)(2 * half));
    const float ang = (float)pos * inv;
    *dst = make_float2(cosf(ang), sinf(ang));
  }
  if (bid < 192) {
    const float* c = P.in[1]; const float* w_ada = P.in[2]; const float* b_ada = P.in[3];
    LAS float* sl = (LAS float*)lds; LAS float* part = (LAS float*)(lds + 16384);
    for (int i = tid; i < NB * DM; i += NTHR) { const float v = c[i]; sl[i] = v / (1.f + __expf(-v)); }
    __syncthreads();
    const int n0 = bid * 32, rowl = lane >> 3, c4 = lane & 7;
    f32x4 a0 = {0, 0, 0, 0}, a1 = a0, a2 = a0, a3 = a0;
#pragma unroll 4
    for (int it = 0; it < 16; ++it) {
      const int k = wave * 128 + it * 8 + rowl;
      const f32x4 wv = *(const f32x4*)(w_ada + (size_t)k * (NMOD * DM) + n0 + 4 * c4);
      a0 += wv * sl[k]; a1 += wv * sl[DM + k]; a2 += wv * sl[2 * DM + k]; a3 += wv * sl[3 * DM + k];
    }
#pragma unroll
    for (int e = 0; e < 4; ++e) {
#pragma unroll
      for (int o = 8; o < 64; o <<= 1) { a0[e] += __shfl_xor(a0[e], o); a1[e] += __shfl_xor(a1[e], o); a2[e] += __shfl_xor(a2[e], o); a3[e] += __shfl_xor(a3[e], o); }
    }
    if (rowl == 0) {
#pragma unroll
      for (int e = 0; e < 4; ++e) { part[(wave * 4 + 0) * 32 + 4 * c4 + e] = a0[e]; part[(wave * 4 + 1) * 32 + 4 * c4 + e] = a1[e]; part[(wave * 4 + 2) * 32 + 4 * c4 + e] = a2[e]; part[(wave * 4 + 3) * 32 + 4 * c4 + e] = a3[e]; }
    }
    __syncthreads();
    if (tid < 128) { const int bb = tid >> 5, col = tid & 31; float s = b_ada[n0 + col];
#pragma unroll
      for (int w = 0; w < 8; ++w) s += part[(w * 4 + bb) * 32 + col];
      ((float*)(ws + WS_MOD))[bb * (NMOD * DM) + n0 + col] = s; }
  }
  const int gw = bid * NWAVE + wave, NGW = G * NWAVE;
  for (int f = gw; f < 43 * 32; f += NGW) { const int slot = f >> 5, s = f & 31;
    if (slot < 35) pack_frag8(P.in[5], INW, 32 * s, 32 * slot, WIN_SCALE, (u32x4*)(ws + WS_WIN) + (size_t)f * 64, lane);
    else { const int blk = slot < 39 ? 20 + (slot - 35) : 30 + (slot - 39); pack_frag8_lo(P.in[5], INW, 32 * s, 32 * blk, WIN_SCALE, (u32x4*)(ws + WS_WIN) + (size_t)f * 64, lane); } }
  for (int f = gw; f < 32 * 64; f += NGW) pack_frag(P.in[13], DM, 16 * (f & 63), 32 * (f >> 6), nullptr, (u32x4*)(ws + WS_WOUT) + (size_t)f * 64, lane);
  for (int f = gw; f < 24 * 12; f += NGW) pack_frag(P.in[7], 768, 16 * (f % 12), 32 * (f / 12), P.in[6], (u32x4*)(ws + WS_WUQ) + (size_t)f * 64, lane);
  for (int f = gw; f < 32 * 8; f += NGW) pack_frag(P.in[9], 1024, 16 * (f & 7), 32 * (f >> 3), P.in[8], (u32x4*)(ws + WS_WUKV) + (size_t)f * 64, lane);
  for (int f = gw; f < 2 * 64; f += NGW) {
    const int nb = f >> 6, s = f & 63, r = lane & 31, h = lane >> 5, col = 32 * nb + r;
    float v[8];
#pragma unroll
    for (int j = 0; j < 8; ++j) { const int k = 16 * s + 8 * h + j; v[j] = col < 4 ? P.in[15][k * 4 + col] : (col < 36 ? P.in[17][k * 32 + col - 4] : 0.f); }
    u32x4 w; w.x = pk2(v[0], v[1]); w.y = pk2(v[2], v[3]); w.z = pk2(v[4], v[5]); w.w = pk2(v[6], v[7]);
    ((u32x4*)(ws + WS_WR) + (size_t)f * 64)[lane] = w;
  }
}

__device__ __forceinline__ void rope64(const f32x16& xa, const f32x16& xb, f32x16& ya, f32x16& yb, const float2* __restrict__ trow, int hi, float scale) {
#pragma unroll
  for (int g = 0; g < 4; ++g) {
    const f32x4 t0 = *(const f32x4*)(trow + 8 * g + 4 * hi), t1 = *(const f32x4*)(trow + 8 * g + 4 * hi + 2);
    const float cc[4] = {t0[0], t0[2], t1[0], t1[2]}, sn[4] = {t0[1], t0[3], t1[1], t1[3]};
#pragma unroll
    for (int i = 0; i < 4; ++i) { const int reg = 4 * g + i; ya[reg] = (xa[reg] * cc[i] - xb[reg] * sn[i]) * scale; yb[reg] = (xb[reg] * cc[i] + xa[reg] * sn[i]) * scale; }
  }
}
__device__ __forceinline__ void rope32(const f32x16& x, f32x16& y, const float2* __restrict__ trow, int hi, float scale) {
#pragma unroll
  for (int g = 0; g < 2; ++g) {
    const f32x4 t0 = *(const f32x4*)(trow + 8 * g + 4 * hi), t1 = *(const f32x4*)(trow + 8 * g + 4 * hi + 2);
    const float cc[4] = {t0[0], t0[2], t1[0], t1[2]}, sn[4] = {t0[1], t0[3], t1[1], t1[3]};
#pragma unroll
    for (int i = 0; i < 4; ++i) { const int reg = 4 * g + i; y[reg] = (x[reg] * cc[i] - x[reg + 8] * sn[i]) * scale; y[reg + 8] = (x[reg + 8] * cc[i] + x[reg] * sn[i]) * scale; }
  }
}
__device__ __forceinline__ float write_c_tile(LAS uchar* base, int pitch, const f32x16& vin, int rr, int f0, int hi) {
  const f32x16 v = vin * WIN_DESCALE;
  float ss = 0.f;
#pragma unroll
  for (int g = 0; g < 4; ++g) { u32x2 w; w.x = pk2(v[4 * g], v[4 * g + 1]); w.y = pk2(v[4 * g + 2], v[4 * g + 3]);
    *(LAS u32x2*)(base + a_off(rr, 2 * (f0 + 8 * g + 4 * hi), pitch)) = w;
    ss += v[4 * g] * v[4 * g] + v[4 * g + 1] * v[4 * g + 1] + v[4 * g + 2] * v[4 * g + 2] + v[4 * g + 3] * v[4 * g + 3]; }
  return ss;
}
__device__ __forceinline__ void store_img8_qk(uchar* img, const f32x16& v, int rb, int r32, int blk, int hi) {
#pragma unroll
  for (int g = 0; g < 4; ++g) { const unsigned w = pk4_fp8(v[4 * g], v[4 * g + 1], v[4 * g + 2], v[4 * g + 3]);
    const int off = blk < 2 ? rb * 4096 + (g >> 1) * 1024 + (blk * 32 + r32) * 16 + 8 * (g & 1) + 4 * hi : rb * 4096 + 2048 + ((g >> 1) * 32 + r32) * 16 + 8 * (g & 1) + 4 * hi;
    *(unsigned*)(img + off) = w; }
}
__device__ __forceinline__ void store_img8_v(uchar* img, const f32x16& v, int rb, int db, int r32, int hi) {
#pragma unroll
  for (int g = 0; g < 4; ++g) *(unsigned*)(img + db * 2048 + rb * 1024 + (hi * 32 + r32) * 16 + 4 * g) = pk4_fp8(v[4 * g], v[4 * g + 1], v[4 * g + 2], v[4 * g + 3]);
}
__device__ __forceinline__ void lds_fadd(LAS float* p, float v) { __hip_atomic_fetch_add(p, v, __ATOMIC_RELAXED, __HIP_MEMORY_SCOPE_WORKGROUP); }

__device__ __forceinline__ void phase1_tile(const KP& P, LAS uchar* lds, const int tile) {
  int lane_ = mk_lane(); asm volatile("" : "+v"(lane_)); const int lane = lane_ & 63, wave = P.wave, tid = wave * 64 + lane, r32 = lane & 31, hi = lane >> 5;
  uchar* ws = P.ws;
  const int t0 = tile * 64, b = t0 / SEQ, pos0 = t0 % SEQ, tb = pos0 >> 6;
  const float* __restrict__ x = P.in[0]; const float* __restrict__ mod = (const float*)(ws + WS_MOD) + b * (NMOD * DM); const float* __restrict__ g1 = P.in[4];
  LAS float* ssq = (LAS float*)(lds + LDS_MISC + 64);
  LAS uchar* krt = lds + LDS_MISC + 1024;
  const float2* tabA = (const float2*)(ws + WS_TABA); const float2* tabB = (const float2*)(ws + WS_TABB);
  if (tid < 128) ssq[tid] = 0.f;
  {
    f32x4 av[4], sv[4];
#pragma unroll
    for (int i = 0; i < 4; ++i) { const int k = 4 * (lane + 64 * i); const f32x4 g = *(const f32x4*)(g1 + k), sc = *(const f32x4*)(mod + DM + k); av[i] = g * (sc + 1.0f); sv[i] = *(const f32x4*)(mod + k); }
#pragma unroll
    for (int hf = 0; hf < 2; ++hf) {
      f32x4 xv[4][4];
#pragma unroll
      for (int rr = 0; rr < 4; ++rr)
#pragma unroll
        for (int i = 0; i < 4; ++i) xv[rr][i] = *(const f32x4*)(x + (size_t)(t0 + wave * 8 + hf * 4 + rr) * DM + 4 * (lane + 64 * i));
#pragma unroll
      for (int rr = 0; rr < 4; ++rr) {
        const int row = wave * 8 + hf * 4 + rr; float ss = 0.f;
#pragma unroll
        for (int i = 0; i < 4; ++i) ss += xv[rr][i][0] * xv[rr][i][0] + xv[rr][i][1] * xv[rr][i][1] + xv[rr][i][2] * xv[rr][i][2] + xv[rr][i][3] * xv[rr][i][3];
        ss = wave_sum(ss); const float rs = rsqrtf(ss * (1.0f / DM) + EPS);
#pragma unroll
        for (int i = 0; i < 4; ++i) { const f32x4 v = xv[rr][i] * rs * av[i] + sv[i];
          *(LAS unsigned*)(lds + a_off(row, 4 * (lane + 64 * i), 1024)) = pk4_fp8(v[0], v[1], v[2], v[3]); }
      }
    }
  }
  __syncthreads();
  const l64x2* WIN = (const l64x2*)(ws + WS_WIN);
#define WSLOT(slot) (WIN + (size_t)((slot) * 32) * 64 + lane)
  f32x16 acc[4][2]; acc_zero<4>(acc);
  f32x16 acc2[1][2]; acc_zero<1>(acc2);
  if (wave < 4) {
    { const l64x2* wp[4] = {WSLOT(4 * wave), WSLOT(4 * wave + 1), WSLOT(4 * wave + 2), WSLOT(4 * wave + 3)}; gemm_slots_f8<4, 4, 32, true, 1, 0x3210>(acc, lds, 1024, wp, lane); }
    if (wave < 3) { const l64x2* wp[1] = {WSLOT(wave == 0 ? 34 : 27 + wave)}; gemm_slots_f8<1, 1, 32, true, 2, 0x0>(acc2, lds, 1024, wp, lane); }
  } else if (wave == 4) {
    { const l64x2* wp[4] = {WSLOT(16), WSLOT(17), WSLOT(18), WSLOT(19)}; gemm_slots_f8<4, 4, 32, true, 1, 0x3210>(acc, lds, 1024, wp, lane); }
    { const l64x2* wp[2] = {WSLOT(33), WSLOT(42)}; gemm_slots_f8<2, 1, 32, true, 1, 0x00>(acc2, lds, 1024, wp, lane); }
  } else if (wave == 7) {
    { const l64x2* wp[4] = {WSLOT(30), WSLOT(39), WSLOT(31), WSLOT(40)}; gemm_slots_f8<4, 4, 32, true, 1, 0x1100>(acc, lds, 1024, wp, lane); }
    { const l64x2* wp[2] = {WSLOT(32), WSLOT(41)}; gemm_slots_f8<2, 4, 32, true, 1, 0x22>(acc, lds, 1024, wp, lane); }
  } else {
    const int kv = wave - 5;
    { const l64x2* wp[4] = {WSLOT(20 + 2 * kv), WSLOT(35 + 2 * kv), WSLOT(21 + 2 * kv), WSLOT(36 + 2 * kv)}; gemm_slots_f8<4, 4, 32, false, 1, 0x1100>(acc, lds, 1024, wp, lane); }
    { const l64x2* wp[2] = {WSLOT(24 + 2 * kv), WSLOT(25 + 2 * kv)}; gemm_slots_f8<2, 4, 32, true, 1, 0x32>(acc, lds, 1024, wp, lane); }
  }
#undef WSLOT
  int tid2_ = mk_lane(); asm volatile("" : "+v"(tid2_)); const int lane2 = tid2_ & 63;
#define lane lane2
  const int r32e = lane2 & 31, hie = lane2 >> 5;
#define r32 r32e
#define hi hie
  if (wave < 4) {
#pragma unroll
    for (int p = 0; p < 2; ++p) { uchar* img = ws + WS_QA + ((size_t)(b * 8 + 2 * wave + p) * 64 + tb) * 8192;
#pragma unroll
      for (int rb = 0; rb < 2; ++rb) { const int rr = 32 * rb + r32; f32x16 ya, yb; rope64(acc[2 * p][rb], acc[2 * p + 1][rb], ya, yb, tabA + (size_t)(pos0 + rr) * 32, hi, QSCALE_A * WIN_DESCALE);
        store_img_qk(img, ya, rr, 0, 4, hi); store_img_qk(img, yb, rr, 32, 4, hi); } }
    if (wave == 0) {
#pragma unroll
      for (int rb = 0; rb < 2; ++rb) { const int rr = 32 * rb + r32; f32x16 y; rope32(acc2[0][rb], y, tabB + (size_t)(pos0 + rr) * 16, hi, WIN_DESCALE);
#pragma unroll
        for (int g = 0; g < 4; ++g) { u32x2 w; w.x = pk2(y[4 * g], y[4 * g + 1]); w.y = pk2(y[4 * g + 2], y[4 * g + 3]); *(LAS u32x2*)(krt + rr * 64 + (8 * g + 4 * hi) * 2) = w; } }
    }
  } else if (wave == 4) {
#pragma unroll
    for (int p = 0; p < 2; ++p) { uchar* img = ws + WS_KVA + ((size_t)(b * 2 + p) * 64 + tb) * 16384;
#pragma unroll
      for (int rb = 0; rb < 2; ++rb) { const int rr = 32 * rb + r32; f32x16 ya, yb; rope64(acc[2 * p][rb], acc[2 * p + 1][rb], ya, yb, tabA + (size_t)(pos0 + rr) * 32, hi, WIN_DESCALE);
        store_img_qk(img, ya, rr, 0, 4, hi); store_img_qk(img, yb, rr, 32, 4, hi); } }
  } else if (wave == 5 || wave == 6) {
    uchar* img = ws + WS_KVA + ((size_t)(b * 2 + (wave - 5)) * 64 + tb) * 16384 + 8192;
#pragma unroll
    for (int i = 0; i < 2; ++i)
#pragma unroll
      for (int rb = 0; rb < 2; ++rb) { const f32x16 y = acc[i][rb] * WIN_DESCALE; store_img_v(img, y, rb, 32 * i + r32, hi); }
  }
  __syncthreads();
  if (wave != 0 && wave != 3) {
#pragma unroll
    for (int rb = 0; rb < 2; ++rb) { const int rr = 32 * rb + r32; float sq = 0.f, skv = 0.f;
      if (wave == 5 || wave == 6) { sq += write_c_tile(lds, 512, acc[2][rb], rr, 64 * (wave - 5), hi); sq += write_c_tile(lds, 512, acc[3][rb], rr, 64 * (wave - 5) + 32, hi); }
      else if (wave == 1 || wave == 2) sq += write_c_tile(lds, 512, acc2[0][rb], rr, 96 + 32 * wave, hi);
      else if (wave == 7) { skv += write_c_tile(lds + 32768, 256, acc[0][rb], rr, 0, hi); skv += write_c_tile(lds + 32768, 256, acc[1][rb], rr, 32, hi); skv += write_c_tile(lds + 32768, 256, acc[2][rb], rr, 64, hi); }
      else skv += write_c_tile(lds + 32768, 256, acc2[0][rb], rr, 96, hi);
      if (wave == 4 || wave == 7) lds_fadd(&ssq[64 + rr], skv); else lds_fadd(&ssq[rr], sq); }
  }
  __syncthreads();
  const int head = wave;
  uchar* imgQ = ws + WS_QB + ((size_t)(b * 8 + head) * 64 + tb) * 8192;
  uchar* imgKV = ws + WS_KVB + ((size_t)(b * 8 + head) * 64 + tb) * 12288;
  {
    f32x16 aq[3][2]; acc_zero<3>(aq);
    const bf16x8* wp[3];
#pragma unroll
    for (int i = 0; i < 3; ++i) wp[i] = (const bf16x8*)(ws + WS_WUQ) + (size_t)((3 * head + i) * 12) * 64 + lane;
    gemm_tile<3, 12, true>(aq, lds, 512, wp, lane);
#pragma unroll
    for (int rb = 0; rb < 2; ++rb) { const int rr = 32 * rb + r32; const float sc = rsqrtf(ssq[rr] * (1.0f / 192.0f) + EPS) * (8.0f * QSCALE_B);
      f32x16 y0 = aq[0][rb] * sc, y1 = aq[1][rb] * sc, y2; rope32(aq[2][rb], y2, tabB + (size_t)(pos0 + rr) * 16, hi, sc);
      store_img8_qk(imgQ, y0, rb, r32, 0, hi); store_img8_qk(imgQ, y1, rb, r32, 1, hi); store_img8_qk(imgQ, y2, rb, r32, 2, hi);
      *(u32x4*)(imgQ + rb * 4096 + 3072 + lane * 16) = u32x4{0u, 0u, 0u, 0u}; }
  }
  {
    f32x16 ak[2][2]; acc_zero<2>(ak);
    const bf16x8* wp[2];
#pragma unroll
    for (int i = 0; i < 2; ++i) wp[i] = (const bf16x8*)(ws + WS_WUKV) + (size_t)((4 * head + i) * 8) * 64 + lane;
    gemm_tile<2, 8, true>(ak, lds + 32768, 256, wp, lane);
#pragma unroll
    for (int rb = 0; rb < 2; ++rb) { const int rr = 32 * rb + r32; const float sc = rsqrtf(ssq[64 + rr] * (1.0f / 128.0f) + EPS);
      f32x16 y0 = ak[0][rb] * sc, y1 = ak[1][rb] * sc; store_img8_qk(imgKV, y0, rb, r32, 0, hi); store_img8_qk(imgKV, y1, rb, r32, 1, hi); }
#pragma unroll
    for (int rb = 0; rb < 2; ++rb) {
      const u32x4 c0 = *(const LAS u32x4*)(krt + (32 * rb + r32) * 64 + hi * 32), c1 = *(const LAS u32x4*)(krt + (32 * rb + r32) * 64 + hi * 32 + 16);
      u32x4 w;
      w.x = pk4_fp8(__uint_as_float(c0.x << 16), __uint_as_float(c0.x & 0xffff0000u), __uint_as_float(c0.y << 16), __uint_as_float(c0.y & 0xffff0000u));
      w.y = pk4_fp8(__uint_as_float(c0.z << 16), __uint_as_float(c0.z & 0xffff0000u), __uint_as_float(c0.w << 16), __uint_as_float(c0.w & 0xffff0000u));
      w.z = pk4_fp8(__uint_as_float(c1.x << 16), __uint_as_float(c1.x & 0xffff0000u), __uint_as_float(c1.y << 16), __uint_as_float(c1.y & 0xffff0000u));
      w.w = pk4_fp8(__uint_as_float(c1.z << 16), __uint_as_float(c1.z & 0xffff0000u), __uint_as_float(c1.w << 16), __uint_as_float(c1.w & 0xffff0000u));
      *(u32x4*)(imgKV + rb * 4096 + 2048 + lane * 16) = w;
      *(u32x4*)(imgKV + rb * 4096 + 3072 + lane * 16) = u32x4{hi ? 0u : 0x00003838u, 0u, 0u, 0u}; }
  }
  {
    f32x16 avv[2][2]; acc_zero<2>(avv);
    const bf16x8* wp[2];
#pragma unroll
    for (int i = 0; i < 2; ++i) wp[i] = (const bf16x8*)(ws + WS_WUKV) + (size_t)((4 * head + 2 + i) * 8) * 64 + lane;
    gemm_tile<2, 8, false>(avv, lds + 32768, 256, wp, lane);
#pragma unroll
    for (int rb = 0; rb < 2; ++rb) { f32x16 sc;
#pragma unroll
      for (int reg = 0; reg < 16; ++reg) sc[reg] = rsqrtf(ssq[64 + 32 * rb + crow(reg, hi)] * (1.0f / 128.0f) + EPS);
#pragma unroll
      for (int i = 0; i < 2; ++i) { f32x16 y = avv[i][rb] * sc; store_img8_v(imgKV + 8192, y, rb, i, r32, hi); } }
  }
  __syncthreads();
#undef lane
#undef r32
#undef hi
}
__device__ __forceinline__ float tile_max(const f32x16& p0, const f32x16& p1) {
  float t = __builtin_amdgcn_fmed3f(p0[0], p1[0], __builtin_inff());
  asm("v_max3_f32 %0, %0, %1, %2\n\tv_max3_f32 %0, %0, %3, %4\n\tv_max3_f32 %0, %0, %5, %6\n\tv_max3_f32 %0, %0, %7, %8\n\t"
      "v_max3_f32 %0, %0, %9, %10\n\tv_max3_f32 %0, %0, %11, %12\n\tv_max3_f32 %0, %0, %13, %14\n\tv_max3_f32 %0, %0, %15, %16"
      : "+v"(t) : "v"(p0[1]), "v"(p1[1]), "v"(p0[2]), "v"(p1[2]), "v"(p0[3]), "v"(p1[3]), "v"(p0[4]), "v"(p1[4]), "v"(p0[5]), "v"(p1[5]), "v"(p0[6]), "v"(p1[6]), "v"(p0[7]), "v"(p1[7]), "v"(p0[8]), "v"(p1[8]));
  asm("v_max3_f32 %0, %0, %1, %2\n\tv_max3_f32 %0, %0, %3, %4\n\tv_max3_f32 %0, %0, %5, %6\n\tv_max3_f32 %0, %0, %7, %8\n\t"
      "v_max3_f32 %0, %0, %9, %10\n\tv_max3_f32 %0, %0, %11, %12\n\tv_max3_f32 %0, %0, %13, %14"
      : "+v"(t) : "v"(p0[9]), "v"(p1[9]), "v"(p0[10]), "v"(p1[10]), "v"(p0[11]), "v"(p1[11]), "v"(p0[12]), "v"(p1[12]), "v"(p0[13]), "v"(p1[13]), "v"(p0[14]), "v"(p1[14]), "v"(p0[15]), "v"(p1[15]));
  return t;
}
template <bool FIRST_POSSIBLE>
__device__ __forceinline__ float softmax_tile(f32x16& p0, f32x16& p1, f32x16& negm, float& m, float& l, f32x16& o0, f32x16& o1, bool first, bf16x8 (&pb)[2][2]) {
  float applied = 0.f;
  float tmax = half_swap_max(tile_max(p0, p1));
  const bool fst = FIRST_POSSIBLE && first;
  const float dm = fst ? tmax : fmaxf(tmax, 0.f);
  if (fst || __any(dm > THR2)) {
    const float alpha = fst ? 1.0f : __builtin_amdgcn_exp2f(-dm);
    m += dm; l *= alpha; applied = dm;
#pragma unroll
    for (int r = 0; r < 16; ++r) { o0[r] *= alpha; o1[r] *= alpha; p0[r] -= dm; p1[r] -= dm; negm[r] = -m; }
  }
  float s = 0.f;
#pragma unroll
  for (int r = 0; r < 16; ++r) { p0[r] = __builtin_amdgcn_exp2f(p0[r]); p1[r] = __builtin_amdgcn_exp2f(p1[r]); s += p0[r] + p1[r]; }
  l += s;
#pragma unroll
  for (int ks = 0; ks < 2; ++ks) {
    u32x4 w0, w1;
    w0.x = pk2(p0[8 * ks + 0], p0[8 * ks + 1]); w0.y = pk2(p0[8 * ks + 2], p0[8 * ks + 3]); w0.z = pk2(p0[8 * ks + 4], p0[8 * ks + 5]); w0.w = pk2(p0[8 * ks + 6], p0[8 * ks + 7]);
    w1.x = pk2(p1[8 * ks + 0], p1[8 * ks + 1]); w1.y = pk2(p1[8 * ks + 2], p1[8 * ks + 3]); w1.z = pk2(p1[8 * ks + 4], p1[8 * ks + 5]); w1.w = pk2(p1[8 * ks + 6], p1[8 * ks + 7]);
    pb[0][ks] = *reinterpret_cast<bf16x8*>(&w0); pb[1][ks] = *reinterpret_cast<bf16x8*>(&w1);
  }
  return applied;
}
__device__ __forceinline__ void pv_tile(const LAS uchar* vimg, const bf16x8 (&pb)[2][2], f32x16& o0, f32x16& o1, int lane) {
#pragma unroll
  for (int kb = 0; kb < 2; ++kb)
#pragma unroll
    for (int ks = 0; ks < 2; ++ks) {
      const bf16x8 v0 = *(const LAS bf16x8*)(vimg + ((((kb * 2 + 0) * 2 + ks) * 64) + lane) * 16);
      const bf16x8 v1 = *(const LAS bf16x8*)(vimg + ((((kb * 2 + 1) * 2 + ks) * 64) + lane) * 16);
      o0 = mfma(v0, pb[kb][ks], o0); o1 = mfma(v1, pb[kb][ks], o1);
    }
}
__device__ __forceinline__ void store_o(bf16_t* __restrict__ orow, f32x16& o0, f32x16& o1, float l, int hi) {
  const float inv = 1.0f / half_swap_sum(l);
#pragma unroll
  for (int g = 0; g < 4; ++g) {
    u32x2 w; w.x = pk2(o0[4 * g] * inv, o0[4 * g + 1] * inv); w.y = pk2(o0[4 * g + 2] * inv, o0[4 * g + 3] * inv); *(u32x2*)(orow + 8 * g + 4 * hi) = w;
    u32x2 z; z.x = pk2(o1[4 * g] * inv, o1[4 * g + 1] * inv); z.y = pk2(o1[4 * g + 2] * inv, o1[4 * g + 3] * inv); *(u32x2*)(orow + 32 + 8 * g + 4 * hi) = z;
  }
}

__device__ __forceinline__ void store_o_l(bf16_t* __restrict__ orow, f32x16& o0, f32x16& o1, float ltot, int hi) {
  const float inv = 1.0f / ltot;
#pragma unroll
  for (int g = 0; g < 4; ++g) {
    u32x2 w; w.x = pk2(o0[4 * g] * inv, o0[4 * g + 1] * inv); w.y = pk2(o0[4 * g + 2] * inv, o0[4 * g + 3] * inv); *(u32x2*)(orow + 8 * g + 4 * hi) = w;
    u32x2 z; z.x = pk2(o1[4 * g] * inv, o1[4 * g + 1] * inv); z.y = pk2(o1[4 * g + 2] * inv, o1[4 * g + 3] * inv); *(u32x2*)(orow + 32 + 8 * g + 4 * hi) = z;
  }
}
constexpr int SWA_LDS = 49152;
__device__ __forceinline__ void swa_unit(const KP& P, LAS uchar* lds_all, int u, bool prefetched) {
  LAS uchar* lds = lds_all + SWA_LDS;
  int lane_ = mk_lane(); asm volatile("" : "+v"(lane_)); const int lane = lane_ & 63, wave = P.wave, tid = wave * 64 + lane, r32 = lane & 31, hi = lane >> 5;
  uchar* ws = P.ws;
  const int n = u & 31, kvh = (u >> 5) & 1, b = u >> 6;
  const uchar* kvimg = ws + WS_KVA + (size_t)(b * 2 + kvh) * 64 * 16384;
  if (!prefetched) {
#pragma unroll 1
    for (int jt = 0; jt < 6; ++jt) { const int gt = 2 * n - 2 + jt; if (gt < 0 || gt >= 64) continue;
      const u32x4* src = (const u32x4*)(kvimg + (size_t)gt * 16384); LAS u32x4* dst = (LAS u32x4*)(lds + jt * 16384);
      const u32x4 v0 = src[tid], v1 = src[tid + 512]; dst[tid] = v0; dst[tid + 512] = v1; }
  }
  __syncthreads();
  const int rbq = wave & 3, jlo = rbq >> 1;
  bf16_t* O = (bf16_t*)(ws + WS_O);
#pragma unroll 1
  for (int hh = 0; hh < 2; ++hh) {
    const int head = kvh * 4 + 2 * (wave >> 2) + hh;
    const uchar* qimg = ws + WS_QA + ((size_t)(b * 8 + head) * 64 + 2 * n + (rbq >> 1)) * 8192;
    bf16x8 qf[4];
#pragma unroll
    for (int s = 0; s < 4; ++s) qf[s] = *(const bf16x8*)(qimg + ((((rbq & 1) * 4 + s) * 64) + lane) * 16);
    const float sink2 = P.in[10][head] * LOG2E;
    float m = sink2, l = hi ? 0.f : 1.f; f32x16 negm, o0 = {}, o1 = {};
#pragma unroll
    for (int r = 0; r < 16; ++r) negm[r] = -sink2;
#pragma unroll 1
    for (int jt = jlo; jt < jlo + 5; ++jt) { const int gt = 2 * n - 2 + jt; if (gt < 0 || gt >= 64) continue;
      const LAS uchar* kimg = lds + jt * 16384;
      f32x16 p0 = negm, p1 = negm;
#pragma unroll
      for (int s = 0; s < 4; ++s) { const bf16x8 k0 = *(const LAS bf16x8*)(kimg + (((0 * 4 + s) * 64) + lane) * 16), k1 = *(const LAS bf16x8*)(kimg + (((1 * 4 + s) * 64) + lane) * 16);
        p0 = mfma(k0, qf[s], p0); p1 = mfma(k1, qf[s], p1); }
      const int base = 64 * jt - 32 * rbq - r32;
#pragma unroll
      for (int r = 0; r < 16; ++r) { const int d0 = base + crow(r, hi);
        p0[r] = ((unsigned)d0 <= 256u) ? p0[r] : -1e30f; p1[r] = ((unsigned)(d0 + 32) <= 256u) ? p1[r] : -1e30f; }
      bf16x8 pb[2][2];
      (void)softmax_tile<false>(p0, p1, negm, m, l, o0, o1, false, pb);
      pv_tile(kimg + 8192, pb, o0, o1, lane);
    }
    store_o(O + (size_t)(b * SEQ + n * 128 + 32 * rbq + r32) * DM + head * 64, o0, o1, l, hi);
  }
  __syncthreads();
}

#define MK_LDS_RD(dst, vaddr, imm) asm volatile("ds_read_b128 %0, %1 offset:%2" : "=v"(dst) : "v"(vaddr), "i"(imm))
template <int N> __device__ __forceinline__ void lgkm_wait() { asm volatile("s_waitcnt lgkmcnt(%0)" :: "i"(N) : "memory"); __builtin_amdgcn_sched_barrier(0); }
__device__ __forceinline__ void pv_regs(const bf16x8 (&vf)[8], const bf16x8 (&pb)[2][2], f32x16& o0, f32x16& o1) {
#pragma unroll
  for (int kb = 0; kb < 2; ++kb)
#pragma unroll
    for (int ks = 0; ks < 2; ++ks) { o0 = mfma(vf[(kb * 2 + 0) * 2 + ks], pb[kb][ks], o0); o1 = mfma(vf[(kb * 2 + 1) * 2 + ks], pb[kb][ks], o1); }
}
__device__ __forceinline__ void mla_dma_step(const uchar* kvimg, LAS uchar* lds, int t, int wave, int lane) {
  const uchar* src = kvimg + (size_t)t * 24576 + wave * 3072 + lane * 16;
  LAS uchar* dst = lds + (t & 1) * 24576 + wave * 3072;
#pragma unroll
  for (int i = 0; i < 3; ++i) __builtin_amdgcn_global_load_lds((const unsigned*)(src + i * 1024), (LAS unsigned*)(dst + i * 1024), 16, 0, 0);
}
template <bool FIRST_POSSIBLE>
__device__ __forceinline__ float softmax_tile8(f32x16& p0, f32x16& p1, float& pad, int& qpad, f32x16& lacc, f32x16& o0, f32x16& o1, bool first, int hi, i32x4& pb0, i32x4& pb1) {
  float applied = 0.f;
  const float tmax = half_swap_max(tile_max(p0, p1)) * 256.0f;
  const bool fst = FIRST_POSSIBLE && first;
  if (fst || __any(tmax > 120.5f)) {
    const float want = fst ? tmax - 96.5f : fmaxf(tmax - 96.5f, 0.f);
    const float nt = pad - want;
    const int wa = __builtin_amdgcn_cvt_pk_fp8_f32(nt, 0.f, 0, false); const float fa = __builtin_amdgcn_cvt_f32_fp8(wa, 0);
    const int wb = __builtin_amdgcn_cvt_pk_fp8_f32(nt - fa, 0.f, 0, false); const float fb = __builtin_amdgcn_cvt_f32_fp8(wb, 0);
    const float pnew = fa + fb, dt = pad - pnew, dts = dt * (1.0f / 256.0f);
    const float alpha = fst ? 1.0f : __builtin_amdgcn_exp2f(-0.125f * dt);
    pad = pnew; applied = dts; qpad = hi ? 0 : ((wa & 0xff) | ((wb & 0xff) << 8));
#pragma unroll
    for (int r = 0; r < 16; ++r) { o0[r] *= alpha; o1[r] *= alpha; lacc[r] *= alpha; p0[r] -= dts; p1[r] -= dts; }
  }
#define MK_P8(P, R) __builtin_amdgcn_perm(mk_pknorm(P[(R) + 2], P[(R) + 3]), mk_pknorm(P[R], P[(R) + 1]), 0x07050301u)
  pb0.x = (int)MK_P8(p0, 0); pb0.y = (int)MK_P8(p0, 4); pb0.z = (int)MK_P8(p0, 8); pb0.w = (int)MK_P8(p0, 12);
  pb1.x = (int)MK_P8(p1, 0); pb1.y = (int)MK_P8(p1, 4); pb1.z = (int)MK_P8(p1, 8); pb1.w = (int)MK_P8(p1, 12);
#undef MK_P8
  return applied;
}
constexpr int N_PACK_JOBS = 3 * 8192;
struct PackJob { const float* p; int ldw; u32x4* dst; float scale; };
__device__ __forceinline__ PackJob pack_job(const KP& P, int f, int lane) {
  const int which = f >> 13, ff = f & 8191, r = lane & 31, h = lane >> 5, e = ff >> 8; PackJob j;
  if (which < 2) { const int nb = (ff >> 5) & 7, s = ff & 31; j.ldw = 256; j.scale = WGU_SCALE;
    j.p = P.in[19 + which] + (size_t)e * DM * 256 + (size_t)(32 * s + 16 * h) * 256 + 32 * nb + r; j.dst = (u32x4*)(P.ws + (which ? WS_WU : WS_WG)) + (size_t)ff * 64 + lane; }
  else { const int nb = (ff >> 3) & 31, s = ff & 7; j.ldw = DM; j.scale = WD_SCALE;
    j.p = P.in[21] + (size_t)e * 256 * DM + (size_t)(32 * s + 16 * h) * DM + 32 * nb + r; j.dst = (u32x4*)(P.ws + WS_WD) + (size_t)ff * 64 + lane; }
  return j;
}
__device__ __forceinline__ u32x4 pack_cvt(const float (&v)[16], float sc) {
  u32x4 w; w.x = pk4_fp8(v[0] * sc, v[1] * sc, v[2] * sc, v[3] * sc); w.y = pk4_fp8(v[4] * sc, v[5] * sc, v[6] * sc, v[7] * sc);
  w.z = pk4_fp8(v[8] * sc, v[9] * sc, v[10] * sc, v[11] * sc); w.w = pk4_fp8(v[12] * sc, v[13] * sc, v[14] * sc, v[15] * sc); return w;
}
__device__ __forceinline__ void mla_unit(const KP& P, LAS uchar* lds, int b, int head, int qblk, int& pk_k, int swa_u) {
  int lane_ = mk_lane(); asm volatile("" : "+v"(lane_)); const int lane = lane_ & 63, wave = P.wave, r32 = lane & 31, hi = lane >> 5;
  uchar* ws = P.ws;
  const uchar* kvimg = ws + WS_KVB + (size_t)(b * 8 + head) * 64 * 12288;
  const uchar* qimg = ws + WS_QB + ((size_t)(b * 8 + head) * 64 + qblk * 4 + (wave >> 1)) * 8192 + (wave & 1) * 4096 + lane * 16;
  const int gw = blockIdx.x * NWAVE + wave, NGW = gridDim.x * NWAVE;
  const i32x4 q00 = *(const i32x4*)(qimg), q01 = *(const i32x4*)(qimg + 1024), q10 = *(const i32x4*)(qimg + 2048);
  float pad = 56.5f; int qpad = hi ? 0 : 0x3066;
  f32x16 o0 = {}, o1 = {}, lacc = {};
  i32x8 ones8 = {0x38383838, 0x38383838, 0x38383838, 0x38383838, 0x38383838, 0x38383838, 0x38383838, 0x38383838};
  asm volatile("" : "+v"(ones8));
  mla_dma_step(kvimg, lds, 0, wave, lane);
#pragma unroll 1
  for (int t = 0; t < 32; ++t) {
    asm volatile("s_waitcnt vmcnt(0)" ::: "memory");
    __syncthreads();
    if (t + 1 < 32 && !(P.variant & 4)) mla_dma_step(kvimg, lds, t + 1, wave, lane);
    if (P.variant & 8) continue;
    u32x4 bandv = {}; int band_off = -1;
    if (swa_u >= 0 && t >= 20) { const int c = (wave * 64 + lane) + 512 * (t - 20), jt = c >> 10, gt = 2 * (swa_u & 31) - 2 + jt;
      if (gt >= 0 && gt < 64) { band_off = c * 16; bandv = *(const u32x4*)(ws + WS_KVA + ((size_t)((swa_u >> 6) * 2 + ((swa_u >> 5) & 1)) * 64 + gt) * 16384 + (c & 1023) * 16); } }
    const int pf = gw + pk_k * NGW; const bool do_pack = pf < N_PACK_JOBS;
    float pv[16]; u32x4* pdst = nullptr; float psc = 0.f;
    if (do_pack) { const PackJob j = pack_job(P, pf, lane); pdst = j.dst; psc = j.scale;
#pragma unroll
      for (int q = 0; q < 16; ++q) pv[q] = j.p[(size_t)q * j.ldw]; }
    f32x16 a0, a1, b0, b1; i32x4 pb0, pb1;
    { const unsigned va = (unsigned)(unsigned long)(lds + (t & 1) * 24576) + lane * 16;
#define MK_KOFF(j) (((j) >> 2) * 12288 + (((j) >> 1) & 1) * 4096 + ((j) & 1) * 2048)
      i32x4 kf[4][2];
#define MK_KRD(j) { MK_LDS_RD(kf[(j) & 3][0], va, MK_KOFF(j)); MK_LDS_RD(kf[(j) & 3][1], va, MK_KOFF(j) + 1024); }
      MK_KRD(0) MK_KRD(1) MK_KRD(2) MK_KRD(3)
      const i32x4 q11 = {qpad, 0, 0, 0};
#define MK_QK_STEP(j, ACC, NW) { lgkm_wait<NW>(); ACC = ((j) & 1) ? mfma_mx_q(kf[(j) & 3][0], kf[(j) & 3][1], q10, q11, ACC) : mfma_mx_q(kf[(j) & 3][0], kf[(j) & 3][1], q00, q01, f32x16{}); if ((j) + 4 < 8) MK_KRD(((j) + 4) & 7) }
      MK_QK_STEP(0, a0, 6) MK_QK_STEP(1, a0, 6) MK_QK_STEP(2, a1, 6) MK_QK_STEP(3, a1, 6) MK_QK_STEP(4, b0, 6) MK_QK_STEP(5, b0, 4) MK_QK_STEP(6, b1, 2) MK_QK_STEP(7, b1, 0)
#undef MK_QK_STEP
#undef MK_KRD
#undef MK_KOFF
      i32x4 vf[4];
#define MK_VRD(tile) { MK_LDS_RD(vf[0], va, (tile) * 12288 + 8192); MK_LDS_RD(vf[1], va, (tile) * 12288 + 8192 + 1024); MK_LDS_RD(vf[2], va, (tile) * 12288 + 8192 + 2048); MK_LDS_RD(vf[3], va, (tile) * 12288 + 8192 + 3072); }
      MK_VRD(0)
      const float dA = softmax_tile8<true>(a0, a1, pad, qpad, lacc, o0, o1, t == 0, hi, pb0, pb1);
      lacc = mfma_mx8(ones8, __builtin_shufflevector(pb0, pb1, 0, 1, 2, 3, 4, 5, 6, 7), lacc);
      lgkm_wait<0>();
      o0 = mfma_mx(vf[0], vf[1], pb0, pb1, o0); o1 = mfma_mx(vf[2], vf[3], pb0, pb1, o1);
      MK_VRD(1)
#undef MK_VRD
      if (__any(dA != 0.f)) {
#pragma unroll
        for (int r = 0; r < 16; ++r) { b0[r] -= dA; b1[r] -= dA; }
      }
      (void)softmax_tile8<false>(b0, b1, pad, qpad, lacc, o0, o1, false, hi, pb0, pb1);
      lacc = mfma_mx8(ones8, __builtin_shufflevector(pb0, pb1, 0, 1, 2, 3, 4, 5, 6, 7), lacc);
      lgkm_wait<0>();
      o0 = mfma_mx(vf[0], vf[1], pb0, pb1, o0); o1 = mfma_mx(vf[2], vf[3], pb0, pb1, o1);
    }
    if (do_pack) { *pdst = pack_cvt(pv, psc); ++pk_k; }
    if (band_off >= 0) *(LAS u32x4*)(lds + SWA_LDS + band_off) = bandv;
  }
  if (!(P.variant & 12)) store_o_l((bf16_t*)(ws + WS_O) + (size_t)(b * SEQ + qblk * 256 + 32 * wave + r32) * DM + 512 + head * 64, o0, o1, lacc[0], hi);
  __syncthreads();
}
__device__ __forceinline__ void phase2(const KP& P, LAS uchar* lds) {
  const int bid = blockIdx.x;
  int pk_k = 0;
  const bool pref = gridDim.x == 256 && !(P.variant & 3);
  if (!(P.variant & 2)) for (int i = bid; i < 512; i += gridDim.x) {
    const int rr = i >> 8, ii = i & 255, xcd = ii & 7, local = ii >> 3, pair = xcd * 4 + rr * 2 + (local >> 4), qblk = local & 15;
    mla_unit(P, lds, pair >> 3, pair & 7, qblk, pk_k, (pref && i >= 256) ? bid : -1);
  }
  if (!(P.variant & 1)) for (int u = bid; u < 256; u += gridDim.x) swa_unit(P, lds, u, pref);
  { const int lane = mk_lane(), wave = P.wave, gw = bid * NWAVE + wave, NGW = gridDim.x * NWAVE;
    for (int f = gw + pk_k * NGW; f < N_PACK_JOBS; f += NGW) { const PackJob j = pack_job(P, f, lane); float v[16];
#pragma unroll
      for (int q = 0; q < 16; ++q) v[q] = j.p[(size_t)q * j.ldw];
      *j.dst = pack_cvt(v, j.scale); } }
}
__device__ __forceinline__ void phase3_tile(const KP& P, LAS uchar* lds, const int tile) {
  int lane_ = mk_lane(); asm volatile("" : "+v"(lane_)); const int lane = lane_ & 63, wave = P.wave, tid = wave * 64 + lane, r32 = lane & 31, hi = lane >> 5;
  uchar* ws = P.ws;
  const int t0 = tile * 64, b = t0 / SEQ;
  const float* __restrict__ x = P.in[0]; const float* __restrict__ mod = (const float*)(ws + WS_MOD) + b * (NMOD * DM);
  LAS float* ssq = (LAS float*)(lds + LDS_MISC + 64);
  LAS int* selE = (LAS int*)(lds + LDS_MISC + 1024);
  LAS float* selW = (LAS float*)(lds + LDS_MISC + 1536);
  LAS int* selP = (LAS int*)(lds + LDS_MISC + 2048);
  LAS int* cntl = (LAS int*)(lds + LDS_MISC + 2560);
  LAS int* basel = (LAS int*)(lds + LDS_MISC + 2688);
  LAS float* logit = (LAS float*)(lds + LDS_MISC + 8192);
  if (tid < 64) ssq[tid] = 0.f;
  if (tid < 32) cntl[tid] = 0;
  {
    const bf16_t* O = (const bf16_t*)(ws + WS_O);
    float ga[8], gb[8];
#pragma unroll
    for (int j = 0; j < 8; ++j) { ga[j] = P.in[11][8 * lane + j]; gb[j] = P.in[12][8 * lane + j]; }
#pragma unroll
    for (int hf = 0; hf < 2; ++hf) {
      u32x4 va[4], vb[4];
#pragma unroll
      for (int rr = 0; rr < 4; ++rr) { const u32x4* src = (const u32x4*)(O + (size_t)(t0 + wave * 8 + hf * 4 + rr) * DM); va[rr] = src[lane]; vb[rr] = src[lane + 64]; }
#pragma unroll
      for (int rr = 0; rr < 4; ++rr) {
        const int row = wave * 8 + hf * 4 + rr; float fa[8], fb[8], sa = 0.f, sb = 0.f;
#pragma unroll
        for (int q = 0; q < 4; ++q) { fa[2 * q] = __uint_as_float(va[rr][q] << 16); fa[2 * q + 1] = __uint_as_float(va[rr][q] & 0xffff0000u);
          fb[2 * q] = __uint_as_float(vb[rr][q] << 16); fb[2 * q + 1] = __uint_as_float(vb[rr][q] & 0xffff0000u); }
#pragma unroll
        for (int j = 0; j < 8; ++j) { sa += fa[j] * fa[j]; sb += fb[j] * fb[j]; }
        sa = wave_sum(sa); sb = wave_sum(sb);
        const float ra = rsqrtf(sa * (1.0f / 512.0f) + EPS), rb_ = rsqrtf(sb * (1.0f / 512.0f) + EPS);
        u32x4 wa, wb;
#pragma unroll
        for (int q = 0; q < 4; ++q) { wa[q] = pk2(fa[2 * q] * ra * ga[2 * q], fa[2 * q + 1] * ra * ga[2 * q + 1]); wb[q] = pk2(fb[2 * q] * rb_ * gb[2 * q], fb[2 * q + 1] * rb_ * gb[2 * q + 1]); }
        *(LAS u32x4*)(lds + a_off(row, 16 * lane, 2048)) = wa; *(LAS u32x4*)(lds + a_off(row, 16 * (lane + 64), 2048)) = wb;
      }
    }
  }
  __syncthreads();
  f32x16 acc[4][2]; acc_zero<4>(acc);
  { const bf16x8* wp[4];
#pragma unroll
    for (int i = 0; i < 4; ++i) wp[i] = (const bf16x8*)(ws + WS_WOUT) + (size_t)((4 * wave + i) * 64) * 64 + lane;
    gemm_tile<4, 64, false, 5>(acc, lds, 2048, wp, lane); }
  if (P.variant & 2) { asm volatile("" :: "v"(acc[0][0][0]), "v"(acc[1][1][3]), "v"(acc[2][0][7]), "v"(acc[3][1][15])); return; }
  bf16_t* X1 = (bf16_t*)(ws + WS_X1);
  float gt[4];
#pragma unroll
  for (int i = 0; i < 4; ++i) gt[i] = mod[2 * DM + 128 * wave + 32 * i + r32];
#pragma unroll
  for (int rb = 0; rb < 2; ++rb) {
    float xr[16][4];
#pragma unroll
    for (int reg = 0; reg < 16; ++reg) { const size_t off = (size_t)(t0 + 32 * rb + crow(reg, hi)) * DM + 128 * wave + r32;
#pragma unroll
      for (int i = 0; i < 4; ++i) xr[reg][i] = x[off + 32 * i]; }
#pragma unroll
    for (int reg = 0; reg < 16; ++reg) { const int row = 32 * rb + crow(reg, hi); const size_t off = (size_t)(t0 + row) * DM + 128 * wave + r32; float ss = 0.f;
#pragma unroll
      for (int i = 0; i < 4; ++i) { const float v = xr[reg][i] + gt[i] * acc[i][rb][reg]; acc[i][rb][reg] = v; X1[off + 32 * i] = (bf16_t)(pk2(v, 0.f) & 0xffffu); ss += v * v; }
#pragma unroll
      for (int o = 16; o; o >>= 1) ss += __shfl_xor(ss, o);
      if (r32 == 0) lds_fadd(&ssq[row], ss); }
  }
  __syncthreads();
  { float a2[4], s2[4];
#pragma unroll
    for (int i = 0; i < 4; ++i) { const int col = 128 * wave + 32 * i + r32; a2[i] = P.in[14][col] * (1.0f + mod[4 * DM + col]); s2[i] = mod[3 * DM + col]; }
#pragma unroll
    for (int rb = 0; rb < 2; ++rb)
#pragma unroll
      for (int reg = 0; reg < 16; ++reg) { const int row = 32 * rb + crow(reg, hi); const float rs = rsqrtf(ssq[row] * (1.0f / DM) + EPS);
#pragma unroll
        for (int i = 0; i < 4; ++i) { const float v = acc[i][rb][reg] * rs * a2[i] + s2[i]; const int col = 128 * wave + 32 * i + r32;
          *(LAS bf16_t*)(lds + a_off(row, 2 * col, 2048)) = (bf16_t)(pk2(v, v) & 0xffffu); } }
  }
  __syncthreads();
  if (P.variant & 1) return;
  if (wave < 4) {
    f32x16 ar[1][2]; acc_zero<1>(ar);
    const bf16x8* wp[1]; wp[0] = (const bf16x8*)(ws + WS_WR) + (size_t)((wave >> 1) * 64) * 64 + lane;
    gemm_tile<1, 64, false>(ar, lds, 2048, wp, lane);
    const int rb = wave & 1, col = 32 * (wave >> 1) + r32;
#pragma unroll
    for (int reg = 0; reg < 16; ++reg) { const float v = rb ? ar[0][1][reg] : ar[0][0][reg]; logit[(32 * rb + crow(reg, hi)) * 64 + col] = v; }
  }
  { uchar* H2 = ws + WS_H2;
#pragma unroll
    for (int rr = 0; rr < 8; ++rr) { const int row = wave * 8 + rr;
      const u32x4 v0 = *(const LAS u32x4*)(lds + a_off(row, 16 * lane, 2048)), v1 = *(const LAS u32x4*)(lds + a_off(row, 16 * (lane + 64), 2048));
      u32x2 w0, w1;
      w0.x = pk4_fp8(__uint_as_float(v0.x << 16) * H2_SCALE, __uint_as_float(v0.x & 0xffff0000u) * H2_SCALE, __uint_as_float(v0.y << 16) * H2_SCALE, __uint_as_float(v0.y & 0xffff0000u) * H2_SCALE);
      w0.y = pk4_fp8(__uint_as_float(v0.z << 16) * H2_SCALE, __uint_as_float(v0.z & 0xffff0000u) * H2_SCALE, __uint_as_float(v0.w << 16) * H2_SCALE, __uint_as_float(v0.w & 0xffff0000u) * H2_SCALE);
      w1.x = pk4_fp8(__uint_as_float(v1.x << 16) * H2_SCALE, __uint_as_float(v1.x & 0xffff0000u) * H2_SCALE, __uint_as_float(v1.y << 16) * H2_SCALE, __uint_as_float(v1.y & 0xffff0000u) * H2_SCALE);
      w1.y = pk4_fp8(__uint_as_float(v1.z << 16) * H2_SCALE, __uint_as_float(v1.z & 0xffff0000u) * H2_SCALE, __uint_as_float(v1.w << 16) * H2_SCALE, __uint_as_float(v1.w & 0xffff0000u) * H2_SCALE);
      u32x2* dst = (u32x2*)(H2 + (size_t)(t0 + row) * DM); dst[lane] = w0; dst[lane + 64] = w1; } }
  __syncthreads();
  if (tid < 64) {
    const float* lg = (const float*)0; (void)lg;
    float gl[4];
#pragma unroll
    for (int i = 0; i < 4; ++i) gl[i] = logit[tid * 64 + i] + P.in[16][i];
    int gi = 0; float gm = gl[0];
#pragma unroll
    for (int i = 1; i < 4; ++i) if (gl[i] > gm) { gm = gl[i]; gi = i; }
    float gs = 0.f;
#pragma unroll
    for (int i = 0; i < 4; ++i) gs += __expf(gl[i] - gm);
    const float gw = 1.0f / gs;
    float el[8];
#pragma unroll
    for (int i = 0; i < 8; ++i) el[i] = logit[tid * 64 + 4 + gi * 8 + i] + P.in[18][gi * 8 + i];
    int i1 = 0; float m1 = el[0];
#pragma unroll
    for (int i = 1; i < 8; ++i) if (el[i] > m1) { m1 = el[i]; i1 = i; }
    int i2 = (i1 + 1) & 7; float m2 = el[i2];
#pragma unroll
    for (int i = 0; i < 8; ++i) if (i != i1 && el[i] > m2) { m2 = el[i]; i2 = i; }
    const float p2 = __expf(m2 - m1), w1 = 1.0f / (1.0f + p2), w2 = p2 * w1;
    const int e1 = gi * 8 + i1, e2 = gi * 8 + i2;
    selE[2 * tid] = e1; selE[2 * tid + 1] = e2; selW[2 * tid] = gw * w1; selW[2 * tid + 1] = gw * w2;
    selP[2 * tid] = __hip_atomic_fetch_add(&cntl[e1], 1, __ATOMIC_RELAXED, __HIP_MEMORY_SCOPE_WORKGROUP);
    selP[2 * tid + 1] = __hip_atomic_fetch_add(&cntl[e2], 1, __ATOMIC_RELAXED, __HIP_MEMORY_SCOPE_WORKGROUP);
  }
  __syncthreads();
  if (tid < 32) { const int c = cntl[tid]; basel[tid] = c ? atomicAdd((int*)(ws + WS_CNT) + tid, c) : 0; }
  __syncthreads();
  if (tid < 128) { const int e = selE[tid], pos = basel[e] + selP[tid];
    ((int*)(ws + WS_LIST))[(size_t)e * 16384 + pos] = (t0 + (tid >> 1)) * 2 + (tid & 1);
    ((float*)(ws + WS_WT))[(size_t)(t0 + (tid >> 1)) * 2 + (tid & 1)] = selW[tid]; }
  __syncthreads();
}

constexpr int P4_ROWS = 144, P4_NRB = 5, P4_MISC = P4_ROWS * 1024;
__device__ __forceinline__ void phase4(const KP& P, LAS uchar* lds) {
  int lane_ = mk_lane(); asm volatile("" : "+v"(lane_)); const int lane = lane_ & 63, wave = P.wave, tid = wave * 64 + lane, r32 = lane & 31, hi = lane >> 5;
  uchar* ws = P.ws;
  LAS int* rinfo = (LAS int*)(lds + P4_MISC + 1024);
  LAS float* rwt = (LAS float*)(lds + P4_MISC + 2048);
  LAS int* ustart = (LAS int*)(lds + P4_MISC + 3072);
  const int* cnt = (const int*)(ws + WS_CNT);
  if (tid == 0) { int acc_ = 0; for (int e = 0; e < 32; ++e) { ustart[e] = acc_; acc_ += (cnt[e] + P4_ROWS - 1) / P4_ROWS; } ustart[32] = acc_; }
  __syncthreads();
  const int total = ustart[32];
  const uchar* H2 = ws + WS_H2; bf16_t* Y = (bf16_t*)(ws + WS_Y);
#pragma unroll 1
  for (int u = blockIdx.x; u < total; u += gridDim.x) {
    int e = 0;
#pragma unroll 1
    for (int k = 1; k < 32; ++k) if (ustart[k] <= u) e = k;
    const int ne = cnt[e], ke = ustart[e + 1] - ustart[e], q = (ne + ke - 1) / ke, j = u - ustart[e], base = j * q, len = min(q, ne - base), nrb = (len + 31) >> 5;
    if (tid < 160) { int info = -1; float w = 0.f;
      if (tid < len) { info = ((const int*)(ws + WS_LIST))[(size_t)e * 16384 + base + tid]; w = ((const float*)(ws + WS_WT))[info]; }
      rinfo[tid] = info; rwt[tid] = w; }
    __syncthreads();
#pragma unroll
    for (int hf = 0; hf < 2; ++hf) {
      u32x4 v[9];
#pragma unroll
      for (int rr = 0; rr < 9; ++rr) { const int info = rinfo[wave * 18 + hf * 9 + rr]; const int tok = info < 0 ? 0 : (info >> 1); v[rr] = ((const u32x4*)(H2 + (size_t)tok * DM))[lane]; }
#pragma unroll
      for (int rr = 0; rr < 9; ++rr) *(LAS u32x4*)(lds + a_off(wave * 18 + hf * 9 + rr, 16 * lane, 1024)) = v[rr];
    }
    __syncthreads();
    f32x16 ag[2][P4_NRB];
#pragma unroll
    for (int i = 0; i < 2; ++i)
#pragma unroll
      for (int rb = 0; rb < P4_NRB; ++rb) ag[i][rb] = f32x16{};
    { const l64x2* wp[2];
      wp[0] = (const l64x2*)(ws + WS_WG) + (size_t)((e * 8 + wave) * 32) * 64 + lane;
      wp[1] = (const l64x2*)(ws + WS_WU) + (size_t)((e * 8 + wave) * 32) * 64 + lane;
      if (!(P.variant & 2)) gemm_tile_f8<2, 32, true, 1, false, P4_NRB>(ag, lds, 1024, wp, lane, nrb); }
    __syncthreads();
    { constexpr float S1 = 1.0f / (H2_SCALE * WGU_SCALE);
#pragma unroll
      for (int rb = 0; rb < P4_NRB; ++rb) if (rb < nrb) { const int rr = 32 * rb + r32; const float w = rwt[rr] * HID_SCALE;
#pragma unroll
        for (int g = 0; g < 4; ++g) { float hv[4];
#pragma unroll
          for (int i = 0; i < 4; ++i) { const float gg = ag[0][rb][4 * g + i] * S1, uu = ag[1][rb][4 * g + i] * S1; hv[i] = gg / (1.0f + __expf(-gg)) * uu * w; }
          *(LAS unsigned*)(lds + a_off(rr, 32 * wave + 8 * g + 4 * hi, 256)) = pk4_fp8(hv[0], hv[1], hv[2], hv[3]); } } }
    __syncthreads();
#pragma unroll 1
    for (int pass = (P.variant & 1) ? 2 : 0; pass < 2; ++pass) {
      f32x16 ad[2][P4_NRB];
#pragma unroll
      for (int i = 0; i < 2; ++i)
#pragma unroll
        for (int rb = 0; rb < P4_NRB; ++rb) ad[i][rb] = f32x16{};
      const l64x2* wp[2];
#pragma unroll
      for (int i = 0; i < 2; ++i) wp[i] = (const l64x2*)(ws + WS_WD) + (size_t)((e * 32 + 4 * wave + 2 * pass + i) * 8) * 64 + lane;
      gemm_tile_f8<2, 8, false, 1, false, P4_NRB>(ad, lds, 256, wp, lane, nrb);
      constexpr float S2 = 1.0f / (HID_SCALE * WD_SCALE);
#pragma unroll
      for (int rb = 0; rb < P4_NRB; ++rb) if (rb < nrb) {
#pragma unroll
        for (int reg = 0; reg < 16; ++reg) { const int info = rinfo[32 * rb + crow(reg, hi)];
          if (info >= 0) { bf16_t* yp = Y + (size_t)info * DM + 128 * wave + 64 * pass + r32;
            yp[0] = (bf16_t)(pk2(ad[0][rb][reg] * S2, 0.f) & 0xffffu); yp[32] = (bf16_t)(pk2(ad[1][rb][reg] * S2, 0.f) & 0xffffu); } } }
    }
    __syncthreads();
  }
}

__device__ __forceinline__ void phase5(const KP& P) {
  int lane_ = mk_lane(); asm volatile("" : "+v"(lane_)); const int lane = lane_ & 63, wave = P.wave;
  uchar* ws = P.ws;
  const bf16_t* Y = (const bf16_t*)(ws + WS_Y);
  const bf16_t* X1 = (const bf16_t*)(ws + WS_X1); float* OUT = P.out;
  f32x4 gf[4];
#pragma unroll
  for (int i = 0; i < 4; ++i) gf[i] = *(const f32x4*)(P.in[22] + 4 * (lane + 64 * i));
  constexpr int RPI = 4;
  const int nwv = gridDim.x * NWAVE, wv = blockIdx.x * NWAVE + wave;
#pragma unroll 1
  for (int t0 = wv * RPI; t0 < T; t0 += nwv * RPI) {
    u32x2 xv[RPI][4]; u32x2 ya[RPI][4], yb[RPI][4];
#pragma unroll
    for (int r = 0; r < RPI; ++r)
#pragma unroll
      for (int i = 0; i < 4; ++i) { const int k = 4 * (lane + 64 * i); const size_t t = t0 + r;
        xv[r][i] = *(const u32x2*)(X1 + t * DM + k); ya[r][i] = *(const u32x2*)(Y + (2 * t) * DM + k); yb[r][i] = *(const u32x2*)(Y + (2 * t + 1) * DM + k); }
    const int b = t0 / SEQ; const float* gt2 = (const float*)(ws + WS_MOD) + b * (NMOD * DM) + 5 * DM;
    f32x4 g2v[4];
#pragma unroll
    for (int i = 0; i < 4; ++i) g2v[i] = *(const f32x4*)(gt2 + 4 * (lane + 64 * i));
#pragma unroll
    for (int r = 0; r < RPI; ++r) {
      f32x4 v[4]; float ss = 0.f;
#pragma unroll
      for (int i = 0; i < 4; ++i) { const u32x2 y0 = ya[r][i], y1 = yb[r][i]; f32x4 ys;
        ys[0] = __uint_as_float(y0.x << 16) + __uint_as_float(y1.x << 16); ys[1] = __uint_as_float(y0.x & 0xffff0000u) + __uint_as_float(y1.x & 0xffff0000u);
        ys[2] = __uint_as_float(y0.y << 16) + __uint_as_float(y1.y << 16); ys[3] = __uint_as_float(y0.y & 0xffff0000u) + __uint_as_float(y1.y & 0xffff0000u);
        f32x4 xf; xf[0] = __uint_as_float(xv[r][i].x << 16); xf[1] = __uint_as_float(xv[r][i].x & 0xffff0000u); xf[2] = __uint_as_float(xv[r][i].y << 16); xf[3] = __uint_as_float(xv[r][i].y & 0xffff0000u);
        v[i] = xf + g2v[i] * ys; ss += v[i][0] * v[i][0] + v[i][1] * v[i][1] + v[i][2] * v[i][2] + v[i][3] * v[i][3]; }
      ss = wave_sum(ss); const float rs = rsqrtf(ss * (1.0f / DM) + EPS);
#pragma unroll
      for (int i = 0; i < 4; ++i) *(f32x4*)(OUT + (size_t)(t0 + r) * DM + 4 * (lane + 64 * i)) = v[i] * rs * gf[i];
    }
  }
}
__global__ void __launch_bounds__(NTHR, 2) mk_fwd(const Params P0) {
  extern __shared__ __attribute__((aligned(16))) uchar lds_raw[];
  LAS uchar* lds = (LAS uchar*)lds_raw;
  KP P; P.in = P0.in; P.out = P0.out; P.ws = P0.ws; P.ph_lo = P0.ph_lo; P.ph_hi = P0.ph_hi; P.variant = P0.variant; P.wave = __builtin_amdgcn_readfirstlane((int)(threadIdx.x >> 6));
  const int bid = blockIdx.x, G = gridDim.x;
  const int lo = P.ph_lo, hi = P.ph_hi;
  volatile LAS unsigned* bst = (volatile LAS unsigned*)(lds + LDS_BYTES - 16);
  if (threadIdx.x < 4) bst[threadIdx.x] = 0u;
  __syncthreads();
  XcdBarrier bar; bar.bar = (unsigned*)(P.ws + WS_CTL); bar.x = 0; bar.st = bst;
  if (hi - lo > 1) bar = xcd_barrier_post((unsigned*)(P.ws + WS_CTL), bst, P.wave == 0 && mk_lane() == 0);
#define IN(k) (lo <= (k) && (k) < hi)
#define BOTH(k) (IN(k) && IN((k) + 1))
  if (IN(0)) { phase0(P, lds); if (BOTH(0)) xcd_barrier(bar, P.wave == 0 && mk_lane() == 0); }
  if (IN(1)) { if (bid < T / 64) phase1_tile(P, lds, bid); if (BOTH(1)) xcd_barrier(bar, P.wave == 0 && mk_lane() == 0); }
  if (IN(2)) { phase2(P, lds); if (BOTH(2)) xcd_barrier(bar, P.wave == 0 && mk_lane() == 0); }
  if (IN(3)) { if (bid < T / 64) phase3_tile(P, lds, bid); if (BOTH(3)) xcd_barrier(bar, P.wave == 0 && mk_lane() == 0); }
  if (IN(4)) { phase4(P, lds); if (BOTH(4)) xcd_barrier(bar, P.wave == 0 && mk_lane() == 0); }
  if (IN(5)) phase5(P);
#undef IN
#undef BOTH
}

extern "C" void kernel_launch(void* const* d_in, const int* in_sizes, int n_in, void* d_out, int out_size, void* d_ws, size_t ws_size, hipStream_t stream) {
  static int ready = 0;
  if (!ready) {
    if (n_in != 23 || out_size != T * DM || ws_size < WS_END) { fprintf(stderr, "kernel_launch: unexpected shapes (n_in %d out %d ws %zu need %zu)\n", n_in, out_size, ws_size, (size_t)WS_END); return; }
    if (hipFuncSetAttribute((const void*)mk_fwd, hipFuncAttributeMaxDynamicSharedMemorySize, LDS_BYTES) != hipSuccess) { fprintf(stderr, "kernel_launch: hipFuncSetAttribute failed\n"); return; }
    ready = 1;
  }
  uchar* ws = (uchar*)d_ws;
  if (hipMemsetAsync(ws + WS_CTL, 0, 32768, stream) != hipSuccess) { fprintf(stderr, "kernel_launch: hipMemsetAsync failed\n"); return; }
  Params p{};
  for (int i = 0; i < 23; ++i) p.in[i] = (const float*)d_in[i];
  p.out = (float*)d_out; p.ws = ws; p.ph_lo = 0; p.ph_hi = 6; p.variant = 0; p.pad = 0;
  hipLaunchKernelGGL(mk_fwd, dim3(T / 64), dim3(NTHR), LDS_BYTES, stream, p);
}
```

```cpp
#include <hip/hip_runtime.h>
#include <cstdio>
#include <cstdint>
constexpr int DM = 1024, NB = 4, SEQ = 4096, T = NB * SEQ;
constexpr int INW = 1120, NMOD = 6;
constexpr float EPS = 1e-6f;
#define LAS __attribute__((address_space(3)))
typedef unsigned short bf16_t;
typedef short bf16x8 __attribute__((ext_vector_type(8)));
typedef float f32x16 __attribute__((ext_vector_type(16)));
typedef float f32x4 __attribute__((ext_vector_type(4)));
typedef unsigned u32x4 __attribute__((ext_vector_type(4)));
typedef unsigned u32x2 __attribute__((ext_vector_type(2)));
typedef unsigned char uchar;

constexpr int NTHR = 512, NWAVE = 8;
constexpr int LDS_A = 0, LDS_MISC = 131072, LDS_BYTES = 163840;
constexpr float LOG2E = 1.4426950408889634f;
constexpr float QSCALE_A = 0.125f * LOG2E * (128.0f / 65535.0f);
constexpr float QSCALE_B = 0.10206207261596575f * LOG2E;
constexpr float THR2 = 10.f;
constexpr float WIN_SCALE = 64.f, WIN_DESCALE = 1.0f / 64.f;
constexpr float H2_SCALE = 8.f, WGU_SCALE = 64.f, WD_SCALE = 32.f, HID_SCALE = 8.f;

constexpr size_t WS_CTL   = 0;
constexpr size_t WS_CNT   = 16384;
constexpr size_t WS_MOD   = 32768;
constexpr size_t WS_TABA  = WS_MOD + 98304;
constexpr size_t WS_TABB  = WS_TABA + 4096 * 32 * 8;
constexpr size_t WS_WIN   = WS_TABB + 4096 * 16 * 8;
constexpr size_t WS_WUQ   = WS_WIN + 35 * 64 * 1024;
constexpr size_t WS_WUKV  = WS_WUQ + 24 * 12 * 1024;
constexpr size_t WS_WOUT  = WS_WUKV + 32 * 8 * 1024;
constexpr size_t WS_WR    = WS_WOUT + 32 * 64 * 1024;
constexpr size_t WS_WG    = WS_WR + 2 * 64 * 1024;
constexpr size_t WS_WU    = WS_WG + (size_t)32 * 8 * 32 * 1024;
constexpr size_t WS_WD    = WS_WU + (size_t)32 * 8 * 32 * 1024;
constexpr size_t WS_LIST  = WS_WD + (size_t)32 * 32 * 8 * 1024;
constexpr size_t WS_WT    = WS_LIST + (size_t)32 * 16384 * 4;
constexpr size_t WS_QA    = WS_WT + (size_t)T * 2 * 4;
constexpr size_t WS_KVA   = WS_QA + (size_t)NB * 8 * 64 * 8192;
constexpr size_t WS_QB    = WS_KVA + (size_t)NB * 2 * 64 * 16384;
constexpr size_t WS_KVB   = WS_QB + (size_t)NB * 8 * 64 * 12288;
constexpr size_t WS_O     = WS_KVB + (size_t)NB * 8 * 64 * 20480;
constexpr size_t WS_H2    = WS_O + (size_t)T * DM * 2;
constexpr size_t WS_X1    = WS_H2 + (size_t)T * DM * 2;
constexpr size_t WS_END   = WS_X1 + (size_t)T * DM * 2;
constexpr size_t WS_Y     = WS_QA;
static_assert((size_t)T * 2 * DM * 2 <= WS_O - WS_QA, "Y overlay");

struct Params { const float* in[23]; float* out; unsigned char* ws; int ph_lo, ph_hi, variant, pad; };
struct KP { const float* const* in; float* out; unsigned char* ws; int ph_lo, ph_hi, wave, variant; };
__device__ __forceinline__ int mk_lane() { return (int)__builtin_amdgcn_mbcnt_hi(~0u, __builtin_amdgcn_mbcnt_lo(~0u, 0u)); }

__device__ __forceinline__ unsigned pk2(float lo, float hi) { unsigned r; asm("v_cvt_pk_bf16_f32 %0, %1, %2" : "=v"(r) : "v"(lo), "v"(hi)); return r; }
__device__ __forceinline__ float bf2f(unsigned short v) { return __uint_as_float((unsigned)v << 16); }
__host__ __device__ __forceinline__ constexpr int crow(int r, int hi) { return (r & 3) + 8 * (r >> 2) + 4 * hi; }
__device__ __forceinline__ f32x16 mfma(bf16x8 a, bf16x8 b, f32x16 c) { return __builtin_amdgcn_mfma_f32_32x32x16_bf16(a, b, c, 0, 0, 0); }
__device__ __forceinline__ float wave_sum(float v) {
#pragma unroll
  for (int o = 32; o; o >>= 1) v += __shfl_xor(v, o);
  return v;
}
__device__ __forceinline__ float half_swap_max(float x) { auto rr = __builtin_amdgcn_permlane32_swap(__float_as_uint(x), __float_as_uint(x), false, false);
  float m; asm("v_max_f32 %0, %1, %2" : "=v"(m) : "v"(rr[0]), "v"(rr[1])); return m; }
__device__ __forceinline__ float half_swap_sum(float x) { auto rr = __builtin_amdgcn_permlane32_swap(__float_as_uint(x), __float_as_uint(x), false, false); return __uint_as_float(rr[0]) + __uint_as_float(rr[1]); }
__host__ __device__ __forceinline__ constexpr int a_off(int row, int kbyte, int pitch) { return row * pitch + (kbyte ^ ((row & 15) << 4)); }
__host__ __device__ __forceinline__ constexpr int img_qk(int rr, int d, int NS) { return ((((rr >> 5) * NS + (d >> 4)) * 64) + ((d >> 3) & 1) * 32 + (rr & 31)) * 16 + (d & 7) * 2; }
__host__ __device__ __forceinline__ constexpr int img_v(int kk, int d) {
  const int kb = kk >> 5, k32 = kk & 31, s = k32 >> 4, k16 = k32 & 15, h = (k16 >> 2) & 1, j = ((k16 >> 3) << 2) | (k16 & 3), db = d >> 5, r = d & 31;
  return (((((kb * 2 + db) * 2 + s) * 64) + h * 32 + r) * 8 + j) * 2;
}

#define XB_TMO      128
#define XB_XCNT(j)  (256  + 64 * (j))
#define XB_XSUB(j)  (1280 + 64 * (j))
#define XB_XGEN(j)  (2304 + 64 * (j))
#define XB_TOP      3328
#define XB_TOPGEN   3392
#define XCD_BAR_WORDS 3456
#define XB_SPIN_CAP (1u << 20)
__device__ __forceinline__ unsigned xb_ld(unsigned* p)              { return __hip_atomic_load(p, __ATOMIC_RELAXED, __HIP_MEMORY_SCOPE_AGENT); }
__device__ __forceinline__ unsigned xb_add(unsigned* p, unsigned v) { return __hip_atomic_fetch_add(p, v, __ATOMIC_RELAXED, __HIP_MEMORY_SCOPE_AGENT); }
__device__ __forceinline__ unsigned xb_xcc_id() { return (unsigned)__builtin_amdgcn_s_getreg((3 << 11) | 20) & 0xFu; }
#define XB_SPIN(cond, bar) do { unsigned _sp = 0; while (cond) { __builtin_amdgcn_s_sleep(1); \
    if ((++_sp & 255u) == 0u) { if (xb_ld(&(bar)[XB_TMO])) break; if (_sp > XB_SPIN_CAP) { atomicAdd(&(bar)[XB_TMO], 1u); break; } } } } while (0)
struct XcdBarrier { unsigned* bar; unsigned x; volatile LAS unsigned* st; };
__device__ __forceinline__ XcdBarrier xcd_barrier_post(unsigned* bar, volatile LAS unsigned* st, bool leader) {
  XcdBarrier b; b.bar = bar; b.x = xb_xcc_id(); b.st = st;
  if (leader) (void)xb_add(&bar[XB_XCNT(b.x)], 1u);
  return b;
}
__device__ __forceinline__ void xcd_barrier_complete(unsigned* bar, unsigned x, unsigned& nloc, unsigned& nx) {
  const unsigned G = gridDim.x * gridDim.y * gridDim.z;
  unsigned sum, cnt, mine, sp = 0u;
  for (;;) {
    sum = 0u; cnt = 0u; mine = 0u;
#pragma unroll
    for (unsigned j = 0; j < 16; ++j) { const unsigned c = xb_ld(&bar[XB_XCNT(j)]); sum += c; cnt += (c > 0u) ? 1u : 0u; mine = (j == x) ? c : mine; }
    if (sum == G) break;
    __builtin_amdgcn_s_sleep(1);
    if ((++sp & 255u) == 0u) { if (xb_ld(&bar[XB_TMO])) break; if (sp > XB_SPIN_CAP) { atomicAdd(&bar[XB_TMO], 1u); break; } }
  }
  nloc = mine > 0u ? mine : 1u; nx = cnt > 0u ? cnt : 1u;
}
__device__ __forceinline__ void xcd_barrier(const XcdBarrier& b, bool leader) {
  asm volatile("s_waitcnt vmcnt(0)" ::: "memory");
  __syncthreads();
  if (leader) {
    unsigned* bar = b.bar;
    __builtin_amdgcn_s_waitcnt(0);
    unsigned nloc = b.st[0], nx = b.st[1];
    if (nloc == 0u) { xcd_barrier_complete(bar, b.x, nloc, nx); b.st[0] = nloc; b.st[1] = nx; }
    const unsigned old = xb_add(&bar[XB_XSUB(b.x)], 1u);
    const unsigned gen = old / nloc;
    if (old + 1u == (gen + 1u) * nloc) {
      __builtin_amdgcn_fence(__ATOMIC_RELEASE, "agent");
      asm volatile("s_waitcnt vmcnt(0)" ::: "memory");
      const unsigned og = xb_add(&bar[XB_TOP], 1u);
      const unsigned tg = og / nx;
      if (og + 1u == (tg + 1u) * nx) xb_add(&bar[XB_TOPGEN], 1u);
      else XB_SPIN(xb_ld(&bar[XB_TOPGEN]) == tg, bar);
      __builtin_amdgcn_fence(__ATOMIC_ACQUIRE, "agent");
      xb_add(&bar[XB_XGEN(b.x)], 1u);
      asm volatile("s_waitcnt vmcnt(0)" ::: "memory");
    } else {
      XB_SPIN(xb_ld(&bar[XB_XGEN(b.x)]) == gen, bar);
      __builtin_amdgcn_fence(__ATOMIC_ACQUIRE, "agent");
      asm volatile("s_waitcnt vmcnt(0)" ::: "memory");
    }
  }
  __syncthreads();
}

template <int NBLK, int NS, bool TR, int D = (NBLK >= 3 ? 4 : 8)>
__device__ __forceinline__ void gemm_tile(f32x16 (&acc)[NBLK][2], const LAS uchar* A, const int pitch, const bf16x8* const (&wp)[NBLK], const int lane) {
  constexpr int NSM = (NS / D) * D;
  const int r = lane & 31, h = lane >> 5;
  const LAS uchar* a0p = A + r * pitch; const LAS uchar* a1p = A + (32 + r) * pitch;
  const int swz = (lane & 15) << 4, kb0 = 16 * h;
  bf16x8 ring[D][NBLK];
#pragma unroll
  for (int d = 0; d < D; ++d)
#pragma unroll
    for (int i = 0; i < NBLK; ++i) ring[d][i] = wp[i][d * 64];
#pragma unroll 1
  for (int s0 = 0; s0 < NSM; s0 += D) {
#pragma unroll
    for (int d = 0; d < D; ++d) {
      const int s = s0 + d;
      const int ko = ((s * 32) + kb0) ^ swz; const bf16x8 fa0 = *(const LAS bf16x8*)(a0p + ko), fa1 = *(const LAS bf16x8*)(a1p + ko);
#pragma unroll
      for (int i = 0; i < NBLK; ++i) {
        if (TR) { acc[i][0] = mfma(ring[d][i], fa0, acc[i][0]); acc[i][1] = mfma(ring[d][i], fa1, acc[i][1]); }
        else    { acc[i][0] = mfma(fa0, ring[d][i], acc[i][0]); acc[i][1] = mfma(fa1, ring[d][i], acc[i][1]); }
      }
      if (s + D < NS) {
#pragma unroll
        for (int i = 0; i < NBLK; ++i) ring[d][i] = wp[i][(s + D) * 64];
      }
    }
  }
#pragma unroll
  for (int d = 0; d < NS - NSM; ++d) {
    const int s = NSM + d;
    const int ko = ((s * 32) + kb0) ^ swz; const bf16x8 fa0 = *(const LAS bf16x8*)(a0p + ko), fa1 = *(const LAS bf16x8*)(a1p + ko);
#pragma unroll
    for (int i = 0; i < NBLK; ++i) {
      if (TR) { acc[i][0] = mfma(ring[d][i], fa0, acc[i][0]); acc[i][1] = mfma(ring[d][i], fa1, acc[i][1]); }
      else    { acc[i][0] = mfma(fa0, ring[d][i], acc[i][0]); acc[i][1] = mfma(fa1, ring[d][i], acc[i][1]); }
    }
  }
}
typedef long l64x2 __attribute__((ext_vector_type(2)));
__device__ __forceinline__ f32x16 mfma8(long a, long b, f32x16 c) { return __builtin_amdgcn_mfma_f32_32x32x16_fp8_fp8(a, b, c, 0, 0, 0); }
__device__ __forceinline__ unsigned pk4_fp8(float a, float b, float c, float d) { int w = 0; w = __builtin_amdgcn_cvt_pk_fp8_f32(a, b, w, false); w = __builtin_amdgcn_cvt_pk_fp8_f32(c, d, w, true); return (unsigned)w; }
typedef int i32x8 __attribute__((ext_vector_type(8)));
typedef int i32x4 __attribute__((ext_vector_type(4)));
#ifndef MK_MX
#define MK_MX 1
#endif
__device__ __forceinline__ f32x16 mfma_mx(i32x4 a0, i32x4 a1, i32x4 b0, i32x4 b1, f32x16 c) {
  const i32x8 a = __builtin_shufflevector(a0, a1, 0, 1, 2, 3, 4, 5, 6, 7), b = __builtin_shufflevector(b0, b1, 0, 1, 2, 3, 4, 5, 6, 7);
  return __builtin_amdgcn_mfma_scale_f32_32x32x64_f8f6f4(a, b, c, 0, 0, 0, 0x7f7f7f7f, 0, 0x7f7f7f7f);
}
__device__ __forceinline__ f32x16 mfma_mx_q(i32x4 a0, i32x4 a1, i32x4 b0, i32x4 b1, f32x16 c) {
  const i32x8 a = __builtin_shufflevector(a0, a1, 0, 1, 2, 3, 4, 5, 6, 7), b = __builtin_shufflevector(b0, b1, 0, 1, 2, 3, 4, 5, 6, 7);
  return __builtin_amdgcn_mfma_scale_f32_32x32x64_f8f6f4(a, b, c, 0, 0, 0, 0x7f7f7f7f, 0, 0x77777777);
}
__device__ __forceinline__ unsigned mk_pknorm(float lo, float hi) { typedef unsigned short u16x2 __attribute__((ext_vector_type(2))); const u16x2 v = __builtin_amdgcn_cvt_pknorm_u16(lo, hi); return __builtin_bit_cast(unsigned, v); }
__device__ __forceinline__ f32x16 mfma_mx8(i32x8 a, i32x8 b, f32x16 c) { return __builtin_amdgcn_mfma_scale_f32_32x32x64_f8f6f4(a, b, c, 0, 0, 0, 0x7f7f7f7f, 0, 0x7f7f7f7f); }
__device__ __forceinline__ i32x8 ld_pair(const i32x4* p0, const i32x4* p1) { const i32x4 x = *p0, y = *p1; return __builtin_shufflevector(x, y, 0, 1, 2, 3, 4, 5, 6, 7); }
template <int NBLK, int NS, bool TR, int D, bool FULL, int NRB>
__device__ __forceinline__ void gemm_tile_f8(f32x16 (&acc)[NBLK][NRB], const LAS uchar* A, const int pitch, const l64x2* const (&wp)[NBLK], const int lane, const int nrb) {
  constexpr int NP = NS / 2;
  static_assert(NS % 2 == 0 && NP % D == 0, "NS even, NP % D");
  const int r = lane & 31, h = lane >> 5;
  const LAS uchar* ap = A + r * pitch;
  const int swz = (lane & 15) << 4, kb0 = 16 * h;
  i32x8 ring[D][NBLK];
#pragma unroll
  for (int d = 0; d < D; ++d)
#pragma unroll
    for (int i = 0; i < NBLK; ++i) ring[d][i] = ld_pair((const i32x4*)(wp[i] + (2 * d) * 64), (const i32x4*)(wp[i] + (2 * d + 1) * 64));
#pragma unroll 1
  for (int p0 = 0; p0 < NP; p0 += D) {
#pragma unroll
    for (int d = 0; d < D; ++d) {
      const int s = 2 * (p0 + d);
      const int ko0 = ((s * 32) + kb0) ^ swz, ko1 = (((s + 1) * 32) + kb0) ^ swz;
#pragma unroll
      for (int rb = 0; rb < NRB; ++rb) {
        if (FULL || rb < nrb) {
          const i32x4 f0 = *(const LAS i32x4*)(ap + rb * 32 * pitch + ko0), f1 = *(const LAS i32x4*)(ap + rb * 32 * pitch + ko1);
          const i32x8 fa = __builtin_shufflevector(f0, f1, 0, 1, 2, 3, 4, 5, 6, 7);
#pragma unroll
          for (int i = 0; i < NBLK; ++i) acc[i][rb] = TR ? mfma_mx8(ring[d][i], fa, acc[i][rb]) : mfma_mx8(fa, ring[d][i], acc[i][rb]);
        }
      }
      if (p0 + d + D < NP) {
#pragma unroll
        for (int i = 0; i < NBLK; ++i) ring[d][i] = ld_pair((const i32x4*)(wp[i] + (2 * (p0 + d + D)) * 64), (const i32x4*)(wp[i] + (2 * (p0 + d + D) + 1) * 64));
      }
    }
  }
}
template <int NSLOT, int NACC, int NS, bool TR, int D, int MAP>
__device__ __forceinline__ void gemm_slots_f8(f32x16 (&acc)[NACC][2], const LAS uchar* A, const int pitch, const l64x2* const (&wp)[NSLOT], const int lane) {
  constexpr int NP = NS / 2;
  static_assert(NS % 2 == 0 && NP % D == 0, "NS even, NP % D");
  const int r = lane & 31, h = lane >> 5;
  const LAS uchar* ap = A + r * pitch;
  const int swz = (lane & 15) << 4, kb0 = 16 * h;
  i32x8 ring[D][NSLOT];
#pragma unroll
  for (int d = 0; d < D; ++d)
#pragma unroll
    for (int i = 0; i < NSLOT; ++i) ring[d][i] = ld_pair((const i32x4*)(wp[i] + (2 * d) * 64), (const i32x4*)(wp[i] + (2 * d + 1) * 64));
#pragma unroll 1
  for (int p0 = 0; p0 < NP; p0 += D) {
#pragma unroll
    for (int d = 0; d < D; ++d) {
      const int s = 2 * (p0 + d);
      const int ko0 = ((s * 32) + kb0) ^ swz, ko1 = (((s + 1) * 32) + kb0) ^ swz;
#pragma unroll
      for (int rb = 0; rb < 2; ++rb) {
        const i32x4 f0 = *(const LAS i32x4*)(ap + rb * 32 * pitch + ko0), f1 = *(const LAS i32x4*)(ap + rb * 32 * pitch + ko1);
        const i32x8 fa = __builtin_shufflevector(f0, f1, 0, 1, 2, 3, 4, 5, 6, 7);
#pragma unroll
        for (int i = 0; i < NSLOT; ++i) { constexpr int dummy = 0; (void)dummy; const int ai = (MAP >> (4 * i)) & 15;
          acc[ai][rb] = TR ? mfma_mx8(ring[d][i], fa, acc[ai][rb]) : mfma_mx8(fa, ring[d][i], acc[ai][rb]); }
      }
      if (p0 + d + D < NP) {
#pragma unroll
        for (int i = 0; i < NSLOT; ++i) ring[d][i] = ld_pair((const i32x4*)(wp[i] + (2 * (p0 + d + D)) * 64), (const i32x4*)(wp[i] + (2 * (p0 + d + D) + 1) * 64));
      }
    }
  }
}
template <int NBLK> __device__ __forceinline__ void acc_zero(f32x16 (&acc)[NBLK][2]) {
#pragma unroll
  for (int i = 0; i < NBLK; ++i) { acc[i][0] = f32x16{}; acc[i][1] = f32x16{}; }
}

__device__ __forceinline__ void store_img_qk(uchar* img, const f32x16& v, int rr, int f0, int NS, int hi) {
#pragma unroll
  for (int g = 0; g < 4; ++g) { u32x2 w; w.x = pk2(v[4 * g], v[4 * g + 1]); w.y = pk2(v[4 * g + 2], v[4 * g + 3]);
    *(u32x2*)(img + img_qk(rr, f0 + 8 * g + 4 * hi, NS)) = w; }
}
__device__ __forceinline__ void store_img_v(uchar* img, const f32x16& v, int kb, int d, int hi) {
#pragma unroll
  for (int g = 0; g < 4; ++g) { u32x2 w; w.x = pk2(v[4 * g], v[4 * g + 1]); w.y = pk2(v[4 * g + 2], v[4 * g + 3]);
    *(u32x2*)(img + img_v(32 * kb + 8 * g + 4 * hi, d)) = w; }
}
__device__ __forceinline__ void pack_frag(const float* __restrict__ W, int ldw, int k0, int n0, const float* __restrict__ rowscale, u32x4* __restrict__ dst, int lane) {
  const int r = lane & 31, h = lane >> 5;
  const float* p = W + (size_t)(k0 + 8 * h) * ldw + n0 + r;
  float v[8];
#pragma unroll
  for (int j = 0; j < 8; ++j) v[j] = p[(size_t)j * ldw];
  if (rowscale) {
#pragma unroll
    for (int j = 0; j < 8; ++j) v[j] *= rowscale[k0 + 8 * h + j];
  }
  u32x4 w; w.x = pk2(v[0], v[1]); w.y = pk2(v[2], v[3]); w.z = pk2(v[4], v[5]); w.w = pk2(v[6], v[7]);
  dst[lane] = w;
}
__device__ __forceinline__ void pack_frag8(const float* __restrict__ W, int ldw, int k0, int n0, float scale, u32x4* __restrict__ dst, int lane) {
  const int r = lane & 31, h = lane >> 5;
  const float* p = W + (size_t)(k0 + 16 * h) * ldw + n0 + r;
  float v[16];
#pragma unroll
  for (int j = 0; j < 16; ++j) v[j] = p[(size_t)j * ldw] * scale;
  u32x4 w; w.x = pk4_fp8(v[0], v[1], v[2], v[3]); w.y = pk4_fp8(v[4], v[5], v[6], v[7]); w.z = pk4_fp8(v[8], v[9], v[10], v[11]); w.w = pk4_fp8(v[12], v[13], v[14], v[15]);
  dst[lane] = w;
}
__device__ __forceinline__ void pack_frag8_lo(const float* __restrict__ W, int ldw, int k0, int n0, float scale, u32x4* __restrict__ dst, int lane) {
  const int r = lane & 31, h = lane >> 5;
  const float* p = W + (size_t)(k0 + 16 * h) * ldw + n0 + r;
  float v[16];
#pragma unroll
  for (int j = 0; j < 16; ++j) { const float x = p[(size_t)j * ldw] * scale; const int q = __builtin_amdgcn_cvt_pk_fp8_f32(x, 0.f, 0, false); v[j] = x - __builtin_amdgcn_cvt_f32_fp8(q, 0); }
  u32x4 w; w.x = pk4_fp8(v[0], v[1], v[2], v[3]); w.y = pk4_fp8(v[4], v[5], v[6], v[7]); w.z = pk4_fp8(v[8], v[9], v[10], v[11]); w.w = pk4_fp8(v[12], v[13], v[14], v[15]);
  dst[lane] = w;
}
__device__ __forceinline__ void phase0(const KP& P, LAS uchar* lds) {
  int lane_ = mk_lane(); asm volatile("" : "+v"(lane_)); const int lane = lane_ & 63, wave = P.wave, tid = wave * 64 + lane, bid = blockIdx.x, G = gridDim.x;
  uchar* ws = P.ws;
  if (bid == 0 && tid < 64) ((int*)(ws + WS_CNT))[tid] = 0;
  for (int idx = bid * NTHR + tid; idx < SEQ * 48; idx += G * NTHR) {
    int pos, i, half; float2* dst;
    if (idx < SEQ * 32) { pos = idx >> 5; i = idx & 31; half = 32; dst = (float2*)(ws + WS_TABA) + idx; }
    else { const int i2 = idx - SEQ * 32; pos = i2 >> 4; i = i2 & 15; half = 16; dst = (float2*)(ws + WS_TABB) + i2; }
    const float inv = 1.0f / powf(10000.0f, (float)(2 * i) / (float)(2 * half));
    const float ang = (float)pos * inv;
    *dst = make_float2(cosf(ang), sinf(ang));
  }
  if (bid < 192) {
    const float* c = P.in[1]; const float* w_ada = P.in[2]; const float* b_ada = P.in[3];
    LAS float* sl = (LAS float*)lds; LAS float* part = (LAS float*)(lds + 16384);
    for (int i = tid; i < NB * DM; i += NTHR) { const float v = c[i]; sl[i] = v / (1.f + __expf(-v)); }
    __syncthreads();
    const int n0 = bid * 32, rowl = lane >> 3, c4 = lane & 7;
    f32x4 a0 = {0, 0, 0, 0}, a1 = a0, a2 = a0, a3 = a0;
#pragma unroll 4
    for (int it = 0; it < 16; ++it) {
      const int k = wave * 128 + it * 8 + rowl;
      const f32x4 wv = *(const f32x4*)(w_ada + (size_t)k * (NMOD * DM) + n0 + 4 * c4);
      a0 += wv * sl[k]; a1 += wv * sl[DM + k]; a2 += wv * sl[2 * DM + k]; a3 += wv * sl[3 * DM + k];
    }
#pragma unroll
    for (int e = 0; e < 4; ++e) {
#pragma unroll
      for (int o = 8; o < 64; o <<= 1) { a0[e] += __shfl_xor(a0[e], o); a1[e] += __shfl_xor(a1[e], o); a2[e] += __shfl_xor(a2[e], o); a3[e] += __shfl_xor(a3[e], o); }
    }
    if (rowl == 0) {
#pragma unroll
      for (int e = 0; e < 4; ++e) { part[(wave * 4 + 0) * 32 + 4 * c4 + e] = a0[e]; part[(wave * 4 + 1) * 32 + 4 * c4 + e] = a1[e]; part[(wave * 4 + 2) * 32 + 4 * c4 + e] = a2[e]; part[(wave * 4 + 3) * 32 + 4 * c4 + e] = a3[e]; }
    }
    __syncthreads();
    if (tid < 128) { const int bb = tid >> 5, col = tid & 31; float s = b_ada[n0 + col];
#pragma unroll
      for (int w = 0; w < 8; ++w) s += part[(w * 4 + bb) * 32 + col];
      ((float*)(ws + WS_MOD))[bb * (NMOD * DM) + n0 + col] = s; }
  }
  const int gw = bid * NWAVE + wave, NGW = G * NWAVE;
  for (int f = gw; f < 43 * 32; f += NGW) { const int slot = f >> 5, s = f & 31;
    if (slot < 35) pack_frag8(P.in[5], INW, 32 * s, 32 * slot, WIN_SCALE, (u32x4*)(ws + WS_WIN) + (size_t)f * 64, lane);
    else { const int blk = slot < 39 ? 20 + (slot - 35) : 30 + (slot - 39); pack_frag8_lo(P.in[5], INW, 32 * s, 32 * blk, WIN_SCALE, (u32x4*)(ws + WS_WIN) + (size_t)f * 64, lane); } }
  for (int f = gw; f < 32 * 64; f += NGW) pack_frag(P.in[13], DM, 16 * (f & 63), 32 * (f >> 6), nullptr, (u32x4*)(ws + WS_WOUT) + (size_t)f * 64, lane);
  for (int f = gw; f < 24 * 12; f += NGW) pack_frag(P.in[7], 768, 16 * (f % 12), 32 * (f / 12), P.in[6], (u32x4*)(ws + WS_WUQ) + (size_t)f * 64, lane);
  for (int f = gw; f < 32 * 8; f += NGW) pack_frag(P.in[9], 1024, 16 * (f & 7), 32 * (f >> 3), P.in[8], (u32x4*)(ws + WS_WUKV) + (size_t)f * 64, lane);
  for (int f = gw; f < 2 * 64; f += NGW) {
    const int nb = f >> 6, s = f & 63, r = lane & 31, h = lane >> 5, col = 32 * nb + r;
    float v[8];
#pragma unroll
    for (int j = 0; j < 8; ++j) { const int k = 16 * s + 8 * h + j; v[j] = col < 4 ? P.in[15][k * 4 + col] : (col < 36 ? P.in[17][k * 32 + col - 4] : 0.f); }
    u32x4 w; w.x = pk2(v[0], v[1]); w.y = pk2(v[2], v[3]); w.z = pk2(v[4], v[5]); w.w = pk2(v[6], v[7]);
    ((u32x4*)(ws + WS_WR) + (size_t)f * 64)[lane] = w;
  }
}

__device__ __forceinline__ void rope64(const f32x16& xa, const f32x16& xb, f32x16& ya, f32x16& yb, const float2* __restrict__ trow, int hi, float scale) {
#pragma unroll
  for (int g = 0; g < 4; ++g) {
    const f32x4 t0 = *(const f32x4*)(trow + 8 * g + 4 * hi), t1 = *(const f32x4*)(trow + 8 * g + 4 * hi + 2);
    const float cc[4] = {t0[0], t0[2], t1[0], t1[2]}, sn[4] = {t0[1], t0[3], t1[1], t1[3]};
#pragma unroll
    for (int i = 0; i < 4; ++i) { const int reg = 4 * g + i; ya[reg] = (xa[reg] * cc[i] - xb[reg] * sn[i]) * scale; yb[reg] = (xb[reg] * cc[i] + xa[reg] * sn[i]) * scale; }
  }
}
__device__ __forceinline__ void rope32(const f32x16& x, f32x16& y, const float2* __restrict__ trow, int hi, float scale) {
#pragma unroll
  for (int g = 0; g < 2; ++g) {
    const f32x4 t0 = *(const f32x4*)(trow + 8 * g + 4 * hi), t1 = *(const f32x4*)(trow + 8 * g + 4 * hi + 2);
    const float cc[4] = {t0[0], t0[2], t1[0], t1[2]}, sn[4] = {t0[1], t0[3], t1[1], t1[3]};
#pragma unroll
    for (int i = 0; i < 4; ++i) { const int reg = 4 * g + i; y[reg] = (x[reg] * cc[i] - x[reg + 8] * sn[i]) * scale; y[reg + 8] = (x[reg + 8] * cc[i] + x[reg] * sn[i]) * scale; }
  }
}
__device__ __forceinline__ float write_c_tile(LAS uchar* base, int pitch, const f32x16& vin, int rr, int f0, int hi) {
  const f32x16 v = vin * WIN_DESCALE;
  float ss = 0.f;
#pragma unroll
  for (int g = 0; g < 4; ++g) { u32x2 w; w.x = pk2(v[4 * g], v[4 * g + 1]); w.y = pk2(v[4 * g + 2], v[4 * g + 3]);
    *(LAS u32x2*)(base + a_off(rr, 2 * (f0 + 8 * g + 4 * hi), pitch)) = w;
    ss += v[4 * g] * v[4 * g] + v[4 * g + 1] * v[4 * g + 1] + v[4 * g + 2] * v[4 * g + 2] + v[4 * g + 3] * v[4 * g + 3]; }
  return ss;
}
__device__ __forceinline__ void store_img8_qk(uchar* img, const f32x16& v, int rb, int r32, int blk, int hi) {
#pragma unroll
  for (int g = 0; g < 4; ++g) { const unsigned w = pk4_fp8(v[4 * g], v[4 * g + 1], v[4 * g + 2], v[4 * g + 3]);
    const int off = blk < 2 ? rb * 4096 + (g >> 1) * 1024 + (blk * 32 + r32) * 16 + 8 * (g & 1) + 4 * hi : rb * 4096 + 2048 + ((g >> 1) * 32 + r32) * 16 + 8 * (g & 1) + 4 * hi;
    *(unsigned*)(img + off) = w; }
}
__device__ __forceinline__ void store_img8_v(uchar* img, const f32x16& v, int rb, int db, int r32, int hi) {
#pragma unroll
  for (int g = 0; g < 4; ++g) *(unsigned*)(img + db * 2048 + rb * 1024 + (hi * 32 + r32) * 16 + 4 * g) = pk4_fp8(v[4 * g], v[4 * g + 1], v[4 * g + 2], v[4 * g + 3]);
}
__device__ __forceinline__ void lds_fadd(LAS float* p, float v) { __hip_atomic_fetch_add(p, v, __ATOMIC_RELAXED, __HIP_MEMORY_SCOPE_WORKGROUP); }

__device__ __forceinline__ void phase1_tile(const KP& P, LAS uchar* lds, const int tile) {
  int lane_ = mk_lane(); asm volatile("" : "+v"(lane_)); const int lane = lane_ & 63, wave = P.wave, tid = wave * 64 + lane, r32 = lane & 31, hi = lane >> 5;
  uchar* ws = P.ws;
  const int t0 = tile * 64, b = t0 / SEQ, pos0 = t0 % SEQ, tb = pos0 >> 6;
  const float* __restrict__ x = P.in[0]; const float* __restrict__ mod = (const float*)(ws + WS_MOD) + b * (NMOD * DM); const float* __restrict__ g1 = P.in[4];
  LAS float* ssq = (LAS float*)(lds + LDS_MISC + 64);
  LAS uchar* krt = lds + LDS_MISC + 1024;
  const float2* tabA = (const float2*)(ws + WS_TABA); const float2* tabB = (const float2*)(ws + WS_TABB);
  if (tid < 128) ssq[tid] = 0.f;
  {
    f32x4 av[4], sv[4];
#pragma unroll
    for (int i = 0; i < 4; ++i) { const int k = 4 * (lane + 64 * i); const f32x4 g = *(const f32x4*)(g1 + k), sc = *(const f32x4*)(mod + DM + k); av[i] = g * (sc + 1.0f); sv[i] = *(const f32x4*)(mod + k); }
#pragma unroll
    for (int hf = 0; hf < 2; ++hf) {
      f32x4 xv[4][4];
#pragma unroll
      for (int rr = 0; rr < 4; ++rr)
#pragma unroll
        for (int i = 0; i < 4; ++i) xv[rr][i] = *(const f32x4*)(x + (size_t)(t0 + wave * 8 + hf * 4 + rr) * DM + 4 * (lane + 64 * i));
#pragma unroll
      for (int rr = 0; rr < 4; ++rr) {
        const int row = wave * 8 + hf * 4 + rr; float ss = 0.f;
#pragma unroll
        for (int i = 0; i < 4; ++i) ss += xv[rr][i][0] * xv[rr][i][0] + xv[rr][i][1] * xv[rr][i][1] + xv[rr][i][2] * xv[rr][i][2] + xv[rr][i][3] * xv[rr][i][3];
        ss = wave_sum(ss); const float rs = rsqrtf(ss * (1.0f / DM) + EPS);
#pragma unroll
        for (int i = 0; i < 4; ++i) { const f32x4 v = xv[rr][i] * rs * av[i] + sv[i];
          *(LAS unsigned*)(lds + a_off(row, 4 * (lane + 64 * i), 1024)) = pk4_fp8(v[0], v[1], v[2], v[3]); }
      }
    }
  }
  __syncthreads();
  const l64x2* WIN = (const l64x2*)(ws + WS_WIN);
#define WSLOT(slot) (WIN + (size_t)((slot) * 32) * 64 + lane)
  f32x16 acc[4][2]; acc_zero<4>(acc);
  f32x16 acc2[1][2]; acc_zero<1>(acc2);
  if (wave < 4) {
    { const l64x2* wp[4] = {WSLOT(4 * wave), WSLOT(4 * wave + 1), WSLOT(4 * wave + 2), WSLOT(4 * wave + 3)}; gemm_slots_f8<4, 4, 32, true, 1, 0x3210>(acc, lds, 1024, wp, lane); }
    if (wave < 3) { const l64x2* wp[1] = {WSLOT(wave == 0 ? 34 : 27 + wave)}; gemm_slots_f8<1, 1, 32, true, 2, 0x0>(acc2, lds, 1024, wp, lane); }
  } else if (wave == 4) {
    { const l64x2* wp[4] = {WSLOT(16), WSLOT(17), WSLOT(18), WSLOT(19)}; gemm_slots_f8<4, 4, 32, true, 1, 0x3210>(acc, lds, 1024, wp, lane); }
    { const l64x2* wp[2] = {WSLOT(33), WSLOT(42)}; gemm_slots_f8<2, 1, 32, true, 1, 0x00>(acc2, lds, 1024, wp, lane); }
  } else if (wave == 7) {
    { const l64x2* wp[4] = {WSLOT(30), WSLOT(39), WSLOT(31), WSLOT(40)}; gemm_slots_f8<4, 4, 32, true, 1, 0x1100>(acc, lds, 1024, wp, lane); }
    { const l64x2* wp[2] = {WSLOT(32), WSLOT(41)}; gemm_slots_f8<2, 4, 32, true, 1, 0x22>(acc, lds, 1024, wp, lane); }
  } else {
    const int kv = wave - 5;
    { const l64x2* wp[4] = {WSLOT(20 + 2 * kv), WSLOT(35 + 2 * kv), WSLOT(21 + 2 * kv), WSLOT(36 + 2 * kv)}; gemm_slots_f8<4, 4, 32, false, 1, 0x1100>(acc, lds, 1024, wp, lane); }
    { const l64x2* wp[2] = {WSLOT(24 + 2 * kv), WSLOT(25 + 2 * kv)}; gemm_slots_f8<2, 4, 32, true, 1, 0x32>(acc, lds, 1024, wp, lane); }
  }
#undef WSLOT
  int tid2_ = mk_lane(); asm volatile("" : "+v"(tid2_)); const int lane2 = tid2_ & 63;
#define lane lane2
  const int r32e = lane2 & 31, hie = lane2 >> 5;
#define r32 r32e
#define hi hie
  if (wave < 4) {
#pragma unroll
    for (int p = 0; p < 2; ++p) { uchar* img = ws + WS_QA + ((size_t)(b * 8 + 2 * wave + p) * 64 + tb) * 8192;
#pragma unroll
      for (int rb = 0; rb < 2; ++rb) { const int rr = 32 * rb + r32; f32x16 ya, yb; rope64(acc[2 * p][rb], acc[2 * p + 1][rb], ya, yb, tabA + (size_t)(pos0 + rr) * 32, hi, QSCALE_A * WIN_DESCALE);
        store_img_qk(img, ya, rr, 0, 4, hi); store_img_qk(img, yb, rr, 32, 4, hi); } }
    if (wave == 0) {
#pragma unroll
      for (int rb = 0; rb < 2; ++rb) { const int rr = 32 * rb + r32; f32x16 y; rope32(acc2[0][rb], y, tabB + (size_t)(pos0 + rr) * 16, hi, WIN_DESCALE);
#pragma unroll
        for (int g = 0; g < 4; ++g) { u32x2 w; w.x = pk2(y[4 * g], y[4 * g + 1]); w.y = pk2(y[4 * g + 2], y[4 * g + 3]); *(LAS u32x2*)(krt + rr * 64 + (8 * g + 4 * hi) * 2) = w; } }
    }
  } else if (wave == 4) {
#pragma unroll
    for (int p = 0; p < 2; ++p) { uchar* img = ws + WS_KVA + ((size_t)(b * 2 + p) * 64 + tb) * 16384;
#pragma unroll
      for (int rb = 0; rb < 2; ++rb) { const int rr = 32 * rb + r32; f32x16 ya, yb; rope64(acc[2 * p][rb], acc[2 * p + 1][rb], ya, yb, tabA + (size_t)(pos0 + rr) * 32, hi, WIN_DESCALE);
        store_img_qk(img, ya, rr, 0, 4, hi); store_img_qk(img, yb, rr, 32, 4, hi); } }
  } else if (wave == 5 || wave == 6) {
    uchar* img = ws + WS_KVA + ((size_t)(b * 2 + (wave - 5)) * 64 + tb) * 16384 + 8192;
#pragma unroll
    for (int i = 0; i < 2; ++i)
#pragma unroll
      for (int rb = 0; rb < 2; ++rb) { const f32x16 y = acc[i][rb] * WIN_DESCALE; store_img_v(img, y, rb, 32 * i + r32, hi); }
  }
  __syncthreads();
  if (wave != 0 && wave != 3) {
#pragma unroll
    for (int rb = 0; rb < 2; ++rb) { const int rr = 32 * rb + r32; float sq = 0.f, skv = 0.f;
      if (wave == 5 || wave == 6) { sq += write_c_tile(lds, 512, acc[2][rb], rr, 64 * (wave - 5), hi); sq += write_c_tile(lds, 512, acc[3][rb], rr, 64 * (wave - 5) + 32, hi); }
      else if (wave == 1 || wave == 2) sq += write_c_tile(lds, 512, acc2[0][rb], rr, 96 + 32 * wave, hi);
      else if (wave == 7) { skv += write_c_tile(lds + 32768, 256, acc[0][rb], rr, 0, hi); skv += write_c_tile(lds + 32768, 256, acc[1][rb], rr, 32, hi); skv += write_c_tile(lds + 32768, 256, acc[2][rb], rr, 64, hi); }
      else skv += write_c_tile(lds + 32768, 256, acc2[0][rb], rr, 96, hi);
      if (wave == 4 || wave == 7) lds_fadd(&ssq[64 + rr], skv); else lds_fadd(&ssq[rr], sq); }
  }
  __syncthreads();
  const int head = wave;
  uchar* imgQ = ws + WS_QB + ((size_t)(b * 8 + head) * 64 + tb) * 8192;
  uchar* imgKV = ws + WS_KVB + ((size_t)(b * 8 + head) * 64 + tb) * 12288;
  {
    f32x16 aq[3][2]; acc_zero<3>(aq);
    const bf16x8* wp[3];
#pragma unroll
    for (int i = 0; i < 3; ++i) wp[i] = (const bf16x8*)(ws + WS_WUQ) + (size_t)((3 * head + i) * 12) * 64 + lane;
    gemm_tile<3, 12, true>(aq, lds, 512, wp, lane);
#pragma unroll
    for (int rb = 0; rb < 2; ++rb) { const int rr = 32 * rb + r32; const float sc = rsqrtf(ssq[rr] * (1.0f / 192.0f) + EPS) * (8.0f * QSCALE_B);
      f32x16 y0 = aq[0][rb] * sc, y1 = aq[1][rb] * sc, y2; rope32(aq[2][rb], y2, tabB + (size_t)(pos0 + rr) * 16, hi, sc);
      store_img8_qk(imgQ, y0, rb, r32, 0, hi); store_img8_qk(imgQ, y1, rb, r32, 1, hi); store_img8_qk(imgQ, y2, rb, r32, 2, hi);
      *(u32x4*)(imgQ + rb * 4096 + 3072 + lane * 16) = u32x4{0u, 0u, 0u, 0u}; }
  }
  {
    f32x16 ak[2][2]; acc_zero<2>(ak);
    const bf16x8* wp[2];
#pragma unroll
    for (int i = 0; i < 2; ++i) wp[i] = (const bf16x8*)(ws + WS_WUKV) + (size_t)((4 * head + i) * 8) * 64 + lane;
    gemm_tile<2, 8, true>(ak, lds + 32768, 256, wp, lane);
#pragma unroll
    for (int rb = 0; rb < 2; ++rb) { const int rr = 32 * rb + r32; const float sc = rsqrtf(ssq[64 + rr] * (1.0f / 128.0f) + EPS);
      f32x16 y0 = ak[0][rb] * sc, y1 = ak[1][rb] * sc; store_img8_qk(imgKV, y0, rb, r32, 0, hi); store_img8_qk(imgKV, y1, rb, r32, 1, hi); }
#pragma unroll
    for (int rb = 0; rb < 2; ++rb) {
      const u32x4 c0 = *(const LAS u32x4*)(krt + (32 * rb + r32) * 64 + hi * 32), c1 = *(const LAS u32x4*)(krt + (32 * rb + r32) * 64 + hi * 32 + 16);
      u32x4 w;
      w.x = pk4_fp8(__uint_as_float(c0.x << 16), __uint_as_float(c0.x & 0xffff0000u), __uint_as_float(c0.y << 16), __uint_as_float(c0.y & 0xffff0000u));
      w.y = pk4_fp8(__uint_as_float(c0.z << 16), __uint_as_float(c0.z & 0xffff0000u), __uint_as_float(c0.w << 16), __uint_as_float(c0.w & 0xffff0000u));
      w.z = pk4_fp8(__uint_as_float(c1.x << 16), __uint_as_float(c1.x & 0xffff0000u), __uint_as_float(c1.y << 16), __uint_as_float(c1.y & 0xffff0000u));
      w.w = pk4_fp8(__uint_as_float(c1.z << 16), __uint_as_float(c1.z & 0xffff0000u), __uint_as_float(c1.w << 16), __uint_as_float(c1.w & 0xffff0000u));
      *(u32x4*)(imgKV + rb * 4096 + 2048 + lane * 16) = w;
      *(u32x4*)(imgKV + rb * 4096 + 3072 + lane * 16) = u32x4{hi ? 0u : 0x00003838u, 0u, 0u, 0u}; }
  }
  {
    f32x16 avv[2][2]; acc_zero<2>(avv);
    const bf16x8* wp[2];
#pragma unroll
    for (int i = 0; i < 2; ++i) wp[i] = (const bf16x8*)(ws + WS_WUKV) + (size_t)((4 * head + 2 + i) * 8) * 64 + lane;
    gemm_tile<2, 8, false>(avv, lds + 32768, 256, wp, lane);
#pragma unroll
    for (int rb = 0; rb < 2; ++rb) { f32x16 sc;
#pragma unroll
      for (int reg = 0; reg < 16; ++reg) sc[reg] = rsqrtf(ssq[64 + 32 * rb + crow(reg, hi)] * (1.0f / 128.0f) + EPS);
#pragma unroll
      for (int i = 0; i < 2; ++i) { f32x16 y = avv[i][rb] * sc; store_img8_v(imgKV + 8192, y, rb, i, r32, hi); } }
  }
  __syncthreads();
#undef lane
#undef r32
#undef hi
}
__device__ __forceinline__ float tile_max(const f32x16& p0, const f32x16& p1) {
  float t = __builtin_amdgcn_fmed3f(p0[0], p1[0], 3.0e38f);
  asm("v_max3_f32 %0, %0, %1, %2\n\tv_max3_f32 %0, %0, %3, %4\n\tv_max3_f32 %0, %0, %5, %6\n\tv_max3_f32 %0, %0, %7, %8\n\t"
      "v_max3_f32 %0, %0, %9, %10\n\tv_max3_f32 %0, %0, %11, %12\n\tv_max3_f32 %0, %0, %13, %14\n\tv_max3_f32 %0, %0, %15, %16"
      : "+v"(t) : "v"(p0[1]), "v"(p1[1]), "v"(p0[2]), "v"(p1[2]), "v"(p0[3]), "v"(p1[3]), "v"(p0[4]), "v"(p1[4]), "v"(p0[5]), "v"(p1[5]), "v"(p0[6]), "v"(p1[6]), "v"(p0[7]), "v"(p1[7]), "v"(p0[8]), "v"(p1[8]));
  asm("v_max3_f32 %0, %0, %1, %2\n\tv_max3_f32 %0, %0, %3, %4\n\tv_max3_f32 %0, %0, %5, %6\n\tv_max3_f32 %0, %0, %7, %8\n\t"
      "v_max3_f32 %0, %0, %9, %10\n\tv_max3_f32 %0, %0, %11, %12\n\tv_max3_f32 %0, %0, %13, %14"
      : "+v"(t) : "v"(p0[9]), "v"(p1[9]), "v"(p0[10]), "v"(p1[10]), "v"(p0[11]), "v"(p1[11]), "v"(p0[12]), "v"(p1[12]), "v"(p0[13]), "v"(p1[13]), "v"(p0[14]), "v"(p1[14]), "v"(p0[15]), "v"(p1[15]));
  return t;
}
constexpr float PXG = 128.0f / 65535.0f;
__device__ __forceinline__ void softmax_tile(f32x16& p0, f32x16& p1, f32x16& negm, float& m, float& l, f32x16& o0, f32x16& o1, bf16x8 (&pb)[2][2]) {
  const float tmax = half_swap_max(tile_max(p0, p1));
  if (__any(tmax > PXG * (127.0f + THR2))) {
    const float dm = fmaxf(tmax * (1.0f / PXG) - 127.0f, 0.f), alpha = __builtin_amdgcn_exp2f(-dm), dp = dm * PXG;
    m += dm; l *= alpha;
#pragma unroll
    for (int r = 0; r < 16; ++r) { o0[r] *= alpha; o1[r] *= alpha; p0[r] -= dp; p1[r] -= dp; negm[r] = PXG * (127.0f - m); }
  }
  typedef __bf16 bf2 __attribute__((ext_vector_type(2)));
  const bf2 one2 = __builtin_bit_cast(bf2, 0x3f803f80u);
  float s = 0.f;
#pragma unroll
  for (int ks = 0; ks < 2; ++ks) {
    unsigned a[4], c[4];
#pragma unroll
    for (int i = 0; i < 4; ++i) { a[i] = mk_pknorm(p0[8 * ks + 2 * i], p0[8 * ks + 2 * i + 1]); c[i] = mk_pknorm(p1[8 * ks + 2 * i], p1[8 * ks + 2 * i + 1]);
      s = __builtin_amdgcn_fdot2_f32_bf16(__builtin_bit_cast(bf2, a[i]), one2, s, false); s = __builtin_amdgcn_fdot2_f32_bf16(__builtin_bit_cast(bf2, c[i]), one2, s, false); }
    const u32x4 w0 = {a[0], a[1], a[2], a[3]}, w1 = {c[0], c[1], c[2], c[3]};
    pb[0][ks] = __builtin_bit_cast(bf16x8, w0); pb[1][ks] = __builtin_bit_cast(bf16x8, w1);
  }
  l += s;
}
__device__ __forceinline__ void pv_tile(const LAS uchar* vimg, const bf16x8 (&pb)[2][2], f32x16& o0, f32x16& o1, int lane) {
#pragma unroll
  for (int kb = 0; kb < 2; ++kb)
#pragma unroll
    for (int ks = 0; ks < 2; ++ks) {
      const bf16x8 v0 = *(const LAS bf16x8*)(vimg + ((((kb * 2 + 0) * 2 + ks) * 64) + lane) * 16);
      const bf16x8 v1 = *(const LAS bf16x8*)(vimg + ((((kb * 2 + 1) * 2 + ks) * 64) + lane) * 16);
      o0 = mfma(v0, pb[kb][ks], o0); o1 = mfma(v1, pb[kb][ks], o1);
    }
}
__device__ __forceinline__ void store_o(bf16_t* __restrict__ orow, f32x16& o0, f32x16& o1, float l, int hi) {
  const float inv = 1.0f / half_swap_sum(l);
#pragma unroll
  for (int g = 0; g < 4; ++g) {
    u32x2 w; w.x = pk2(o0[4 * g] * inv, o0[4 * g + 1] * inv); w.y = pk2(o0[4 * g + 2] * inv, o0[4 * g + 3] * inv); *(u32x2*)(orow + 8 * g + 4 * hi) = w;
    u32x2 z; z.x = pk2(o1[4 * g] * inv, o1[4 * g + 1] * inv); z.y = pk2(o1[4 * g + 2] * inv, o1[4 * g + 3] * inv); *(u32x2*)(orow + 32 + 8 * g + 4 * hi) = z;
  }
}

__device__ __forceinline__ void store_o_l(bf16_t* __restrict__ orow, f32x16& o0, f32x16& o1, float ltot, int hi) {
  const float inv = 1.0f / ltot;
#pragma unroll
  for (int g = 0; g < 4; ++g) {
    u32x2 w; w.x = pk2(o0[4 * g] * inv, o0[4 * g + 1] * inv); w.y = pk2(o0[4 * g + 2] * inv, o0[4 * g + 3] * inv); *(u32x2*)(orow + 8 * g + 4 * hi) = w;
    u32x2 z; z.x = pk2(o1[4 * g] * inv, o1[4 * g + 1] * inv); z.y = pk2(o1[4 * g + 2] * inv, o1[4 * g + 3] * inv); *(u32x2*)(orow + 32 + 8 * g + 4 * hi) = z;
  }
}
constexpr int SWA_LDS = 49152;
__device__ __forceinline__ void swa_unit(const KP& P, LAS uchar* lds_all, int u, bool prefetched) {
  LAS uchar* lds = lds_all + SWA_LDS;
  int lane_ = mk_lane(); asm volatile("" : "+v"(lane_)); const int lane = lane_ & 63, wave = P.wave, tid = wave * 64 + lane, r32 = lane & 31, hi = lane >> 5;
  uchar* ws = P.ws;
  const int n = u & 31, kvh = (u >> 5) & 1, b = u >> 6;
  const uchar* kvimg = ws + WS_KVA + (size_t)(b * 2 + kvh) * 64 * 16384;
  if (!prefetched) {
#pragma unroll 1
    for (int jt = 0; jt < 6; ++jt) { const int gt = 2 * n - 2 + jt; if (gt < 0 || gt >= 64) continue;
      const u32x4* src = (const u32x4*)(kvimg + (size_t)gt * 16384); LAS u32x4* dst = (LAS u32x4*)(lds + jt * 16384);
      const u32x4 v0 = src[tid], v1 = src[tid + 512]; dst[tid] = v0; dst[tid + 512] = v1; }
  }
  __syncthreads();
  const int rbq = wave & 3, jlo = rbq >> 1;
  bf16_t* O = (bf16_t*)(ws + WS_O);
#pragma unroll 1
  for (int hh = 0; hh < 2; ++hh) {
    const int head = kvh * 4 + 2 * (wave >> 2) + hh;
    const uchar* qimg = ws + WS_QA + ((size_t)(b * 8 + head) * 64 + 2 * n + (rbq >> 1)) * 8192;
    bf16x8 qf[4];
#pragma unroll
    for (int s = 0; s < 4; ++s) qf[s] = *(const bf16x8*)(qimg + ((((rbq & 1) * 4 + s) * 64) + lane) * 16);
    const float sink2 = P.in[10][head] * LOG2E;
    float m = sink2, l = hi ? 0.f : 1.f; f32x16 negm, o0 = {}, o1 = {};
#pragma unroll
    for (int r = 0; r < 16; ++r) negm[r] = PXG * (127.0f - sink2);
#pragma unroll 1
    for (int jt = jlo; jt < jlo + 5; ++jt) { const int gt = 2 * n - 2 + jt; if (gt < 0 || gt >= 64) continue;
      const LAS uchar* kimg = lds + jt * 16384;
      f32x16 p0 = negm, p1 = negm;
#pragma unroll
      for (int s = 0; s < 4; ++s) { const bf16x8 k0 = *(const LAS bf16x8*)(kimg + (((0 * 4 + s) * 64) + lane) * 16), k1 = *(const LAS bf16x8*)(kimg + (((1 * 4 + s) * 64) + lane) * 16);
        p0 = mfma(k0, qf[s], p0); p1 = mfma(k1, qf[s], p1); }
      if (jt == jlo || jt == jlo + 4) { const int base = 64 * jt - 32 * rbq - r32;
#pragma unroll
        for (int r = 0; r < 16; ++r) { const int d0 = base + crow(r, hi);
          p0[r] = ((unsigned)d0 <= 256u) ? p0[r] : -1e30f; p1[r] = ((unsigned)(d0 + 32) <= 256u) ? p1[r] : -1e30f; } }
      bf16x8 pb[2][2];
      softmax_tile(p0, p1, negm, m, l, o0, o1, pb);
      pv_tile(kimg + 8192, pb, o0, o1, lane);
    }
    store_o(O + (size_t)(b * SEQ + n * 128 + 32 * rbq + r32) * DM + head * 64, o0, o1, l, hi);
  }
  __syncthreads();
}

#define MK_LDS_RD(dst, vaddr, imm) asm volatile("ds_read_b128 %0, %1 offset:%2" : "=v"(dst) : "v"(vaddr), "i"(imm))
template <int N> __device__ __forceinline__ void lgkm_wait() { asm volatile("s_waitcnt lgkmcnt(%0)" :: "i"(N) : "memory"); __builtin_amdgcn_sched_barrier(0); }
__device__ __forceinline__ void pv_regs(const bf16x8 (&vf)[8], const bf16x8 (&pb)[2][2], f32x16& o0, f32x16& o1) {
#pragma unroll
  for (int kb = 0; kb < 2; ++kb)
#pragma unroll
    for (int ks = 0; ks < 2; ++ks) { o0 = mfma(vf[(kb * 2 + 0) * 2 + ks], pb[kb][ks], o0); o1 = mfma(vf[(kb * 2 + 1) * 2 + ks], pb[kb][ks], o1); }
}
__device__ __forceinline__ void mla_dma_step(const uchar* kvimg, LAS uchar* lds, int t, int wave, int lane) {
  const uchar* src = kvimg + (size_t)t * 24576 + wave * 3072 + lane * 16;
  LAS uchar* dst = lds + (t & 1) * 24576 + wave * 3072;
#pragma unroll
  for (int i = 0; i < 3; ++i) __builtin_amdgcn_global_load_lds((const unsigned*)(src + i * 1024), (LAS unsigned*)(dst + i * 1024), 16, 0, 0);
}
template <bool FIRST_POSSIBLE>
__device__ __forceinline__ float softmax_tile8(f32x16& p0, f32x16& p1, float& pad, int& qpad, f32x16& lacc, f32x16& o0, f32x16& o1, bool first, int hi, i32x4& pb0, i32x4& pb1) {
  float applied = 0.f;
  const float tmax_s = half_swap_max(tile_max(p0, p1));
  const bool fst = FIRST_POSSIBLE && first;
  if (fst || __any(tmax_s > 120.5f / 256.0f)) {
    const float tmax = tmax_s * 256.0f;
    const float want = fst ? tmax - 96.5f : fmaxf(tmax - 96.5f, 0.f);
    const float nt = pad - want;
    const int wa = __builtin_amdgcn_cvt_pk_fp8_f32(nt, 0.f, 0, false); const float fa = __builtin_amdgcn_cvt_f32_fp8(wa, 0);
    const int wb = __builtin_amdgcn_cvt_pk_fp8_f32(nt - fa, 0.f, 0, false); const float fb = __builtin_amdgcn_cvt_f32_fp8(wb, 0);
    const float pnew = fa + fb, dt = pad - pnew, dts = dt * (1.0f / 256.0f);
    const float alpha = fst ? 1.0f : __builtin_amdgcn_exp2f(-0.125f * dt);
    pad = pnew; applied = dts; qpad = hi ? 0 : ((wa & 0xff) | ((wb & 0xff) << 8));
#pragma unroll
    for (int r = 0; r < 16; ++r) { o0[r] *= alpha; o1[r] *= alpha; lacc[r] *= alpha; p0[r] -= dts; p1[r] -= dts; }
  }
#define MK_P8(P, R) __builtin_amdgcn_perm(mk_pknorm(P[(R) + 2], P[(R) + 3]), mk_pknorm(P[R], P[(R) + 1]), 0x07050301u)
  pb0.x = (int)MK_P8(p0, 0); pb0.y = (int)MK_P8(p0, 4); pb0.z = (int)MK_P8(p0, 8); pb0.w = (int)MK_P8(p0, 12);
  pb1.x = (int)MK_P8(p1, 0); pb1.y = (int)MK_P8(p1, 4); pb1.z = (int)MK_P8(p1, 8); pb1.w = (int)MK_P8(p1, 12);
#undef MK_P8
  return applied;
}
constexpr int N_PACK_JOBS = 3 * 8192;
struct PackJob { const float* p; int ldw; u32x4* dst; float scale; };
__device__ __forceinline__ PackJob pack_job(const KP& P, int f, int lane) {
  const int which = f >> 13, ff = f & 8191, r = lane & 31, h = lane >> 5, e = ff >> 8; PackJob j;
  if (which < 2) { const int nb = (ff >> 5) & 7, s = ff & 31; j.ldw = 256; j.scale = WGU_SCALE;
    j.p = P.in[19 + which] + (size_t)e * DM * 256 + (size_t)(32 * s + 16 * h) * 256 + 32 * nb + r; j.dst = (u32x4*)(P.ws + (which ? WS_WU : WS_WG)) + (size_t)ff * 64 + lane; }
  else { const int nb = (ff >> 3) & 31, s = ff & 7; j.ldw = DM; j.scale = WD_SCALE;
    j.p = P.in[21] + (size_t)e * 256 * DM + (size_t)(32 * s + 16 * h) * DM + 32 * nb + r; j.dst = (u32x4*)(P.ws + WS_WD) + (size_t)ff * 64 + lane; }
  return j;
}
__device__ __forceinline__ u32x4 pack_cvt(const float (&v)[16], float sc) {
  u32x4 w; w.x = pk4_fp8(v[0] * sc, v[1] * sc, v[2] * sc, v[3] * sc); w.y = pk4_fp8(v[4] * sc, v[5] * sc, v[6] * sc, v[7] * sc);
  w.z = pk4_fp8(v[8] * sc, v[9] * sc, v[10] * sc, v[11] * sc); w.w = pk4_fp8(v[12] * sc, v[13] * sc, v[14] * sc, v[15] * sc); return w;
}
__device__ __forceinline__ void mla_unit(const KP& P, LAS uchar* lds, int b, int head, int qblk, int& pk_k, int swa_u) {
  int lane_ = mk_lane(); asm volatile("" : "+v"(lane_)); const int lane = lane_ & 63, wave = P.wave, r32 = lane & 31, hi = lane >> 5;
  uchar* ws = P.ws;
  const uchar* kvimg = ws + WS_KVB + (size_t)(b * 8 + head) * 64 * 12288;
  const uchar* qimg = ws + WS_QB + ((size_t)(b * 8 + head) * 64 + qblk * 4 + (wave >> 1)) * 8192 + (wave & 1) * 4096 + lane * 16;
  const int gw = blockIdx.x * NWAVE + wave, NGW = gridDim.x * NWAVE;
  const i32x4 q00 = *(const i32x4*)(qimg), q01 = *(const i32x4*)(qimg + 1024), q10 = *(const i32x4*)(qimg + 2048);
  float pad = 56.5f; int qpad = hi ? 0 : 0x3066;
  f32x16 o0 = {}, o1 = {}, lacc = {};
  i32x8 ones8 = {0x38383838, 0x38383838, 0x38383838, 0x38383838, 0x38383838, 0x38383838, 0x38383838, 0x38383838};
  asm volatile("" : "+v"(ones8));
  mla_dma_step(kvimg, lds, 0, wave, lane);
#pragma unroll 1
  for (int t = 0; t < 32; ++t) {
    asm volatile("s_waitcnt vmcnt(0)" ::: "memory");
    __syncthreads();
    if (t + 1 < 32 && !(P.variant & 4)) mla_dma_step(kvimg, lds, t + 1, wave, lane);
    if (P.variant & 8) continue;
    u32x4 bandv = {}; int band_off = -1;
    if (swa_u >= 0 && t >= 20) { const int c = (wave * 64 + lane) + 512 * (t - 20), jt = c >> 10, gt = 2 * (swa_u & 31) - 2 + jt;
      if (gt >= 0 && gt < 64) { band_off = c * 16; bandv = *(const u32x4*)(ws + WS_KVA + ((size_t)((swa_u >> 6) * 2 + ((swa_u >> 5) & 1)) * 64 + gt) * 16384 + (c & 1023) * 16); } }
    const int pf = gw + pk_k * NGW; const bool do_pack = pf < N_PACK_JOBS;
    float pv[16]; u32x4* pdst = nullptr; float psc = 0.f;
    if (do_pack) { const PackJob j = pack_job(P, pf, lane); pdst = j.dst; psc = j.scale;
#pragma unroll
      for (int q = 0; q < 16; ++q) pv[q] = j.p[(size_t)q * j.ldw]; }
    f32x16 a0, a1, b0, b1; i32x4 pb0, pb1;
    { const unsigned va = (unsigned)(unsigned long)(lds + (t & 1) * 24576) + lane * 16;
#define MK_KOFF(j) (((j) >> 2) * 12288 + (((j) >> 1) & 1) * 4096 + ((j) & 1) * 2048)
      i32x4 kf[4][2];
#define MK_KRD(j) { MK_LDS_RD(kf[(j) & 3][0], va, MK_KOFF(j)); MK_LDS_RD(kf[(j) & 3][1], va, MK_KOFF(j) + 1024); }
      MK_KRD(0) MK_KRD(1) MK_KRD(2) MK_KRD(3)
      const i32x4 q11 = {qpad, 0, 0, 0};
#define MK_QK_STEP(j, ACC, NW) { lgkm_wait<NW>(); ACC = ((j) & 1) ? mfma_mx_q(kf[(j) & 3][0], kf[(j) & 3][1], q10, q11, ACC) : mfma_mx_q(kf[(j) & 3][0], kf[(j) & 3][1], q00, q01, f32x16{}); if ((j) + 4 < 8) MK_KRD(((j) + 4) & 7) }
      MK_QK_STEP(0, a0, 6) MK_QK_STEP(1, a0, 6) MK_QK_STEP(2, a1, 6) MK_QK_STEP(3, a1, 6) MK_QK_STEP(4, b0, 6) MK_QK_STEP(5, b0, 4) MK_QK_STEP(6, b1, 2) MK_QK_STEP(7, b1, 0)
#undef MK_QK_STEP
#undef MK_KRD
#undef MK_KOFF
      i32x4 vf[4];
#define MK_VRD(tile) { MK_LDS_RD(vf[0], va, (tile) * 12288 + 8192); MK_LDS_RD(vf[1], va, (tile) * 12288 + 8192 + 1024); MK_LDS_RD(vf[2], va, (tile) * 12288 + 8192 + 2048); MK_LDS_RD(vf[3], va, (tile) * 12288 + 8192 + 3072); }
      MK_VRD(0)
      const float dA = softmax_tile8<true>(a0, a1, pad, qpad, lacc, o0, o1, t == 0, hi, pb0, pb1);
      lacc = mfma_mx8(ones8, __builtin_shufflevector(pb0, pb1, 0, 1, 2, 3, 4, 5, 6, 7), lacc);
      lgkm_wait<0>();
      o0 = mfma_mx(vf[0], vf[1], pb0, pb1, o0); o1 = mfma_mx(vf[2], vf[3], pb0, pb1, o1);
      MK_VRD(1)
#undef MK_VRD
      if (__any(dA != 0.f)) {
#pragma unroll
        for (int r = 0; r < 16; ++r) { b0[r] -= dA; b1[r] -= dA; }
      }
      (void)softmax_tile8<false>(b0, b1, pad, qpad, lacc, o0, o1, false, hi, pb0, pb1);
      lacc = mfma_mx8(ones8, __builtin_shufflevector(pb0, pb1, 0, 1, 2, 3, 4, 5, 6, 7), lacc);
      lgkm_wait<0>();
      o0 = mfma_mx(vf[0], vf[1], pb0, pb1, o0); o1 = mfma_mx(vf[2], vf[3], pb0, pb1, o1);
    }
    if (do_pack) { *pdst = pack_cvt(pv, psc); ++pk_k; }
    if (band_off >= 0) *(LAS u32x4*)(lds + SWA_LDS + band_off) = bandv;
  }
  if (!(P.variant & 12)) store_o_l((bf16_t*)(ws + WS_O) + (size_t)(b * SEQ + qblk * 256 + 32 * wave + r32) * DM + 512 + head * 64, o0, o1, lacc[0], hi);
  __syncthreads();
}
__device__ __forceinline__ void phase2(const KP& P, LAS uchar* lds) {
  const int bid = blockIdx.x;
  int pk_k = 0;
  const bool pref = gridDim.x == 256 && !(P.variant & 3);
  if (!(P.variant & 2)) for (int i = bid; i < 512; i += gridDim.x) {
    const int rr = i >> 8, ii = i & 255, xcd = ii & 7, local = ii >> 3, pair = xcd * 4 + rr * 2 + (local >> 4), qblk = local & 15;
    mla_unit(P, lds, pair >> 3, pair & 7, qblk, pk_k, (pref && i >= 256) ? bid : -1);
  }
  if (!(P.variant & 1)) for (int u = bid; u < 256; u += gridDim.x) swa_unit(P, lds, u, pref);
  { const int lane = mk_lane(), wave = P.wave, gw = bid * NWAVE + wave, NGW = gridDim.x * NWAVE;
    for (int f = gw + pk_k * NGW; f < N_PACK_JOBS; f += NGW) { const PackJob j = pack_job(P, f, lane); float v[16];
#pragma unroll
      for (int q = 0; q < 16; ++q) v[q] = j.p[(size_t)q * j.ldw];
      *j.dst = pack_cvt(v, j.scale); } }
}
__device__ __forceinline__ void phase3_tile(const KP& P, LAS uchar* lds, const int tile) {
  int lane_ = mk_lane(); asm volatile("" : "+v"(lane_)); const int lane = lane_ & 63, wave = P.wave, tid = wave * 64 + lane, r32 = lane & 31, hi = lane >> 5;
  uchar* ws = P.ws;
  const int t0 = tile * 64, b = t0 / SEQ;
  const float* __restrict__ x = P.in[0]; const float* __restrict__ mod = (const float*)(ws + WS_MOD) + b * (NMOD * DM);
  LAS float* ssq = (LAS float*)(lds + LDS_MISC + 64);
  LAS int* selE = (LAS int*)(lds + LDS_MISC + 1024);
  LAS float* selW = (LAS float*)(lds + LDS_MISC + 1536);
  LAS int* selP = (LAS int*)(lds + LDS_MISC + 2048);
  LAS int* cntl = (LAS int*)(lds + LDS_MISC + 2560);
  LAS int* basel = (LAS int*)(lds + LDS_MISC + 2688);
  LAS float* logit = (LAS float*)(lds + LDS_MISC + 8192);
  if (tid < 64) ssq[tid] = 0.f;
  if (tid < 32) cntl[tid] = 0;
  {
    const bf16_t* O = (const bf16_t*)(ws + WS_O);
    float ga[8], gb[8];
#pragma unroll
    for (int j = 0; j < 8; ++j) { ga[j] = P.in[11][8 * lane + j]; gb[j] = P.in[12][8 * lane + j]; }
#pragma unroll
    for (int hf = 0; hf < 2; ++hf) {
      u32x4 va[4], vb[4];
#pragma unroll
      for (int rr = 0; rr < 4; ++rr) { const u32x4* src = (const u32x4*)(O + (size_t)(t0 + wave * 8 + hf * 4 + rr) * DM); va[rr] = src[lane]; vb[rr] = src[lane + 64]; }
#pragma unroll
      for (int rr = 0; rr < 4; ++rr) {
        const int row = wave * 8 + hf * 4 + rr; float fa[8], fb[8], sa = 0.f, sb = 0.f;
#pragma unroll
        for (int q = 0; q < 4; ++q) { fa[2 * q] = __uint_as_float(va[rr][q] << 16); fa[2 * q + 1] = __uint_as_float(va[rr][q] & 0xffff0000u);
          fb[2 * q] = __uint_as_float(vb[rr][q] << 16); fb[2 * q + 1] = __uint_as_float(vb[rr][q] & 0xffff0000u); }
#pragma unroll
        for (int j = 0; j < 8; ++j) { sa += fa[j] * fa[j]; sb += fb[j] * fb[j]; }
        sa = wave_sum(sa); sb = wave_sum(sb);
        const float ra = rsqrtf(sa * (1.0f / 512.0f) + EPS), rb_ = rsqrtf(sb * (1.0f / 512.0f) + EPS);
        u32x4 wa, wb;
#pragma unroll
        for (int q = 0; q < 4; ++q) { wa[q] = pk2(fa[2 * q] * ra * ga[2 * q], fa[2 * q + 1] * ra * ga[2 * q + 1]); wb[q] = pk2(fb[2 * q] * rb_ * gb[2 * q], fb[2 * q + 1] * rb_ * gb[2 * q + 1]); }
        *(LAS u32x4*)(lds + a_off(row, 16 * lane, 2048)) = wa; *(LAS u32x4*)(lds + a_off(row, 16 * (lane + 64), 2048)) = wb;
      }
    }
  }
  __syncthreads();
  f32x16 acc[4][2]; acc_zero<4>(acc);
  { const bf16x8* wp[4];
#pragma unroll
    for (int i = 0; i < 4; ++i) wp[i] = (const bf16x8*)(ws + WS_WOUT) + (size_t)((4 * wave + i) * 64) * 64 + lane;
    gemm_tile<4, 64, false, 5>(acc, lds, 2048, wp, lane); }
  if (P.variant & 2) { asm volatile("" :: "v"(acc[0][0][0]), "v"(acc[1][1][3]), "v"(acc[2][0][7]), "v"(acc[3][1][15])); return; }
  bf16_t* X1 = (bf16_t*)(ws + WS_X1);
  float gt[4];
#pragma unroll
  for (int i = 0; i < 4; ++i) gt[i] = mod[2 * DM + 128 * wave + 32 * i + r32];
#pragma unroll
  for (int rb = 0; rb < 2; ++rb) {
    float xr[16][4];
#pragma unroll
    for (int reg = 0; reg < 16; ++reg) { const size_t off = (size_t)(t0 + 32 * rb + crow(reg, hi)) * DM + 128 * wave + r32;
#pragma unroll
      for (int i = 0; i < 4; ++i) xr[reg][i] = x[off + 32 * i]; }
#pragma unroll
    for (int reg = 0; reg < 16; ++reg) { const int row = 32 * rb + crow(reg, hi); const size_t off = (size_t)(t0 + row) * DM + 128 * wave + r32; float ss = 0.f;
#pragma unroll
      for (int i = 0; i < 4; ++i) { const float v = xr[reg][i] + gt[i] * acc[i][rb][reg]; acc[i][rb][reg] = v; X1[off + 32 * i] = (bf16_t)(pk2(v, 0.f) & 0xffffu); ss += v * v; }
#pragma unroll
      for (int o = 16; o; o >>= 1) ss += __shfl_xor(ss, o);
      if (r32 == 0) lds_fadd(&ssq[row], ss); }
  }
  __syncthreads();
  { float a2[4], s2[4];
#pragma unroll
    for (int i = 0; i < 4; ++i) { const int col = 128 * wave + 32 * i + r32; a2[i] = P.in[14][col] * (1.0f + mod[4 * DM + col]); s2[i] = mod[3 * DM + col]; }
#pragma unroll
    for (int rb = 0; rb < 2; ++rb)
#pragma unroll
      for (int reg = 0; reg < 16; ++reg) { const int row = 32 * rb + crow(reg, hi); const float rs = rsqrtf(ssq[row] * (1.0f / DM) + EPS);
#pragma unroll
        for (int i = 0; i < 4; ++i) { const float v = acc[i][rb][reg] * rs * a2[i] + s2[i]; const int col = 128 * wave + 32 * i + r32;
          *(LAS bf16_t*)(lds + a_off(row, 2 * col, 2048)) = (bf16_t)(pk2(v, v) & 0xffffu); } }
  }
  __syncthreads();
  if (P.variant & 1) return;
  if (wave < 4) {
    f32x16 ar[1][2]; acc_zero<1>(ar);
    const bf16x8* wp[1]; wp[0] = (const bf16x8*)(ws + WS_WR) + (size_t)((wave >> 1) * 64) * 64 + lane;
    gemm_tile<1, 64, false>(ar, lds, 2048, wp, lane);
    const int rb = wave & 1, col = 32 * (wave >> 1) + r32;
#pragma unroll
    for (int reg = 0; reg < 16; ++reg) { const float v = rb ? ar[0][1][reg] : ar[0][0][reg]; logit[(32 * rb + crow(reg, hi)) * 64 + col] = v; }
  }
  { uchar* H2 = ws + WS_H2;
#pragma unroll
    for (int rr = 0; rr < 8; ++rr) { const int row = wave * 8 + rr;
      const u32x4 v0 = *(const LAS u32x4*)(lds + a_off(row, 16 * lane, 2048)), v1 = *(const LAS u32x4*)(lds + a_off(row, 16 * (lane + 64), 2048));
      u32x2 w0, w1;
      w0.x = pk4_fp8(__uint_as_float(v0.x << 16) * H2_SCALE, __uint_as_float(v0.x & 0xffff0000u) * H2_SCALE, __uint_as_float(v0.y << 16) * H2_SCALE, __uint_as_float(v0.y & 0xffff0000u) * H2_SCALE);
      w0.y = pk4_fp8(__uint_as_float(v0.z << 16) * H2_SCALE, __uint_as_float(v0.z & 0xffff0000u) * H2_SCALE, __uint_as_float(v0.w << 16) * H2_SCALE, __uint_as_float(v0.w & 0xffff0000u) * H2_SCALE);
      w1.x = pk4_fp8(__uint_as_float(v1.x << 16) * H2_SCALE, __uint_as_float(v1.x & 0xffff0000u) * H2_SCALE, __uint_as_float(v1.y << 16) * H2_SCALE, __uint_as_float(v1.y & 0xffff0000u) * H2_SCALE);
      w1.y = pk4_fp8(__uint_as_float(v1.z << 16) * H2_SCALE, __uint_as_float(v1.z & 0xffff0000u) * H2_SCALE, __uint_as_float(v1.w << 16) * H2_SCALE, __uint_as_float(v1.w & 0xffff0000u) * H2_SCALE);
      u32x2* dst = (u32x2*)(H2 + (size_t)(t0 + row) * DM); dst[lane] = w0; dst[lane + 64] = w1; } }
  __syncthreads();
  if (tid < 64) {
    const float* lg = (const float*)0; (void)lg;
    float gl[4];
#pragma unroll
    for (int i = 0; i < 4; ++i) gl[i] = logit[tid * 64 + i] + P.in[16][i];
    int gi = 0; float gm = gl[0];
#pragma unroll
    for (int i = 1; i < 4; ++i) if (gl[i] > gm) { gm = gl[i]; gi = i; }
    float gs = 0.f;
#pragma unroll
    for (int i = 0; i < 4; ++i) gs += __expf(gl[i] - gm);
    const float gw = 1.0f / gs;
    float el[8];
#pragma unroll
    for (int i = 0; i < 8; ++i) el[i] = logit[tid * 64 + 4 + gi * 8 + i] + P.in[18][gi * 8 + i];
    int i1 = 0; float m1 = el[0];
#pragma unroll
    for (int i = 1; i < 8; ++i) if (el[i] > m1) { m1 = el[i]; i1 = i; }
    int i2 = (i1 + 1) & 7; float m2 = el[i2];
#pragma unroll
    for (int i = 0; i < 8; ++i) if (i != i1 && el[i] > m2) { m2 = el[i]; i2 = i; }
    const float p2 = __expf(m2 - m1), w1 = 1.0f / (1.0f + p2), w2 = p2 * w1;
    const int e1 = gi * 8 + i1, e2 = gi * 8 + i2;
    selE[2 * tid] = e1; selE[2 * tid + 1] = e2; selW[2 * tid] = gw * w1; selW[2 * tid + 1] = gw * w2;
    selP[2 * tid] = __hip_atomic_fetch_add(&cntl[e1], 1, __ATOMIC_RELAXED, __HIP_MEMORY_SCOPE_WORKGROUP);
    selP[2 * tid + 1] = __hip_atomic_fetch_add(&cntl[e2], 1, __ATOMIC_RELAXED, __HIP_MEMORY_SCOPE_WORKGROUP);
  }
  __syncthreads();
  if (tid < 32) { const int c = cntl[tid]; basel[tid] = c ? atomicAdd((int*)(ws + WS_CNT) + tid, c) : 0; }
  __syncthreads();
  if (tid < 128) { const int e = selE[tid], pos = basel[e] + selP[tid];
    ((int*)(ws + WS_LIST))[(size_t)e * 16384 + pos] = (t0 + (tid >> 1)) * 2 + (tid & 1);
    ((float*)(ws + WS_WT))[(size_t)(t0 + (tid >> 1)) * 2 + (tid & 1)] = selW[tid]; }
  __syncthreads();
}

constexpr int P4_ROWS = 144, P4_NRB = 5, P4_MISC = P4_ROWS * 1024;
__device__ __forceinline__ void phase4(const KP& P, LAS uchar* lds) {
  int lane_ = mk_lane(); asm volatile("" : "+v"(lane_)); const int lane = lane_ & 63, wave = P.wave, tid = wave * 64 + lane, r32 = lane & 31, hi = lane >> 5;
  uchar* ws = P.ws;
  LAS int* rinfo = (LAS int*)(lds + P4_MISC + 1024);
  LAS float* rwt = (LAS float*)(lds + P4_MISC + 2048);
  LAS int* ustart = (LAS int*)(lds + P4_MISC + 3072);
  const int* cnt = (const int*)(ws + WS_CNT);
  if (tid == 0) { int acc_ = 0; for (int e = 0; e < 32; ++e) { ustart[e] = acc_; acc_ += (cnt[e] + P4_ROWS - 1) / P4_ROWS; } ustart[32] = acc_; }
  __syncthreads();
  const int total = ustart[32];
  const uchar* H2 = ws + WS_H2; bf16_t* Y = (bf16_t*)(ws + WS_Y);
#pragma unroll 1
  for (int u = blockIdx.x; u < total; u += gridDim.x) {
    int e = 0;
#pragma unroll 1
    for (int k = 1; k < 32; ++k) if (ustart[k] <= u) e = k;
    const int ne = cnt[e], ke = ustart[e + 1] - ustart[e], q = (ne + ke - 1) / ke, j = u - ustart[e], base = j * q, len = min(q, ne - base), nrb = (len + 31) >> 5;
    if (tid < 160) { int info = -1; float w = 0.f;
      if (tid < len) { info = ((const int*)(ws + WS_LIST))[(size_t)e * 16384 + base + tid]; w = ((const float*)(ws + WS_WT))[info]; }
      rinfo[tid] = info; rwt[tid] = w; }
    __syncthreads();
#pragma unroll
    for (int hf = 0; hf < 2; ++hf) {
      u32x4 v[9];
#pragma unroll
      for (int rr = 0; rr < 9; ++rr) { const int info = rinfo[wave * 18 + hf * 9 + rr]; const int tok = info < 0 ? 0 : (info >> 1); v[rr] = ((const u32x4*)(H2 + (size_t)tok * DM))[lane]; }
#pragma unroll
      for (int rr = 0; rr < 9; ++rr) *(LAS u32x4*)(lds + a_off(wave * 18 + hf * 9 + rr, 16 * lane, 1024)) = v[rr];
    }
    __syncthreads();
    f32x16 ag[2][P4_NRB];
#pragma unroll
    for (int i = 0; i < 2; ++i)
#pragma unroll
      for (int rb = 0; rb < P4_NRB; ++rb) ag[i][rb] = f32x16{};
    { const l64x2* wp[2];
      wp[0] = (const l64x2*)(ws + WS_WG) + (size_t)((e * 8 + wave) * 32) * 64 + lane;
      wp[1] = (const l64x2*)(ws + WS_WU) + (size_t)((e * 8 + wave) * 32) * 64 + lane;
      if (!(P.variant & 2)) gemm_tile_f8<2, 32, true, 1, false, P4_NRB>(ag, lds, 1024, wp, lane, nrb); }
    __syncthreads();
    { constexpr float S1 = 1.0f / (H2_SCALE * WGU_SCALE);
#pragma unroll
      for (int rb = 0; rb < P4_NRB; ++rb) if (rb < nrb) { const int rr = 32 * rb + r32; const float w = rwt[rr] * HID_SCALE;
#pragma unroll
        for (int g = 0; g < 4; ++g) { float hv[4];
#pragma unroll
          for (int i = 0; i < 4; ++i) { const float gg = ag[0][rb][4 * g + i] * S1, uu = ag[1][rb][4 * g + i] * S1; hv[i] = gg / (1.0f + __expf(-gg)) * uu * w; }
          *(LAS unsigned*)(lds + a_off(rr, 32 * wave + 8 * g + 4 * hi, 256)) = pk4_fp8(hv[0], hv[1], hv[2], hv[3]); } } }
    __syncthreads();
#pragma unroll 1
    for (int pass = (P.variant & 1) ? 2 : 0; pass < 2; ++pass) {
      f32x16 ad[2][P4_NRB];
#pragma unroll
      for (int i = 0; i < 2; ++i)
#pragma unroll
        for (int rb = 0; rb < P4_NRB; ++rb) ad[i][rb] = f32x16{};
      const l64x2* wp[2];
#pragma unroll
      for (int i = 0; i < 2; ++i) wp[i] = (const l64x2*)(ws + WS_WD) + (size_t)((e * 32 + 4 * wave + 2 * pass + i) * 8) * 64 + lane;
      gemm_tile_f8<2, 8, false, 1, false, P4_NRB>(ad, lds, 256, wp, lane, nrb);
      constexpr float S2 = 1.0f / (HID_SCALE * WD_SCALE);
#pragma unroll
      for (int rb = 0; rb < P4_NRB; ++rb) if (rb < nrb) {
#pragma unroll
        for (int reg = 0; reg < 16; ++reg) { const int info = rinfo[32 * rb + crow(reg, hi)];
          if (info >= 0) { bf16_t* yp = Y + (size_t)info * DM + 128 * wave + 64 * pass + r32;
            yp[0] = (bf16_t)(pk2(ad[0][rb][reg] * S2, 0.f) & 0xffffu); yp[32] = (bf16_t)(pk2(ad[1][rb][reg] * S2, 0.f) & 0xffffu); } } }
    }
    __syncthreads();
  }
}

__device__ __forceinline__ void phase5(const KP& P) {
  int lane_ = mk_lane(); asm volatile("" : "+v"(lane_)); const int lane = lane_ & 63, wave = P.wave;
  uchar* ws = P.ws;
  const bf16_t* Y = (const bf16_t*)(ws + WS_Y);
  const bf16_t* X1 = (const bf16_t*)(ws + WS_X1); float* OUT = P.out;
  f32x4 gf[4];
#pragma unroll
  for (int i = 0; i < 4; ++i) gf[i] = *(const f32x4*)(P.in[22] + 4 * (lane + 64 * i));
  constexpr int RPI = 4;
  const int nwv = gridDim.x * NWAVE, wv = blockIdx.x * NWAVE + wave;
#pragma unroll 1
  for (int t0 = wv * RPI; t0 < T; t0 += nwv * RPI) {
    u32x2 xv[RPI][4]; u32x2 ya[RPI][4], yb[RPI][4];
#pragma unroll
    for (int r = 0; r < RPI; ++r)
#pragma unroll
      for (int i = 0; i < 4; ++i) { const int k = 4 * (lane + 64 * i); const size_t t = t0 + r;
        xv[r][i] = *(const u32x2*)(X1 + t * DM + k); ya[r][i] = *(const u32x2*)(Y + (2 * t) * DM + k); yb[r][i] = *(const u32x2*)(Y + (2 * t + 1) * DM + k); }
    const int b = t0 / SEQ; const float* gt2 = (const float*)(ws + WS_MOD) + b * (NMOD * DM) + 5 * DM;
    f32x4 g2v[4];
#pragma unroll
    for (int i = 0; i < 4; ++i) g2v[i] = *(const f32x4*)(gt2 + 4 * (lane + 64 * i));
#pragma unroll
    for (int r = 0; r < RPI; ++r) {
      f32x4 v[4]; float ss = 0.f;
#pragma unroll
      for (int i = 0; i < 4; ++i) { const u32x2 y0 = ya[r][i], y1 = yb[r][i]; f32x4 ys;
        ys[0] = __uint_as_float(y0.x << 16) + __uint_as_float(y1.x << 16); ys[1] = __uint_as_float(y0.x & 0xffff0000u) + __uint_as_float(y1.x & 0xffff0000u);
        ys[2] = __uint_as_float(y0.y << 16) + __uint_as_float(y1.y << 16); ys[3] = __uint_as_float(y0.y & 0xffff0000u) + __uint_as_float(y1.y & 0xffff0000u);
        f32x4 xf; xf[0] = __uint_as_float(xv[r][i].x << 16); xf[1] = __uint_as_float(xv[r][i].x & 0xffff0000u); xf[2] = __uint_as_float(xv[r][i].y << 16); xf[3] = __uint_as_float(xv[r][i].y & 0xffff0000u);
        v[i] = xf + g2v[i] * ys; ss += v[i][0] * v[i][0] + v[i][1] * v[i][1] + v[i][2] * v[i][2] + v[i][3] * v[i][3]; }
      ss = wave_sum(ss); const float rs = rsqrtf(ss * (1.0f / DM) + EPS);
#pragma unroll
      for (int i = 0; i < 4; ++i) *(f32x4*)(OUT + (size_t)(t0 + r) * DM + 4 * (lane + 64 * i)) = v[i] * rs * gf[i];
    }
  }
}
__global__ void __launch_bounds__(NTHR, 2) mk_fwd(const Params P0) {
  extern __shared__ __attribute__((aligned(16))) uchar lds_raw[];
  LAS uchar* lds = (LAS uchar*)lds_raw;
  KP P; P.in = P0.in; P.out = P0.out; P.ws = P0.ws; P.ph_lo = P0.ph_lo; P.ph_hi = P0.ph_hi; P.variant = P0.variant; P.wave = __builtin_amdgcn_readfirstlane((int)(threadIdx.x >> 6));
  const int bid = blockIdx.x, G = gridDim.x;
  const int lo = P.ph_lo, hi = P.ph_hi;
  volatile LAS unsigned* bst = (volatile LAS unsigned*)(lds + LDS_BYTES - 16);
  if (threadIdx.x < 4) bst[threadIdx.x] = 0u;
  __syncthreads();
  XcdBarrier bar; bar.bar = (unsigned*)(P.ws + WS_CTL); bar.x = 0; bar.st = bst;
  if (hi - lo > 1) bar = xcd_barrier_post((unsigned*)(P.ws + WS_CTL), bst, P.wave == 0 && mk_lane() == 0);
#define IN(k) (lo <= (k) && (k) < hi)
#define BOTH(k) (IN(k) && IN((k) + 1))
  if (IN(0)) { phase0(P, lds); if (BOTH(0)) xcd_barrier(bar, P.wave == 0 && mk_lane() == 0); }
  if (IN(1)) { if (bid < T / 64) phase1_tile(P, lds, bid); if (BOTH(1)) xcd_barrier(bar, P.wave == 0 && mk_lane() == 0); }
  if (IN(2)) { phase2(P, lds); if (BOTH(2)) xcd_barrier(bar, P.wave == 0 && mk_lane() == 0); }
  if (IN(3)) { if (bid < T / 64) phase3_tile(P, lds, bid); if (BOTH(3)) xcd_barrier(bar, P.wave == 0 && mk_lane() == 0); }
  if (IN(4)) { phase4(P, lds); if (BOTH(4)) xcd_barrier(bar, P.wave == 0 && mk_lane() == 0); }
  if (IN(5)) phase5(P);
#undef IN
#undef BOTH
}

extern "C" void kernel_launch(void* const* d_in, const int* in_sizes, int n_in, void* d_out, int out_size, void* d_ws, size_t ws_size, hipStream_t stream) {
  static int ready = 0;
  if (!ready) {
    if (n_in != 23 || out_size != T * DM || ws_size < WS_END) { fprintf(stderr, "kernel_launch: unexpected shapes (n_in %d out %d ws %zu need %zu)\n", n_in, out_size, ws_size, (size_t)WS_END); return; }
    if (hipFuncSetAttribute((const void*)mk_fwd, hipFuncAttributeMaxDynamicSharedMemorySize, LDS_BYTES) != hipSuccess) { fprintf(stderr, "kernel_launch: hipFuncSetAttribute failed\n"); return; }
    ready = 1;
  }
  uchar* ws = (uchar*)d_ws;
  if (hipMemsetAsync(ws + WS_CTL, 0, 32768, stream) != hipSuccess) { fprintf(stderr, "kernel_launch: hipMemsetAsync failed\n"); return; }
  Params p{};
  for (int i = 0; i < 23; ++i) p.in[i] = (const float*)d_in[i];
  p.out = (float*)d_out; p.ws = ws; p.ph_lo = 0; p.ph_hi = 6; p.variant = 0; p.pad = 0;
  hipLaunchKernelGGL(mk_fwd, dim3(T / 64), dim3(NTHR), LDS_BYTES, stream, p);
}
```

```cpp
#include <hip/hip_runtime.h>
#include <cstdio>
#include <cstdint>
constexpr int DM = 1024, NB = 4, SEQ = 4096, T = NB * SEQ;
constexpr int INW = 1120, NMOD = 6;
constexpr float EPS = 1e-6f;
#define LAS __attribute__((address_space(3)))
typedef unsigned short bf16_t;
typedef short bf16x8 __attribute__((ext_vector_type(8)));
typedef float f32x16 __attribute__((ext_vector_type(16)));
typedef float f32x4 __attribute__((ext_vector_type(4)));
typedef unsigned u32x4 __attribute__((ext_vector_type(4)));
typedef unsigned u32x2 __attribute__((ext_vector_type(2)));
typedef unsigned char uchar;

constexpr int NTHR = 512, NWAVE = 8;
constexpr int LDS_A = 0, LDS_MISC = 131072, LDS_BYTES = 163840;
constexpr float LOG2E = 1.4426950408889634f;
constexpr float QSCALE_A = 0.125f * LOG2E * (128.0f / 65535.0f);
constexpr float QSCALE_B = 0.10206207261596575f * LOG2E;
constexpr float THR2 = 10.f;
constexpr float WIN_SCALE = 64.f, WIN_DESCALE = 1.0f / 64.f;
constexpr float H2_SCALE = 8.f, WGU_SCALE = 64.f, WD_SCALE = 32.f, HID_SCALE = 8.f;

constexpr size_t WS_CTL   = 0;
constexpr size_t WS_CNT   = 16384;
constexpr size_t WS_MOD   = 32768;
constexpr size_t WS_TABA  = WS_MOD + 98304;
constexpr size_t WS_TABB  = WS_TABA + 4096 * 32 * 8;
constexpr size_t WS_WIN   = WS_TABB + 4096 * 16 * 8;
constexpr size_t WS_WUQ   = WS_WIN + 35 * 64 * 1024;
constexpr size_t WS_WUKV  = WS_WUQ + 24 * 12 * 1024;
constexpr size_t WS_WOUT  = WS_WUKV + 32 * 8 * 1024;
constexpr size_t WS_WR    = WS_WOUT + 32 * 64 * 1024;
constexpr size_t WS_WG    = WS_WR + 2 * 64 * 1024;
constexpr size_t WS_WU    = WS_WG + (size_t)32 * 8 * 32 * 1024;
constexpr size_t WS_WD    = WS_WU + (size_t)32 * 8 * 32 * 1024;
constexpr size_t WS_LIST  = WS_WD + (size_t)32 * 32 * 8 * 1024;
constexpr size_t WS_WT    = WS_LIST + (size_t)32 * 16384 * 4;
constexpr size_t WS_QA    = WS_WT + (size_t)T * 2 * 4;
constexpr size_t WS_KVA   = WS_QA + (size_t)NB * 8 * 64 * 8192;
constexpr size_t WS_QB    = WS_KVA + (size_t)NB * 2 * 64 * 16384;
constexpr size_t WS_KVB   = WS_QB + (size_t)NB * 8 * 64 * 12288;
constexpr size_t WS_O     = WS_KVB + (size_t)NB * 8 * 64 * 20480;
constexpr size_t WS_H2    = WS_O + (size_t)T * DM * 2;
constexpr size_t WS_X1    = WS_H2 + (size_t)T * DM * 2;
constexpr size_t WS_XB    = WS_X1 + (size_t)T * DM * 2;
constexpr size_t WS_END   = WS_XB + (size_t)T * DM * 2;
constexpr size_t WS_Y     = WS_QA;
static_assert((size_t)T * 2 * DM * 2 <= WS_O - WS_QA, "Y overlay");

struct Params { const float* in[23]; float* out; unsigned char* ws; int ph_lo, ph_hi, variant, pad; };
struct KP { const float* const* in; float* out; unsigned char* ws; int ph_lo, ph_hi, wave, variant; };
__device__ __forceinline__ int mk_lane() { return (int)__builtin_amdgcn_mbcnt_hi(~0u, __builtin_amdgcn_mbcnt_lo(~0u, 0u)); }

__device__ __forceinline__ unsigned pk2(float lo, float hi) { unsigned r; asm("v_cvt_pk_bf16_f32 %0, %1, %2" : "=v"(r) : "v"(lo), "v"(hi)); return r; }
__device__ __forceinline__ float bf2f(unsigned short v) { return __uint_as_float((unsigned)v << 16); }
__host__ __device__ __forceinline__ constexpr int crow(int r, int hi) { return (r & 3) + 8 * (r >> 2) + 4 * hi; }
__device__ __forceinline__ f32x16 mfma(bf16x8 a, bf16x8 b, f32x16 c) { return __builtin_amdgcn_mfma_f32_32x32x16_bf16(a, b, c, 0, 0, 0); }
__device__ __forceinline__ float wave_sum(float v) {
#pragma unroll
  for (int o = 32; o; o >>= 1) v += __shfl_xor(v, o);
  return v;
}
__device__ __forceinline__ float half_swap_max(float x) { auto rr = __builtin_amdgcn_permlane32_swap(__float_as_uint(x), __float_as_uint(x), false, false);
  float m; asm("v_max_f32 %0, %1, %2" : "=v"(m) : "v"(rr[0]), "v"(rr[1])); return m; }
__device__ __forceinline__ float half_swap_sum(float x) { auto rr = __builtin_amdgcn_permlane32_swap(__float_as_uint(x), __float_as_uint(x), false, false); return __uint_as_float(rr[0]) + __uint_as_float(rr[1]); }
__host__ __device__ __forceinline__ constexpr int a_off(int row, int kbyte, int pitch) { return row * pitch + (kbyte ^ ((row & 15) << 4)); }
__host__ __device__ __forceinline__ constexpr int img_qk(int rr, int d, int NS) { return ((((rr >> 5) * NS + (d >> 4)) * 64) + ((d >> 3) & 1) * 32 + (rr & 31)) * 16 + (d & 7) * 2; }
__host__ __device__ __forceinline__ constexpr int img_v(int kk, int d) {
  const int kb = kk >> 5, k32 = kk & 31, s = k32 >> 4, k16 = k32 & 15, h = (k16 >> 2) & 1, j = ((k16 >> 3) << 2) | (k16 & 3), db = d >> 5, r = d & 31;
  return (((((kb * 2 + db) * 2 + s) * 64) + h * 32 + r) * 8 + j) * 2;
}

#define XB_TMO      128
#define XB_XCNT(j)  (256  + 64 * (j))
#define XB_XSUB(j)  (1280 + 64 * (j))
#define XB_XGEN(j)  (2304 + 64 * (j))
#define XB_TOP      3328
#define XB_TOPGEN   3392
#define XCD_BAR_WORDS 3456
#define XB_SPIN_CAP (1u << 20)
__device__ __forceinline__ unsigned xb_ld(unsigned* p)              { return __hip_atomic_load(p, __ATOMIC_RELAXED, __HIP_MEMORY_SCOPE_AGENT); }
__device__ __forceinline__ unsigned xb_add(unsigned* p, unsigned v) { return __hip_atomic_fetch_add(p, v, __ATOMIC_RELAXED, __HIP_MEMORY_SCOPE_AGENT); }
__device__ __forceinline__ unsigned xb_xcc_id() { return (unsigned)__builtin_amdgcn_s_getreg((3 << 11) | 20) & 0xFu; }
#define XB_SPIN(cond, bar) do { unsigned _sp = 0; while (cond) { __builtin_amdgcn_s_sleep(1); \
    if ((++_sp & 255u) == 0u) { if (xb_ld(&(bar)[XB_TMO])) break; if (_sp > XB_SPIN_CAP) { atomicAdd(&(bar)[XB_TMO], 1u); break; } } } } while (0)
struct XcdBarrier { unsigned* bar; unsigned x; volatile LAS unsigned* st; };
__device__ __forceinline__ XcdBarrier xcd_barrier_post(unsigned* bar, volatile LAS unsigned* st, bool leader) {
  XcdBarrier b; b.bar = bar; b.x = xb_xcc_id(); b.st = st;
  if (leader) (void)xb_add(&bar[XB_XCNT(b.x)], 1u);
  return b;
}
__device__ __forceinline__ void xcd_barrier_complete(unsigned* bar, unsigned x, unsigned& nloc, unsigned& nx) {
  const unsigned G = gridDim.x * gridDim.y * gridDim.z;
  unsigned sum, cnt, mine, sp = 0u;
  for (;;) {
    sum = 0u; cnt = 0u; mine = 0u;
#pragma unroll
    for (unsigned j = 0; j < 16; ++j) { const unsigned c = xb_ld(&bar[XB_XCNT(j)]); sum += c; cnt += (c > 0u) ? 1u : 0u; mine = (j == x) ? c : mine; }
    if (sum == G) break;
    __builtin_amdgcn_s_sleep(1);
    if ((++sp & 255u) == 0u) { if (xb_ld(&bar[XB_TMO])) break; if (sp > XB_SPIN_CAP) { atomicAdd(&bar[XB_TMO], 1u); break; } }
  }
  nloc = mine > 0u ? mine : 1u; nx = cnt > 0u ? cnt : 1u;
}
__device__ __forceinline__ void xcd_barrier(const XcdBarrier& b, bool leader) {
  asm volatile("s_waitcnt vmcnt(0)" ::: "memory");
  __syncthreads();
  if (leader) {
    unsigned* bar = b.bar;
    __builtin_amdgcn_s_waitcnt(0);
    unsigned nloc = b.st[0], nx = b.st[1];
    if (nloc == 0u) { xcd_barrier_complete(bar, b.x, nloc, nx); b.st[0] = nloc; b.st[1] = nx; }
    const unsigned old = xb_add(&bar[XB_XSUB(b.x)], 1u);
    const unsigned gen = old / nloc;
    if (old + 1u == (gen + 1u) * nloc) {
      __builtin_amdgcn_fence(__ATOMIC_RELEASE, "agent");
      asm volatile("s_waitcnt vmcnt(0)" ::: "memory");
      const unsigned og = xb_add(&bar[XB_TOP], 1u);
      const unsigned tg = og / nx;
      if (og + 1u == (tg + 1u) * nx) xb_add(&bar[XB_TOPGEN], 1u);
      else XB_SPIN(xb_ld(&bar[XB_TOPGEN]) == tg, bar);
      __builtin_amdgcn_fence(__ATOMIC_ACQUIRE, "agent");
      xb_add(&bar[XB_XGEN(b.x)], 1u);
      asm volatile("s_waitcnt vmcnt(0)" ::: "memory");
    } else {
      XB_SPIN(xb_ld(&bar[XB_XGEN(b.x)]) == gen, bar);
      __builtin_amdgcn_fence(__ATOMIC_ACQUIRE, "agent");
      asm volatile("s_waitcnt vmcnt(0)" ::: "memory");
    }
  }
  __syncthreads();
}

template <int NBLK, int NS, bool TR, int D = (NBLK >= 3 ? 4 : 8)>
__device__ __forceinline__ void gemm_tile(f32x16 (&acc)[NBLK][2], const LAS uchar* A, const int pitch, const bf16x8* const (&wp)[NBLK], const int lane) {
  constexpr int NSM = (NS / D) * D;
  const int r = lane & 31, h = lane >> 5;
  const LAS uchar* a0p = A + r * pitch; const LAS uchar* a1p = A + (32 + r) * pitch;
  const int swz = (lane & 15) << 4, kb0 = 16 * h;
  bf16x8 ring[D][NBLK];
#pragma unroll
  for (int d = 0; d < D; ++d)
#pragma unroll
    for (int i = 0; i < NBLK; ++i) ring[d][i] = wp[i][d * 64];
#pragma unroll 1
  for (int s0 = 0; s0 < NSM; s0 += D) {
#pragma unroll
    for (int d = 0; d < D; ++d) {
      const int s = s0 + d;
      const int ko = ((s * 32) + kb0) ^ swz; const bf16x8 fa0 = *(const LAS bf16x8*)(a0p + ko), fa1 = *(const LAS bf16x8*)(a1p + ko);
#pragma unroll
      for (int i = 0; i < NBLK; ++i) {
        if (TR) { acc[i][0] = mfma(ring[d][i], fa0, acc[i][0]); acc[i][1] = mfma(ring[d][i], fa1, acc[i][1]); }
        else    { acc[i][0] = mfma(fa0, ring[d][i], acc[i][0]); acc[i][1] = mfma(fa1, ring[d][i], acc[i][1]); }
      }
      if (s + D < NS) {
#pragma unroll
        for (int i = 0; i < NBLK; ++i) ring[d][i] = wp[i][(s + D) * 64];
      }
    }
  }
#pragma unroll
  for (int d = 0; d < NS - NSM; ++d) {
    const int s = NSM + d;
    const int ko = ((s * 32) + kb0) ^ swz; const bf16x8 fa0 = *(const LAS bf16x8*)(a0p + ko), fa1 = *(const LAS bf16x8*)(a1p + ko);
#pragma unroll
    for (int i = 0; i < NBLK; ++i) {
      if (TR) { acc[i][0] = mfma(ring[d][i], fa0, acc[i][0]); acc[i][1] = mfma(ring[d][i], fa1, acc[i][1]); }
      else    { acc[i][0] = mfma(fa0, ring[d][i], acc[i][0]); acc[i][1] = mfma(fa1, ring[d][i], acc[i][1]); }
    }
  }
}
typedef long l64x2 __attribute__((ext_vector_type(2)));
__device__ __forceinline__ f32x16 mfma8(long a, long b, f32x16 c) { return __builtin_amdgcn_mfma_f32_32x32x16_fp8_fp8(a, b, c, 0, 0, 0); }
__device__ __forceinline__ unsigned pk4_fp8(float a, float b, float c, float d) { int w = 0; w = __builtin_amdgcn_cvt_pk_fp8_f32(a, b, w, false); w = __builtin_amdgcn_cvt_pk_fp8_f32(c, d, w, true); return (unsigned)w; }
typedef int i32x8 __attribute__((ext_vector_type(8)));
typedef int i32x4 __attribute__((ext_vector_type(4)));
#ifndef MK_MX
#define MK_MX 1
#endif
__device__ __forceinline__ f32x16 mfma_mx(i32x4 a0, i32x4 a1, i32x4 b0, i32x4 b1, f32x16 c) {
  const i32x8 a = __builtin_shufflevector(a0, a1, 0, 1, 2, 3, 4, 5, 6, 7), b = __builtin_shufflevector(b0, b1, 0, 1, 2, 3, 4, 5, 6, 7);
  return __builtin_amdgcn_mfma_scale_f32_32x32x64_f8f6f4(a, b, c, 0, 0, 0, 0x7f7f7f7f, 0, 0x7f7f7f7f);
}
__device__ __forceinline__ f32x16 mfma_mx_q(i32x4 a0, i32x4 a1, i32x4 b0, i32x4 b1, f32x16 c) {
  const i32x8 a = __builtin_shufflevector(a0, a1, 0, 1, 2, 3, 4, 5, 6, 7), b = __builtin_shufflevector(b0, b1, 0, 1, 2, 3, 4, 5, 6, 7);
  return __builtin_amdgcn_mfma_scale_f32_32x32x64_f8f6f4(a, b, c, 0, 0, 0, 0x7f7f7f7f, 0, 0x77777777);
}
__device__ __forceinline__ unsigned mk_pknorm(float lo, float hi) { typedef unsigned short u16x2 __attribute__((ext_vector_type(2))); const u16x2 v = __builtin_amdgcn_cvt_pknorm_u16(lo, hi); return __builtin_bit_cast(unsigned, v); }
__device__ __forceinline__ f32x16 mfma_mx8(i32x8 a, i32x8 b, f32x16 c) { return __builtin_amdgcn_mfma_scale_f32_32x32x64_f8f6f4(a, b, c, 0, 0, 0, 0x7f7f7f7f, 0, 0x7f7f7f7f); }
__device__ __forceinline__ i32x8 ld_pair(const i32x4* p0, const i32x4* p1) { const i32x4 x = *p0, y = *p1; return __builtin_shufflevector(x, y, 0, 1, 2, 3, 4, 5, 6, 7); }
template <int NBLK, int NS, bool TR, int D, bool FULL, int NRB>
__device__ __forceinline__ void gemm_tile_f8(f32x16 (&acc)[NBLK][NRB], const LAS uchar* A, const int pitch, const l64x2* const (&wp)[NBLK], const int lane, const int nrb) {
  constexpr int NP = NS / 2;
  static_assert(NS % 2 == 0 && NP % D == 0, "NS even, NP % D");
  const int r = lane & 31, h = lane >> 5;
  const LAS uchar* ap = A + r * pitch;
  const int swz = (lane & 15) << 4, kb0 = 16 * h;
  i32x8 ring[D][NBLK];
#pragma unroll
  for (int d = 0; d < D; ++d)
#pragma unroll
    for (int i = 0; i < NBLK; ++i) ring[d][i] = ld_pair((const i32x4*)(wp[i] + (2 * d) * 64), (const i32x4*)(wp[i] + (2 * d + 1) * 64));
#pragma unroll 1
  for (int p0 = 0; p0 < NP; p0 += D) {
#pragma unroll
    for (int d = 0; d < D; ++d) {
      const int s = 2 * (p0 + d);
      const int ko0 = ((s * 32) + kb0) ^ swz, ko1 = (((s + 1) * 32) + kb0) ^ swz;
#pragma unroll
      for (int rb = 0; rb < NRB; ++rb) {
        if (FULL || rb < nrb) {
          const i32x4 f0 = *(const LAS i32x4*)(ap + rb * 32 * pitch + ko0), f1 = *(const LAS i32x4*)(ap + rb * 32 * pitch + ko1);
          const i32x8 fa = __builtin_shufflevector(f0, f1, 0, 1, 2, 3, 4, 5, 6, 7);
#pragma unroll
          for (int i = 0; i < NBLK; ++i) acc[i][rb] = TR ? mfma_mx8(ring[d][i], fa, acc[i][rb]) : mfma_mx8(fa, ring[d][i], acc[i][rb]);
        }
      }
      if (p0 + d + D < NP) {
#pragma unroll
        for (int i = 0; i < NBLK; ++i) ring[d][i] = ld_pair((const i32x4*)(wp[i] + (2 * (p0 + d + D)) * 64), (const i32x4*)(wp[i] + (2 * (p0 + d + D) + 1) * 64));
      }
    }
  }
}
template <int NSLOT, int NACC, int NS, bool TR, int D, int MAP>
__device__ __forceinline__ void gemm_slots_f8(f32x16 (&acc)[NACC][2], const LAS uchar* A, const int pitch, const l64x2* const (&wp)[NSLOT], const int lane) {
  constexpr int NP = NS / 2;
  static_assert(NS % 2 == 0 && NP % D == 0, "NS even, NP % D");
  const int r = lane & 31, h = lane >> 5;
  const LAS uchar* ap = A + r * pitch;
  const int swz = (lane & 15) << 4, kb0 = 16 * h;
  i32x8 ring[D][NSLOT];
#pragma unroll
  for (int d = 0; d < D; ++d)
#pragma unroll
    for (int i = 0; i < NSLOT; ++i) ring[d][i] = ld_pair((const i32x4*)(wp[i] + (2 * d) * 64), (const i32x4*)(wp[i] + (2 * d + 1) * 64));
#pragma unroll 1
  for (int p0 = 0; p0 < NP; p0 += D) {
#pragma unroll
    for (int d = 0; d < D; ++d) {
      const int s = 2 * (p0 + d);
      const int ko0 = ((s * 32) + kb0) ^ swz, ko1 = (((s + 1) * 32) + kb0) ^ swz;
#pragma unroll
      for (int rb = 0; rb < 2; ++rb) {
        const i32x4 f0 = *(const LAS i32x4*)(ap + rb * 32 * pitch + ko0), f1 = *(const LAS i32x4*)(ap + rb * 32 * pitch + ko1);
        const i32x8 fa = __builtin_shufflevector(f0, f1, 0, 1, 2, 3, 4, 5, 6, 7);
#pragma unroll
        for (int i = 0; i < NSLOT; ++i) { constexpr int dummy = 0; (void)dummy; const int ai = (MAP >> (4 * i)) & 15;
          acc[ai][rb] = TR ? mfma_mx8(ring[d][i], fa, acc[ai][rb]) : mfma_mx8(fa, ring[d][i], acc[ai][rb]); }
      }
      if (p0 + d + D < NP) {
#pragma unroll
        for (int i = 0; i < NSLOT; ++i) ring[d][i] = ld_pair((const i32x4*)(wp[i] + (2 * (p0 + d + D)) * 64), (const i32x4*)(wp[i] + (2 * (p0 + d + D) + 1) * 64));
      }
    }
  }
}
template <int NBLK> __device__ __forceinline__ void acc_zero(f32x16 (&acc)[NBLK][2]) {
#pragma unroll
  for (int i = 0; i < NBLK; ++i) { acc[i][0] = f32x16{}; acc[i][1] = f32x16{}; }
}

__device__ __forceinline__ void store_img_qk(uchar* img, const f32x16& v, int rr, int f0, int NS, int hi) {
#pragma unroll
  for (int g = 0; g < 4; ++g) { u32x2 w; w.x = pk2(v[4 * g], v[4 * g + 1]); w.y = pk2(v[4 * g + 2], v[4 * g + 3]);
    *(u32x2*)(img + img_qk(rr, f0 + 8 * g + 4 * hi, NS)) = w; }
}
__device__ __forceinline__ void store_img_v(uchar* img, const f32x16& v, int kb, int d, int hi) {
#pragma unroll
  for (int g = 0; g < 4; ++g) { u32x2 w; w.x = pk2(v[4 * g], v[4 * g + 1]); w.y = pk2(v[4 * g + 2], v[4 * g + 3]);
    *(u32x2*)(img + img_v(32 * kb + 8 * g + 4 * hi, d)) = w; }
}
__device__ __forceinline__ void pack_frag(const float* __restrict__ W, int ldw, int k0, int n0, const float* __restrict__ rowscale, u32x4* __restrict__ dst, int lane) {
  const int r = lane & 31, h = lane >> 5;
  const float* p = W + (size_t)(k0 + 8 * h) * ldw + n0 + r;
  float v[8];
#pragma unroll
  for (int j = 0; j < 8; ++j) v[j] = p[(size_t)j * ldw];
  if (rowscale) {
#pragma unroll
    for (int j = 0; j < 8; ++j) v[j] *= rowscale[k0 + 8 * h + j];
  }
  u32x4 w; w.x = pk2(v[0], v[1]); w.y = pk2(v[2], v[3]); w.z = pk2(v[4], v[5]); w.w = pk2(v[6], v[7]);
  dst[lane] = w;
}
__device__ __forceinline__ void pack_frag8(const float* __restrict__ W, int ldw, int k0, int n0, float scale, u32x4* __restrict__ dst, int lane) {
  const int r = lane & 31, h = lane >> 5;
  const float* p = W + (size_t)(k0 + 16 * h) * ldw + n0 + r;
  float v[16];
#pragma unroll
  for (int j = 0; j < 16; ++j) v[j] = p[(size_t)j * ldw] * scale;
  u32x4 w; w.x = pk4_fp8(v[0], v[1], v[2], v[3]); w.y = pk4_fp8(v[4], v[5], v[6], v[7]); w.z = pk4_fp8(v[8], v[9], v[10], v[11]); w.w = pk4_fp8(v[12], v[13], v[14], v[15]);
  dst[lane] = w;
}
__device__ __forceinline__ void pack_frag8_lo(const float* __restrict__ W, int ldw, int k0, int n0, float scale, u32x4* __restrict__ dst, int lane) {
  const int r = lane & 31, h = lane >> 5;
  const float* p = W + (size_t)(k0 + 16 * h) * ldw + n0 + r;
  float v[16];
#pragma unroll
  for (int j = 0; j < 16; ++j) { const float x = p[(size_t)j * ldw] * scale; const int q = __builtin_amdgcn_cvt_pk_fp8_f32(x, 0.f, 0, false); v[j] = x - __builtin_amdgcn_cvt_f32_fp8(q, 0); }
  u32x4 w; w.x = pk4_fp8(v[0], v[1], v[2], v[3]); w.y = pk4_fp8(v[4], v[5], v[6], v[7]); w.z = pk4_fp8(v[8], v[9], v[10], v[11]); w.w = pk4_fp8(v[12], v[13], v[14], v[15]);
  dst[lane] = w;
}
__device__ __forceinline__ void phase0(const KP& P, LAS uchar* lds) {
  int lane_ = mk_lane(); asm volatile("" : "+v"(lane_)); const int lane = lane_ & 63, wave = P.wave, tid = wave * 64 + lane, bid = blockIdx.x, G = gridDim.x;
  uchar* ws = P.ws;
  if (bid == 0 && tid < 64) ((int*)(ws + WS_CNT))[tid] = 0;
  for (int idx = bid * NTHR + tid; idx < SEQ * 48; idx += G * NTHR) {
    int pos, i, half; float2* dst;
    if (idx < SEQ * 32) { pos = idx >> 5; i = idx & 31; half = 32; dst = (float2*)(ws + WS_TABA) + idx; }
    else { const int i2 = idx - SEQ * 32; pos = i2 >> 4; i = i2 & 15; half = 16; dst = (float2*)(ws + WS_TABB) + i2; }
    const float inv = 1.0f / powf(10000.0f, (float)(2 * i) / (float)(2 * half));
    const float ang = (float)pos * inv;
    *dst = make_float2(cosf(ang), sinf(ang));
  }
  if (bid < 192) {
    const float* c = P.in[1]; const float* w_ada = P.in[2]; const float* b_ada = P.in[3];
    LAS float* sl = (LAS float*)lds; LAS float* part = (LAS float*)(lds + 16384);
    for (int i = tid; i < NB * DM; i += NTHR) { const float v = c[i]; sl[i] = v / (1.f + __expf(-v)); }
    __syncthreads();
    const int n0 = bid * 32, rowl = lane >> 3, c4 = lane & 7;
    f32x4 a0 = {0, 0, 0, 0}, a1 = a0, a2 = a0, a3 = a0;
#pragma unroll 4
    for (int it = 0; it < 16; ++it) {
      const int k = wave * 128 + it * 8 + rowl;
      const f32x4 wv = *(const f32x4*)(w_ada + (size_t)k * (NMOD * DM) + n0 + 4 * c4);
      a0 += wv * sl[k]; a1 += wv * sl[DM + k]; a2 += wv * sl[2 * DM + k]; a3 += wv * sl[3 * DM + k];
    }
#pragma unroll
    for (int e = 0; e < 4; ++e) {
#pragma unroll
      for (int o = 8; o < 64; o <<= 1) { a0[e] += __shfl_xor(a0[e], o); a1[e] += __shfl_xor(a1[e], o); a2[e] += __shfl_xor(a2[e], o); a3[e] += __shfl_xor(a3[e], o); }
    }
    if (rowl == 0) {
#pragma unroll
      for (int e = 0; e < 4; ++e) { part[(wave * 4 + 0) * 32 + 4 * c4 + e] = a0[e]; part[(wave * 4 + 1) * 32 + 4 * c4 + e] = a1[e]; part[(wave * 4 + 2) * 32 + 4 * c4 + e] = a2[e]; part[(wave * 4 + 3) * 32 + 4 * c4 + e] = a3[e]; }
    }
    __syncthreads();
    if (tid < 128) { const int bb = tid >> 5, col = tid & 31; float s = b_ada[n0 + col];
#pragma unroll
      for (int w = 0; w < 8; ++w) s += part[(w * 4 + bb) * 32 + col];
      ((float*)(ws + WS_MOD))[bb * (NMOD * DM) + n0 + col] = s; }
  }
  const int gw = bid * NWAVE + wave, NGW = G * NWAVE;
  for (int f = gw; f < 43 * 32; f += NGW) { const int slot = f >> 5, s = f & 31;
    if (slot < 35) pack_frag8(P.in[5], INW, 32 * s, 32 * slot, WIN_SCALE, (u32x4*)(ws + WS_WIN) + (size_t)f * 64, lane);
    else { const int blk = slot < 39 ? 20 + (slot - 35) : 30 + (slot - 39); pack_frag8_lo(P.in[5], INW, 32 * s, 32 * blk, WIN_SCALE, (u32x4*)(ws + WS_WIN) + (size_t)f * 64, lane); } }
  for (int f = gw; f < 32 * 64; f += NGW) pack_frag(P.in[13], DM, 16 * (f & 63), 32 * (f >> 6), nullptr, (u32x4*)(ws + WS_WOUT) + (size_t)f * 64, lane);
  for (int f = gw; f < 24 * 12; f += NGW) pack_frag(P.in[7], 768, 16 * (f % 12), 32 * (f / 12), P.in[6], (u32x4*)(ws + WS_WUQ) + (size_t)f * 64, lane);
  for (int f = gw; f < 32 * 8; f += NGW) pack_frag(P.in[9], 1024, 16 * (f & 7), 32 * (f >> 3), P.in[8], (u32x4*)(ws + WS_WUKV) + (size_t)f * 64, lane);
  for (int f = gw; f < 2 * 64; f += NGW) {
    const int nb = f >> 6, s = f & 63, r = lane & 31, h = lane >> 5, col = 32 * nb + r;
    float v[8];
#pragma unroll
    for (int j = 0; j < 8; ++j) { const int k = 16 * s + 8 * h + j; v[j] = col < 4 ? P.in[15][k * 4 + col] : (col < 36 ? P.in[17][k * 32 + col - 4] : 0.f); }
    u32x4 w; w.x = pk2(v[0], v[1]); w.y = pk2(v[2], v[3]); w.z = pk2(v[4], v[5]); w.w = pk2(v[6], v[7]);
    ((u32x4*)(ws + WS_WR) + (size_t)f * 64)[lane] = w;
  }
}

__device__ __forceinline__ void rope64(const f32x16& xa, const f32x16& xb, f32x16& ya, f32x16& yb, const float2* __restrict__ trow, int hi, float scale) {
#pragma unroll
  for (int g = 0; g < 4; ++g) {
    const f32x4 t0 = *(const f32x4*)(trow + 8 * g + 4 * hi), t1 = *(const f32x4*)(trow + 8 * g + 4 * hi + 2);
    const float cc[4] = {t0[0], t0[2], t1[0], t1[2]}, sn[4] = {t0[1], t0[3], t1[1], t1[3]};
#pragma unroll
    for (int i = 0; i < 4; ++i) { const int reg = 4 * g + i; ya[reg] = (xa[reg] * cc[i] - xb[reg] * sn[i]) * scale; yb[reg] = (xb[reg] * cc[i] + xa[reg] * sn[i]) * scale; }
  }
}
__device__ __forceinline__ void rope32(const f32x16& x, f32x16& y, const float2* __restrict__ trow, int hi, float scale) {
#pragma unroll
  for (int g = 0; g < 2; ++g) {
    const f32x4 t0 = *(const f32x4*)(trow + 8 * g + 4 * hi), t1 = *(const f32x4*)(trow + 8 * g + 4 * hi + 2);
    const float cc[4] = {t0[0], t0[2], t1[0], t1[2]}, sn[4] = {t0[1], t0[3], t1[1], t1[3]};
#pragma unroll
    for (int i = 0; i < 4; ++i) { const int reg = 4 * g + i; y[reg] = (x[reg] * cc[i] - x[reg + 8] * sn[i]) * scale; y[reg + 8] = (x[reg + 8] * cc[i] + x[reg] * sn[i]) * scale; }
  }
}
__device__ __forceinline__ float write_c_tile(LAS uchar* base, int pitch, const f32x16& vin, int rr, int f0, int hi) {
  const f32x16 v = vin * WIN_DESCALE;
  float ss = 0.f;
#pragma unroll
  for (int g = 0; g < 4; ++g) { u32x2 w; w.x = pk2(v[4 * g], v[4 * g + 1]); w.y = pk2(v[4 * g + 2], v[4 * g + 3]);
    *(LAS u32x2*)(base + a_off(rr, 2 * (f0 + 8 * g + 4 * hi), pitch)) = w;
    ss += v[4 * g] * v[4 * g] + v[4 * g + 1] * v[4 * g + 1] + v[4 * g + 2] * v[4 * g + 2] + v[4 * g + 3] * v[4 * g + 3]; }
  return ss;
}
__device__ __forceinline__ void store_img8_qk(uchar* img, const f32x16& v, int rb, int r32, int blk, int hi) {
#pragma unroll
  for (int g = 0; g < 4; ++g) { const unsigned w = pk4_fp8(v[4 * g], v[4 * g + 1], v[4 * g + 2], v[4 * g + 3]);
    const int off = blk < 2 ? rb * 4096 + (g >> 1) * 1024 + (blk * 32 + r32) * 16 + 8 * (g & 1) + 4 * hi : rb * 4096 + 2048 + ((g >> 1) * 32 + r32) * 16 + 8 * (g & 1) + 4 * hi;
    *(unsigned*)(img + off) = w; }
}
__device__ __forceinline__ void store_img8_v(uchar* img, const f32x16& v, int rb, int db, int r32, int hi) {
#pragma unroll
  for (int g = 0; g < 4; ++g) *(unsigned*)(img + db * 2048 + rb * 1024 + (hi * 32 + r32) * 16 + 4 * g) = pk4_fp8(v[4 * g], v[4 * g + 1], v[4 * g + 2], v[4 * g + 3]);
}
__device__ __forceinline__ void lds_fadd(LAS float* p, float v) { __hip_atomic_fetch_add(p, v, __ATOMIC_RELAXED, __HIP_MEMORY_SCOPE_WORKGROUP); }

__device__ __forceinline__ void phase1_tile(const KP& P, LAS uchar* lds, const int tile) {
  int lane_ = mk_lane(); asm volatile("" : "+v"(lane_)); const int lane = lane_ & 63, wave = P.wave, tid = wave * 64 + lane, r32 = lane & 31, hi = lane >> 5;
  uchar* ws = P.ws;
  const int t0 = tile * 64, b = t0 / SEQ, pos0 = t0 % SEQ, tb = pos0 >> 6;
  const float* __restrict__ x = P.in[0]; const float* __restrict__ mod = (const float*)(ws + WS_MOD) + b * (NMOD * DM); const float* __restrict__ g1 = P.in[4];
  LAS float* ssq = (LAS float*)(lds + LDS_MISC + 64);
  LAS uchar* krt = lds + LDS_MISC + 1024;
  const float2* tabA = (const float2*)(ws + WS_TABA); const float2* tabB = (const float2*)(ws + WS_TABB);
  if (tid < 128) ssq[tid] = 0.f;
  {
    f32x4 av[4], sv[4];
#pragma unroll
    for (int i = 0; i < 4; ++i) { const int k = 4 * (lane + 64 * i); const f32x4 g = *(const f32x4*)(g1 + k), sc = *(const f32x4*)(mod + DM + k); av[i] = g * (sc + 1.0f); sv[i] = *(const f32x4*)(mod + k); }
#pragma unroll
    for (int hf = 0; hf < 2; ++hf) {
      f32x4 xv[4][4];
#pragma unroll
      for (int rr = 0; rr < 4; ++rr)
#pragma unroll
        for (int i = 0; i < 4; ++i) xv[rr][i] = *(const f32x4*)(x + (size_t)(t0 + wave * 8 + hf * 4 + rr) * DM + 4 * (lane + 64 * i));
#pragma unroll
      for (int rr = 0; rr < 4; ++rr) {
        const int row = wave * 8 + hf * 4 + rr; float ss = 0.f;
#pragma unroll
        for (int i = 0; i < 4; ++i) { ss += xv[rr][i][0] * xv[rr][i][0] + xv[rr][i][1] * xv[rr][i][1] + xv[rr][i][2] * xv[rr][i][2] + xv[rr][i][3] * xv[rr][i][3];
          u32x2 xb; xb.x = pk2(xv[rr][i][0], xv[rr][i][1]); xb.y = pk2(xv[rr][i][2], xv[rr][i][3]);
          *(u32x2*)(ws + WS_XB + ((size_t)(t0 + row) * DM + 4 * (lane + 64 * i)) * 2) = xb; }
        ss = wave_sum(ss); const float rs = rsqrtf(ss * (1.0f / DM) + EPS);
#pragma unroll
        for (int i = 0; i < 4; ++i) { const f32x4 v = xv[rr][i] * rs * av[i] + sv[i];
          *(LAS unsigned*)(lds + a_off(row, 4 * (lane + 64 * i), 1024)) = pk4_fp8(v[0], v[1], v[2], v[3]); }
      }
    }
  }
  __syncthreads();
  const l64x2* WIN = (const l64x2*)(ws + WS_WIN);
#define WSLOT(slot) (WIN + (size_t)((slot) * 32) * 64 + lane)
  f32x16 acc[4][2]; acc_zero<4>(acc);
  f32x16 acc2[1][2]; acc_zero<1>(acc2);
  if (wave < 4) {
    { const l64x2* wp[4] = {WSLOT(4 * wave), WSLOT(4 * wave + 1), WSLOT(4 * wave + 2), WSLOT(4 * wave + 3)}; gemm_slots_f8<4, 4, 32, true, 1, 0x3210>(acc, lds, 1024, wp, lane); }
    if (wave < 3) { const l64x2* wp[1] = {WSLOT(wave == 0 ? 34 : 27 + wave)}; gemm_slots_f8<1, 1, 32, true, 2, 0x0>(acc2, lds, 1024, wp, lane); }
  } else if (wave == 4) {
    { const l64x2* wp[4] = {WSLOT(16), WSLOT(17), WSLOT(18), WSLOT(19)}; gemm_slots_f8<4, 4, 32, true, 1, 0x3210>(acc, lds, 1024, wp, lane); }
    { const l64x2* wp[2] = {WSLOT(33), WSLOT(42)}; gemm_slots_f8<2, 1, 32, true, 1, 0x00>(acc2, lds, 1024, wp, lane); }
  } else if (wave == 7) {
    { const l64x2* wp[4] = {WSLOT(30), WSLOT(39), WSLOT(31), WSLOT(40)}; gemm_slots_f8<4, 4, 32, true, 1, 0x1100>(acc, lds, 1024, wp, lane); }
    { const l64x2* wp[2] = {WSLOT(32), WSLOT(41)}; gemm_slots_f8<2, 4, 32, true, 1, 0x22>(acc, lds, 1024, wp, lane); }
  } else {
    const int kv = wave - 5;
    { const l64x2* wp[4] = {WSLOT(20 + 2 * kv), WSLOT(35 + 2 * kv), WSLOT(21 + 2 * kv), WSLOT(36 + 2 * kv)}; gemm_slots_f8<4, 4, 32, false, 1, 0x1100>(acc, lds, 1024, wp, lane); }
    { const l64x2* wp[2] = {WSLOT(24 + 2 * kv), WSLOT(25 + 2 * kv)}; gemm_slots_f8<2, 4, 32, true, 1, 0x32>(acc, lds, 1024, wp, lane); }
  }
#undef WSLOT
  int tid2_ = mk_lane(); asm volatile("" : "+v"(tid2_)); const int lane2 = tid2_ & 63;
#define lane lane2
  const int r32e = lane2 & 31, hie = lane2 >> 5;
#define r32 r32e
#define hi hie
  if (wave < 4) {
#pragma unroll
    for (int p = 0; p < 2; ++p) { uchar* img = ws + WS_QA + ((size_t)(b * 8 + 2 * wave + p) * 64 + tb) * 8192;
#pragma unroll
      for (int rb = 0; rb < 2; ++rb) { const int rr = 32 * rb + r32; f32x16 ya, yb; rope64(acc[2 * p][rb], acc[2 * p + 1][rb], ya, yb, tabA + (size_t)(pos0 + rr) * 32, hi, QSCALE_A * WIN_DESCALE);
        store_img_qk(img, ya, rr, 0, 4, hi); store_img_qk(img, yb, rr, 32, 4, hi); } }
    if (wave == 0) {
#pragma unroll
      for (int rb = 0; rb < 2; ++rb) { const int rr = 32 * rb + r32; f32x16 y; rope32(acc2[0][rb], y, tabB + (size_t)(pos0 + rr) * 16, hi, WIN_DESCALE);
#pragma unroll
        for (int g = 0; g < 4; ++g) { u32x2 w; w.x = pk2(y[4 * g], y[4 * g + 1]); w.y = pk2(y[4 * g + 2], y[4 * g + 3]); *(LAS u32x2*)(krt + rr * 64 + (8 * g + 4 * hi) * 2) = w; } }
    }
  } else if (wave == 4) {
#pragma unroll
    for (int p = 0; p < 2; ++p) { uchar* img = ws + WS_KVA + ((size_t)(b * 2 + p) * 64 + tb) * 16384;
#pragma unroll
      for (int rb = 0; rb < 2; ++rb) { const int rr = 32 * rb + r32; f32x16 ya, yb; rope64(acc[2 * p][rb], acc[2 * p + 1][rb], ya, yb, tabA + (size_t)(pos0 + rr) * 32, hi, WIN_DESCALE);
        store_img_qk(img, ya, rr, 0, 4, hi); store_img_qk(img, yb, rr, 32, 4, hi); } }
  } else if (wave == 5 || wave == 6) {
    uchar* img = ws + WS_KVA + ((size_t)(b * 2 + (wave - 5)) * 64 + tb) * 16384 + 8192;
#pragma unroll
    for (int i = 0; i < 2; ++i)
#pragma unroll
      for (int rb = 0; rb < 2; ++rb) { const f32x16 y = acc[i][rb] * WIN_DESCALE; store_img_v(img, y, rb, 32 * i + r32, hi); }
  }
  __syncthreads();
  if (wave != 0 && wave != 3) {
#pragma unroll
    for (int rb = 0; rb < 2; ++rb) { const int rr = 32 * rb + r32; float sq = 0.f, skv = 0.f;
      if (wave == 5 || wave == 6) { sq += write_c_tile(lds, 512, acc[2][rb], rr, 64 * (wave - 5), hi); sq += write_c_tile(lds, 512, acc[3][rb], rr, 64 * (wave - 5) + 32, hi); }
      else if (wave == 1 || wave == 2) sq += write_c_tile(lds, 512, acc2[0][rb], rr, 96 + 32 * wave, hi);
      else if (wave == 7) { skv += write_c_tile(lds + 32768, 256, acc[0][rb], rr, 0, hi); skv += write_c_tile(lds + 32768, 256, acc[1][rb], rr, 32, hi); skv += write_c_tile(lds + 32768, 256, acc[2][rb], rr, 64, hi); }
      else skv += write_c_tile(lds + 32768, 256, acc2[0][rb], rr, 96, hi);
      if (wave == 4 || wave == 7) lds_fadd(&ssq[64 + rr], skv); else lds_fadd(&ssq[rr], sq); }
  }
  __syncthreads();
  const int head = wave;
  uchar* imgQ = ws + WS_QB + ((size_t)(b * 8 + head) * 64 + tb) * 8192;
  uchar* imgKV = ws + WS_KVB + ((size_t)(b * 8 + head) * 64 + tb) * 12288;
  {
    f32x16 aq[3][2]; acc_zero<3>(aq);
    const bf16x8* wp[3];
#pragma unroll
    for (int i = 0; i < 3; ++i) wp[i] = (const bf16x8*)(ws + WS_WUQ) + (size_t)((3 * head + i) * 12) * 64 + lane;
    gemm_tile<3, 12, true>(aq, lds, 512, wp, lane);
#pragma unroll
    for (int rb = 0; rb < 2; ++rb) { const int rr = 32 * rb + r32; const float sc = rsqrtf(ssq[rr] * (1.0f / 192.0f) + EPS) * (8.0f * QSCALE_B);
      f32x16 y0 = aq[0][rb] * sc, y1 = aq[1][rb] * sc, y2; rope32(aq[2][rb], y2, tabB + (size_t)(pos0 + rr) * 16, hi, sc);
      store_img8_qk(imgQ, y0, rb, r32, 0, hi); store_img8_qk(imgQ, y1, rb, r32, 1, hi); store_img8_qk(imgQ, y2, rb, r32, 2, hi);
      *(u32x4*)(imgQ + rb * 4096 + 3072 + lane * 16) = u32x4{0u, 0u, 0u, 0u}; }
  }
  {
    f32x16 ak[2][2]; acc_zero<2>(ak);
    const bf16x8* wp[2];
#pragma unroll
    for (int i = 0; i < 2; ++i) wp[i] = (const bf16x8*)(ws + WS_WUKV) + (size_t)((4 * head + i) * 8) * 64 + lane;
    gemm_tile<2, 8, true>(ak, lds + 32768, 256, wp, lane);
#pragma unroll
    for (int rb = 0; rb < 2; ++rb) { const int rr = 32 * rb + r32; const float sc = rsqrtf(ssq[64 + rr] * (1.0f / 128.0f) + EPS);
      f32x16 y0 = ak[0][rb] * sc, y1 = ak[1][rb] * sc; store_img8_qk(imgKV, y0, rb, r32, 0, hi); store_img8_qk(imgKV, y1, rb, r32, 1, hi); }
#pragma unroll
    for (int rb = 0; rb < 2; ++rb) {
      const u32x4 c0 = *(const LAS u32x4*)(krt + (32 * rb + r32) * 64 + hi * 32), c1 = *(const LAS u32x4*)(krt + (32 * rb + r32) * 64 + hi * 32 + 16);
      u32x4 w;
      w.x = pk4_fp8(__uint_as_float(c0.x << 16), __uint_as_float(c0.x & 0xffff0000u), __uint_as_float(c0.y << 16), __uint_as_float(c0.y & 0xffff0000u));
      w.y = pk4_fp8(__uint_as_float(c0.z << 16), __uint_as_float(c0.z & 0xffff0000u), __uint_as_float(c0.w << 16), __uint_as_float(c0.w & 0xffff0000u));
      w.z = pk4_fp8(__uint_as_float(c1.x << 16), __uint_as_float(c1.x & 0xffff0000u), __uint_as_float(c1.y << 16), __uint_as_float(c1.y & 0xffff0000u));
      w.w = pk4_fp8(__uint_as_float(c1.z << 16), __uint_as_float(c1.z & 0xffff0000u), __uint_as_float(c1.w << 16), __uint_as_float(c1.w & 0xffff0000u));
      *(u32x4*)(imgKV + rb * 4096 + 2048 + lane * 16) = w;
      *(u32x4*)(imgKV + rb * 4096 + 3072 + lane * 16) = u32x4{hi ? 0u : 0x00003838u, 0u, 0u, 0u}; }
  }
  {
    f32x16 avv[2][2]; acc_zero<2>(avv);
    const bf16x8* wp[2];
#pragma unroll
    for (int i = 0; i < 2; ++i) wp[i] = (const bf16x8*)(ws + WS_WUKV) + (size_t)((4 * head + 2 + i) * 8) * 64 + lane;
    gemm_tile<2, 8, false>(avv, lds + 32768, 256, wp, lane);
#pragma unroll
    for (int rb = 0; rb < 2; ++rb) { f32x16 sc;
#pragma unroll
      for (int reg = 0; reg < 16; ++reg) sc[reg] = rsqrtf(ssq[64 + 32 * rb + crow(reg, hi)] * (1.0f / 128.0f) + EPS);
#pragma unroll
      for (int i = 0; i < 2; ++i) { f32x16 y = avv[i][rb] * sc; store_img8_v(imgKV + 8192, y, rb, i, r32, hi); } }
  }
  __syncthreads();
#undef lane
#undef r32
#undef hi
}
__device__ __forceinline__ float tile_max(const f32x16& p0, const f32x16& p1) {
  float t = __builtin_amdgcn_fmed3f(p0[0], p1[0], 3.0e38f);
  asm("v_max3_f32 %0, %0, %1, %2\n\tv_max3_f32 %0, %0, %3, %4\n\tv_max3_f32 %0, %0, %5, %6\n\tv_max3_f32 %0, %0, %7, %8\n\t"
      "v_max3_f32 %0, %0, %9, %10\n\tv_max3_f32 %0, %0, %11, %12\n\tv_max3_f32 %0, %0, %13, %14\n\tv_max3_f32 %0, %0, %15, %16"
      : "+v"(t) : "v"(p0[1]), "v"(p1[1]), "v"(p0[2]), "v"(p1[2]), "v"(p0[3]), "v"(p1[3]), "v"(p0[4]), "v"(p1[4]), "v"(p0[5]), "v"(p1[5]), "v"(p0[6]), "v"(p1[6]), "v"(p0[7]), "v"(p1[7]), "v"(p0[8]), "v"(p1[8]));
  asm("v_max3_f32 %0, %0, %1, %2\n\tv_max3_f32 %0, %0, %3, %4\n\tv_max3_f32 %0, %0, %5, %6\n\tv_max3_f32 %0, %0, %7, %8\n\t"
      "v_max3_f32 %0, %0, %9, %10\n\tv_max3_f32 %0, %0, %11, %12\n\tv_max3_f32 %0, %0, %13, %14"
      : "+v"(t) : "v"(p0[9]), "v"(p1[9]), "v"(p0[10]), "v"(p1[10]), "v"(p0[11]), "v"(p1[11]), "v"(p0[12]), "v"(p1[12]), "v"(p0[13]), "v"(p1[13]), "v"(p0[14]), "v"(p1[14]), "v"(p0[15]), "v"(p1[15]));
  return t;
}
constexpr float PXG = 128.0f / 65535.0f;
__device__ __forceinline__ void softmax_tile(f32x16& p0, f32x16& p1, f32x16& negm, float& m, float& l, f32x16& o0, f32x16& o1, bf16x8 (&pb)[2][2]) {
  const float tmax = half_swap_max(tile_max(p0, p1));
  if (__any(tmax > PXG * (127.0f + THR2))) {
    const float dm = fmaxf(tmax * (1.0f / PXG) - 127.0f, 0.f), alpha = __builtin_amdgcn_exp2f(-dm), dp = dm * PXG;
    m += dm; l *= alpha;
#pragma unroll
    for (int r = 0; r < 16; ++r) { o0[r] *= alpha; o1[r] *= alpha; p0[r] -= dp; p1[r] -= dp; negm[r] = PXG * (127.0f - m); }
  }
  typedef __bf16 bf2 __attribute__((ext_vector_type(2)));
  const bf2 one2 = __builtin_bit_cast(bf2, 0x3f803f80u);
  float s = 0.f;
#pragma unroll
  for (int ks = 0; ks < 2; ++ks) {
    unsigned a[4], c[4];
#pragma unroll
    for (int i = 0; i < 4; ++i) { a[i] = mk_pknorm(p0[8 * ks + 2 * i], p0[8 * ks + 2 * i + 1]); c[i] = mk_pknorm(p1[8 * ks + 2 * i], p1[8 * ks + 2 * i + 1]);
      s = __builtin_amdgcn_fdot2_f32_bf16(__builtin_bit_cast(bf2, a[i]), one2, s, false); s = __builtin_amdgcn_fdot2_f32_bf16(__builtin_bit_cast(bf2, c[i]), one2, s, false); }
    const u32x4 w0 = {a[0], a[1], a[2], a[3]}, w1 = {c[0], c[1], c[2], c[3]};
    pb[0][ks] = __builtin_bit_cast(bf16x8, w0); pb[1][ks] = __builtin_bit_cast(bf16x8, w1);
  }
  l += s;
}
__device__ __forceinline__ void pv_tile(const LAS uchar* vimg, const bf16x8 (&pb)[2][2], f32x16& o0, f32x16& o1, int lane) {
#pragma unroll
  for (int kb = 0; kb < 2; ++kb)
#pragma unroll
    for (int ks = 0; ks < 2; ++ks) {
      const bf16x8 v0 = *(const LAS bf16x8*)(vimg + ((((kb * 2 + 0) * 2 + ks) * 64) + lane) * 16);
      const bf16x8 v1 = *(const LAS bf16x8*)(vimg + ((((kb * 2 + 1) * 2 + ks) * 64) + lane) * 16);
      o0 = mfma(v0, pb[kb][ks], o0); o1 = mfma(v1, pb[kb][ks], o1);
    }
}
__device__ __forceinline__ void store_o(bf16_t* __restrict__ orow, f32x16& o0, f32x16& o1, float l, int hi) {
  const float inv = 1.0f / half_swap_sum(l);
#pragma unroll
  for (int g = 0; g < 4; ++g) {
    u32x2 w; w.x = pk2(o0[4 * g] * inv, o0[4 * g + 1] * inv); w.y = pk2(o0[4 * g + 2] * inv, o0[4 * g + 3] * inv); *(u32x2*)(orow + 8 * g + 4 * hi) = w;
    u32x2 z; z.x = pk2(o1[4 * g] * inv, o1[4 * g + 1] * inv); z.y = pk2(o1[4 * g + 2] * inv, o1[4 * g + 3] * inv); *(u32x2*)(orow + 32 + 8 * g + 4 * hi) = z;
  }
}

__device__ __forceinline__ void store_o_l(bf16_t* __restrict__ orow, f32x16& o0, f32x16& o1, float ltot, int hi) {
  const float inv = 1.0f / ltot;
#pragma unroll
  for (int g = 0; g < 4; ++g) {
    u32x2 w; w.x = pk2(o0[4 * g] * inv, o0[4 * g + 1] * inv); w.y = pk2(o0[4 * g + 2] * inv, o0[4 * g + 3] * inv); *(u32x2*)(orow + 8 * g + 4 * hi) = w;
    u32x2 z; z.x = pk2(o1[4 * g] * inv, o1[4 * g + 1] * inv); z.y = pk2(o1[4 * g + 2] * inv, o1[4 * g + 3] * inv); *(u32x2*)(orow + 32 + 8 * g + 4 * hi) = z;
  }
}
constexpr int SWA_LDS = 49152;
__device__ __forceinline__ void swa_unit(const KP& P, LAS uchar* lds_all, int u, bool prefetched) {
  LAS uchar* lds = lds_all + SWA_LDS;
  int lane_ = mk_lane(); asm volatile("" : "+v"(lane_)); const int lane = lane_ & 63, wave = P.wave, tid = wave * 64 + lane, r32 = lane & 31, hi = lane >> 5;
  uchar* ws = P.ws;
  const int n = u & 31, kvh = (u >> 5) & 1, b = u >> 6;
  const uchar* kvimg = ws + WS_KVA + (size_t)(b * 2 + kvh) * 64 * 16384;
  if (!prefetched) {
#pragma unroll 1
    for (int jt = 0; jt < 6; ++jt) { const int gt = 2 * n - 2 + jt; if (gt < 0 || gt >= 64) continue;
      const u32x4* src = (const u32x4*)(kvimg + (size_t)gt * 16384); LAS u32x4* dst = (LAS u32x4*)(lds + jt * 16384);
      const u32x4 v0 = src[tid], v1 = src[tid + 512]; dst[tid] = v0; dst[tid + 512] = v1; }
  }
  __syncthreads();
  const int rbq = wave & 3, jlo = rbq >> 1;
  bf16_t* O = (bf16_t*)(ws + WS_O);
#pragma unroll 1
  for (int hh = 0; hh < 2; ++hh) {
    const int head = kvh * 4 + 2 * (wave >> 2) + hh;
    const uchar* qimg = ws + WS_QA + ((size_t)(b * 8 + head) * 64 + 2 * n + (rbq >> 1)) * 8192;
    bf16x8 qf[4];
#pragma unroll
    for (int s = 0; s < 4; ++s) qf[s] = *(const bf16x8*)(qimg + ((((rbq & 1) * 4 + s) * 64) + lane) * 16);
    const float sink2 = P.in[10][head] * LOG2E;
    float m = sink2, l = hi ? 0.f : 1.f; f32x16 negm, o0 = {}, o1 = {};
#pragma unroll
    for (int r = 0; r < 16; ++r) negm[r] = PXG * (127.0f - sink2);
#pragma unroll 1
    for (int jt = jlo; jt < jlo + 5; ++jt) { const int gt = 2 * n - 2 + jt; if (gt < 0 || gt >= 64) continue;
      const LAS uchar* kimg = lds + jt * 16384;
      f32x16 p0 = negm, p1 = negm;
#pragma unroll
      for (int s = 0; s < 4; ++s) { const bf16x8 k0 = *(const LAS bf16x8*)(kimg + (((0 * 4 + s) * 64) + lane) * 16), k1 = *(const LAS bf16x8*)(kimg + (((1 * 4 + s) * 64) + lane) * 16);
        p0 = mfma(k0, qf[s], p0); p1 = mfma(k1, qf[s], p1); }
      if (jt == jlo || jt == jlo + 4) { const int base = 64 * jt - 32 * rbq - r32;
#pragma unroll
        for (int r = 0; r < 16; ++r) { const int d0 = base + crow(r, hi);
          p0[r] = ((unsigned)d0 <= 256u) ? p0[r] : -1e30f; p1[r] = ((unsigned)(d0 + 32) <= 256u) ? p1[r] : -1e30f; } }
      bf16x8 pb[2][2];
      softmax_tile(p0, p1, negm, m, l, o0, o1, pb);
      pv_tile(kimg + 8192, pb, o0, o1, lane);
    }
    store_o(O + (size_t)(b * SEQ + n * 128 + 32 * rbq + r32) * DM + head * 64, o0, o1, l, hi);
  }
  __syncthreads();
}

#define MK_LDS_RD(dst, vaddr, imm) asm volatile("ds_read_b128 %0, %1 offset:%2" : "=v"(dst) : "v"(vaddr), "i"(imm))
template <int N> __device__ __forceinline__ void lgkm_wait() { asm volatile("s_waitcnt lgkmcnt(%0)" :: "i"(N) : "memory"); __builtin_amdgcn_sched_barrier(0); }
__device__ __forceinline__ void pv_regs(const bf16x8 (&vf)[8], const bf16x8 (&pb)[2][2], f32x16& o0, f32x16& o1) {
#pragma unroll
  for (int kb = 0; kb < 2; ++kb)
#pragma unroll
    for (int ks = 0; ks < 2; ++ks) { o0 = mfma(vf[(kb * 2 + 0) * 2 + ks], pb[kb][ks], o0); o1 = mfma(vf[(kb * 2 + 1) * 2 + ks], pb[kb][ks], o1); }
}
__device__ __forceinline__ void mla_dma_step(const uchar* kvimg, LAS uchar* lds, int t, int wave, int lane) {
  const uchar* src = kvimg + (size_t)t * 24576 + wave * 3072 + lane * 16;
  LAS uchar* dst = lds + (t & 1) * 24576 + wave * 3072;
#pragma unroll
  for (int i = 0; i < 3; ++i) __builtin_amdgcn_global_load_lds((const unsigned*)(src + i * 1024), (LAS unsigned*)(dst + i * 1024), 16, 0, 0);
}
template <bool FIRST_POSSIBLE>
__device__ __forceinline__ float softmax_tile8(f32x16& p0, f32x16& p1, float& pad, int& qpad, f32x16& lacc, f32x16& o0, f32x16& o1, bool first, int hi, i32x4& pb0, i32x4& pb1) {
  float applied = 0.f;
  const float tmax_s = half_swap_max(tile_max(p0, p1));
  const bool fst = FIRST_POSSIBLE && first;
  if (fst || __any(tmax_s > 120.5f / 256.0f)) {
    const float tmax = tmax_s * 256.0f;
    const float want = fst ? tmax - 96.5f : fmaxf(tmax - 96.5f, 0.f);
    const float nt = pad - want;
    const int wa = __builtin_amdgcn_cvt_pk_fp8_f32(nt, 0.f, 0, false); const float fa = __builtin_amdgcn_cvt_f32_fp8(wa, 0);
    const int wb = __builtin_amdgcn_cvt_pk_fp8_f32(nt - fa, 0.f, 0, false); const float fb = __builtin_amdgcn_cvt_f32_fp8(wb, 0);
    const float pnew = fa + fb, dt = pad - pnew, dts = dt * (1.0f / 256.0f);
    const float alpha = fst ? 1.0f : __builtin_amdgcn_exp2f(-0.125f * dt);
    pad = pnew; applied = dts; qpad = hi ? 0 : ((wa & 0xff) | ((wb & 0xff) << 8));
#pragma unroll
    for (int r = 0; r < 16; ++r) { o0[r] *= alpha; o1[r] *= alpha; lacc[r] *= alpha; p0[r] -= dts; p1[r] -= dts; }
  }
#define MK_P8(P, R) __builtin_amdgcn_perm(mk_pknorm(P[(R) + 2], P[(R) + 3]), mk_pknorm(P[R], P[(R) + 1]), 0x07050301u)
  pb0.x = (int)MK_P8(p0, 0); pb0.y = (int)MK_P8(p0, 4); pb0.z = (int)MK_P8(p0, 8); pb0.w = (int)MK_P8(p0, 12);
  pb1.x = (int)MK_P8(p1, 0); pb1.y = (int)MK_P8(p1, 4); pb1.z = (int)MK_P8(p1, 8); pb1.w = (int)MK_P8(p1, 12);
#undef MK_P8
  return applied;
}
constexpr int N_PACK_JOBS = 3 * 8192;
struct PackJob { const float* p; int ldw; u32x4* dst; float scale; };
__device__ __forceinline__ PackJob pack_job(const KP& P, int f, int lane) {
  const int which = f >> 13, ff = f & 8191, r = lane & 31, h = lane >> 5, e = ff >> 8; PackJob j;
  if (which < 2) { const int nb = (ff >> 5) & 7, s = ff & 31; j.ldw = 256; j.scale = WGU_SCALE;
    j.p = P.in[19 + which] + (size_t)e * DM * 256 + (size_t)(32 * s + 16 * h) * 256 + 32 * nb + r; j.dst = (u32x4*)(P.ws + (which ? WS_WU : WS_WG)) + (size_t)ff * 64 + lane; }
  else { const int nb = (ff >> 3) & 31, s = ff & 7; j.ldw = DM; j.scale = WD_SCALE;
    j.p = P.in[21] + (size_t)e * 256 * DM + (size_t)(32 * s + 16 * h) * DM + 32 * nb + r; j.dst = (u32x4*)(P.ws + WS_WD) + (size_t)ff * 64 + lane; }
  return j;
}
__device__ __forceinline__ u32x4 pack_cvt(const float (&v)[16], float sc) {
  u32x4 w; w.x = pk4_fp8(v[0] * sc, v[1] * sc, v[2] * sc, v[3] * sc); w.y = pk4_fp8(v[4] * sc, v[5] * sc, v[6] * sc, v[7] * sc);
  w.z = pk4_fp8(v[8] * sc, v[9] * sc, v[10] * sc, v[11] * sc); w.w = pk4_fp8(v[12] * sc, v[13] * sc, v[14] * sc, v[15] * sc); return w;
}
__device__ __forceinline__ void mla_unit(const KP& P, LAS uchar* lds, int b, int head, int qblk, int& pk_k, int swa_u) {
  int lane_ = mk_lane(); asm volatile("" : "+v"(lane_)); const int lane = lane_ & 63, wave = P.wave, r32 = lane & 31, hi = lane >> 5;
  uchar* ws = P.ws;
  const uchar* kvimg = ws + WS_KVB + (size_t)(b * 8 + head) * 64 * 12288;
  const uchar* qimg = ws + WS_QB + ((size_t)(b * 8 + head) * 64 + qblk * 4 + (wave >> 1)) * 8192 + (wave & 1) * 4096 + lane * 16;
  const int gw = blockIdx.x * NWAVE + wave, NGW = gridDim.x * NWAVE;
  const i32x4 q00 = *(const i32x4*)(qimg), q01 = *(const i32x4*)(qimg + 1024), q10 = *(const i32x4*)(qimg + 2048);
  float pad = 56.5f; int qpad = hi ? 0 : 0x3066;
  f32x16 o0 = {}, o1 = {}, lacc = {};
  i32x8 ones8 = {0x38383838, 0x38383838, 0x38383838, 0x38383838, 0x38383838, 0x38383838, 0x38383838, 0x38383838};
  asm volatile("" : "+v"(ones8));
  mla_dma_step(kvimg, lds, 0, wave, lane);
#pragma unroll 1
  for (int t = 0; t < 32; ++t) {
    asm volatile("s_waitcnt vmcnt(0)" ::: "memory");
    __syncthreads();
    if (t + 1 < 32 && !(P.variant & 4)) mla_dma_step(kvimg, lds, t + 1, wave, lane);
    if (P.variant & 8) continue;
    u32x4 bandv = {}; int band_off = -1;
    if (swa_u >= 0 && t >= 20) { const int c = (wave * 64 + lane) + 512 * (t - 20), jt = c >> 10, gt = 2 * (swa_u & 31) - 2 + jt;
      if (gt >= 0 && gt < 64) { band_off = c * 16; bandv = *(const u32x4*)(ws + WS_KVA + ((size_t)((swa_u >> 6) * 2 + ((swa_u >> 5) & 1)) * 64 + gt) * 16384 + (c & 1023) * 16); } }
    const int pf = gw + pk_k * NGW; const bool do_pack = pf < N_PACK_JOBS;
    float pv[16]; u32x4* pdst = nullptr; float psc = 0.f;
    if (do_pack) { const PackJob j = pack_job(P, pf, lane); pdst = j.dst; psc = j.scale;
#pragma unroll
      for (int q = 0; q < 16; ++q) pv[q] = j.p[(size_t)q * j.ldw]; }
    f32x16 a0, a1, b0, b1; i32x4 pb0, pb1;
    { const unsigned va = (unsigned)(unsigned long)(lds + (t & 1) * 24576) + lane * 16;
#define MK_KOFF(j) (((j) >> 2) * 12288 + (((j) >> 1) & 1) * 4096 + ((j) & 1) * 2048)
      i32x4 kf[4][2];
#define MK_KRD(j) { MK_LDS_RD(kf[(j) & 3][0], va, MK_KOFF(j)); MK_LDS_RD(kf[(j) & 3][1], va, MK_KOFF(j) + 1024); }
      MK_KRD(0) MK_KRD(1) MK_KRD(2) MK_KRD(3)
      const i32x4 q11 = {qpad, 0, 0, 0};
#define MK_QK_STEP(j, ACC, NW) { lgkm_wait<NW>(); ACC = ((j) & 1) ? mfma_mx_q(kf[(j) & 3][0], kf[(j) & 3][1], q10, q11, ACC) : mfma_mx_q(kf[(j) & 3][0], kf[(j) & 3][1], q00, q01, f32x16{}); if ((j) + 4 < 8) MK_KRD(((j) + 4) & 7) }
      MK_QK_STEP(0, a0, 6) MK_QK_STEP(1, a0, 6) MK_QK_STEP(2, a1, 6) MK_QK_STEP(3, a1, 6) MK_QK_STEP(4, b0, 6) MK_QK_STEP(5, b0, 4) MK_QK_STEP(6, b1, 2) MK_QK_STEP(7, b1, 0)
#undef MK_QK_STEP
#undef MK_KRD
#undef MK_KOFF
      i32x4 vf[4];
#define MK_VRD(tile) { MK_LDS_RD(vf[0], va, (tile) * 12288 + 8192); MK_LDS_RD(vf[1], va, (tile) * 12288 + 8192 + 1024); MK_LDS_RD(vf[2], va, (tile) * 12288 + 8192 + 2048); MK_LDS_RD(vf[3], va, (tile) * 12288 + 8192 + 3072); }
      MK_VRD(0)
      const float dA = softmax_tile8<true>(a0, a1, pad, qpad, lacc, o0, o1, t == 0, hi, pb0, pb1);
      lacc = mfma_mx8(ones8, __builtin_shufflevector(pb0, pb1, 0, 1, 2, 3, 4, 5, 6, 7), lacc);
      lgkm_wait<0>();
      o0 = mfma_mx(vf[0], vf[1], pb0, pb1, o0); o1 = mfma_mx(vf[2], vf[3], pb0, pb1, o1);
      MK_VRD(1)
#undef MK_VRD
      if (__any(dA != 0.f)) {
#pragma unroll
        for (int r = 0; r < 16; ++r) { b0[r] -= dA; b1[r] -= dA; }
      }
      (void)softmax_tile8<false>(b0, b1, pad, qpad, lacc, o0, o1, false, hi, pb0, pb1);
      lacc = mfma_mx8(ones8, __builtin_shufflevector(pb0, pb1, 0, 1, 2, 3, 4, 5, 6, 7), lacc);
      lgkm_wait<0>();
      o0 = mfma_mx(vf[0], vf[1], pb0, pb1, o0); o1 = mfma_mx(vf[2], vf[3], pb0, pb1, o1);
    }
    if (do_pack) { *pdst = pack_cvt(pv, psc); ++pk_k; }
    if (band_off >= 0) *(LAS u32x4*)(lds + SWA_LDS + band_off) = bandv;
  }
  if (!(P.variant & 12)) store_o_l((bf16_t*)(ws + WS_O) + (size_t)(b * SEQ + qblk * 256 + 32 * wave + r32) * DM + 512 + head * 64, o0, o1, lacc[0], hi);
  __syncthreads();
}
__device__ __forceinline__ void phase2(const KP& P, LAS uchar* lds) {
  const int bid = blockIdx.x;
  int pk_k = 0;
  const bool pref = gridDim.x == 256 && !(P.variant & 3);
  if (!(P.variant & 2)) for (int i = bid; i < 512; i += gridDim.x) {
    const int rr = i >> 8, ii = i & 255, xcd = ii & 7, local = ii >> 3, pair = xcd * 4 + rr * 2 + (local >> 4), qblk = local & 15;
    mla_unit(P, lds, pair >> 3, pair & 7, qblk, pk_k, (pref && i >= 256) ? bid : -1);
  }
  if (!(P.variant & 1)) for (int u = bid; u < 256; u += gridDim.x) swa_unit(P, lds, u, pref);
  { const int lane = mk_lane(), wave = P.wave, gw = bid * NWAVE + wave, NGW = gridDim.x * NWAVE;
    for (int f = gw + pk_k * NGW; f < N_PACK_JOBS; f += NGW) { const PackJob j = pack_job(P, f, lane); float v[16];
#pragma unroll
      for (int q = 0; q < 16; ++q) v[q] = j.p[(size_t)q * j.ldw];
      *j.dst = pack_cvt(v, j.scale); } }
}
__device__ __forceinline__ void phase3_tile(const KP& P, LAS uchar* lds, const int tile) {
  int lane_ = mk_lane(); asm volatile("" : "+v"(lane_)); const int lane = lane_ & 63, wave = P.wave, tid = wave * 64 + lane, r32 = lane & 31, hi = lane >> 5;
  uchar* ws = P.ws;
  const int t0 = tile * 64, b = t0 / SEQ;
  const float* __restrict__ x = P.in[0]; const float* __restrict__ mod = (const float*)(ws + WS_MOD) + b * (NMOD * DM);
  LAS float* ssq = (LAS float*)(lds + LDS_MISC + 64);
  LAS int* selE = (LAS int*)(lds + LDS_MISC + 1024);
  LAS float* selW = (LAS float*)(lds + LDS_MISC + 1536);
  LAS int* selP = (LAS int*)(lds + LDS_MISC + 2048);
  LAS int* cntl = (LAS int*)(lds + LDS_MISC + 2560);
  LAS int* basel = (LAS int*)(lds + LDS_MISC + 2688);
  LAS float* logit = (LAS float*)(lds + LDS_MISC + 8192);
  if (tid < 64) ssq[tid] = 0.f;
  if (tid < 32) cntl[tid] = 0;
  {
    const bf16_t* O = (const bf16_t*)(ws + WS_O);
    float ga[8], gb[8];
#pragma unroll
    for (int j = 0; j < 8; ++j) { ga[j] = P.in[11][8 * lane + j]; gb[j] = P.in[12][8 * lane + j]; }
#pragma unroll
    for (int hf = 0; hf < 2; ++hf) {
      u32x4 va[4], vb[4];
#pragma unroll
      for (int rr = 0; rr < 4; ++rr) { const u32x4* src = (const u32x4*)(O + (size_t)(t0 + wave * 8 + hf * 4 + rr) * DM); va[rr] = src[lane]; vb[rr] = src[lane + 64]; }
#pragma unroll
      for (int rr = 0; rr < 4; ++rr) {
        const int row = wave * 8 + hf * 4 + rr; float fa[8], fb[8], sa = 0.f, sb = 0.f;
#pragma unroll
        for (int q = 0; q < 4; ++q) { fa[2 * q] = __uint_as_float(va[rr][q] << 16); fa[2 * q + 1] = __uint_as_float(va[rr][q] & 0xffff0000u);
          fb[2 * q] = __uint_as_float(vb[rr][q] << 16); fb[2 * q + 1] = __uint_as_float(vb[rr][q] & 0xffff0000u); }
#pragma unroll
        for (int j = 0; j < 8; ++j) { sa += fa[j] * fa[j]; sb += fb[j] * fb[j]; }
        sa = wave_sum(sa); sb = wave_sum(sb);
        const float ra = rsqrtf(sa * (1.0f / 512.0f) + EPS), rb_ = rsqrtf(sb * (1.0f / 512.0f) + EPS);
        u32x4 wa, wb;
#pragma unroll
        for (int q = 0; q < 4; ++q) { wa[q] = pk2(fa[2 * q] * ra * ga[2 * q], fa[2 * q + 1] * ra * ga[2 * q + 1]); wb[q] = pk2(fb[2 * q] * rb_ * gb[2 * q], fb[2 * q + 1] * rb_ * gb[2 * q + 1]); }
        *(LAS u32x4*)(lds + a_off(row, 16 * lane, 2048)) = wa; *(LAS u32x4*)(lds + a_off(row, 16 * (lane + 64), 2048)) = wb;
      }
    }
  }
  __syncthreads();
  f32x16 acc[4][2]; acc_zero<4>(acc);
  { const bf16x8* wp[4];
#pragma unroll
    for (int i = 0; i < 4; ++i) wp[i] = (const bf16x8*)(ws + WS_WOUT) + (size_t)((4 * wave + i) * 64) * 64 + lane;
    gemm_tile<4, 64, false, 5>(acc, lds, 2048, wp, lane); }
  if (P.variant & 2) { asm volatile("" :: "v"(acc[0][0][0]), "v"(acc[1][1][3]), "v"(acc[2][0][7]), "v"(acc[3][1][15])); return; }
  bf16_t* X1 = (bf16_t*)(ws + WS_X1); const unsigned short* XB = (const unsigned short*)(ws + WS_XB);
  float gt[4];
#pragma unroll
  for (int i = 0; i < 4; ++i) gt[i] = mod[2 * DM + 128 * wave + 32 * i + r32];
#pragma unroll
  for (int rb = 0; rb < 2; ++rb) {
    float xr[16][4];
#pragma unroll
    for (int reg = 0; reg < 16; ++reg) { const size_t off = (size_t)(t0 + 32 * rb + crow(reg, hi)) * DM + 128 * wave + r32;
#pragma unroll
      for (int i = 0; i < 4; ++i) xr[reg][i] = __uint_as_float((unsigned)XB[off + 32 * i] << 16); }
#pragma unroll
    for (int reg = 0; reg < 16; ++reg) { const int row = 32 * rb + crow(reg, hi); const size_t off = (size_t)(t0 + row) * DM + 128 * wave + r32; float ss = 0.f;
#pragma unroll
      for (int i = 0; i < 4; ++i) { const float v = xr[reg][i] + gt[i] * acc[i][rb][reg]; acc[i][rb][reg] = v; X1[off + 32 * i] = (bf16_t)(pk2(v, 0.f) & 0xffffu); ss += v * v; }
#pragma unroll
      for (int o = 16; o; o >>= 1) ss += __shfl_xor(ss, o);
      if (r32 == 0) lds_fadd(&ssq[row], ss); }
  }
  __syncthreads();
  { float a2[4], s2[4];
#pragma unroll
    for (int i = 0; i < 4; ++i) { const int col = 128 * wave + 32 * i + r32; a2[i] = P.in[14][col] * (1.0f + mod[4 * DM + col]); s2[i] = mod[3 * DM + col]; }
#pragma unroll
    for (int rb = 0; rb < 2; ++rb)
#pragma unroll
      for (int reg = 0; reg < 16; ++reg) { const int row = 32 * rb + crow(reg, hi); const float rs = rsqrtf(ssq[row] * (1.0f / DM) + EPS);
#pragma unroll
        for (int i = 0; i < 4; ++i) { const float v = acc[i][rb][reg] * rs * a2[i] + s2[i]; const int col = 128 * wave + 32 * i + r32;
          *(LAS bf16_t*)(lds + a_off(row, 2 * col, 2048)) = (bf16_t)(pk2(v, v) & 0xffffu); } }
  }
  __syncthreads();
  if (P.variant & 1) return;
  if (wave < 4) {
    f32x16 ar[1][2]; acc_zero<1>(ar);
    const bf16x8* wp[1]; wp[0] = (const bf16x8*)(ws + WS_WR) + (size_t)((wave >> 1) * 64) * 64 + lane;
    gemm_tile<1, 64, false>(ar, lds, 2048, wp, lane);
    const int rb = wave & 1, col = 32 * (wave >> 1) + r32;
#pragma unroll
    for (int reg = 0; reg < 16; ++reg) { const float v = rb ? ar[0][1][reg] : ar[0][0][reg]; logit[(32 * rb + crow(reg, hi)) * 64 + col] = v; }
  }
  { uchar* H2 = ws + WS_H2;
#pragma unroll
    for (int rr = 0; rr < 8; ++rr) { const int row = wave * 8 + rr;
      const u32x4 v0 = *(const LAS u32x4*)(lds + a_off(row, 16 * lane, 2048)), v1 = *(const LAS u32x4*)(lds + a_off(row, 16 * (lane + 64), 2048));
      u32x2 w0, w1;
      w0.x = pk4_fp8(__uint_as_float(v0.x << 16) * H2_SCALE, __uint_as_float(v0.x & 0xffff0000u) * H2_SCALE, __uint_as_float(v0.y << 16) * H2_SCALE, __uint_as_float(v0.y & 0xffff0000u) * H2_SCALE);
      w0.y = pk4_fp8(__uint_as_float(v0.z << 16) * H2_SCALE, __uint_as_float(v0.z & 0xffff0000u) * H2_SCALE, __uint_as_float(v0.w << 16) * H2_SCALE, __uint_as_float(v0.w & 0xffff0000u) * H2_SCALE);
      w1.x = pk4_fp8(__uint_as_float(v1.x << 16) * H2_SCALE, __uint_as_float(v1.x & 0xffff0000u) * H2_SCALE, __uint_as_float(v1.y << 16) * H2_SCALE, __uint_as_float(v1.y & 0xffff0000u) * H2_SCALE);
      w1.y = pk4_fp8(__uint_as_float(v1.z << 16) * H2_SCALE, __uint_as_float(v1.z & 0xffff0000u) * H2_SCALE, __uint_as_float(v1.w << 16) * H2_SCALE, __uint_as_float(v1.w & 0xffff0000u) * H2_SCALE);
      u32x2* dst = (u32x2*)(H2 + (size_t)(t0 + row) * DM); dst[lane] = w0; dst[lane + 64] = w1; } }
  __syncthreads();
  if (tid < 64) {
    const float* lg = (const float*)0; (void)lg;
    float gl[4];
#pragma unroll
    for (int i = 0; i < 4; ++i) gl[i] = logit[tid * 64 + i] + P.in[16][i];
    int gi = 0; float gm = gl[0];
#pragma unroll
    for (int i = 1; i < 4; ++i) if (gl[i] > gm) { gm = gl[i]; gi = i; }
    float gs = 0.f;
#pragma unroll
    for (int i = 0; i < 4; ++i) gs += __expf(gl[i] - gm);
    const float gw = 1.0f / gs;
    float el[8];
#pragma unroll
    for (int i = 0; i < 8; ++i) el[i] = logit[tid * 64 + 4 + gi * 8 + i] + P.in[18][gi * 8 + i];
    int i1 = 0; float m1 = el[0];
#pragma unroll
    for (int i = 1; i < 8; ++i) if (el[i] > m1) { m1 = el[i]; i1 = i; }
    int i2 = (i1 + 1) & 7; float m2 = el[i2];
#pragma unroll
    for (int i = 0; i < 8; ++i) if (i != i1 && el[i] > m2) { m2 = el[i]; i2 = i; }
    const float p2 = __expf(m2 - m1), w1 = 1.0f / (1.0f + p2), w2 = p2 * w1;
    const int e1 = gi * 8 + i1, e2 = gi * 8 + i2;
    selE[2 * tid] = e1; selE[2 * tid + 1] = e2; selW[2 * tid] = gw * w1; selW[2 * tid + 1] = gw * w2;
    selP[2 * tid] = __hip_atomic_fetch_add(&cntl[e1], 1, __ATOMIC_RELAXED, __HIP_MEMORY_SCOPE_WORKGROUP);
    selP[2 * tid + 1] = __hip_atomic_fetch_add(&cntl[e2], 1, __ATOMIC_RELAXED, __HIP_MEMORY_SCOPE_WORKGROUP);
  }
  __syncthreads();
  if (tid < 32) { const int c = cntl[tid]; basel[tid] = c ? atomicAdd((int*)(ws + WS_CNT) + tid, c) : 0; }
  __syncthreads();
  if (tid < 128) { const int e = selE[tid], pos = basel[e] + selP[tid];
    ((int*)(ws + WS_LIST))[(size_t)e * 16384 + pos] = (t0 + (tid >> 1)) * 2 + (tid & 1);
    ((float*)(ws + WS_WT))[(size_t)(t0 + (tid >> 1)) * 2 + (tid & 1)] = selW[tid]; }
  __syncthreads();
}

constexpr int P4_ROWS = 144, P4_NRB = 5, P4_MISC = P4_ROWS * 1024;
__device__ __forceinline__ void phase4(const KP& P, LAS uchar* lds) {
  int lane_ = mk_lane(); asm volatile("" : "+v"(lane_)); const int lane = lane_ & 63, wave = P.wave, tid = wave * 64 + lane, r32 = lane & 31, hi = lane >> 5;
  uchar* ws = P.ws;
  LAS int* rinfo = (LAS int*)(lds + P4_MISC + 1024);
  LAS float* rwt = (LAS float*)(lds + P4_MISC + 2048);
  LAS int* ustart = (LAS int*)(lds + P4_MISC + 3072);
  const int* cnt = (const int*)(ws + WS_CNT);
  if (tid == 0) { int acc_ = 0; for (int e = 0; e < 32; ++e) { ustart[e] = acc_; acc_ += (cnt[e] + P4_ROWS - 1) / P4_ROWS; } ustart[32] = acc_; }
  __syncthreads();
  const int total = ustart[32];
  const uchar* H2 = ws + WS_H2; bf16_t* Y = (bf16_t*)(ws + WS_Y);
#pragma unroll 1
  for (int u = blockIdx.x; u < total; u += gridDim.x) {
    int e = 0;
#pragma unroll 1
    for (int k = 1; k < 32; ++k) if (ustart[k] <= u) e = k;
    const int ne = cnt[e], ke = ustart[e + 1] - ustart[e], q = (ne + ke - 1) / ke, j = u - ustart[e], base = j * q, len = min(q, ne - base), nrb = (len + 31) >> 5;
    if (tid < 160) { int info = -1; float w = 0.f;
      if (tid < len) { info = ((const int*)(ws + WS_LIST))[(size_t)e * 16384 + base + tid]; w = ((const float*)(ws + WS_WT))[info]; }
      rinfo[tid] = info; rwt[tid] = w; }
    __syncthreads();
#pragma unroll
    for (int hf = 0; hf < 2; ++hf) {
      u32x4 v[9];
#pragma unroll
      for (int rr = 0; rr < 9; ++rr) { const int info = rinfo[wave * 18 + hf * 9 + rr]; const int tok = info < 0 ? 0 : (info >> 1); v[rr] = ((const u32x4*)(H2 + (size_t)tok * DM))[lane]; }
#pragma unroll
      for (int rr = 0; rr < 9; ++rr) *(LAS u32x4*)(lds + a_off(wave * 18 + hf * 9 + rr, 16 * lane, 1024)) = v[rr];
    }
    __syncthreads();
    f32x16 ag[2][P4_NRB];
#pragma unroll
    for (int i = 0; i < 2; ++i)
#pragma unroll
      for (int rb = 0; rb < P4_NRB; ++rb) ag[i][rb] = f32x16{};
    { const l64x2* wp[2];
      wp[0] = (const l64x2*)(ws + WS_WG) + (size_t)((e * 8 + wave) * 32) * 64 + lane;
      wp[1] = (const l64x2*)(ws + WS_WU) + (size_t)((e * 8 + wave) * 32) * 64 + lane;
      if (!(P.variant & 2)) gemm_tile_f8<2, 32, true, 1, false, P4_NRB>(ag, lds, 1024, wp, lane, nrb); }
    __syncthreads();
    { constexpr float S1 = 1.0f / (H2_SCALE * WGU_SCALE);
#pragma unroll
      for (int rb = 0; rb < P4_NRB; ++rb) if (rb < nrb) { const int rr = 32 * rb + r32; const float w = rwt[rr] * HID_SCALE;
#pragma unroll
        for (int g = 0; g < 4; ++g) { float hv[4];
#pragma unroll
          for (int i = 0; i < 4; ++i) { const float gg = ag[0][rb][4 * g + i] * S1, uu = ag[1][rb][4 * g + i] * S1; hv[i] = gg / (1.0f + __expf(-gg)) * uu * w; }
          *(LAS unsigned*)(lds + a_off(rr, 32 * wave + 8 * g + 4 * hi, 256)) = pk4_fp8(hv[0], hv[1], hv[2], hv[3]); } } }
    __syncthreads();
#pragma unroll 1
    for (int pass = (P.variant & 1) ? 2 : 0; pass < 2; ++pass) {
      f32x16 ad[2][P4_NRB];
#pragma unroll
      for (int i = 0; i < 2; ++i)
#pragma unroll
        for (int rb = 0; rb < P4_NRB; ++rb) ad[i][rb] = f32x16{};
      const l64x2* wp[2];
#pragma unroll
      for (int i = 0; i < 2; ++i) wp[i] = (const l64x2*)(ws + WS_WD) + (size_t)((e * 32 + 4 * wave + 2 * pass + i) * 8) * 64 + lane;
      gemm_tile_f8<2, 8, false, 1, false, P4_NRB>(ad, lds, 256, wp, lane, nrb);
      constexpr float S2 = 1.0f / (HID_SCALE * WD_SCALE);
#pragma unroll
      for (int rb = 0; rb < P4_NRB; ++rb) if (rb < nrb) {
#pragma unroll
        for (int reg = 0; reg < 16; ++reg) { const int info = rinfo[32 * rb + crow(reg, hi)];
          if (info >= 0) { bf16_t* yp = Y + (size_t)info * DM + 128 * wave + 64 * pass + r32;
            yp[0] = (bf16_t)(pk2(ad[0][rb][reg] * S2, 0.f) & 0xffffu); yp[32] = (bf16_t)(pk2(ad[1][rb][reg] * S2, 0.f) & 0xffffu); } } }
    }
    __syncthreads();
  }
}

__device__ __forceinline__ void phase5(const KP& P) {
  int lane_ = mk_lane(); asm volatile("" : "+v"(lane_)); const int lane = lane_ & 63, wave = P.wave;
  uchar* ws = P.ws;
  const bf16_t* Y = (const bf16_t*)(ws + WS_Y);
  const bf16_t* X1 = (const bf16_t*)(ws + WS_X1); float* OUT = P.out;
  f32x4 gf[4];
#pragma unroll
  for (int i = 0; i < 4; ++i) gf[i] = *(const f32x4*)(P.in[22] + 4 * (lane + 64 * i));
  constexpr int RPI = 4;
  const int nwv = gridDim.x * NWAVE, wv = blockIdx.x * NWAVE + wave;
#pragma unroll 1
  for (int t0 = wv * RPI; t0 < T; t0 += nwv * RPI) {
    u32x2 xv[RPI][4]; u32x2 ya[RPI][4], yb[RPI][4];
#pragma unroll
    for (int r = 0; r < RPI; ++r)
#pragma unroll
      for (int i = 0; i < 4; ++i) { const int k = 4 * (lane + 64 * i); const size_t t = t0 + r;
        xv[r][i] = *(const u32x2*)(X1 + t * DM + k); ya[r][i] = *(const u32x2*)(Y + (2 * t) * DM + k); yb[r][i] = *(const u32x2*)(Y + (2 * t + 1) * DM + k); }
    const int b = t0 / SEQ; const float* gt2 = (const float*)(ws + WS_MOD) + b * (NMOD * DM) + 5 * DM;
    f32x4 g2v[4];
#pragma unroll
    for (int i = 0; i < 4; ++i) g2v[i] = *(const f32x4*)(gt2 + 4 * (lane + 64 * i));
#pragma unroll
    for (int r = 0; r < RPI; ++r) {
      f32x4 v[4]; float ss = 0.f;
#pragma unroll
      for (int i = 0; i < 4; ++i) { const u32x2 y0 = ya[r][i], y1 = yb[r][i]; f32x4 ys;
        ys[0] = __uint_as_float(y0.x << 16) + __uint_as_float(y1.x << 16); ys[1] = __uint_as_float(y0.x & 0xffff0000u) + __uint_as_float(y1.x & 0xffff0000u);
        ys[2] = __uint_as_float(y0.y << 16) + __uint_as_float(y1.y << 16); ys[3] = __uint_as_float(y0.y & 0xffff0000u) + __uint_as_float(y1.y & 0xffff0000u);
        f32x4 xf; xf[0] = __uint_as_float(xv[r][i].x << 16); xf[1] = __uint_as_float(xv[r][i].x & 0xffff0000u); xf[2] = __uint_as_float(xv[r][i].y << 16); xf[3] = __uint_as_float(xv[r][i].y & 0xffff0000u);
        v[i] = xf + g2v[i] * ys; ss += v[i][0] * v[i][0] + v[i][1] * v[i][1] + v[i][2] * v[i][2] + v[i][3] * v[i][3]; }
      ss = wave_sum(ss); const float rs = rsqrtf(ss * (1.0f / DM) + EPS);
#pragma unroll
      for (int i = 0; i < 4; ++i) *(f32x4*)(OUT + (size_t)(t0 + r) * DM + 4 * (lane + 64 * i)) = v[i] * rs * gf[i];
    }
  }
}
__global__ void __launch_bounds__(NTHR, 2) mk_fwd(const Params P0) {
  extern __shared__ __attribute__((aligned(16))) uchar lds_raw[];
  LAS uchar* lds = (LAS uchar*)lds_raw;
  KP P; P.in = P0.in; P.out = P0.out; P.ws = P0.ws; P.ph_lo = P0.ph_lo; P.ph_hi = P0.ph_hi; P.variant = P0.variant; P.wave = __builtin_amdgcn_readfirstlane((int)(threadIdx.x >> 6));
  const int bid = blockIdx.x, G = gridDim.x;
  const int lo = P.ph_lo, hi = P.ph_hi;
  volatile LAS unsigned* bst = (volatile LAS unsigned*)(lds + LDS_BYTES - 16);
  if (threadIdx.x < 4) bst[threadIdx.x] = 0u;
  __syncthreads();
  XcdBarrier bar; bar.bar = (unsigned*)(P.ws + WS_CTL); bar.x = 0; bar.st = bst;
  if (hi - lo > 1) bar = xcd_barrier_post((unsigned*)(P.ws + WS_CTL), bst, P.wave == 0 && mk_lane() == 0);
#define IN(k) (lo <= (k) && (k) < hi)
#define BOTH(k) (IN(k) && IN((k) + 1))
  if (IN(0)) { phase0(P, lds); if (BOTH(0)) xcd_barrier(bar, P.wave == 0 && mk_lane() == 0); }
  if (IN(1)) { if (bid < T / 64) phase1_tile(P, lds, bid); if (BOTH(1)) xcd_barrier(bar, P.wave == 0 && mk_lane() == 0); }
  if (IN(2)) { phase2(P, lds); if (BOTH(2)) xcd_barrier(bar, P.wave == 0 && mk_lane() == 0); }
  if (IN(3)) { if (bid < T / 64) phase3_tile(P, lds, bid); if (BOTH(3)) xcd_barrier(bar, P.wave == 0 && mk_lane() == 0); }
  if (IN(4)) { phase4(P, lds); if (BOTH(4)) xcd_barrier(bar, P.wave == 0 && mk_lane() == 0); }
  if (IN(5)) phase5(P);
#undef IN
#undef BOTH
}

extern "C" void kernel_launch(void* const* d_in, const int* in_sizes, int n_in, void* d_out, int out_size, void* d_ws, size_t ws_size, hipStream_t stream) {
  static int ready = 0;
  if (!ready) {
    if (n_in != 23 || out_size != T * DM || ws_size < WS_END) { fprintf(stderr, "kernel_launch: unexpected shapes (n_in %d out %d ws %zu need %zu)\n", n_in, out_size, ws_size, (size_t)WS_END); return; }
    if (hipFuncSetAttribute((const void*)mk_fwd, hipFuncAttributeMaxDynamicSharedMemorySize, LDS_BYTES) != hipSuccess) { fprintf(stderr, "kernel_launch: hipFuncSetAttribute failed\n"); return; }
    ready = 1;
  }
  uchar* ws = (uchar*)d_ws;
  if (hipMemsetAsync(ws + WS_CTL, 0, 32768, stream) != hipSuccess) { fprintf(stderr, "kernel_launch: hipMemsetAsync failed\n"); return; }
  Params p{};
  for (int i = 0; i < 23; ++i) p.in[i] = (const float*)d_in[i];
  p.out = (float*)d_out; p.ws = ws; p.ph_lo = 0; p.ph_hi = 6; p.variant = 0; p.pad = 0;
  hipLaunchKernelGGL(mk_fwd, dim3(T / 64), dim3(NTHR), LDS_BYTES, stream, p);
}
```

```cpp
#include <hip/hip_runtime.h>
#include <cstdio>
#include <cstdint>
constexpr int DM = 1024, NB = 4, SEQ = 4096, T = NB * SEQ;
constexpr int INW = 1120, NMOD = 6;
constexpr float EPS = 1e-6f;
#define LAS __attribute__((address_space(3)))
typedef unsigned short bf16_t;
typedef short bf16x8 __attribute__((ext_vector_type(8)));
typedef float f32x16 __attribute__((ext_vector_type(16)));
typedef float f32x4 __attribute__((ext_vector_type(4)));
typedef unsigned u32x4 __attribute__((ext_vector_type(4)));
typedef unsigned u32x2 __attribute__((ext_vector_type(2)));
typedef unsigned char uchar;

constexpr int NTHR = 512, NWAVE = 8;
constexpr int LDS_A = 0, LDS_MISC = 131072, LDS_BYTES = 163840;
constexpr float LOG2E = 1.4426950408889634f;
constexpr float QSCALE_A = 0.125f * LOG2E * (128.0f / 65535.0f);
constexpr float QSCALE_B = 0.10206207261596575f * LOG2E;
constexpr float THR2 = 10.f;
constexpr float WIN_SCALE = 64.f, WIN_DESCALE = 1.0f / 64.f;
constexpr float H2_SCALE = 8.f, WGU_SCALE = 64.f, WD_SCALE = 32.f, HID_SCALE = 8.f;

constexpr size_t WS_CTL   = 0;
constexpr size_t WS_CNT   = 16384;
constexpr size_t WS_MOD   = 32768;
constexpr size_t WS_TABA  = WS_MOD + 98304;
constexpr size_t WS_TABB  = WS_TABA + 4096 * 32 * 8;
constexpr size_t WS_WIN   = WS_TABB + 4096 * 16 * 8;
constexpr size_t WS_WUQ   = WS_WIN + 35 * 64 * 1024;
constexpr size_t WS_WUKV  = WS_WUQ + 24 * 12 * 1024;
constexpr size_t WS_WOUT  = WS_WUKV + 32 * 8 * 1024;
constexpr size_t WS_WR    = WS_WOUT + 32 * 64 * 1024;
constexpr size_t WS_WG    = WS_WR + 2 * 64 * 1024;
constexpr size_t WS_WU    = WS_WG + (size_t)32 * 8 * 32 * 1024;
constexpr size_t WS_WD    = WS_WU + (size_t)32 * 8 * 32 * 1024;
constexpr size_t WS_LIST  = WS_WD + (size_t)32 * 32 * 8 * 1024;
constexpr size_t WS_WT    = WS_LIST + (size_t)32 * 16384 * 4;
constexpr size_t WS_QA    = WS_WT + (size_t)T * 2 * 4;
constexpr size_t WS_KVA   = WS_QA + (size_t)NB * 8 * 64 * 8192;
constexpr size_t WS_QB    = WS_KVA + (size_t)NB * 2 * 64 * 16384;
constexpr size_t WS_KVB   = WS_QB + (size_t)NB * 8 * 64 * 12288;
constexpr size_t WS_O     = WS_KVB + (size_t)NB * 8 * 64 * 20480;
constexpr size_t WS_H2    = WS_O + (size_t)T * DM * 2;
constexpr size_t WS_X1    = WS_H2 + (size_t)T * DM * 2;
constexpr size_t WS_XB    = WS_X1 + (size_t)T * DM * 2;
constexpr size_t WS_END   = WS_XB + (size_t)T * DM * 2;
constexpr size_t WS_Y     = WS_QA;
static_assert((size_t)T * 2 * DM * 2 <= WS_O - WS_QA, "Y overlay");

struct Params { const float* in[23]; float* out; unsigned char* ws; int ph_lo, ph_hi, variant, pad; };
struct KP { const float* const* in; float* out; unsigned char* ws; int ph_lo, ph_hi, wave, variant; };
__device__ __forceinline__ int mk_lane() { return (int)__builtin_amdgcn_mbcnt_hi(~0u, __builtin_amdgcn_mbcnt_lo(~0u, 0u)); }

__device__ __forceinline__ unsigned pk2(float lo, float hi) { unsigned r; asm("v_cvt_pk_bf16_f32 %0, %1, %2" : "=v"(r) : "v"(lo), "v"(hi)); return r; }
__device__ __forceinline__ float bf2f(unsigned short v) { return __uint_as_float((unsigned)v << 16); }
__host__ __device__ __forceinline__ constexpr int crow(int r, int hi) { return (r & 3) + 8 * (r >> 2) + 4 * hi; }
__device__ __forceinline__ f32x16 mfma(bf16x8 a, bf16x8 b, f32x16 c) { return __builtin_amdgcn_mfma_f32_32x32x16_bf16(a, b, c, 0, 0, 0); }
__device__ __forceinline__ float wave_sum(float v) {
#pragma unroll
  for (int o = 32; o; o >>= 1) v += __shfl_xor(v, o);
  return v;
}
__device__ __forceinline__ float half_swap_max(float x) { auto rr = __builtin_amdgcn_permlane32_swap(__float_as_uint(x), __float_as_uint(x), false, false);
  float m; asm("v_max_f32 %0, %1, %2" : "=v"(m) : "v"(rr[0]), "v"(rr[1])); return m; }
__device__ __forceinline__ float half_swap_sum(float x) { auto rr = __builtin_amdgcn_permlane32_swap(__float_as_uint(x), __float_as_uint(x), false, false); return __uint_as_float(rr[0]) + __uint_as_float(rr[1]); }
template <typename TT> __device__ __forceinline__ void st_wt(TT* p, TT v) { __hip_atomic_store(p, v, __ATOMIC_RELAXED, __HIP_MEMORY_SCOPE_AGENT); }
__device__ __forceinline__ void st_wt8(void* p, u32x2 v) { st_wt((unsigned long long*)p, __builtin_bit_cast(unsigned long long, v)); }
__device__ __forceinline__ void st_wt16(void* p, u32x4 v) { st_wt8(p, u32x2{v.x, v.y}); st_wt8((uchar*)p + 8, u32x2{v.z, v.w}); }
__host__ __device__ __forceinline__ constexpr int a_off(int row, int kbyte, int pitch) { return row * pitch + (kbyte ^ ((row & 15) << 4)); }
__host__ __device__ __forceinline__ constexpr int img_qk(int rr, int d, int NS) { return ((((rr >> 5) * NS + (d >> 4)) * 64) + ((d >> 3) & 1) * 32 + (rr & 31)) * 16 + (d & 7) * 2; }
__host__ __device__ __forceinline__ constexpr int img_v(int kk, int d) {
  const int kb = kk >> 5, k32 = kk & 31, s = k32 >> 4, k16 = k32 & 15, h = (k16 >> 2) & 1, j = ((k16 >> 3) << 2) | (k16 & 3), db = d >> 5, r = d & 31;
  return (((((kb * 2 + db) * 2 + s) * 64) + h * 32 + r) * 8 + j) * 2;
}

#define XB_TMO      128
#define XB_XCNT(j)  (256  + 64 * (j))
#define XB_XSUB(j)  (1280 + 64 * (j))
#define XB_XGEN(j)  (2304 + 64 * (j))
#define XB_TOP      3328
#define XB_TOPGEN   3392
#define XCD_BAR_WORDS 3456
#define XB_SPIN_CAP (1u << 20)
__device__ __forceinline__ unsigned xb_ld(unsigned* p)              { return __hip_atomic_load(p, __ATOMIC_RELAXED, __HIP_MEMORY_SCOPE_AGENT); }
__device__ __forceinline__ unsigned xb_add(unsigned* p, unsigned v) { return __hip_atomic_fetch_add(p, v, __ATOMIC_RELAXED, __HIP_MEMORY_SCOPE_AGENT); }
__device__ __forceinline__ unsigned xb_xcc_id() { return (unsigned)__builtin_amdgcn_s_getreg((3 << 11) | 20) & 0xFu; }
#define XB_SPIN(cond, bar) do { unsigned _sp = 0; while (cond) { __builtin_amdgcn_s_sleep(1); \
    if ((++_sp & 255u) == 0u) { if (xb_ld(&(bar)[XB_TMO])) break; if (_sp > XB_SPIN_CAP) { atomicAdd(&(bar)[XB_TMO], 1u); break; } } } } while (0)
struct XcdBarrier { unsigned* bar; unsigned x; volatile LAS unsigned* st; };
__device__ __forceinline__ XcdBarrier xcd_barrier_post(unsigned* bar, volatile LAS unsigned* st, bool leader) {
  XcdBarrier b; b.bar = bar; b.x = xb_xcc_id(); b.st = st;
  if (leader) (void)xb_add(&bar[XB_XCNT(b.x)], 1u);
  return b;
}
__device__ __forceinline__ void xcd_barrier_complete(unsigned* bar, unsigned x, unsigned& nloc, unsigned& nx) {
  const unsigned G = gridDim.x * gridDim.y * gridDim.z;
  unsigned sum, cnt, mine, sp = 0u;
  for (;;) {
    sum = 0u; cnt = 0u; mine = 0u;
#pragma unroll
    for (unsigned j = 0; j < 16; ++j) { const unsigned c = xb_ld(&bar[XB_XCNT(j)]); sum += c; cnt += (c > 0u) ? 1u : 0u; mine = (j == x) ? c : mine; }
    if (sum == G) break;
    __builtin_amdgcn_s_sleep(1);
    if ((++sp & 255u) == 0u) { if (xb_ld(&bar[XB_TMO])) break; if (sp > XB_SPIN_CAP) { atomicAdd(&bar[XB_TMO], 1u); break; } }
  }
  nloc = mine > 0u ? mine : 1u; nx = cnt > 0u ? cnt : 1u;
}
__device__ __forceinline__ void xcd_barrier(const XcdBarrier& b, bool leader) {
  asm volatile("s_waitcnt vmcnt(0)" ::: "memory");
  __syncthreads();
  if (leader) {
    unsigned* bar = b.bar;
    __builtin_amdgcn_s_waitcnt(0);
    unsigned nloc = b.st[0], nx = b.st[1];
    if (nloc == 0u) { xcd_barrier_complete(bar, b.x, nloc, nx); b.st[0] = nloc; b.st[1] = nx; }
    const unsigned old = xb_add(&bar[XB_XSUB(b.x)], 1u);
    const unsigned gen = old / nloc;
    if (old + 1u == (gen + 1u) * nloc) {
      __builtin_amdgcn_fence(__ATOMIC_RELEASE, "agent");
      asm volatile("s_waitcnt vmcnt(0)" ::: "memory");
      const unsigned og = xb_add(&bar[XB_TOP], 1u);
      const unsigned tg = og / nx;
      if (og + 1u == (tg + 1u) * nx) xb_add(&bar[XB_TOPGEN], 1u);
      else XB_SPIN(xb_ld(&bar[XB_TOPGEN]) == tg, bar);
      __builtin_amdgcn_fence(__ATOMIC_ACQUIRE, "agent");
      xb_add(&bar[XB_XGEN(b.x)], 1u);
      asm volatile("s_waitcnt vmcnt(0)" ::: "memory");
    } else {
      XB_SPIN(xb_ld(&bar[XB_XGEN(b.x)]) == gen, bar);
      __builtin_amdgcn_fence(__ATOMIC_ACQUIRE, "agent");
      asm volatile("s_waitcnt vmcnt(0)" ::: "memory");
    }
  }
  __syncthreads();
}

template <int NBLK, int NS, bool TR, int D = (NBLK >= 3 ? 4 : 8)>
__device__ __forceinline__ void gemm_tile(f32x16 (&acc)[NBLK][2], const LAS uchar* A, const int pitch, const bf16x8* const (&wp)[NBLK], const int lane) {
  constexpr int NSM = (NS / D) * D;
  const int r = lane & 31, h = lane >> 5;
  const LAS uchar* a0p = A + r * pitch; const LAS uchar* a1p = A + (32 + r) * pitch;
  const int swz = (lane & 15) << 4, kb0 = 16 * h;
  bf16x8 ring[D][NBLK];
#pragma unroll
  for (int d = 0; d < D; ++d)
#pragma unroll
    for (int i = 0; i < NBLK; ++i) ring[d][i] = wp[i][d * 64];
#pragma unroll 1
  for (int s0 = 0; s0 < NSM; s0 += D) {
#pragma unroll
    for (int d = 0; d < D; ++d) {
      const int s = s0 + d;
      const int ko = ((s * 32) + kb0) ^ swz; const bf16x8 fa0 = *(const LAS bf16x8*)(a0p + ko), fa1 = *(const LAS bf16x8*)(a1p + ko);
#pragma unroll
      for (int i = 0; i < NBLK; ++i) {
        if (TR) { acc[i][0] = mfma(ring[d][i], fa0, acc[i][0]); acc[i][1] = mfma(ring[d][i], fa1, acc[i][1]); }
        else    { acc[i][0] = mfma(fa0, ring[d][i], acc[i][0]); acc[i][1] = mfma(fa1, ring[d][i], acc[i][1]); }
      }
      if (s + D < NS) {
#pragma unroll
        for (int i = 0; i < NBLK; ++i) ring[d][i] = wp[i][(s + D) * 64];
      }
    }
  }
#pragma unroll
  for (int d = 0; d < NS - NSM; ++d) {
    const int s = NSM + d;
    const int ko = ((s * 32) + kb0) ^ swz; const bf16x8 fa0 = *(const LAS bf16x8*)(a0p + ko), fa1 = *(const LAS bf16x8*)(a1p + ko);
#pragma unroll
    for (int i = 0; i < NBLK; ++i) {
      if (TR) { acc[i][0] = mfma(ring[d][i], fa0, acc[i][0]); acc[i][1] = mfma(ring[d][i], fa1, acc[i][1]); }
      else    { acc[i][0] = mfma(fa0, ring[d][i], acc[i][0]); acc[i][1] = mfma(fa1, ring[d][i], acc[i][1]); }
    }
  }
}
typedef long l64x2 __attribute__((ext_vector_type(2)));
__device__ __forceinline__ f32x16 mfma8(long a, long b, f32x16 c) { return __builtin_amdgcn_mfma_f32_32x32x16_fp8_fp8(a, b, c, 0, 0, 0); }
__device__ __forceinline__ unsigned pk4_fp8(float a, float b, float c, float d) { int w = 0; w = __builtin_amdgcn_cvt_pk_fp8_f32(a, b, w, false); w = __builtin_amdgcn_cvt_pk_fp8_f32(c, d, w, true); return (unsigned)w; }
typedef int i32x8 __attribute__((ext_vector_type(8)));
typedef int i32x4 __attribute__((ext_vector_type(4)));
#ifndef MK_MX
#define MK_MX 1
#endif
__device__ __forceinline__ f32x16 mfma_mx(i32x4 a0, i32x4 a1, i32x4 b0, i32x4 b1, f32x16 c) {
  const i32x8 a = __builtin_shufflevector(a0, a1, 0, 1, 2, 3, 4, 5, 6, 7), b = __builtin_shufflevector(b0, b1, 0, 1, 2, 3, 4, 5, 6, 7);
  return __builtin_amdgcn_mfma_scale_f32_32x32x64_f8f6f4(a, b, c, 0, 0, 0, 0x7f7f7f7f, 0, 0x7f7f7f7f);
}
__device__ __forceinline__ f32x16 mfma_mx_q(i32x4 a0, i32x4 a1, i32x4 b0, i32x4 b1, f32x16 c) {
  const i32x8 a = __builtin_shufflevector(a0, a1, 0, 1, 2, 3, 4, 5, 6, 7), b = __builtin_shufflevector(b0, b1, 0, 1, 2, 3, 4, 5, 6, 7);
  return __builtin_amdgcn_mfma_scale_f32_32x32x64_f8f6f4(a, b, c, 0, 0, 0, 0x7f7f7f7f, 0, 0x77777777);
}
__device__ __forceinline__ unsigned mk_pknorm(float lo, float hi) { typedef unsigned short u16x2 __attribute__((ext_vector_type(2))); const u16x2 v = __builtin_amdgcn_cvt_pknorm_u16(lo, hi); return __builtin_bit_cast(unsigned, v); }
__device__ __forceinline__ f32x16 mfma_mx8(i32x8 a, i32x8 b, f32x16 c) { return __builtin_amdgcn_mfma_scale_f32_32x32x64_f8f6f4(a, b, c, 0, 0, 0, 0x7f7f7f7f, 0, 0x7f7f7f7f); }
__device__ __forceinline__ i32x8 ld_pair(const i32x4* p0, const i32x4* p1) { const i32x4 x = *p0, y = *p1; return __builtin_shufflevector(x, y, 0, 1, 2, 3, 4, 5, 6, 7); }
template <int NBLK, int NS, bool TR, int D, bool FULL, int NRB>
__device__ __forceinline__ void gemm_tile_f8(f32x16 (&acc)[NBLK][NRB], const LAS uchar* A, const int pitch, const l64x2* const (&wp)[NBLK], const int lane, const int nrb) {
  constexpr int NP = NS / 2;
  static_assert(NS % 2 == 0 && NP % D == 0, "NS even, NP % D");
  const int r = lane & 31, h = lane >> 5;
  const LAS uchar* ap = A + r * pitch;
  const int swz = (lane & 15) << 4, kb0 = 16 * h;
  i32x8 ring[D][NBLK];
#pragma unroll
  for (int d = 0; d < D; ++d)
#pragma unroll
    for (int i = 0; i < NBLK; ++i) ring[d][i] = ld_pair((const i32x4*)(wp[i] + (2 * d) * 64), (const i32x4*)(wp[i] + (2 * d + 1) * 64));
#pragma unroll 1
  for (int p0 = 0; p0 < NP; p0 += D) {
#pragma unroll
    for (int d = 0; d < D; ++d) {
      const int s = 2 * (p0 + d);
      const int ko0 = ((s * 32) + kb0) ^ swz, ko1 = (((s + 1) * 32) + kb0) ^ swz;
#pragma unroll
      for (int rb = 0; rb < NRB; ++rb) {
        if (FULL || rb < nrb) {
          const i32x4 f0 = *(const LAS i32x4*)(ap + rb * 32 * pitch + ko0), f1 = *(const LAS i32x4*)(ap + rb * 32 * pitch + ko1);
          const i32x8 fa = __builtin_shufflevector(f0, f1, 0, 1, 2, 3, 4, 5, 6, 7);
#pragma unroll
          for (int i = 0; i < NBLK; ++i) acc[i][rb] = TR ? mfma_mx8(ring[d][i], fa, acc[i][rb]) : mfma_mx8(fa, ring[d][i], acc[i][rb]);
        }
      }
      if (p0 + d + D < NP) {
#pragma unroll
        for (int i = 0; i < NBLK; ++i) ring[d][i] = ld_pair((const i32x4*)(wp[i] + (2 * (p0 + d + D)) * 64), (const i32x4*)(wp[i] + (2 * (p0 + d + D) + 1) * 64));
      }
    }
  }
}
template <int NSLOT, int NACC, int NS, bool TR, int D, int MAP>
__device__ __forceinline__ void gemm_slots_f8(f32x16 (&acc)[NACC][2], const LAS uchar* A, const int pitch, const l64x2* const (&wp)[NSLOT], const int lane) {
  constexpr int NP = NS / 2;
  static_assert(NS % 2 == 0 && NP % D == 0, "NS even, NP % D");
  const int r = lane & 31, h = lane >> 5;
  const LAS uchar* ap = A + r * pitch;
  const int swz = (lane & 15) << 4, kb0 = 16 * h;
  i32x8 ring[D][NSLOT];
#pragma unroll
  for (int d = 0; d < D; ++d)
#pragma unroll
    for (int i = 0; i < NSLOT; ++i) ring[d][i] = ld_pair((const i32x4*)(wp[i] + (2 * d) * 64), (const i32x4*)(wp[i] + (2 * d + 1) * 64));
#pragma unroll 1
  for (int p0 = 0; p0 < NP; p0 += D) {
#pragma unroll
    for (int d = 0; d < D; ++d) {
      const int s = 2 * (p0 + d);
      const int ko0 = ((s * 32) + kb0) ^ swz, ko1 = (((s + 1) * 32) + kb0) ^ swz;
#pragma unroll
      for (int rb = 0; rb < 2; ++rb) {
        const i32x4 f0 = *(const LAS i32x4*)(ap + rb * 32 * pitch + ko0), f1 = *(const LAS i32x4*)(ap + rb * 32 * pitch + ko1);
        const i32x8 fa = __builtin_shufflevector(f0, f1, 0, 1, 2, 3, 4, 5, 6, 7);
#pragma unroll
        for (int i = 0; i < NSLOT; ++i) { constexpr int dummy = 0; (void)dummy; const int ai = (MAP >> (4 * i)) & 15;
          acc[ai][rb] = TR ? mfma_mx8(ring[d][i], fa, acc[ai][rb]) : mfma_mx8(fa, ring[d][i], acc[ai][rb]); }
      }
      if (p0 + d + D < NP) {
#pragma unroll
        for (int i = 0; i < NSLOT; ++i) ring[d][i] = ld_pair((const i32x4*)(wp[i] + (2 * (p0 + d + D)) * 64), (const i32x4*)(wp[i] + (2 * (p0 + d + D) + 1) * 64));
      }
    }
  }
}
template <int NBLK> __device__ __forceinline__ void acc_zero(f32x16 (&acc)[NBLK][2]) {
#pragma unroll
  for (int i = 0; i < NBLK; ++i) { acc[i][0] = f32x16{}; acc[i][1] = f32x16{}; }
}

__device__ __forceinline__ void store_img_qk(uchar* img, const f32x16& v, int rr, int f0, int NS, int hi) {
#pragma unroll
  for (int g = 0; g < 4; ++g) { u32x2 w; w.x = pk2(v[4 * g], v[4 * g + 1]); w.y = pk2(v[4 * g + 2], v[4 * g + 3]);
    *(u32x2*)(img + img_qk(rr, f0 + 8 * g + 4 * hi, NS)) = w; }
}
__device__ __forceinline__ void store_img_v(uchar* img, const f32x16& v, int kb, int d, int hi) {
#pragma unroll
  for (int g = 0; g < 4; ++g) { u32x2 w; w.x = pk2(v[4 * g], v[4 * g + 1]); w.y = pk2(v[4 * g + 2], v[4 * g + 3]);
    *(u32x2*)(img + img_v(32 * kb + 8 * g + 4 * hi, d)) = w; }
}
__device__ __forceinline__ void pack_frag(const float* __restrict__ W, int ldw, int k0, int n0, const float* __restrict__ rowscale, u32x4* __restrict__ dst, int lane) {
  const int r = lane & 31, h = lane >> 5;
  const float* p = W + (size_t)(k0 + 8 * h) * ldw + n0 + r;
  float v[8];
#pragma unroll
  for (int j = 0; j < 8; ++j) v[j] = p[(size_t)j * ldw];
  if (rowscale) {
#pragma unroll
    for (int j = 0; j < 8; ++j) v[j] *= rowscale[k0 + 8 * h + j];
  }
  u32x4 w; w.x = pk2(v[0], v[1]); w.y = pk2(v[2], v[3]); w.z = pk2(v[4], v[5]); w.w = pk2(v[6], v[7]);
  dst[lane] = w;
}
__device__ __forceinline__ void pack_frag8(const float* __restrict__ W, int ldw, int k0, int n0, float scale, u32x4* __restrict__ dst, int lane) {
  const int r = lane & 31, h = lane >> 5;
  const float* p = W + (size_t)(k0 + 16 * h) * ldw + n0 + r;
  float v[16];
#pragma unroll
  for (int j = 0; j < 16; ++j) v[j] = p[(size_t)j * ldw] * scale;
  u32x4 w; w.x = pk4_fp8(v[0], v[1], v[2], v[3]); w.y = pk4_fp8(v[4], v[5], v[6], v[7]); w.z = pk4_fp8(v[8], v[9], v[10], v[11]); w.w = pk4_fp8(v[12], v[13], v[14], v[15]);
  dst[lane] = w;
}
__device__ __forceinline__ void pack_frag8_lo(const float* __restrict__ W, int ldw, int k0, int n0, float scale, u32x4* __restrict__ dst, int lane) {
  const int r = lane & 31, h = lane >> 5;
  const float* p = W + (size_t)(k0 + 16 * h) * ldw + n0 + r;
  float v[16];
#pragma unroll
  for (int j = 0; j < 16; ++j) { const float x = p[(size_t)j * ldw] * scale; const int q = __builtin_amdgcn_cvt_pk_fp8_f32(x, 0.f, 0, false); v[j] = x - __builtin_amdgcn_cvt_f32_fp8(q, 0); }
  u32x4 w; w.x = pk4_fp8(v[0], v[1], v[2], v[3]); w.y = pk4_fp8(v[4], v[5], v[6], v[7]); w.z = pk4_fp8(v[8], v[9], v[10], v[11]); w.w = pk4_fp8(v[12], v[13], v[14], v[15]);
  dst[lane] = w;
}
__device__ __forceinline__ void phase0(const KP& P, LAS uchar* lds) {
  int lane_ = mk_lane(); asm volatile("" : "+v"(lane_)); const int lane = lane_ & 63, wave = P.wave, tid = wave * 64 + lane, bid = blockIdx.x, G = gridDim.x;
  uchar* ws = P.ws;
  if (bid == 0 && tid < 64) ((int*)(ws + WS_CNT))[tid] = 0;
  for (int idx = bid * NTHR + tid; idx < SEQ * 48; idx += G * NTHR) {
    int pos, i, half; float2* dst;
    if (idx < SEQ * 32) { pos = idx >> 5; i = idx & 31; half = 32; dst = (float2*)(ws + WS_TABA) + idx; }
    else { const int i2 = idx - SEQ * 32; pos = i2 >> 4; i = i2 & 15; half = 16; dst = (float2*)(ws + WS_TABB) + i2; }
    const float inv = 1.0f / powf(10000.0f, (float)(2 * i) / (float)(2 * half));
    const float ang = (float)pos * inv;
    *dst = make_float2(cosf(ang), sinf(ang));
  }
  if (bid < 192) {
    const float* c = P.in[1]; const float* w_ada = P.in[2]; const float* b_ada = P.in[3];
    LAS float* sl = (LAS float*)lds; LAS float* part = (LAS float*)(lds + 16384);
    for (int i = tid; i < NB * DM; i += NTHR) { const float v = c[i]; sl[i] = v / (1.f + __expf(-v)); }
    __syncthreads();
    const int n0 = bid * 32, rowl = lane >> 3, c4 = lane & 7;
    f32x4 a0 = {0, 0, 0, 0}, a1 = a0, a2 = a0, a3 = a0;
#pragma unroll 4
    for (int it = 0; it < 16; ++it) {
      const int k = wave * 128 + it * 8 + rowl;
      const f32x4 wv = *(const f32x4*)(w_ada + (size_t)k * (NMOD * DM) + n0 + 4 * c4);
      a0 += wv * sl[k]; a1 += wv * sl[DM + k]; a2 += wv * sl[2 * DM + k]; a3 += wv * sl[3 * DM + k];
    }
#pragma unroll
    for (int e = 0; e < 4; ++e) {
#pragma unroll
      for (int o = 8; o < 64; o <<= 1) { a0[e] += __shfl_xor(a0[e], o); a1[e] += __shfl_xor(a1[e], o); a2[e] += __shfl_xor(a2[e], o); a3[e] += __shfl_xor(a3[e], o); }
    }
    if (rowl == 0) {
#pragma unroll
      for (int e = 0; e < 4; ++e) { part[(wave * 4 + 0) * 32 + 4 * c4 + e] = a0[e]; part[(wave * 4 + 1) * 32 + 4 * c4 + e] = a1[e]; part[(wave * 4 + 2) * 32 + 4 * c4 + e] = a2[e]; part[(wave * 4 + 3) * 32 + 4 * c4 + e] = a3[e]; }
    }
    __syncthreads();
    if (tid < 128) { const int bb = tid >> 5, col = tid & 31; float s = b_ada[n0 + col];
#pragma unroll
      for (int w = 0; w < 8; ++w) s += part[(w * 4 + bb) * 32 + col];
      ((float*)(ws + WS_MOD))[bb * (NMOD * DM) + n0 + col] = s; }
  }
  const int gw = bid * NWAVE + wave, NGW = G * NWAVE;
  for (int f = gw; f < 43 * 32; f += NGW) { const int slot = f >> 5, s = f & 31;
    if (slot < 35) pack_frag8(P.in[5], INW, 32 * s, 32 * slot, WIN_SCALE, (u32x4*)(ws + WS_WIN) + (size_t)f * 64, lane);
    else { const int blk = slot < 39 ? 20 + (slot - 35) : 30 + (slot - 39); pack_frag8_lo(P.in[5], INW, 32 * s, 32 * blk, WIN_SCALE, (u32x4*)(ws + WS_WIN) + (size_t)f * 64, lane); } }
  for (int f = gw; f < 32 * 64; f += NGW) pack_frag(P.in[13], DM, 16 * (f & 63), 32 * (f >> 6), nullptr, (u32x4*)(ws + WS_WOUT) + (size_t)f * 64, lane);
  for (int f = gw; f < 24 * 12; f += NGW) pack_frag(P.in[7], 768, 16 * (f % 12), 32 * (f / 12), P.in[6], (u32x4*)(ws + WS_WUQ) + (size_t)f * 64, lane);
  for (int f = gw; f < 32 * 8; f += NGW) pack_frag(P.in[9], 1024, 16 * (f & 7), 32 * (f >> 3), P.in[8], (u32x4*)(ws + WS_WUKV) + (size_t)f * 64, lane);
  for (int f = gw; f < 2 * 64; f += NGW) {
    const int nb = f >> 6, s = f & 63, r = lane & 31, h = lane >> 5, col = 32 * nb + r;
    float v[8];
#pragma unroll
    for (int j = 0; j < 8; ++j) { const int k = 16 * s + 8 * h + j; v[j] = col < 4 ? P.in[15][k * 4 + col] : (col < 36 ? P.in[17][k * 32 + col - 4] : 0.f); }
    u32x4 w; w.x = pk2(v[0], v[1]); w.y = pk2(v[2], v[3]); w.z = pk2(v[4], v[5]); w.w = pk2(v[6], v[7]);
    ((u32x4*)(ws + WS_WR) + (size_t)f * 64)[lane] = w;
  }
}

__device__ __forceinline__ void rope64(const f32x16& xa, const f32x16& xb, f32x16& ya, f32x16& yb, const float2* __restrict__ trow, int hi, float scale) {
#pragma unroll
  for (int g = 0; g < 4; ++g) {
    const f32x4 t0 = *(const f32x4*)(trow + 8 * g + 4 * hi), t1 = *(const f32x4*)(trow + 8 * g + 4 * hi + 2);
    const float cc[4] = {t0[0], t0[2], t1[0], t1[2]}, sn[4] = {t0[1], t0[3], t1[1], t1[3]};
#pragma unroll
    for (int i = 0; i < 4; ++i) { const int reg = 4 * g + i; ya[reg] = (xa[reg] * cc[i] - xb[reg] * sn[i]) * scale; yb[reg] = (xb[reg] * cc[i] + xa[reg] * sn[i]) * scale; }
  }
}
__device__ __forceinline__ void rope32(const f32x16& x, f32x16& y, const float2* __restrict__ trow, int hi, float scale) {
#pragma unroll
  for (int g = 0; g < 2; ++g) {
    const f32x4 t0 = *(const f32x4*)(trow + 8 * g + 4 * hi), t1 = *(const f32x4*)(trow + 8 * g + 4 * hi + 2);
    const float cc[4] = {t0[0], t0[2], t1[0], t1[2]}, sn[4] = {t0[1], t0[3], t1[1], t1[3]};
#pragma unroll
    for (int i = 0; i < 4; ++i) { const int reg = 4 * g + i; y[reg] = (x[reg] * cc[i] - x[reg + 8] * sn[i]) * scale; y[reg + 8] = (x[reg + 8] * cc[i] + x[reg] * sn[i]) * scale; }
  }
}
__device__ __forceinline__ float write_c_tile(LAS uchar* base, int pitch, const f32x16& vin, int rr, int f0, int hi) {
  const f32x16 v = vin * WIN_DESCALE;
  float ss = 0.f;
#pragma unroll
  for (int g = 0; g < 4; ++g) { u32x2 w; w.x = pk2(v[4 * g], v[4 * g + 1]); w.y = pk2(v[4 * g + 2], v[4 * g + 3]);
    *(LAS u32x2*)(base + a_off(rr, 2 * (f0 + 8 * g + 4 * hi), pitch)) = w;
    ss += v[4 * g] * v[4 * g] + v[4 * g + 1] * v[4 * g + 1] + v[4 * g + 2] * v[4 * g + 2] + v[4 * g + 3] * v[4 * g + 3]; }
  return ss;
}
__device__ __forceinline__ void store_img8_qk(uchar* img, const f32x16& v, int rb, int r32, int blk, int hi) {
#pragma unroll
  for (int g = 0; g < 4; ++g) { const unsigned w = pk4_fp8(v[4 * g], v[4 * g + 1], v[4 * g + 2], v[4 * g + 3]);
    const int off = blk < 2 ? rb * 4096 + (g >> 1) * 1024 + (blk * 32 + r32) * 16 + 8 * (g & 1) + 4 * hi : rb * 4096 + 2048 + ((g >> 1) * 32 + r32) * 16 + 8 * (g & 1) + 4 * hi;
    *(unsigned*)(img + off) = w; }
}
__device__ __forceinline__ void store_img8_v(uchar* img, const f32x16& v, int rb, int db, int r32, int hi) {
#pragma unroll
  for (int g = 0; g < 4; ++g) *(unsigned*)(img + db * 2048 + rb * 1024 + (hi * 32 + r32) * 16 + 4 * g) = pk4_fp8(v[4 * g], v[4 * g + 1], v[4 * g + 2], v[4 * g + 3]);
}
__device__ __forceinline__ void lds_fadd(LAS float* p, float v) { __hip_atomic_fetch_add(p, v, __ATOMIC_RELAXED, __HIP_MEMORY_SCOPE_WORKGROUP); }

__device__ __forceinline__ void phase1_tile(const KP& P, LAS uchar* lds, const int tile) {
  int lane_ = mk_lane(); asm volatile("" : "+v"(lane_)); const int lane = lane_ & 63, wave = P.wave, tid = wave * 64 + lane, r32 = lane & 31, hi = lane >> 5;
  uchar* ws = P.ws;
  const int t0 = tile * 64, b = t0 / SEQ, pos0 = t0 % SEQ, tb = pos0 >> 6;
  const float* __restrict__ x = P.in[0]; const float* __restrict__ mod = (const float*)(ws + WS_MOD) + b * (NMOD * DM); const float* __restrict__ g1 = P.in[4];
  LAS float* ssq = (LAS float*)(lds + LDS_MISC + 64);
  LAS uchar* krt = lds + LDS_MISC + 1024;
  const float2* tabA = (const float2*)(ws + WS_TABA); const float2* tabB = (const float2*)(ws + WS_TABB);
  if (tid < 128) ssq[tid] = 0.f;
  {
    f32x4 av[4], sv[4];
#pragma unroll
    for (int i = 0; i < 4; ++i) { const int k = 4 * (lane + 64 * i); const f32x4 g = *(const f32x4*)(g1 + k), sc = *(const f32x4*)(mod + DM + k); av[i] = g * (sc + 1.0f); sv[i] = *(const f32x4*)(mod + k); }
#pragma unroll
    for (int hf = 0; hf < 2; ++hf) {
      f32x4 xv[4][4];
#pragma unroll
      for (int rr = 0; rr < 4; ++rr)
#pragma unroll
        for (int i = 0; i < 4; ++i) xv[rr][i] = *(const f32x4*)(x + (size_t)(t0 + wave * 8 + hf * 4 + rr) * DM + 4 * (lane + 64 * i));
#pragma unroll
      for (int rr = 0; rr < 4; ++rr) {
        const int row = wave * 8 + hf * 4 + rr; float ss = 0.f;
#pragma unroll
        for (int i = 0; i < 4; ++i) { ss += xv[rr][i][0] * xv[rr][i][0] + xv[rr][i][1] * xv[rr][i][1] + xv[rr][i][2] * xv[rr][i][2] + xv[rr][i][3] * xv[rr][i][3];
          u32x2 xb; xb.x = pk2(xv[rr][i][0], xv[rr][i][1]); xb.y = pk2(xv[rr][i][2], xv[rr][i][3]);
          *(u32x2*)(ws + WS_XB + ((size_t)(t0 + row) * DM + 4 * (lane + 64 * i)) * 2) = xb; }
        ss = wave_sum(ss); const float rs = rsqrtf(ss * (1.0f / DM) + EPS);
#pragma unroll
        for (int i = 0; i < 4; ++i) { const f32x4 v = xv[rr][i] * rs * av[i] + sv[i];
          *(LAS unsigned*)(lds + a_off(row, 4 * (lane + 64 * i), 1024)) = pk4_fp8(v[0], v[1], v[2], v[3]); }
      }
    }
  }
  __syncthreads();
  const l64x2* WIN = (const l64x2*)(ws + WS_WIN);
#define WSLOT(slot) (WIN + (size_t)((slot) * 32) * 64 + lane)
  f32x16 acc[4][2]; acc_zero<4>(acc);
  f32x16 acc2[1][2]; acc_zero<1>(acc2);
  if (wave < 4) {
    { const l64x2* wp[4] = {WSLOT(4 * wave), WSLOT(4 * wave + 1), WSLOT(4 * wave + 2), WSLOT(4 * wave + 3)}; gemm_slots_f8<4, 4, 32, true, 1, 0x3210>(acc, lds, 1024, wp, lane); }
    if (wave < 3) { const l64x2* wp[1] = {WSLOT(wave == 0 ? 34 : 27 + wave)}; gemm_slots_f8<1, 1, 32, true, 2, 0x0>(acc2, lds, 1024, wp, lane); }
  } else if (wave == 4) {
    { const l64x2* wp[4] = {WSLOT(16), WSLOT(17), WSLOT(18), WSLOT(19)}; gemm_slots_f8<4, 4, 32, true, 1, 0x3210>(acc, lds, 1024, wp, lane); }
    { const l64x2* wp[2] = {WSLOT(33), WSLOT(42)}; gemm_slots_f8<2, 1, 32, true, 1, 0x00>(acc2, lds, 1024, wp, lane); }
  } else if (wave == 7) {
    { const l64x2* wp[4] = {WSLOT(30), WSLOT(39), WSLOT(31), WSLOT(40)}; gemm_slots_f8<4, 4, 32, true, 1, 0x1100>(acc, lds, 1024, wp, lane); }
    { const l64x2* wp[2] = {WSLOT(32), WSLOT(41)}; gemm_slots_f8<2, 4, 32, true, 1, 0x22>(acc, lds, 1024, wp, lane); }
  } else {
    const int kv = wave - 5;
    { const l64x2* wp[4] = {WSLOT(20 + 2 * kv), WSLOT(35 + 2 * kv), WSLOT(21 + 2 * kv), WSLOT(36 + 2 * kv)}; gemm_slots_f8<4, 4, 32, false, 1, 0x1100>(acc, lds, 1024, wp, lane); }
    { const l64x2* wp[2] = {WSLOT(24 + 2 * kv), WSLOT(25 + 2 * kv)}; gemm_slots_f8<2, 4, 32, true, 1, 0x32>(acc, lds, 1024, wp, lane); }
  }
#undef WSLOT
  int tid2_ = mk_lane(); asm volatile("" : "+v"(tid2_)); const int lane2 = tid2_ & 63;
#define lane lane2
  const int r32e = lane2 & 31, hie = lane2 >> 5;
#define r32 r32e
#define hi hie
  if (wave < 4) {
#pragma unroll
    for (int p = 0; p < 2; ++p) { uchar* img = ws + WS_QA + ((size_t)(b * 8 + 2 * wave + p) * 64 + tb) * 8192;
#pragma unroll
      for (int rb = 0; rb < 2; ++rb) { const int rr = 32 * rb + r32; f32x16 ya, yb; rope64(acc[2 * p][rb], acc[2 * p + 1][rb], ya, yb, tabA + (size_t)(pos0 + rr) * 32, hi, QSCALE_A * WIN_DESCALE);
        store_img_qk(img, ya, rr, 0, 4, hi); store_img_qk(img, yb, rr, 32, 4, hi); } }
    if (wave == 0) {
#pragma unroll
      for (int rb = 0; rb < 2; ++rb) { const int rr = 32 * rb + r32; f32x16 y; rope32(acc2[0][rb], y, tabB + (size_t)(pos0 + rr) * 16, hi, WIN_DESCALE);
#pragma unroll
        for (int g = 0; g < 4; ++g) { u32x2 w; w.x = pk2(y[4 * g], y[4 * g + 1]); w.y = pk2(y[4 * g + 2], y[4 * g + 3]); *(LAS u32x2*)(krt + rr * 64 + (8 * g + 4 * hi) * 2) = w; } }
    }
  } else if (wave == 4) {
#pragma unroll
    for (int p = 0; p < 2; ++p) { uchar* img = ws + WS_KVA + ((size_t)(b * 2 + p) * 64 + tb) * 16384;
#pragma unroll
      for (int rb = 0; rb < 2; ++rb) { const int rr = 32 * rb + r32; f32x16 ya, yb; rope64(acc[2 * p][rb], acc[2 * p + 1][rb], ya, yb, tabA + (size_t)(pos0 + rr) * 32, hi, WIN_DESCALE);
        store_img_qk(img, ya, rr, 0, 4, hi); store_img_qk(img, yb, rr, 32, 4, hi); } }
  } else if (wave == 5 || wave == 6) {
    uchar* img = ws + WS_KVA + ((size_t)(b * 2 + (wave - 5)) * 64 + tb) * 16384 + 8192;
#pragma unroll
    for (int i = 0; i < 2; ++i)
#pragma unroll
      for (int rb = 0; rb < 2; ++rb) { const f32x16 y = acc[i][rb] * WIN_DESCALE; store_img_v(img, y, rb, 32 * i + r32, hi); }
  }
  __syncthreads();
  if (wave != 0 && wave != 3) {
#pragma unroll
    for (int rb = 0; rb < 2; ++rb) { const int rr = 32 * rb + r32; float sq = 0.f, skv = 0.f;
      if (wave == 5 || wave == 6) { sq += write_c_tile(lds, 512, acc[2][rb], rr, 64 * (wave - 5), hi); sq += write_c_tile(lds, 512, acc[3][rb], rr, 64 * (wave - 5) + 32, hi); }
      else if (wave == 1 || wave == 2) sq += write_c_tile(lds, 512, acc2[0][rb], rr, 96 + 32 * wave, hi);
      else if (wave == 7) { skv += write_c_tile(lds + 32768, 256, acc[0][rb], rr, 0, hi); skv += write_c_tile(lds + 32768, 256, acc[1][rb], rr, 32, hi); skv += write_c_tile(lds + 32768, 256, acc[2][rb], rr, 64, hi); }
      else skv += write_c_tile(lds + 32768, 256, acc2[0][rb], rr, 96, hi);
      if (wave == 4 || wave == 7) lds_fadd(&ssq[64 + rr], skv); else lds_fadd(&ssq[rr], sq); }
  }
  __syncthreads();
  const int head = wave;
  uchar* imgQ = ws + WS_QB + ((size_t)(b * 8 + head) * 64 + tb) * 8192;
  uchar* imgKV = ws + WS_KVB + ((size_t)(b * 8 + head) * 64 + tb) * 12288;
  {
    f32x16 aq[3][2]; acc_zero<3>(aq);
    const bf16x8* wp[3];
#pragma unroll
    for (int i = 0; i < 3; ++i) wp[i] = (const bf16x8*)(ws + WS_WUQ) + (size_t)((3 * head + i) * 12) * 64 + lane;
    gemm_tile<3, 12, true>(aq, lds, 512, wp, lane);
#pragma unroll
    for (int rb = 0; rb < 2; ++rb) { const int rr = 32 * rb + r32; const float sc = rsqrtf(ssq[rr] * (1.0f / 192.0f) + EPS) * (8.0f * QSCALE_B);
      f32x16 y0 = aq[0][rb] * sc, y1 = aq[1][rb] * sc, y2; rope32(aq[2][rb], y2, tabB + (size_t)(pos0 + rr) * 16, hi, sc);
      store_img8_qk(imgQ, y0, rb, r32, 0, hi); store_img8_qk(imgQ, y1, rb, r32, 1, hi); store_img8_qk(imgQ, y2, rb, r32, 2, hi);
      *(u32x4*)(imgQ + rb * 4096 + 3072 + lane * 16) = u32x4{0u, 0u, 0u, 0u}; }
  }
  {
    f32x16 ak[2][2]; acc_zero<2>(ak);
    const bf16x8* wp[2];
#pragma unroll
    for (int i = 0; i < 2; ++i) wp[i] = (const bf16x8*)(ws + WS_WUKV) + (size_t)((4 * head + i) * 8) * 64 + lane;
    gemm_tile<2, 8, true>(ak, lds + 32768, 256, wp, lane);
#pragma unroll
    for (int rb = 0; rb < 2; ++rb) { const int rr = 32 * rb + r32; const float sc = rsqrtf(ssq[64 + rr] * (1.0f / 128.0f) + EPS);
      f32x16 y0 = ak[0][rb] * sc, y1 = ak[1][rb] * sc; store_img8_qk(imgKV, y0, rb, r32, 0, hi); store_img8_qk(imgKV, y1, rb, r32, 1, hi); }
#pragma unroll
    for (int rb = 0; rb < 2; ++rb) {
      const u32x4 c0 = *(const LAS u32x4*)(krt + (32 * rb + r32) * 64 + hi * 32), c1 = *(const LAS u32x4*)(krt + (32 * rb + r32) * 64 + hi * 32 + 16);
      u32x4 w;
      w.x = pk4_fp8(__uint_as_float(c0.x << 16), __uint_as_float(c0.x & 0xffff0000u), __uint_as_float(c0.y << 16), __uint_as_float(c0.y & 0xffff0000u));
      w.y = pk4_fp8(__uint_as_float(c0.z << 16), __uint_as_float(c0.z & 0xffff0000u), __uint_as_float(c0.w << 16), __uint_as_float(c0.w & 0xffff0000u));
      w.z = pk4_fp8(__uint_as_float(c1.x << 16), __uint_as_float(c1.x & 0xffff0000u), __uint_as_float(c1.y << 16), __uint_as_float(c1.y & 0xffff0000u));
      w.w = pk4_fp8(__uint_as_float(c1.z << 16), __uint_as_float(c1.z & 0xffff0000u), __uint_as_float(c1.w << 16), __uint_as_float(c1.w & 0xffff0000u));
      *(u32x4*)(imgKV + rb * 4096 + 2048 + lane * 16) = w;
      *(u32x4*)(imgKV + rb * 4096 + 3072 + lane * 16) = u32x4{hi ? 0u : 0x00003838u, 0u, 0u, 0u}; }
  }
  {
    f32x16 avv[2][2]; acc_zero<2>(avv);
    const bf16x8* wp[2];
#pragma unroll
    for (int i = 0; i < 2; ++i) wp[i] = (const bf16x8*)(ws + WS_WUKV) + (size_t)((4 * head + 2 + i) * 8) * 64 + lane;
    gemm_tile<2, 8, false>(avv, lds + 32768, 256, wp, lane);
#pragma unroll
    for (int rb = 0; rb < 2; ++rb) { f32x16 sc;
#pragma unroll
      for (int reg = 0; reg < 16; ++reg) sc[reg] = rsqrtf(ssq[64 + 32 * rb + crow(reg, hi)] * (1.0f / 128.0f) + EPS);
#pragma unroll
      for (int i = 0; i < 2; ++i) { f32x16 y = avv[i][rb] * sc; store_img8_v(imgKV + 8192, y, rb, i, r32, hi); } }
  }
  __syncthreads();
#undef lane
#undef r32
#undef hi
}
__device__ __forceinline__ float tile_max(const f32x16& p0, const f32x16& p1) {
  float t = __builtin_amdgcn_fmed3f(p0[0], p1[0], 3.0e38f);
  asm("v_max3_f32 %0, %0, %1, %2\n\tv_max3_f32 %0, %0, %3, %4\n\tv_max3_f32 %0, %0, %5, %6\n\tv_max3_f32 %0, %0, %7, %8\n\t"
      "v_max3_f32 %0, %0, %9, %10\n\tv_max3_f32 %0, %0, %11, %12\n\tv_max3_f32 %0, %0, %13, %14\n\tv_max3_f32 %0, %0, %15, %16"
      : "+v"(t) : "v"(p0[1]), "v"(p1[1]), "v"(p0[2]), "v"(p1[2]), "v"(p0[3]), "v"(p1[3]), "v"(p0[4]), "v"(p1[4]), "v"(p0[5]), "v"(p1[5]), "v"(p0[6]), "v"(p1[6]), "v"(p0[7]), "v"(p1[7]), "v"(p0[8]), "v"(p1[8]));
  asm("v_max3_f32 %0, %0, %1, %2\n\tv_max3_f32 %0, %0, %3, %4\n\tv_max3_f32 %0, %0, %5, %6\n\tv_max3_f32 %0, %0, %7, %8\n\t"
      "v_max3_f32 %0, %0, %9, %10\n\tv_max3_f32 %0, %0, %11, %12\n\tv_max3_f32 %0, %0, %13, %14"
      : "+v"(t) : "v"(p0[9]), "v"(p1[9]), "v"(p0[10]), "v"(p1[10]), "v"(p0[11]), "v"(p1[11]), "v"(p0[12]), "v"(p1[12]), "v"(p0[13]), "v"(p1[13]), "v"(p0[14]), "v"(p1[14]), "v"(p0[15]), "v"(p1[15]));
  return t;
}
constexpr float PXG = 128.0f / 65535.0f;
__device__ __forceinline__ void softmax_tile(f32x16& p0, f32x16& p1, f32x16& negm, float& m, float& l, f32x16& o0, f32x16& o1, bf16x8 (&pb)[2][2]) {
  const float tmax = half_swap_max(tile_max(p0, p1));
  if (__any(tmax > PXG * (127.0f + THR2))) {
    const float dm = fmaxf(tmax * (1.0f / PXG) - 127.0f, 0.f), alpha = __builtin_amdgcn_exp2f(-dm), dp = dm * PXG;
    m += dm; l *= alpha;
#pragma unroll
    for (int r = 0; r < 16; ++r) { o0[r] *= alpha; o1[r] *= alpha; p0[r] -= dp; p1[r] -= dp; negm[r] = PXG * (127.0f - m); }
  }
  typedef __bf16 bf2 __attribute__((ext_vector_type(2)));
  const bf2 one2 = __builtin_bit_cast(bf2, 0x3f803f80u);
  float s = 0.f;
#pragma unroll
  for (int ks = 0; ks < 2; ++ks) {
    unsigned a[4], c[4];
#pragma unroll
    for (int i = 0; i < 4; ++i) { a[i] = mk_pknorm(p0[8 * ks + 2 * i], p0[8 * ks + 2 * i + 1]); c[i] = mk_pknorm(p1[8 * ks + 2 * i], p1[8 * ks + 2 * i + 1]);
      s = __builtin_amdgcn_fdot2_f32_bf16(__builtin_bit_cast(bf2, a[i]), one2, s, false); s = __builtin_amdgcn_fdot2_f32_bf16(__builtin_bit_cast(bf2, c[i]), one2, s, false); }
    const u32x4 w0 = {a[0], a[1], a[2], a[3]}, w1 = {c[0], c[1], c[2], c[3]};
    pb[0][ks] = __builtin_bit_cast(bf16x8, w0); pb[1][ks] = __builtin_bit_cast(bf16x8, w1);
  }
  l += s;
}
__device__ __forceinline__ void pv_tile(const LAS uchar* vimg, const bf16x8 (&pb)[2][2], f32x16& o0, f32x16& o1, int lane) {
#pragma unroll
  for (int kb = 0; kb < 2; ++kb)
#pragma unroll
    for (int ks = 0; ks < 2; ++ks) {
      const bf16x8 v0 = *(const LAS bf16x8*)(vimg + ((((kb * 2 + 0) * 2 + ks) * 64) + lane) * 16);
      const bf16x8 v1 = *(const LAS bf16x8*)(vimg + ((((kb * 2 + 1) * 2 + ks) * 64) + lane) * 16);
      o0 = mfma(v0, pb[kb][ks], o0); o1 = mfma(v1, pb[kb][ks], o1);
    }
}
__device__ __forceinline__ void store_o(bf16_t* __restrict__ orow, f32x16& o0, f32x16& o1, float l, int hi) {
  const float inv = 1.0f / half_swap_sum(l);
#pragma unroll
  for (int g = 0; g < 4; ++g) {
    u32x2 w; w.x = pk2(o0[4 * g] * inv, o0[4 * g + 1] * inv); w.y = pk2(o0[4 * g + 2] * inv, o0[4 * g + 3] * inv); *(u32x2*)(orow + 8 * g + 4 * hi) = w;
    u32x2 z; z.x = pk2(o1[4 * g] * inv, o1[4 * g + 1] * inv); z.y = pk2(o1[4 * g + 2] * inv, o1[4 * g + 3] * inv); *(u32x2*)(orow + 32 + 8 * g + 4 * hi) = z;
  }
}

__device__ __forceinline__ void store_o_l(bf16_t* __restrict__ orow, f32x16& o0, f32x16& o1, float ltot, int hi) {
  const float inv = 1.0f / ltot;
#pragma unroll
  for (int g = 0; g < 4; ++g) {
    u32x2 w; w.x = pk2(o0[4 * g] * inv, o0[4 * g + 1] * inv); w.y = pk2(o0[4 * g + 2] * inv, o0[4 * g + 3] * inv); *(u32x2*)(orow + 8 * g + 4 * hi) = w;
    u32x2 z; z.x = pk2(o1[4 * g] * inv, o1[4 * g + 1] * inv); z.y = pk2(o1[4 * g + 2] * inv, o1[4 * g + 3] * inv); *(u32x2*)(orow + 32 + 8 * g + 4 * hi) = z;
  }
}
constexpr int SWA_LDS = 49152;
__device__ __forceinline__ void swa_unit(const KP& P, LAS uchar* lds_all, int u, bool prefetched) {
  LAS uchar* lds = lds_all + SWA_LDS;
  int lane_ = mk_lane(); asm volatile("" : "+v"(lane_)); const int lane = lane_ & 63, wave = P.wave, tid = wave * 64 + lane, r32 = lane & 31, hi = lane >> 5;
  uchar* ws = P.ws;
  const int n = u & 31, kvh = (u >> 5) & 1, b = u >> 6;
  const uchar* kvimg = ws + WS_KVA + (size_t)(b * 2 + kvh) * 64 * 16384;
  if (!prefetched) {
#pragma unroll 1
    for (int jt = 0; jt < 6; ++jt) { const int gt = 2 * n - 2 + jt; if (gt < 0 || gt >= 64) continue;
      const u32x4* src = (const u32x4*)(kvimg + (size_t)gt * 16384); LAS u32x4* dst = (LAS u32x4*)(lds + jt * 16384);
      const u32x4 v0 = src[tid], v1 = src[tid + 512]; dst[tid] = v0; dst[tid + 512] = v1; }
  }
  __syncthreads();
  const int rbq = wave & 3, jlo = rbq >> 1;
  bf16_t* O = (bf16_t*)(ws + WS_O);
#pragma unroll 1
  for (int hh = 0; hh < 2; ++hh) {
    const int head = kvh * 4 + 2 * (wave >> 2) + hh;
    const uchar* qimg = ws + WS_QA + ((size_t)(b * 8 + head) * 64 + 2 * n + (rbq >> 1)) * 8192;
    bf16x8 qf[4];
#pragma unroll
    for (int s = 0; s < 4; ++s) qf[s] = *(const bf16x8*)(qimg + ((((rbq & 1) * 4 + s) * 64) + lane) * 16);
    const float sink2 = P.in[10][head] * LOG2E;
    float m = sink2, l = hi ? 0.f : 1.f; f32x16 negm, o0 = {}, o1 = {};
#pragma unroll
    for (int r = 0; r < 16; ++r) negm[r] = PXG * (127.0f - sink2);
#pragma unroll 1
    for (int jt = jlo; jt < jlo + 5; ++jt) { const int gt = 2 * n - 2 + jt; if (gt < 0 || gt >= 64) continue;
      const LAS uchar* kimg = lds + jt * 16384;
      f32x16 p0 = negm, p1 = negm;
#pragma unroll
      for (int s = 0; s < 4; ++s) { const bf16x8 k0 = *(const LAS bf16x8*)(kimg + (((0 * 4 + s) * 64) + lane) * 16), k1 = *(const LAS bf16x8*)(kimg + (((1 * 4 + s) * 64) + lane) * 16);
        p0 = mfma(k0, qf[s], p0); p1 = mfma(k1, qf[s], p1); }
      if (jt == jlo || jt == jlo + 4) { const int base = 64 * jt - 32 * rbq - r32;
#pragma unroll
        for (int r = 0; r < 16; ++r) { const int d0 = base + crow(r, hi);
          p0[r] = ((unsigned)d0 <= 256u) ? p0[r] : -1e30f; p1[r] = ((unsigned)(d0 + 32) <= 256u) ? p1[r] : -1e30f; } }
      bf16x8 pb[2][2];
      softmax_tile(p0, p1, negm, m, l, o0, o1, pb);
      pv_tile(kimg + 8192, pb, o0, o1, lane);
    }
    store_o(O + (size_t)(b * SEQ + n * 128 + 32 * rbq + r32) * DM + head * 64, o0, o1, l, hi);
  }
  __syncthreads();
}

#define MK_LDS_RD(dst, vaddr, imm) asm volatile("ds_read_b128 %0, %1 offset:%2" : "=v"(dst) : "v"(vaddr), "i"(imm))
template <int N> __device__ __forceinline__ void lgkm_wait() { asm volatile("s_waitcnt lgkmcnt(%0)" :: "i"(N) : "memory"); __builtin_amdgcn_sched_barrier(0); }
__device__ __forceinline__ void pv_regs(const bf16x8 (&vf)[8], const bf16x8 (&pb)[2][2], f32x16& o0, f32x16& o1) {
#pragma unroll
  for (int kb = 0; kb < 2; ++kb)
#pragma unroll
    for (int ks = 0; ks < 2; ++ks) { o0 = mfma(vf[(kb * 2 + 0) * 2 + ks], pb[kb][ks], o0); o1 = mfma(vf[(kb * 2 + 1) * 2 + ks], pb[kb][ks], o1); }
}
__device__ __forceinline__ void mla_dma_step(const uchar* kvimg, LAS uchar* lds, int t, int wave, int lane) {
  const uchar* src = kvimg + (size_t)t * 24576 + wave * 3072 + lane * 16;
  LAS uchar* dst = lds + (t & 1) * 24576 + wave * 3072;
#pragma unroll
  for (int i = 0; i < 3; ++i) __builtin_amdgcn_global_load_lds((const unsigned*)(src + i * 1024), (LAS unsigned*)(dst + i * 1024), 16, 0, 0);
}
template <bool FIRST_POSSIBLE>
__device__ __forceinline__ float softmax_tile8(f32x16& p0, f32x16& p1, float& pad, int& qpad, f32x16& lacc, f32x16& o0, f32x16& o1, bool first, int hi, i32x4& pb0, i32x4& pb1) {
  float applied = 0.f;
  const float tmax_s = half_swap_max(tile_max(p0, p1));
  const bool fst = FIRST_POSSIBLE && first;
  if (fst || __any(tmax_s > 120.5f / 256.0f)) {
    const float tmax = tmax_s * 256.0f;
    const float want = fst ? tmax - 96.5f : fmaxf(tmax - 96.5f, 0.f);
    const float nt = pad - want;
    const int wa = __builtin_amdgcn_cvt_pk_fp8_f32(nt, 0.f, 0, false); const float fa = __builtin_amdgcn_cvt_f32_fp8(wa, 0);
    const int wb = __builtin_amdgcn_cvt_pk_fp8_f32(nt - fa, 0.f, 0, false); const float fb = __builtin_amdgcn_cvt_f32_fp8(wb, 0);
    const float pnew = fa + fb, dt = pad - pnew, dts = dt * (1.0f / 256.0f);
    const float alpha = fst ? 1.0f : __builtin_amdgcn_exp2f(-0.125f * dt);
    pad = pnew; applied = dts; qpad = hi ? 0 : ((wa & 0xff) | ((wb & 0xff) << 8));
#pragma unroll
    for (int r = 0; r < 16; ++r) { o0[r] *= alpha; o1[r] *= alpha; lacc[r] *= alpha; p0[r] -= dts; p1[r] -= dts; }
  }
#define MK_P8(P, R) __builtin_amdgcn_perm(mk_pknorm(P[(R) + 2], P[(R) + 3]), mk_pknorm(P[R], P[(R) + 1]), 0x07050301u)
  pb0.x = (int)MK_P8(p0, 0); pb0.y = (int)MK_P8(p0, 4); pb0.z = (int)MK_P8(p0, 8); pb0.w = (int)MK_P8(p0, 12);
  pb1.x = (int)MK_P8(p1, 0); pb1.y = (int)MK_P8(p1, 4); pb1.z = (int)MK_P8(p1, 8); pb1.w = (int)MK_P8(p1, 12);
#undef MK_P8
  return applied;
}
constexpr int N_PACK_JOBS = 3 * 8192;
struct PackJob { const float* p; int ldw; u32x4* dst; float scale; };
__device__ __forceinline__ PackJob pack_job(const KP& P, int f, int lane) {
  const int which = f >> 13, ff = f & 8191, r = lane & 31, h = lane >> 5, e = ff >> 8; PackJob j;
  if (which < 2) { const int nb = (ff >> 5) & 7, s = ff & 31; j.ldw = 256; j.scale = WGU_SCALE;
    j.p = P.in[19 + which] + (size_t)e * DM * 256 + (size_t)(32 * s + 16 * h) * 256 + 32 * nb + r; j.dst = (u32x4*)(P.ws + (which ? WS_WU : WS_WG)) + (size_t)ff * 64 + lane; }
  else { const int nb = (ff >> 3) & 31, s = ff & 7; j.ldw = DM; j.scale = WD_SCALE;
    j.p = P.in[21] + (size_t)e * 256 * DM + (size_t)(32 * s + 16 * h) * DM + 32 * nb + r; j.dst = (u32x4*)(P.ws + WS_WD) + (size_t)ff * 64 + lane; }
  return j;
}
__device__ __forceinline__ u32x4 pack_cvt(const float (&v)[16], float sc) {
  u32x4 w; w.x = pk4_fp8(v[0] * sc, v[1] * sc, v[2] * sc, v[3] * sc); w.y = pk4_fp8(v[4] * sc, v[5] * sc, v[6] * sc, v[7] * sc);
  w.z = pk4_fp8(v[8] * sc, v[9] * sc, v[10] * sc, v[11] * sc); w.w = pk4_fp8(v[12] * sc, v[13] * sc, v[14] * sc, v[15] * sc); return w;
}
__device__ __forceinline__ void mla_unit(const KP& P, LAS uchar* lds, int b, int head, int qblk, int& pk_k, int swa_u) {
  int lane_ = mk_lane(); asm volatile("" : "+v"(lane_)); const int lane = lane_ & 63, wave = P.wave, r32 = lane & 31, hi = lane >> 5;
  uchar* ws = P.ws;
  const uchar* kvimg = ws + WS_KVB + (size_t)(b * 8 + head) * 64 * 12288;
  const uchar* qimg = ws + WS_QB + ((size_t)(b * 8 + head) * 64 + qblk * 4 + (wave >> 1)) * 8192 + (wave & 1) * 4096 + lane * 16;
  const int gw = blockIdx.x * NWAVE + wave, NGW = gridDim.x * NWAVE;
  const i32x4 q00 = *(const i32x4*)(qimg), q01 = *(const i32x4*)(qimg + 1024), q10 = *(const i32x4*)(qimg + 2048);
  float pad = 56.5f; int qpad = hi ? 0 : 0x3066;
  f32x16 o0 = {}, o1 = {}, lacc = {};
  i32x8 ones8 = {0x38383838, 0x38383838, 0x38383838, 0x38383838, 0x38383838, 0x38383838, 0x38383838, 0x38383838};
  asm volatile("" : "+v"(ones8));
  mla_dma_step(kvimg, lds, 0, wave, lane);
#pragma unroll 1
  for (int t = 0; t < 32; ++t) {
    asm volatile("s_waitcnt vmcnt(0)" ::: "memory");
    __syncthreads();
    if (t + 1 < 32 && !(P.variant & 4)) mla_dma_step(kvimg, lds, t + 1, wave, lane);
    if (P.variant & 8) continue;
    u32x4 bandv = {}; int band_off = -1;
    if (swa_u >= 0 && t >= 20) { const int c = (wave * 64 + lane) + 512 * (t - 20), jt = c >> 10, gt = 2 * (swa_u & 31) - 2 + jt;
      if (gt >= 0 && gt < 64) { band_off = c * 16; bandv = *(const u32x4*)(ws + WS_KVA + ((size_t)((swa_u >> 6) * 2 + ((swa_u >> 5) & 1)) * 64 + gt) * 16384 + (c & 1023) * 16); } }
    const int pf = gw + pk_k * NGW; const bool do_pack = pf < N_PACK_JOBS;
    float pv[16]; u32x4* pdst = nullptr; float psc = 0.f;
    if (do_pack) { const PackJob j = pack_job(P, pf, lane); pdst = j.dst; psc = j.scale;
#pragma unroll
      for (int q = 0; q < 16; ++q) pv[q] = j.p[(size_t)q * j.ldw]; }
    f32x16 a0, a1, b0, b1; i32x4 pb0, pb1;
    { const unsigned va = (unsigned)(unsigned long)(lds + (t & 1) * 24576) + lane * 16;
#define MK_KOFF(j) (((j) >> 2) * 12288 + (((j) >> 1) & 1) * 4096 + ((j) & 1) * 2048)
      i32x4 kf[4][2];
#define MK_KRD(j) { MK_LDS_RD(kf[(j) & 3][0], va, MK_KOFF(j)); MK_LDS_RD(kf[(j) & 3][1], va, MK_KOFF(j) + 1024); }
      MK_KRD(0) MK_KRD(1) MK_KRD(2) MK_KRD(3)
      const i32x4 q11 = {qpad, 0, 0, 0};
#define MK_QK_STEP(j, ACC, NW) { lgkm_wait<NW>(); ACC = ((j) & 1) ? mfma_mx_q(kf[(j) & 3][0], kf[(j) & 3][1], q10, q11, ACC) : mfma_mx_q(kf[(j) & 3][0], kf[(j) & 3][1], q00, q01, f32x16{}); if ((j) + 4 < 8) MK_KRD(((j) + 4) & 7) }
      MK_QK_STEP(0, a0, 6) MK_QK_STEP(1, a0, 6) MK_QK_STEP(2, a1, 6) MK_QK_STEP(3, a1, 6) MK_QK_STEP(4, b0, 6) MK_QK_STEP(5, b0, 4) MK_QK_STEP(6, b1, 2) MK_QK_STEP(7, b1, 0)
#undef MK_QK_STEP
#undef MK_KRD
#undef MK_KOFF
      i32x4 vf[4];
#define MK_VRD(tile) { MK_LDS_RD(vf[0], va, (tile) * 12288 + 8192); MK_LDS_RD(vf[1], va, (tile) * 12288 + 8192 + 1024); MK_LDS_RD(vf[2], va, (tile) * 12288 + 8192 + 2048); MK_LDS_RD(vf[3], va, (tile) * 12288 + 8192 + 3072); }
      MK_VRD(0)
      const float dA = softmax_tile8<true>(a0, a1, pad, qpad, lacc, o0, o1, t == 0, hi, pb0, pb1);
      lacc = mfma_mx8(ones8, __builtin_shufflevector(pb0, pb1, 0, 1, 2, 3, 4, 5, 6, 7), lacc);
      lgkm_wait<0>();
      o0 = mfma_mx(vf[0], vf[1], pb0, pb1, o0); o1 = mfma_mx(vf[2], vf[3], pb0, pb1, o1);
      MK_VRD(1)
#undef MK_VRD
      if (__any(dA != 0.f)) {
#pragma unroll
        for (int r = 0; r < 16; ++r) { b0[r] -= dA; b1[r] -= dA; }
      }
      (void)softmax_tile8<false>(b0, b1, pad, qpad, lacc, o0, o1, false, hi, pb0, pb1);
      lacc = mfma_mx8(ones8, __builtin_shufflevector(pb0, pb1, 0, 1, 2, 3, 4, 5, 6, 7), lacc);
      lgkm_wait<0>();
      o0 = mfma_mx(vf[0], vf[1], pb0, pb1, o0); o1 = mfma_mx(vf[2], vf[3], pb0, pb1, o1);
    }
    if (do_pack) { *pdst = pack_cvt(pv, psc); ++pk_k; }
    if (band_off >= 0) *(LAS u32x4*)(lds + SWA_LDS + band_off) = bandv;
  }
  if (!(P.variant & 12)) store_o_l((bf16_t*)(ws + WS_O) + (size_t)(b * SEQ + qblk * 256 + 32 * wave + r32) * DM + 512 + head * 64, o0, o1, lacc[0], hi);
  __syncthreads();
}
__device__ __forceinline__ void phase2(const KP& P, LAS uchar* lds) {
  const int bid = blockIdx.x;
  int pk_k = 0;
  const bool pref = gridDim.x == 256 && !(P.variant & 3);
  if (!(P.variant & 2)) for (int i = bid; i < 512; i += gridDim.x) {
    const int rr = i >> 8, ii = i & 255, xcd = ii & 7, local = ii >> 3, pair = xcd * 4 + rr * 2 + (local >> 4), qblk = local & 15;
    mla_unit(P, lds, pair >> 3, pair & 7, qblk, pk_k, (pref && i >= 256) ? bid : -1);
  }
  if (!(P.variant & 1)) for (int u = bid; u < 256; u += gridDim.x) swa_unit(P, lds, u, pref);
  { const int lane = mk_lane(), wave = P.wave, gw = bid * NWAVE + wave, NGW = gridDim.x * NWAVE;
    for (int f = gw + pk_k * NGW; f < N_PACK_JOBS; f += NGW) { const PackJob j = pack_job(P, f, lane); float v[16];
#pragma unroll
      for (int q = 0; q < 16; ++q) v[q] = j.p[(size_t)q * j.ldw];
      *j.dst = pack_cvt(v, j.scale); } }
}
__device__ __forceinline__ void phase3_tile(const KP& P, LAS uchar* lds, const int tile) {
  int lane_ = mk_lane(); asm volatile("" : "+v"(lane_)); const int lane = lane_ & 63, wave = P.wave, tid = wave * 64 + lane, r32 = lane & 31, hi = lane >> 5;
  uchar* ws = P.ws;
  const int t0 = tile * 64, b = t0 / SEQ;
  const float* __restrict__ x = P.in[0]; const float* __restrict__ mod = (const float*)(ws + WS_MOD) + b * (NMOD * DM);
  LAS float* ssq = (LAS float*)(lds + LDS_MISC + 64);
  LAS int* selE = (LAS int*)(lds + LDS_MISC + 1024);
  LAS float* selW = (LAS float*)(lds + LDS_MISC + 1536);
  LAS int* selP = (LAS int*)(lds + LDS_MISC + 2048);
  LAS int* cntl = (LAS int*)(lds + LDS_MISC + 2560);
  LAS int* basel = (LAS int*)(lds + LDS_MISC + 2688);
  LAS float* logit = (LAS float*)(lds + LDS_MISC + 8192);
  if (tid < 64) ssq[tid] = 0.f;
  if (tid < 32) cntl[tid] = 0;
  {
    const bf16_t* O = (const bf16_t*)(ws + WS_O);
    float ga[8], gb[8];
#pragma unroll
    for (int j = 0; j < 8; ++j) { ga[j] = P.in[11][8 * lane + j]; gb[j] = P.in[12][8 * lane + j]; }
#pragma unroll
    for (int hf = 0; hf < 2; ++hf) {
      u32x4 va[4], vb[4];
#pragma unroll
      for (int rr = 0; rr < 4; ++rr) { const u32x4* src = (const u32x4*)(O + (size_t)(t0 + wave * 8 + hf * 4 + rr) * DM); va[rr] = src[lane]; vb[rr] = src[lane + 64]; }
#pragma unroll
      for (int rr = 0; rr < 4; ++rr) {
        const int row = wave * 8 + hf * 4 + rr; float fa[8], fb[8], sa = 0.f, sb = 0.f;
#pragma unroll
        for (int q = 0; q < 4; ++q) { fa[2 * q] = __uint_as_float(va[rr][q] << 16); fa[2 * q + 1] = __uint_as_float(va[rr][q] & 0xffff0000u);
          fb[2 * q] = __uint_as_float(vb[rr][q] << 16); fb[2 * q + 1] = __uint_as_float(vb[rr][q] & 0xffff0000u); }
#pragma unroll
        for (int j = 0; j < 8; ++j) { sa += fa[j] * fa[j]; sb += fb[j] * fb[j]; }
        sa = wave_sum(sa); sb = wave_sum(sb);
        const float ra = rsqrtf(sa * (1.0f / 512.0f) + EPS), rb_ = rsqrtf(sb * (1.0f / 512.0f) + EPS);
        u32x4 wa, wb;
#pragma unroll
        for (int q = 0; q < 4; ++q) { wa[q] = pk2(fa[2 * q] * ra * ga[2 * q], fa[2 * q + 1] * ra * ga[2 * q + 1]); wb[q] = pk2(fb[2 * q] * rb_ * gb[2 * q], fb[2 * q + 1] * rb_ * gb[2 * q + 1]); }
        *(LAS u32x4*)(lds + a_off(row, 16 * lane, 2048)) = wa; *(LAS u32x4*)(lds + a_off(row, 16 * (lane + 64), 2048)) = wb;
      }
    }
  }
  __syncthreads();
  f32x16 acc[4][2]; acc_zero<4>(acc);
  { const bf16x8* wp[4];
#pragma unroll
    for (int i = 0; i < 4; ++i) wp[i] = (const bf16x8*)(ws + WS_WOUT) + (size_t)((4 * wave + i) * 64) * 64 + lane;
    gemm_tile<4, 64, false, 5>(acc, lds, 2048, wp, lane); }
  if (P.variant & 2) { asm volatile("" :: "v"(acc[0][0][0]), "v"(acc[1][1][3]), "v"(acc[2][0][7]), "v"(acc[3][1][15])); return; }
  bf16_t* X1 = (bf16_t*)(ws + WS_X1); const unsigned short* XB = (const unsigned short*)(ws + WS_XB);
  float gt[4];
#pragma unroll
  for (int i = 0; i < 4; ++i) gt[i] = mod[2 * DM + 128 * wave + 32 * i + r32];
#pragma unroll
  for (int rb = 0; rb < 2; ++rb) {
    float xr[16][4];
#pragma unroll
    for (int reg = 0; reg < 16; ++reg) { const size_t off = (size_t)(t0 + 32 * rb + crow(reg, hi)) * DM + 128 * wave + r32;
#pragma unroll
      for (int i = 0; i < 4; ++i) xr[reg][i] = __uint_as_float((unsigned)XB[off + 32 * i] << 16); }
#pragma unroll
    for (int reg = 0; reg < 16; ++reg) { const int row = 32 * rb + crow(reg, hi); const size_t off = (size_t)(t0 + row) * DM + 128 * wave + r32; float ss = 0.f;
#pragma unroll
      for (int i = 0; i < 4; ++i) { const float v = xr[reg][i] + gt[i] * acc[i][rb][reg]; acc[i][rb][reg] = v; st_wt(X1 + off + 32 * i, (bf16_t)(pk2(v, 0.f) & 0xffffu)); ss += v * v; }
#pragma unroll
      for (int o = 16; o; o >>= 1) ss += __shfl_xor(ss, o);
      if (r32 == 0) lds_fadd(&ssq[row], ss); }
  }
  __syncthreads();
  { float a2[4], s2[4];
#pragma unroll
    for (int i = 0; i < 4; ++i) { const int col = 128 * wave + 32 * i + r32; a2[i] = P.in[14][col] * (1.0f + mod[4 * DM + col]); s2[i] = mod[3 * DM + col]; }
#pragma unroll
    for (int rb = 0; rb < 2; ++rb)
#pragma unroll
      for (int reg = 0; reg < 16; ++reg) { const int row = 32 * rb + crow(reg, hi); const float rs = rsqrtf(ssq[row] * (1.0f / DM) + EPS);
#pragma unroll
        for (int i = 0; i < 4; ++i) { const float v = acc[i][rb][reg] * rs * a2[i] + s2[i]; const int col = 128 * wave + 32 * i + r32;
          *(LAS bf16_t*)(lds + a_off(row, 2 * col, 2048)) = (bf16_t)(pk2(v, v) & 0xffffu); } }
  }
  __syncthreads();
  if (P.variant & 1) return;
  if (wave < 4) {
    f32x16 ar[1][2]; acc_zero<1>(ar);
    const bf16x8* wp[1]; wp[0] = (const bf16x8*)(ws + WS_WR) + (size_t)((wave >> 1) * 64) * 64 + lane;
    gemm_tile<1, 64, false>(ar, lds, 2048, wp, lane);
    const int rb = wave & 1, col = 32 * (wave >> 1) + r32;
#pragma unroll
    for (int reg = 0; reg < 16; ++reg) { const float v = rb ? ar[0][1][reg] : ar[0][0][reg]; logit[(32 * rb + crow(reg, hi)) * 64 + col] = v; }
  }
  { uchar* H2 = ws + WS_H2;
#pragma unroll
    for (int rr = 0; rr < 8; ++rr) { const int row = wave * 8 + rr;
      const u32x4 v0 = *(const LAS u32x4*)(lds + a_off(row, 16 * lane, 2048)), v1 = *(const LAS u32x4*)(lds + a_off(row, 16 * (lane + 64), 2048));
      u32x2 w0, w1;
      w0.x = pk4_fp8(__uint_as_float(v0.x << 16) * H2_SCALE, __uint_as_float(v0.x & 0xffff0000u) * H2_SCALE, __uint_as_float(v0.y << 16) * H2_SCALE, __uint_as_float(v0.y & 0xffff0000u) * H2_SCALE);
      w0.y = pk4_fp8(__uint_as_float(v0.z << 16) * H2_SCALE, __uint_as_float(v0.z & 0xffff0000u) * H2_SCALE, __uint_as_float(v0.w << 16) * H2_SCALE, __uint_as_float(v0.w & 0xffff0000u) * H2_SCALE);
      w1.x = pk4_fp8(__uint_as_float(v1.x << 16) * H2_SCALE, __uint_as_float(v1.x & 0xffff0000u) * H2_SCALE, __uint_as_float(v1.y << 16) * H2_SCALE, __uint_as_float(v1.y & 0xffff0000u) * H2_SCALE);
      w1.y = pk4_fp8(__uint_as_float(v1.z << 16) * H2_SCALE, __uint_as_float(v1.z & 0xffff0000u) * H2_SCALE, __uint_as_float(v1.w << 16) * H2_SCALE, __uint_as_float(v1.w & 0xffff0000u) * H2_SCALE);
      u32x2* dst = (u32x2*)(H2 + (size_t)(t0 + row) * DM); dst[lane] = w0; dst[lane + 64] = w1; } }
  __syncthreads();
  if (tid < 64) {
    const float* lg = (const float*)0; (void)lg;
    float gl[4];
#pragma unroll
    for (int i = 0; i < 4; ++i) gl[i] = logit[tid * 64 + i] + P.in[16][i];
    int gi = 0; float gm = gl[0];
#pragma unroll
    for (int i = 1; i < 4; ++i) if (gl[i] > gm) { gm = gl[i]; gi = i; }
    float gs = 0.f;
#pragma unroll
    for (int i = 0; i < 4; ++i) gs += __expf(gl[i] - gm);
    const float gw = 1.0f / gs;
    float el[8];
#pragma unroll
    for (int i = 0; i < 8; ++i) el[i] = logit[tid * 64 + 4 + gi * 8 + i] + P.in[18][gi * 8 + i];
    int i1 = 0; float m1 = el[0];
#pragma unroll
    for (int i = 1; i < 8; ++i) if (el[i] > m1) { m1 = el[i]; i1 = i; }
    int i2 = (i1 + 1) & 7; float m2 = el[i2];
#pragma unroll
    for (int i = 0; i < 8; ++i) if (i != i1 && el[i] > m2) { m2 = el[i]; i2 = i; }
    const float p2 = __expf(m2 - m1), w1 = 1.0f / (1.0f + p2), w2 = p2 * w1;
    const int e1 = gi * 8 + i1, e2 = gi * 8 + i2;
    selE[2 * tid] = e1; selE[2 * tid + 1] = e2; selW[2 * tid] = gw * w1; selW[2 * tid + 1] = gw * w2;
    selP[2 * tid] = __hip_atomic_fetch_add(&cntl[e1], 1, __ATOMIC_RELAXED, __HIP_MEMORY_SCOPE_WORKGROUP);
    selP[2 * tid + 1] = __hip_atomic_fetch_add(&cntl[e2], 1, __ATOMIC_RELAXED, __HIP_MEMORY_SCOPE_WORKGROUP);
  }
  __syncthreads();
  if (tid < 32) { const int c = cntl[tid]; basel[tid] = c ? atomicAdd((int*)(ws + WS_CNT) + tid, c) : 0; }
  __syncthreads();
  if (tid < 128) { const int e = selE[tid], pos = basel[e] + selP[tid];
    ((int*)(ws + WS_LIST))[(size_t)e * 16384 + pos] = (t0 + (tid >> 1)) * 2 + (tid & 1);
    ((float*)(ws + WS_WT))[(size_t)(t0 + (tid >> 1)) * 2 + (tid & 1)] = selW[tid]; }
  __syncthreads();
}

constexpr int P4_ROWS = 144, P4_NRB = 5, P4_MISC = P4_ROWS * 1024;
__device__ __forceinline__ void phase4(const KP& P, LAS uchar* lds) {
  int lane_ = mk_lane(); asm volatile("" : "+v"(lane_)); const int lane = lane_ & 63, wave = P.wave, tid = wave * 64 + lane, r32 = lane & 31, hi = lane >> 5;
  uchar* ws = P.ws;
  LAS int* rinfo = (LAS int*)(lds + P4_MISC + 1024);
  LAS float* rwt = (LAS float*)(lds + P4_MISC + 2048);
  LAS int* ustart = (LAS int*)(lds + P4_MISC + 3072);
  const int* cnt = (const int*)(ws + WS_CNT);
  if (tid == 0) { int acc_ = 0; for (int e = 0; e < 32; ++e) { ustart[e] = acc_; acc_ += (cnt[e] + P4_ROWS - 1) / P4_ROWS; } ustart[32] = acc_; }
  __syncthreads();
  const int total = ustart[32];
  const uchar* H2 = ws + WS_H2; bf16_t* Y = (bf16_t*)(ws + WS_Y);
#pragma unroll 1
  for (int u = blockIdx.x; u < total; u += gridDim.x) {
    int e = 0;
#pragma unroll 1
    for (int k = 1; k < 32; ++k) if (ustart[k] <= u) e = k;
    const int ne = cnt[e], ke = ustart[e + 1] - ustart[e], q = (ne + ke - 1) / ke, j = u - ustart[e], base = j * q, len = min(q, ne - base), nrb = (len + 31) >> 5;
    if (tid < 160) { int info = -1; float w = 0.f;
      if (tid < len) { info = ((const int*)(ws + WS_LIST))[(size_t)e * 16384 + base + tid]; w = ((const float*)(ws + WS_WT))[info]; }
      rinfo[tid] = info; rwt[tid] = w; }
    __syncthreads();
#pragma unroll
    for (int hf = 0; hf < 2; ++hf) {
      u32x4 v[9];
#pragma unroll
      for (int rr = 0; rr < 9; ++rr) { const int info = rinfo[wave * 18 + hf * 9 + rr]; const int tok = info < 0 ? 0 : (info >> 1); v[rr] = ((const u32x4*)(H2 + (size_t)tok * DM))[lane]; }
#pragma unroll
      for (int rr = 0; rr < 9; ++rr) *(LAS u32x4*)(lds + a_off(wave * 18 + hf * 9 + rr, 16 * lane, 1024)) = v[rr];
    }
    __syncthreads();
    f32x16 ag[2][P4_NRB];
#pragma unroll
    for (int i = 0; i < 2; ++i)
#pragma unroll
      for (int rb = 0; rb < P4_NRB; ++rb) ag[i][rb] = f32x16{};
    { const l64x2* wp[2];
      wp[0] = (const l64x2*)(ws + WS_WG) + (size_t)((e * 8 + wave) * 32) * 64 + lane;
      wp[1] = (const l64x2*)(ws + WS_WU) + (size_t)((e * 8 + wave) * 32) * 64 + lane;
      if (!(P.variant & 2)) gemm_tile_f8<2, 32, true, 1, false, P4_NRB>(ag, lds, 1024, wp, lane, nrb); }
    __syncthreads();
    { constexpr float S1 = 1.0f / (H2_SCALE * WGU_SCALE);
#pragma unroll
      for (int rb = 0; rb < P4_NRB; ++rb) if (rb < nrb) { const int rr = 32 * rb + r32; const float w = rwt[rr] * HID_SCALE;
#pragma unroll
        for (int g = 0; g < 4; ++g) { float hv[4];
#pragma unroll
          for (int i = 0; i < 4; ++i) { const float gg = ag[0][rb][4 * g + i] * S1, uu = ag[1][rb][4 * g + i] * S1; hv[i] = gg / (1.0f + __expf(-gg)) * uu * w; }
          *(LAS unsigned*)(lds + a_off(rr, 32 * wave + 8 * g + 4 * hi, 256)) = pk4_fp8(hv[0], hv[1], hv[2], hv[3]); } } }
    __syncthreads();
#pragma unroll 1
    for (int pass = (P.variant & 1) ? 2 : 0; pass < 2; ++pass) {
      f32x16 ad[2][P4_NRB];
#pragma unroll
      for (int i = 0; i < 2; ++i)
#pragma unroll
        for (int rb = 0; rb < P4_NRB; ++rb) ad[i][rb] = f32x16{};
      const l64x2* wp[2];
#pragma unroll
      for (int i = 0; i < 2; ++i) wp[i] = (const l64x2*)(ws + WS_WD) + (size_t)((e * 32 + 4 * wave + 2 * pass + i) * 8) * 64 + lane;
      gemm_tile_f8<2, 8, false, 1, false, P4_NRB>(ad, lds, 256, wp, lane, nrb);
      constexpr float S2 = 1.0f / (HID_SCALE * WD_SCALE);
#pragma unroll
      for (int rb = 0; rb < P4_NRB; ++rb) if (rb < nrb) {
#pragma unroll
        for (int reg = 0; reg < 16; ++reg) { const int info = rinfo[32 * rb + crow(reg, hi)];
          if (info >= 0) { bf16_t* yp = Y + (size_t)info * DM + 128 * wave + 64 * pass + r32;
            st_wt(yp, (bf16_t)(pk2(ad[0][rb][reg] * S2, 0.f) & 0xffffu)); st_wt(yp + 32, (bf16_t)(pk2(ad[1][rb][reg] * S2, 0.f) & 0xffffu)); } } }
    }
    __syncthreads();
  }
}

__device__ __forceinline__ void phase5(const KP& P) {
  int lane_ = mk_lane(); asm volatile("" : "+v"(lane_)); const int lane = lane_ & 63, wave = P.wave;
  uchar* ws = P.ws;
  const bf16_t* Y = (const bf16_t*)(ws + WS_Y);
  const bf16_t* X1 = (const bf16_t*)(ws + WS_X1); float* OUT = P.out;
  f32x4 gf[4];
#pragma unroll
  for (int i = 0; i < 4; ++i) gf[i] = *(const f32x4*)(P.in[22] + 4 * (lane + 64 * i));
  constexpr int RPI = 4;
  const int nwv = gridDim.x * NWAVE, wv = blockIdx.x * NWAVE + wave;
#pragma unroll 1
  for (int t0 = wv * RPI; t0 < T; t0 += nwv * RPI) {
    u32x2 xv[RPI][4]; u32x2 ya[RPI][4], yb[RPI][4];
#pragma unroll
    for (int r = 0; r < RPI; ++r)
#pragma unroll
      for (int i = 0; i < 4; ++i) { const int k = 4 * (lane + 64 * i); const size_t t = t0 + r;
        xv[r][i] = *(const u32x2*)(X1 + t * DM + k); ya[r][i] = *(const u32x2*)(Y + (2 * t) * DM + k); yb[r][i] = *(const u32x2*)(Y + (2 * t + 1) * DM + k); }
    const int b = t0 / SEQ; const float* gt2 = (const float*)(ws + WS_MOD) + b * (NMOD * DM) + 5 * DM;
    f32x4 g2v[4];
#pragma unroll
    for (int i = 0; i < 4; ++i) g2v[i] = *(const f32x4*)(gt2 + 4 * (lane + 64 * i));
#pragma unroll
    for (int r = 0; r < RPI; ++r) {
      f32x4 v[4]; float ss = 0.f;
#pragma unroll
      for (int i = 0; i < 4; ++i) { const u32x2 y0 = ya[r][i], y1 = yb[r][i]; f32x4 ys;
        ys[0] = __uint_as_float(y0.x << 16) + __uint_as_float(y1.x << 16); ys[1] = __uint_as_float(y0.x & 0xffff0000u) + __uint_as_float(y1.x & 0xffff0000u);
        ys[2] = __uint_as_float(y0.y << 16) + __uint_as_float(y1.y << 16); ys[3] = __uint_as_float(y0.y & 0xffff0000u) + __uint_as_float(y1.y & 0xffff0000u);
        f32x4 xf; xf[0] = __uint_as_float(xv[r][i].x << 16); xf[1] = __uint_as_float(xv[r][i].x & 0xffff0000u); xf[2] = __uint_as_float(xv[r][i].y << 16); xf[3] = __uint_as_float(xv[r][i].y & 0xffff0000u);
        v[i] = xf + g2v[i] * ys; ss += v[i][0] * v[i][0] + v[i][1] * v[i][1] + v[i][2] * v[i][2] + v[i][3] * v[i][3]; }
      ss = wave_sum(ss); const float rs = rsqrtf(ss * (1.0f / DM) + EPS);
#pragma unroll
      for (int i = 0; i < 4; ++i) *(f32x4*)(OUT + (size_t)(t0 + r) * DM + 4 * (lane + 64 * i)) = v[i] * rs * gf[i];
    }
  }
}
__global__ void __launch_bounds__(NTHR, 2) mk_fwd(const Params P0) {
  extern __shared__ __attribute__((aligned(16))) uchar lds_raw[];
  LAS uchar* lds = (LAS uchar*)lds_raw;
  KP P; P.in = P0.in; P.out = P0.out; P.ws = P0.ws; P.ph_lo = P0.ph_lo; P.ph_hi = P0.ph_hi; P.variant = P0.variant; P.wave = __builtin_amdgcn_readfirstlane((int)(threadIdx.x >> 6));
  const int bid = blockIdx.x, G = gridDim.x;
  const int lo = P.ph_lo, hi = P.ph_hi;
  volatile LAS unsigned* bst = (volatile LAS unsigned*)(lds + LDS_BYTES - 16);
  if (threadIdx.x < 4) bst[threadIdx.x] = 0u;
  __syncthreads();
  XcdBarrier bar; bar.bar = (unsigned*)(P.ws + WS_CTL); bar.x = 0; bar.st = bst;
  if (hi - lo > 1) bar = xcd_barrier_post((unsigned*)(P.ws + WS_CTL), bst, P.wave == 0 && mk_lane() == 0);
#define IN(k) (lo <= (k) && (k) < hi)
#define BOTH(k) (IN(k) && IN((k) + 1))
  if (IN(0)) { phase0(P, lds); if (BOTH(0)) xcd_barrier(bar, P.wave == 0 && mk_lane() == 0); }
  if (IN(1)) { if (bid < T / 64) phase1_tile(P, lds, bid); if (BOTH(1)) xcd_barrier(bar, P.wave == 0 && mk_lane() == 0); }
  if (IN(2)) { phase2(P, lds); if (BOTH(2)) xcd_barrier(bar, P.wave == 0 && mk_lane() == 0); }
  if (IN(3)) { if (bid < T / 64) phase3_tile(P, lds, bid); if (BOTH(3)) xcd_barrier(bar, P.wave == 0 && mk_lane() == 0); }
  if (IN(4)) { phase4(P, lds); if (BOTH(4)) xcd_barrier(bar, P.wave == 0 && mk_lane() == 0); }
  if (IN(5)) phase5(P);
#undef IN
#undef BOTH
}

extern "C" void kernel_launch(void* const* d_in, const int* in_sizes, int n_in, void* d_out, int out_size, void* d_ws, size_t ws_size, hipStream_t stream) {
  static int ready = 0;
  if (!ready) {
    if (n_in != 23 || out_size != T * DM || ws_size < WS_END) { fprintf(stderr, "kernel_launch: unexpected shapes (n_in %d out %d ws %zu need %zu)\n", n_in, out_size, ws_size, (size_t)WS_END); return; }
    if (hipFuncSetAttribute((const void*)mk_fwd, hipFuncAttributeMaxDynamicSharedMemorySize, LDS_BYTES) != hipSuccess) { fprintf(stderr, "kernel_launch: hipFuncSetAttribute failed\n"); return; }
    ready = 1;
  }
  uchar* ws = (uchar*)d_ws;
  if (hipMemsetAsync(ws + WS_CTL, 0, 32768, stream) != hipSuccess) { fprintf(stderr, "kernel_launch: hipMemsetAsync failed\n"); return; }
  Params p{};
  for (int i = 0; i < 23; ++i) p.in[i] = (const float*)d_in[i];
  p.out = (float*)d_out; p.ws = ws; p.ph_lo = 0; p.ph_hi = 6; p.variant = 0; p.pad = 0;
  hipLaunchKernelGGL(mk_fwd, dim3(T / 64), dim3(NTHR), LDS_BYTES, stream, p);
}
```

```cpp
#include <hip/hip_runtime.h>
#include <cstdio>
#include <cstdint>
constexpr int DM = 1024, NB = 4, SEQ = 4096, T = NB * SEQ;
constexpr int INW = 1120, NMOD = 6;
constexpr float EPS = 1e-6f;
#define LAS __attribute__((address_space(3)))
typedef unsigned short bf16_t;
typedef short bf16x8 __attribute__((ext_vector_type(8)));
typedef float f32x16 __attribute__((ext_vector_type(16)));
typedef float f32x4 __attribute__((ext_vector_type(4)));
typedef unsigned u32x4 __attribute__((ext_vector_type(4)));
typedef unsigned u32x2 __attribute__((ext_vector_type(2)));
typedef unsigned char uchar;

constexpr int NTHR = 512, NWAVE = 8;
constexpr int LDS_A = 0, LDS_MISC = 131072, LDS_BYTES = 163840;
constexpr float LOG2E = 1.4426950408889634f;
constexpr float QSCALE_A = 0.125f * LOG2E * (128.0f / 65535.0f);
constexpr float QSCALE_B = 0.10206207261596575f * LOG2E;
constexpr float THR2 = 10.f;
constexpr float WIN_SCALE = 64.f, WIN_DESCALE = 1.0f / 64.f;
constexpr float H2_SCALE = 8.f, WGU_SCALE = 64.f, WD_SCALE = 32.f, HID_SCALE = 8.f;

constexpr size_t WS_CTL   = 0;
constexpr size_t WS_CNT   = 16384;
constexpr size_t WS_MOD   = 32768;
constexpr size_t WS_TABA  = WS_MOD + 98304;
constexpr size_t WS_TABB  = WS_TABA + 4096 * 32 * 8;
constexpr size_t WS_WIN   = WS_TABB + 4096 * 16 * 8;
constexpr size_t WS_WUQ   = WS_WIN + 35 * 64 * 1024;
constexpr size_t WS_WUKV  = WS_WUQ + 24 * 12 * 1024;
constexpr size_t WS_WOUT  = WS_WUKV + 32 * 8 * 1024;
constexpr size_t WS_WR    = WS_WOUT + 32 * 64 * 1024;
constexpr size_t WS_WG    = WS_WR + 2 * 64 * 1024;
constexpr size_t WS_WU    = WS_WG + (size_t)32 * 8 * 32 * 1024;
constexpr size_t WS_WD    = WS_WU + (size_t)32 * 8 * 32 * 1024;
constexpr size_t WS_LIST  = WS_WD + (size_t)32 * 32 * 8 * 1024;
constexpr size_t WS_WT    = WS_LIST + (size_t)32 * 16384 * 4;
constexpr size_t WS_QA    = WS_WT + (size_t)T * 2 * 4;
constexpr size_t WS_KVA   = WS_QA + (size_t)NB * 8 * 64 * 8192;
constexpr size_t WS_QB    = WS_KVA + (size_t)NB * 2 * 64 * 16384;
constexpr size_t WS_KVB   = WS_QB + (size_t)NB * 8 * 64 * 12288;
constexpr size_t WS_O     = WS_KVB + (size_t)NB * 8 * 64 * 20480;
constexpr size_t WS_H2    = WS_O + (size_t)T * DM * 2;
constexpr size_t WS_X1    = WS_H2 + (size_t)T * DM * 2;
constexpr size_t WS_XB    = WS_X1 + (size_t)T * DM * 2;
constexpr size_t WS_END   = WS_XB + (size_t)T * DM * 2;
constexpr size_t WS_Y     = WS_QA;
static_assert((size_t)T * 2 * DM * 2 <= WS_O - WS_QA, "Y overlay");

struct Params { const float* in[23]; float* out; unsigned char* ws; int ph_lo, ph_hi, variant, pad; };
struct KP { const float* const* in; float* out; unsigned char* ws; int ph_lo, ph_hi, wave, variant; };
__device__ __forceinline__ int mk_lane() { return (int)__builtin_amdgcn_mbcnt_hi(~0u, __builtin_amdgcn_mbcnt_lo(~0u, 0u)); }

__device__ __forceinline__ unsigned pk2(float lo, float hi) { unsigned r; asm("v_cvt_pk_bf16_f32 %0, %1, %2" : "=v"(r) : "v"(lo), "v"(hi)); return r; }
__device__ __forceinline__ float bf2f(unsigned short v) { return __uint_as_float((unsigned)v << 16); }
__host__ __device__ __forceinline__ constexpr int crow(int r, int hi) { return (r & 3) + 8 * (r >> 2) + 4 * hi; }
__device__ __forceinline__ f32x16 mfma(bf16x8 a, bf16x8 b, f32x16 c) { return __builtin_amdgcn_mfma_f32_32x32x16_bf16(a, b, c, 0, 0, 0); }
__device__ __forceinline__ float wave_sum(float v) {
#pragma unroll
  for (int o = 32; o; o >>= 1) v += __shfl_xor(v, o);
  return v;
}
__device__ __forceinline__ float half_swap_max(float x) { auto rr = __builtin_amdgcn_permlane32_swap(__float_as_uint(x), __float_as_uint(x), false, false);
  float m; asm("v_max_f32 %0, %1, %2" : "=v"(m) : "v"(rr[0]), "v"(rr[1])); return m; }
__device__ __forceinline__ float half_swap_sum(float x) { auto rr = __builtin_amdgcn_permlane32_swap(__float_as_uint(x), __float_as_uint(x), false, false); return __uint_as_float(rr[0]) + __uint_as_float(rr[1]); }
template <typename TT> __device__ __forceinline__ void st_wt(TT* p, TT v) { __hip_atomic_store(p, v, __ATOMIC_RELAXED, __HIP_MEMORY_SCOPE_AGENT); }
__device__ __forceinline__ void st_wt8(void* p, u32x2 v) { st_wt((unsigned long long*)p, __builtin_bit_cast(unsigned long long, v)); }
__device__ __forceinline__ void st_wt16(void* p, u32x4 v) { st_wt8(p, u32x2{v.x, v.y}); st_wt8((uchar*)p + 8, u32x2{v.z, v.w}); }
__host__ __device__ __forceinline__ constexpr int a_off(int row, int kbyte, int pitch) { return row * pitch + (kbyte ^ ((row & 15) << 4)); }
__host__ __device__ __forceinline__ constexpr int img_qk(int rr, int d, int NS) { return ((((rr >> 5) * NS + (d >> 4)) * 64) + ((d >> 3) & 1) * 32 + (rr & 31)) * 16 + (d & 7) * 2; }
__host__ __device__ __forceinline__ constexpr int img_v(int kk, int d) {
  const int kb = kk >> 5, k32 = kk & 31, s = k32 >> 4, k16 = k32 & 15, h = (k16 >> 2) & 1, j = ((k16 >> 3) << 2) | (k16 & 3), db = d >> 5, r = d & 31;
  return (((((kb * 2 + db) * 2 + s) * 64) + h * 32 + r) * 8 + j) * 2;
}

#define XB_TMO      128
#define XB_XCNT(j)  (256  + 64 * (j))
#define XB_XSUB(j)  (1280 + 64 * (j))
#define XB_XGEN(j)  (2304 + 64 * (j))
#define XB_TOP      3328
#define XB_TOPGEN   3392
#define XCD_BAR_WORDS 3456
#define XB_SPIN_CAP (1u << 20)
__device__ __forceinline__ unsigned xb_ld(unsigned* p)              { return __hip_atomic_load(p, __ATOMIC_RELAXED, __HIP_MEMORY_SCOPE_AGENT); }
__device__ __forceinline__ unsigned xb_add(unsigned* p, unsigned v) { return __hip_atomic_fetch_add(p, v, __ATOMIC_RELAXED, __HIP_MEMORY_SCOPE_AGENT); }
__device__ __forceinline__ unsigned xb_xcc_id() { return (unsigned)__builtin_amdgcn_s_getreg((3 << 11) | 20) & 0xFu; }
#define XB_SPIN(cond, bar) do { unsigned _sp = 0; while (cond) { __builtin_amdgcn_s_sleep(1); \
    if ((++_sp & 255u) == 0u) { if (xb_ld(&(bar)[XB_TMO])) break; if (_sp > XB_SPIN_CAP) { atomicAdd(&(bar)[XB_TMO], 1u); break; } } } } while (0)
struct XcdBarrier { unsigned* bar; unsigned x; volatile LAS unsigned* st; };
__device__ __forceinline__ XcdBarrier xcd_barrier_post(unsigned* bar, volatile LAS unsigned* st, bool leader) {
  XcdBarrier b; b.bar = bar; b.x = xb_xcc_id(); b.st = st;
  if (leader) (void)xb_add(&bar[XB_XCNT(b.x)], 1u);
  return b;
}
__device__ __forceinline__ void xcd_barrier_complete(unsigned* bar, unsigned x, unsigned& nloc, unsigned& nx) {
  const unsigned G = gridDim.x * gridDim.y * gridDim.z;
  unsigned sum, cnt, mine, sp = 0u;
  for (;;) {
    sum = 0u; cnt = 0u; mine = 0u;
#pragma unroll
    for (unsigned j = 0; j < 16; ++j) { const unsigned c = xb_ld(&bar[XB_XCNT(j)]); sum += c; cnt += (c > 0u) ? 1u : 0u; mine = (j == x) ? c : mine; }
    if (sum == G) break;
    __builtin_amdgcn_s_sleep(1);
    if ((++sp & 255u) == 0u) { if (xb_ld(&bar[XB_TMO])) break; if (sp > XB_SPIN_CAP) { atomicAdd(&bar[XB_TMO], 1u); break; } }
  }
  nloc = mine > 0u ? mine : 1u; nx = cnt > 0u ? cnt : 1u;
}
__device__ __forceinline__ void xcd_barrier(const XcdBarrier& b, bool leader) {
  asm volatile("s_waitcnt vmcnt(0)" ::: "memory");
  __syncthreads();
  if (leader) {
    unsigned* bar = b.bar;
    __builtin_amdgcn_s_waitcnt(0);
    unsigned nloc = b.st[0], nx = b.st[1];
    if (nloc == 0u) { xcd_barrier_complete(bar, b.x, nloc, nx); b.st[0] = nloc; b.st[1] = nx; }
    const unsigned old = xb_add(&bar[XB_XSUB(b.x)], 1u);
    const unsigned gen = old / nloc;
    if (old + 1u == (gen + 1u) * nloc) {
      __builtin_amdgcn_fence(__ATOMIC_RELEASE, "agent");
      asm volatile("s_waitcnt vmcnt(0)" ::: "memory");
      const unsigned og = xb_add(&bar[XB_TOP], 1u);
      const unsigned tg = og / nx;
      if (og + 1u == (tg + 1u) * nx) xb_add(&bar[XB_TOPGEN], 1u);
      else XB_SPIN(xb_ld(&bar[XB_TOPGEN]) == tg, bar);
      __builtin_amdgcn_fence(__ATOMIC_ACQUIRE, "agent");
      xb_add(&bar[XB_XGEN(b.x)], 1u);
      asm volatile("s_waitcnt vmcnt(0)" ::: "memory");
    } else {
      XB_SPIN(xb_ld(&bar[XB_XGEN(b.x)]) == gen, bar);
      __builtin_amdgcn_fence(__ATOMIC_ACQUIRE, "agent");
      asm volatile("s_waitcnt vmcnt(0)" ::: "memory");
    }
  }
  __syncthreads();
}

template <int NBLK, int NS, bool TR, int D = (NBLK >= 3 ? 4 : 8)>
__device__ __forceinline__ void gemm_tile(f32x16 (&acc)[NBLK][2], const LAS uchar* A, const int pitch, const bf16x8* const (&wp)[NBLK], const int lane) {
  constexpr int NSM = (NS / D) * D;
  const int r = lane & 31, h = lane >> 5;
  const LAS uchar* a0p = A + r * pitch; const LAS uchar* a1p = A + (32 + r) * pitch;
  const int swz = (lane & 15) << 4, kb0 = 16 * h;
  bf16x8 ring[D][NBLK];
#pragma unroll
  for (int d = 0; d < D; ++d)
#pragma unroll
    for (int i = 0; i < NBLK; ++i) ring[d][i] = wp[i][d * 64];
#pragma unroll 1
  for (int s0 = 0; s0 < NSM; s0 += D) {
#pragma unroll
    for (int d = 0; d < D; ++d) {
      const int s = s0 + d;
      const int ko = ((s * 32) + kb0) ^ swz; const bf16x8 fa0 = *(const LAS bf16x8*)(a0p + ko), fa1 = *(const LAS bf16x8*)(a1p + ko);
#pragma unroll
      for (int i = 0; i < NBLK; ++i) {
        if (TR) { acc[i][0] = mfma(ring[d][i], fa0, acc[i][0]); acc[i][1] = mfma(ring[d][i], fa1, acc[i][1]); }
        else    { acc[i][0] = mfma(fa0, ring[d][i], acc[i][0]); acc[i][1] = mfma(fa1, ring[d][i], acc[i][1]); }
      }
      if (s + D < NS) {
#pragma unroll
        for (int i = 0; i < NBLK; ++i) ring[d][i] = wp[i][(s + D) * 64];
      }
    }
  }
#pragma unroll
  for (int d = 0; d < NS - NSM; ++d) {
    const int s = NSM + d;
    const int ko = ((s * 32) + kb0) ^ swz; const bf16x8 fa0 = *(const LAS bf16x8*)(a0p + ko), fa1 = *(const LAS bf16x8*)(a1p + ko);
#pragma unroll
    for (int i = 0; i < NBLK; ++i) {
      if (TR) { acc[i][0] = mfma(ring[d][i], fa0, acc[i][0]); acc[i][1] = mfma(ring[d][i], fa1, acc[i][1]); }
      else    { acc[i][0] = mfma(fa0, ring[d][i], acc[i][0]); acc[i][1] = mfma(fa1, ring[d][i], acc[i][1]); }
    }
  }
}
typedef long l64x2 __attribute__((ext_vector_type(2)));
__device__ __forceinline__ f32x16 mfma8(long a, long b, f32x16 c) { return __builtin_amdgcn_mfma_f32_32x32x16_fp8_fp8(a, b, c, 0, 0, 0); }
__device__ __forceinline__ unsigned pk4_fp8(float a, float b, float c, float d) { int w = 0; w = __builtin_amdgcn_cvt_pk_fp8_f32(a, b, w, false); w = __builtin_amdgcn_cvt_pk_fp8_f32(c, d, w, true); return (unsigned)w; }
typedef int i32x8 __attribute__((ext_vector_type(8)));
typedef int i32x4 __attribute__((ext_vector_type(4)));
#ifndef MK_MX
#define MK_MX 1
#endif
__device__ __forceinline__ f32x16 mfma_mx(i32x4 a0, i32x4 a1, i32x4 b0, i32x4 b1, f32x16 c) {
  const i32x8 a = __builtin_shufflevector(a0, a1, 0, 1, 2, 3, 4, 5, 6, 7), b = __builtin_shufflevector(b0, b1, 0, 1, 2, 3, 4, 5, 6, 7);
  return __builtin_amdgcn_mfma_scale_f32_32x32x64_f8f6f4(a, b, c, 0, 0, 0, 0x7f7f7f7f, 0, 0x7f7f7f7f);
}
__device__ __forceinline__ f32x16 mfma_mx_q(i32x4 a0, i32x4 a1, i32x4 b0, i32x4 b1, f32x16 c) {
  const i32x8 a = __builtin_shufflevector(a0, a1, 0, 1, 2, 3, 4, 5, 6, 7), b = __builtin_shufflevector(b0, b1, 0, 1, 2, 3, 4, 5, 6, 7);
  return __builtin_amdgcn_mfma_scale_f32_32x32x64_f8f6f4(a, b, c, 0, 0, 0, 0x7f7f7f7f, 0, 0x77777777);
}
__device__ __forceinline__ unsigned mk_pknorm(float lo, float hi) { typedef unsigned short u16x2 __attribute__((ext_vector_type(2))); const u16x2 v = __builtin_amdgcn_cvt_pknorm_u16(lo, hi); return __builtin_bit_cast(unsigned, v); }
__device__ __forceinline__ f32x16 mfma_mx8(i32x8 a, i32x8 b, f32x16 c) { return __builtin_amdgcn_mfma_scale_f32_32x32x64_f8f6f4(a, b, c, 0, 0, 0, 0x7f7f7f7f, 0, 0x7f7f7f7f); }
__device__ __forceinline__ i32x8 ld_pair(const i32x4* p0, const i32x4* p1) { const i32x4 x = *p0, y = *p1; return __builtin_shufflevector(x, y, 0, 1, 2, 3, 4, 5, 6, 7); }
template <int NBLK, int NS, bool TR, int D, bool FULL, int NRB>
__device__ __forceinline__ void gemm_tile_f8(f32x16 (&acc)[NBLK][NRB], const LAS uchar* A, const int pitch, const l64x2* const (&wp)[NBLK], const int lane, const int nrb) {
  constexpr int NP = NS / 2;
  static_assert(NS % 2 == 0 && NP % D == 0, "NS even, NP % D");
  const int r = lane & 31, h = lane >> 5;
  const LAS uchar* ap = A + r * pitch;
  const int swz = (lane & 15) << 4, kb0 = 16 * h;
  i32x8 ring[D][NBLK];
#pragma unroll
  for (int d = 0; d < D; ++d)
#pragma unroll
    for (int i = 0; i < NBLK; ++i) ring[d][i] = ld_pair((const i32x4*)(wp[i] + (2 * d) * 64), (const i32x4*)(wp[i] + (2 * d + 1) * 64));
#pragma unroll 1
  for (int p0 = 0; p0 < NP; p0 += D) {
#pragma unroll
    for (int d = 0; d < D; ++d) {
      const int s = 2 * (p0 + d);
      const int ko0 = ((s * 32) + kb0) ^ swz, ko1 = (((s + 1) * 32) + kb0) ^ swz;
#pragma unroll
      for (int rb = 0; rb < NRB; ++rb) {
        if (FULL || rb < nrb) {
          const i32x4 f0 = *(const LAS i32x4*)(ap + rb * 32 * pitch + ko0), f1 = *(const LAS i32x4*)(ap + rb * 32 * pitch + ko1);
          const i32x8 fa = __builtin_shufflevector(f0, f1, 0, 1, 2, 3, 4, 5, 6, 7);
#pragma unroll
          for (int i = 0; i < NBLK; ++i) acc[i][rb] = TR ? mfma_mx8(ring[d][i], fa, acc[i][rb]) : mfma_mx8(fa, ring[d][i], acc[i][rb]);
        }
      }
      if (p0 + d + D < NP) {
#pragma unroll
        for (int i = 0; i < NBLK; ++i) ring[d][i] = ld_pair((const i32x4*)(wp[i] + (2 * (p0 + d + D)) * 64), (const i32x4*)(wp[i] + (2 * (p0 + d + D) + 1) * 64));
      }
    }
  }
}
template <int NSLOT, int NACC, int NS, bool TR, int D, int MAP>
__device__ __forceinline__ void gemm_slots_f8(f32x16 (&acc)[NACC][2], const LAS uchar* A, const int pitch, const l64x2* const (&wp)[NSLOT], const int lane) {
  constexpr int NP = NS / 2;
  static_assert(NS % 2 == 0 && NP % D == 0, "NS even, NP % D");
  const int r = lane & 31, h = lane >> 5;
  const LAS uchar* ap = A + r * pitch;
  const int swz = (lane & 15) << 4, kb0 = 16 * h;
  i32x8 ring[D][NSLOT];
#pragma unroll
  for (int d = 0; d < D; ++d)
#pragma unroll
    for (int i = 0; i < NSLOT; ++i) ring[d][i] = ld_pair((const i32x4*)(wp[i] + (2 * d) * 64), (const i32x4*)(wp[i] + (2 * d + 1) * 64));
#pragma unroll 1
  for (int p0 = 0; p0 < NP; p0 += D) {
#pragma unroll
    for (int d = 0; d < D; ++d) {
      const int s = 2 * (p0 + d);
      const int ko0 = ((s * 32) + kb0) ^ swz, ko1 = (((s + 1) * 32) + kb0) ^ swz;
#pragma unroll
      for (int rb = 0; rb < 2; ++rb) {
        const i32x4 f0 = *(const LAS i32x4*)(ap + rb * 32 * pitch + ko0), f1 = *(const LAS i32x4*)(ap + rb * 32 * pitch + ko1);
        const i32x8 fa = __builtin_shufflevector(f0, f1, 0, 1, 2, 3, 4, 5, 6, 7);
#pragma unroll
        for (int i = 0; i < NSLOT; ++i) { constexpr int dummy = 0; (void)dummy; const int ai = (MAP >> (4 * i)) & 15;
          acc[ai][rb] = TR ? mfma_mx8(ring[d][i], fa, acc[ai][rb]) : mfma_mx8(fa, ring[d][i], acc[ai][rb]); }
      }
      if (p0 + d + D < NP) {
#pragma unroll
        for (int i = 0; i < NSLOT; ++i) ring[d][i] = ld_pair((const i32x4*)(wp[i] + (2 * (p0 + d + D)) * 64), (const i32x4*)(wp[i] + (2 * (p0 + d + D) + 1) * 64));
      }
    }
  }
}
template <int NBLK> __device__ __forceinline__ void acc_zero(f32x16 (&acc)[NBLK][2]) {
#pragma unroll
  for (int i = 0; i < NBLK; ++i) { acc[i][0] = f32x16{}; acc[i][1] = f32x16{}; }
}

__device__ __forceinline__ void store_img_qk(uchar* img, const f32x16& v, int rr, int f0, int NS, int hi) {
#pragma unroll
  for (int g = 0; g < 4; ++g) { u32x2 w; w.x = pk2(v[4 * g], v[4 * g + 1]); w.y = pk2(v[4 * g + 2], v[4 * g + 3]);
    *(u32x2*)(img + img_qk(rr, f0 + 8 * g + 4 * hi, NS)) = w; }
}
__device__ __forceinline__ void store_img_v(uchar* img, const f32x16& v, int kb, int d, int hi) {
#pragma unroll
  for (int g = 0; g < 4; ++g) { u32x2 w; w.x = pk2(v[4 * g], v[4 * g + 1]); w.y = pk2(v[4 * g + 2], v[4 * g + 3]);
    *(u32x2*)(img + img_v(32 * kb + 8 * g + 4 * hi, d)) = w; }
}
__device__ __forceinline__ void pack_frag(const float* __restrict__ W, int ldw, int k0, int n0, const float* __restrict__ rowscale, u32x4* __restrict__ dst, int lane) {
  const int r = lane & 31, h = lane >> 5;
  const float* p = W + (size_t)(k0 + 8 * h) * ldw + n0 + r;
  float v[8];
#pragma unroll
  for (int j = 0; j < 8; ++j) v[j] = p[(size_t)j * ldw];
  if (rowscale) {
#pragma unroll
    for (int j = 0; j < 8; ++j) v[j] *= rowscale[k0 + 8 * h + j];
  }
  u32x4 w; w.x = pk2(v[0], v[1]); w.y = pk2(v[2], v[3]); w.z = pk2(v[4], v[5]); w.w = pk2(v[6], v[7]);
  dst[lane] = w;
}
__device__ __forceinline__ void pack_frag8(const float* __restrict__ W, int ldw, int k0, int n0, float scale, u32x4* __restrict__ dst, int lane) {
  const int r = lane & 31, h = lane >> 5;
  const float* p = W + (size_t)(k0 + 16 * h) * ldw + n0 + r;
  float v[16];
#pragma unroll
  for (int j = 0; j < 16; ++j) v[j] = p[(size_t)j * ldw] * scale;
  u32x4 w; w.x = pk4_fp8(v[0], v[1], v[2], v[3]); w.y = pk4_fp8(v[4], v[5], v[6], v[7]); w.z = pk4_fp8(v[8], v[9], v[10], v[11]); w.w = pk4_fp8(v[12], v[13], v[14], v[15]);
  dst[lane] = w;
}
__device__ __forceinline__ void pack_frag8_lo(const float* __restrict__ W, int ldw, int k0, int n0, float scale, u32x4* __restrict__ dst, int lane) {
  const int r = lane & 31, h = lane >> 5;
  const float* p = W + (size_t)(k0 + 16 * h) * ldw + n0 + r;
  float v[16];
#pragma unroll
  for (int j = 0; j < 16; ++j) { const float x = p[(size_t)j * ldw] * scale; const int q = __builtin_amdgcn_cvt_pk_fp8_f32(x, 0.f, 0, false); v[j] = x - __builtin_amdgcn_cvt_f32_fp8(q, 0); }
  u32x4 w; w.x = pk4_fp8(v[0], v[1], v[2], v[3]); w.y = pk4_fp8(v[4], v[5], v[6], v[7]); w.z = pk4_fp8(v[8], v[9], v[10], v[11]); w.w = pk4_fp8(v[12], v[13], v[14], v[15]);
  dst[lane] = w;
}
__device__ __forceinline__ void phase0(const KP& P, LAS uchar* lds) {
  int lane_ = mk_lane(); asm volatile("" : "+v"(lane_)); const int lane = lane_ & 63, wave = P.wave, tid = wave * 64 + lane, bid = blockIdx.x, G = gridDim.x;
  uchar* ws = P.ws;
  if (bid == 0 && tid < 64) ((int*)(ws + WS_CNT))[tid] = 0;
  for (int idx = bid * NTHR + tid; idx < SEQ * 48; idx += G * NTHR) {
    int pos, i, half; float2* dst;
    if (idx < SEQ * 32) { pos = idx >> 5; i = idx & 31; half = 32; dst = (float2*)(ws + WS_TABA) + idx; }
    else { const int i2 = idx - SEQ * 32; pos = i2 >> 4; i = i2 & 15; half = 16; dst = (float2*)(ws + WS_TABB) + i2; }
    const float inv = 1.0f / powf(10000.0f, (float)(2 * i) / (float)(2 * half));
    const float ang = (float)pos * inv;
    *dst = make_float2(cosf(ang), sinf(ang));
  }
  if (bid < 192) {
    const float* c = P.in[1]; const float* w_ada = P.in[2]; const float* b_ada = P.in[3];
    LAS float* sl = (LAS float*)lds; LAS float* part = (LAS float*)(lds + 16384);
    for (int i = tid; i < NB * DM; i += NTHR) { const float v = c[i]; sl[i] = v / (1.f + __expf(-v)); }
    __syncthreads();
    const int n0 = bid * 32, rowl = lane >> 3, c4 = lane & 7;
    f32x4 a0 = {0, 0, 0, 0}, a1 = a0, a2 = a0, a3 = a0;
#pragma unroll 4
    for (int it = 0; it < 16; ++it) {
      const int k = wave * 128 + it * 8 + rowl;
      const f32x4 wv = *(const f32x4*)(w_ada + (size_t)k * (NMOD * DM) + n0 + 4 * c4);
      a0 += wv * sl[k]; a1 += wv * sl[DM + k]; a2 += wv * sl[2 * DM + k]; a3 += wv * sl[3 * DM + k];
    }
#pragma unroll
    for (int e = 0; e < 4; ++e) {
#pragma unroll
      for (int o = 8; o < 64; o <<= 1) { a0[e] += __shfl_xor(a0[e], o); a1[e] += __shfl_xor(a1[e], o); a2[e] += __shfl_xor(a2[e], o); a3[e] += __shfl_xor(a3[e], o); }
    }
    if (rowl == 0) {
#pragma unroll
      for (int e = 0; e < 4; ++e) { part[(wave * 4 + 0) * 32 + 4 * c4 + e] = a0[e]; part[(wave * 4 + 1) * 32 + 4 * c4 + e] = a1[e]; part[(wave * 4 + 2) * 32 + 4 * c4 + e] = a2[e]; part[(wave * 4 + 3) * 32 + 4 * c4 + e] = a3[e]; }
    }
    __syncthreads();
    if (tid < 128) { const int bb = tid >> 5, col = tid & 31; float s = b_ada[n0 + col];
#pragma unroll
      for (int w = 0; w < 8; ++w) s += part[(w * 4 + bb) * 32 + col];
      ((float*)(ws + WS_MOD))[bb * (NMOD * DM) + n0 + col] = s; }
  }
  const int gw = bid * NWAVE + wave, NGW = G * NWAVE;
  for (int f = gw; f < 43 * 32; f += NGW) { const int slot = f >> 5, s = f & 31;
    if (slot < 35) pack_frag8(P.in[5], INW, 32 * s, 32 * slot, WIN_SCALE, (u32x4*)(ws + WS_WIN) + (size_t)f * 64, lane);
    else { const int blk = slot < 39 ? 20 + (slot - 35) : 30 + (slot - 39); pack_frag8_lo(P.in[5], INW, 32 * s, 32 * blk, WIN_SCALE, (u32x4*)(ws + WS_WIN) + (size_t)f * 64, lane); } }
  for (int f = gw; f < 32 * 64; f += NGW) pack_frag(P.in[13], DM, 16 * (f & 63), 32 * (f >> 6), nullptr, (u32x4*)(ws + WS_WOUT) + (size_t)f * 64, lane);
  for (int f = gw; f < 24 * 12; f += NGW) pack_frag(P.in[7], 768, 16 * (f % 12), 32 * (f / 12), P.in[6], (u32x4*)(ws + WS_WUQ) + (size_t)f * 64, lane);
  for (int f = gw; f < 32 * 8; f += NGW) pack_frag(P.in[9], 1024, 16 * (f & 7), 32 * (f >> 3), P.in[8], (u32x4*)(ws + WS_WUKV) + (size_t)f * 64, lane);
  for (int f = gw; f < 2 * 64; f += NGW) {
    const int nb = f >> 6, s = f & 63, r = lane & 31, h = lane >> 5, col = 32 * nb + r;
    float v[8];
#pragma unroll
    for (int j = 0; j < 8; ++j) { const int k = 16 * s + 8 * h + j; v[j] = col < 4 ? P.in[15][k * 4 + col] : (col < 36 ? P.in[17][k * 32 + col - 4] : 0.f); }
    u32x4 w; w.x = pk2(v[0], v[1]); w.y = pk2(v[2], v[3]); w.z = pk2(v[4], v[5]); w.w = pk2(v[6], v[7]);
    ((u32x4*)(ws + WS_WR) + (size_t)f * 64)[lane] = w;
  }
}

__device__ __forceinline__ void rope64(const f32x16& xa, const f32x16& xb, f32x16& ya, f32x16& yb, const float2* __restrict__ trow, int hi, float scale) {
#pragma unroll
  for (int g = 0; g < 4; ++g) {
    const f32x4 t0 = *(const f32x4*)(trow + 8 * g + 4 * hi), t1 = *(const f32x4*)(trow + 8 * g + 4 * hi + 2);
    const float cc[4] = {t0[0], t0[2], t1[0], t1[2]}, sn[4] = {t0[1], t0[3], t1[1], t1[3]};
#pragma unroll
    for (int i = 0; i < 4; ++i) { const int reg = 4 * g + i; ya[reg] = (xa[reg] * cc[i] - xb[reg] * sn[i]) * scale; yb[reg] = (xb[reg] * cc[i] + xa[reg] * sn[i]) * scale; }
  }
}
__device__ __forceinline__ void rope32(const f32x16& x, f32x16& y, const float2* __restrict__ trow, int hi, float scale) {
#pragma unroll
  for (int g = 0; g < 2; ++g) {
    const f32x4 t0 = *(const f32x4*)(trow + 8 * g + 4 * hi), t1 = *(const f32x4*)(trow + 8 * g + 4 * hi + 2);
    const float cc[4] = {t0[0], t0[2], t1[0], t1[2]}, sn[4] = {t0[1], t0[3], t1[1], t1[3]};
#pragma unroll
    for (int i = 0; i < 4; ++i) { const int reg = 4 * g + i; y[reg] = (x[reg] * cc[i] - x[reg + 8] * sn[i]) * scale; y[reg + 8] = (x[reg + 8] * cc[i] + x[reg] * sn[i]) * scale; }
  }
}
__device__ __forceinline__ float write_c_tile(LAS uchar* base, int pitch, const f32x16& vin, int rr, int f0, int hi) {
  const f32x16 v = vin * WIN_DESCALE;
  float ss = 0.f;
#pragma unroll
  for (int g = 0; g < 4; ++g) { u32x2 w; w.x = pk2(v[4 * g], v[4 * g + 1]); w.y = pk2(v[4 * g + 2], v[4 * g + 3]);
    *(LAS u32x2*)(base + a_off(rr, 2 * (f0 + 8 * g + 4 * hi), pitch)) = w;
    ss += v[4 * g] * v[4 * g] + v[4 * g + 1] * v[4 * g + 1] + v[4 * g + 2] * v[4 * g + 2] + v[4 * g + 3] * v[4 * g + 3]; }
  return ss;
}
__device__ __forceinline__ void store_img8_qk(uchar* img, const f32x16& v, int rb, int r32, int blk, int hi) {
#pragma unroll
  for (int g = 0; g < 4; ++g) { const unsigned w = pk4_fp8(v[4 * g], v[4 * g + 1], v[4 * g + 2], v[4 * g + 3]);
    const int off = blk < 2 ? rb * 4096 + (g >> 1) * 1024 + (blk * 32 + r32) * 16 + 8 * (g & 1) + 4 * hi : rb * 4096 + 2048 + ((g >> 1) * 32 + r32) * 16 + 8 * (g & 1) + 4 * hi;
    *(unsigned*)(img + off) = w; }
}
__device__ __forceinline__ void store_img8_v(uchar* img, const f32x16& v, int rb, int db, int r32, int hi) {
#pragma unroll
  for (int g = 0; g < 4; ++g) *(unsigned*)(img + db * 2048 + rb * 1024 + (hi * 32 + r32) * 16 + 4 * g) = pk4_fp8(v[4 * g], v[4 * g + 1], v[4 * g + 2], v[4 * g + 3]);
}
__device__ __forceinline__ void lds_fadd(LAS float* p, float v) { __hip_atomic_fetch_add(p, v, __ATOMIC_RELAXED, __HIP_MEMORY_SCOPE_WORKGROUP); }

__device__ __forceinline__ void phase1_tile(const KP& P, LAS uchar* lds, const int tile) {
  int lane_ = mk_lane(); asm volatile("" : "+v"(lane_)); const int lane = lane_ & 63, wave = P.wave, tid = wave * 64 + lane, r32 = lane & 31, hi = lane >> 5;
  uchar* ws = P.ws;
  const int t0 = tile * 64, b = t0 / SEQ, pos0 = t0 % SEQ, tb = pos0 >> 6;
  const float* __restrict__ x = P.in[0]; const float* __restrict__ mod = (const float*)(ws + WS_MOD) + b * (NMOD * DM); const float* __restrict__ g1 = P.in[4];
  LAS float* ssq = (LAS float*)(lds + LDS_MISC + 64);
  LAS uchar* krt = lds + LDS_MISC + 1024;
  const float2* tabA = (const float2*)(ws + WS_TABA); const float2* tabB = (const float2*)(ws + WS_TABB);
  if (tid < 128) ssq[tid] = 0.f;
  {
    f32x4 av[4], sv[4];
#pragma unroll
    for (int i = 0; i < 4; ++i) { const int k = 4 * (lane + 64 * i); const f32x4 g = *(const f32x4*)(g1 + k), sc = *(const f32x4*)(mod + DM + k); av[i] = g * (sc + 1.0f); sv[i] = *(const f32x4*)(mod + k); }
#pragma unroll
    for (int hf = 0; hf < 2; ++hf) {
      f32x4 xv[4][4];
#pragma unroll
      for (int rr = 0; rr < 4; ++rr)
#pragma unroll
        for (int i = 0; i < 4; ++i) xv[rr][i] = __builtin_nontemporal_load((const f32x4*)(x + (size_t)(t0 + wave * 8 + hf * 4 + rr) * DM + 4 * (lane + 64 * i)));
#pragma unroll
      for (int rr = 0; rr < 4; ++rr) {
        const int row = wave * 8 + hf * 4 + rr; float ss = 0.f;
#pragma unroll
        for (int i = 0; i < 4; ++i) { ss += xv[rr][i][0] * xv[rr][i][0] + xv[rr][i][1] * xv[rr][i][1] + xv[rr][i][2] * xv[rr][i][2] + xv[rr][i][3] * xv[rr][i][3];
          u32x2 xb; xb.x = pk2(xv[rr][i][0], xv[rr][i][1]); xb.y = pk2(xv[rr][i][2], xv[rr][i][3]);
          *(u32x2*)(ws + WS_XB + ((size_t)(t0 + row) * DM + 4 * (lane + 64 * i)) * 2) = xb; }
        ss = wave_sum(ss); const float rs = rsqrtf(ss * (1.0f / DM) + EPS);
#pragma unroll
        for (int i = 0; i < 4; ++i) { const f32x4 v = xv[rr][i] * rs * av[i] + sv[i];
          *(LAS unsigned*)(lds + a_off(row, 4 * (lane + 64 * i), 1024)) = pk4_fp8(v[0], v[1], v[2], v[3]); }
      }
    }
  }
  __syncthreads();
  const l64x2* WIN = (const l64x2*)(ws + WS_WIN);
#define WSLOT(slot) (WIN + (size_t)((slot) * 32) * 64 + lane)
  f32x16 acc[4][2]; acc_zero<4>(acc);
  f32x16 acc2[1][2]; acc_zero<1>(acc2);
  if (wave < 4) {
    { const l64x2* wp[4] = {WSLOT(4 * wave), WSLOT(4 * wave + 1), WSLOT(4 * wave + 2), WSLOT(4 * wave + 3)}; gemm_slots_f8<4, 4, 32, true, 1, 0x3210>(acc, lds, 1024, wp, lane); }
    if (wave < 3) { const l64x2* wp[1] = {WSLOT(wave == 0 ? 34 : 27 + wave)}; gemm_slots_f8<1, 1, 32, true, 2, 0x0>(acc2, lds, 1024, wp, lane); }
  } else if (wave == 4) {
    { const l64x2* wp[4] = {WSLOT(16), WSLOT(17), WSLOT(18), WSLOT(19)}; gemm_slots_f8<4, 4, 32, true, 1, 0x3210>(acc, lds, 1024, wp, lane); }
    { const l64x2* wp[2] = {WSLOT(33), WSLOT(42)}; gemm_slots_f8<2, 1, 32, true, 1, 0x00>(acc2, lds, 1024, wp, lane); }
  } else if (wave == 7) {
    { const l64x2* wp[4] = {WSLOT(30), WSLOT(39), WSLOT(31), WSLOT(40)}; gemm_slots_f8<4, 4, 32, true, 1, 0x1100>(acc, lds, 1024, wp, lane); }
    { const l64x2* wp[2] = {WSLOT(32), WSLOT(41)}; gemm_slots_f8<2, 4, 32, true, 1, 0x22>(acc, lds, 1024, wp, lane); }
  } else {
    const int kv = wave - 5;
    { const l64x2* wp[4] = {WSLOT(20 + 2 * kv), WSLOT(35 + 2 * kv), WSLOT(21 + 2 * kv), WSLOT(36 + 2 * kv)}; gemm_slots_f8<4, 4, 32, false, 1, 0x1100>(acc, lds, 1024, wp, lane); }
    { const l64x2* wp[2] = {WSLOT(24 + 2 * kv), WSLOT(25 + 2 * kv)}; gemm_slots_f8<2, 4, 32, true, 1, 0x32>(acc, lds, 1024, wp, lane); }
  }
#undef WSLOT
  int tid2_ = mk_lane(); asm volatile("" : "+v"(tid2_)); const int lane2 = tid2_ & 63;
#define lane lane2
  const int r32e = lane2 & 31, hie = lane2 >> 5;
#define r32 r32e
#define hi hie
  if (wave < 4) {
#pragma unroll
    for (int p = 0; p < 2; ++p) { uchar* img = ws + WS_QA + ((size_t)(b * 8 + 2 * wave + p) * 64 + tb) * 8192;
#pragma unroll
      for (int rb = 0; rb < 2; ++rb) { const int rr = 32 * rb + r32; f32x16 ya, yb; rope64(acc[2 * p][rb], acc[2 * p + 1][rb], ya, yb, tabA + (size_t)(pos0 + rr) * 32, hi, QSCALE_A * WIN_DESCALE);
        store_img_qk(img, ya, rr, 0, 4, hi); store_img_qk(img, yb, rr, 32, 4, hi); } }
    if (wave == 0) {
#pragma unroll
      for (int rb = 0; rb < 2; ++rb) { const int rr = 32 * rb + r32; f32x16 y; rope32(acc2[0][rb], y, tabB + (size_t)(pos0 + rr) * 16, hi, WIN_DESCALE);
#pragma unroll
        for (int g = 0; g < 4; ++g) { u32x2 w; w.x = pk2(y[4 * g], y[4 * g + 1]); w.y = pk2(y[4 * g + 2], y[4 * g + 3]); *(LAS u32x2*)(krt + rr * 64 + (8 * g + 4 * hi) * 2) = w; } }
    }
  } else if (wave == 4) {
#pragma unroll
    for (int p = 0; p < 2; ++p) { uchar* img = ws + WS_KVA + ((size_t)(b * 2 + p) * 64 + tb) * 16384;
#pragma unroll
      for (int rb = 0; rb < 2; ++rb) { const int rr = 32 * rb + r32; f32x16 ya, yb; rope64(acc[2 * p][rb], acc[2 * p + 1][rb], ya, yb, tabA + (size_t)(pos0 + rr) * 32, hi, WIN_DESCALE);
        store_img_qk(img, ya, rr, 0, 4, hi); store_img_qk(img, yb, rr, 32, 4, hi); } }
  } else if (wave == 5 || wave == 6) {
    uchar* img = ws + WS_KVA + ((size_t)(b * 2 + (wave - 5)) * 64 + tb) * 16384 + 8192;
#pragma unroll
    for (int i = 0; i < 2; ++i)
#pragma unroll
      for (int rb = 0; rb < 2; ++rb) { const f32x16 y = acc[i][rb] * WIN_DESCALE; store_img_v(img, y, rb, 32 * i + r32, hi); }
  }
  __syncthreads();
  if (wave != 0 && wave != 3) {
#pragma unroll
    for (int rb = 0; rb < 2; ++rb) { const int rr = 32 * rb + r32; float sq = 0.f, skv = 0.f;
      if (wave == 5 || wave == 6) { sq += write_c_tile(lds, 512, acc[2][rb], rr, 64 * (wave - 5), hi); sq += write_c_tile(lds, 512, acc[3][rb], rr, 64 * (wave - 5) + 32, hi); }
      else if (wave == 1 || wave == 2) sq += write_c_tile(lds, 512, acc2[0][rb], rr, 96 + 32 * wave, hi);
      else if (wave == 7) { skv += write_c_tile(lds + 32768, 256, acc[0][rb], rr, 0, hi); skv += write_c_tile(lds + 32768, 256, acc[1][rb], rr, 32, hi); skv += write_c_tile(lds + 32768, 256, acc[2][rb], rr, 64, hi); }
      else skv += write_c_tile(lds + 32768, 256, acc2[0][rb], rr, 96, hi);
      if (wave == 4 || wave == 7) lds_fadd(&ssq[64 + rr], skv); else lds_fadd(&ssq[rr], sq); }
  }
  __syncthreads();
  const int head = wave;
  uchar* imgQ = ws + WS_QB + ((size_t)(b * 8 + head) * 64 + tb) * 8192;
  uchar* imgKV = ws + WS_KVB + ((size_t)(b * 8 + head) * 64 + tb) * 12288;
  {
    f32x16 aq[3][2]; acc_zero<3>(aq);
    const bf16x8* wp[3];
#pragma unroll
    for (int i = 0; i < 3; ++i) wp[i] = (const bf16x8*)(ws + WS_WUQ) + (size_t)((3 * head + i) * 12) * 64 + lane;
    gemm_tile<3, 12, true>(aq, lds, 512, wp, lane);
#pragma unroll
    for (int rb = 0; rb < 2; ++rb) { const int rr = 32 * rb + r32; const float sc = rsqrtf(ssq[rr] * (1.0f / 192.0f) + EPS) * (8.0f * QSCALE_B);
      f32x16 y0 = aq[0][rb] * sc, y1 = aq[1][rb] * sc, y2; rope32(aq[2][rb], y2, tabB + (size_t)(pos0 + rr) * 16, hi, sc);
      store_img8_qk(imgQ, y0, rb, r32, 0, hi); store_img8_qk(imgQ, y1, rb, r32, 1, hi); store_img8_qk(imgQ, y2, rb, r32, 2, hi);
      *(u32x4*)(imgQ + rb * 4096 + 3072 + lane * 16) = u32x4{0u, 0u, 0u, 0u}; }
  }
  {
    f32x16 ak[2][2]; acc_zero<2>(ak);
    const bf16x8* wp[2];
#pragma unroll
    for (int i = 0; i < 2; ++i) wp[i] = (const bf16x8*)(ws + WS_WUKV) + (size_t)((4 * head + i) * 8) * 64 + lane;
    gemm_tile<2, 8, true>(ak, lds + 32768, 256, wp, lane);
#pragma unroll
    for (int rb = 0; rb < 2; ++rb) { const int rr = 32 * rb + r32; const float sc = rsqrtf(ssq[64 + rr] * (1.0f / 128.0f) + EPS);
      f32x16 y0 = ak[0][rb] * sc, y1 = ak[1][rb] * sc; store_img8_qk(imgKV, y0, rb, r32, 0, hi); store_img8_qk(imgKV, y1, rb, r32, 1, hi); }
#pragma unroll
    for (int rb = 0; rb < 2; ++rb) {
      const u32x4 c0 = *(const LAS u32x4*)(krt + (32 * rb + r32) * 64 + hi * 32), c1 = *(const LAS u32x4*)(krt + (32 * rb + r32) * 64 + hi * 32 + 16);
      u32x4 w;
      w.x = pk4_fp8(__uint_as_float(c0.x << 16), __uint_as_float(c0.x & 0xffff0000u), __uint_as_float(c0.y << 16), __uint_as_float(c0.y & 0xffff0000u));
      w.y = pk4_fp8(__uint_as_float(c0.z << 16), __uint_as_float(c0.z & 0xffff0000u), __uint_as_float(c0.w << 16), __uint_as_float(c0.w & 0xffff0000u));
      w.z = pk4_fp8(__uint_as_float(c1.x << 16), __uint_as_float(c1.x & 0xffff0000u), __uint_as_float(c1.y << 16), __uint_as_float(c1.y & 0xffff0000u));
      w.w = pk4_fp8(__uint_as_float(c1.z << 16), __uint_as_float(c1.z & 0xffff0000u), __uint_as_float(c1.w << 16), __uint_as_float(c1.w & 0xffff0000u));
      *(u32x4*)(imgKV + rb * 4096 + 2048 + lane * 16) = w;
      *(u32x4*)(imgKV + rb * 4096 + 3072 + lane * 16) = u32x4{hi ? 0u : 0x00003838u, 0u, 0u, 0u}; }
  }
  {
    f32x16 avv[2][2]; acc_zero<2>(avv);
    const bf16x8* wp[2];
#pragma unroll
    for (int i = 0; i < 2; ++i) wp[i] = (const bf16x8*)(ws + WS_WUKV) + (size_t)((4 * head + 2 + i) * 8) * 64 + lane;
    gemm_tile<2, 8, false>(avv, lds + 32768, 256, wp, lane);
#pragma unroll
    for (int rb = 0; rb < 2; ++rb) { f32x16 sc;
#pragma unroll
      for (int reg = 0; reg < 16; ++reg) sc[reg] = rsqrtf(ssq[64 + 32 * rb + crow(reg, hi)] * (1.0f / 128.0f) + EPS);
#pragma unroll
      for (int i = 0; i < 2; ++i) { f32x16 y = avv[i][rb] * sc; store_img8_v(imgKV + 8192, y, rb, i, r32, hi); } }
  }
  __syncthreads();
#undef lane
#undef r32
#undef hi
}
__device__ __forceinline__ float tile_max(const f32x16& p0, const f32x16& p1) {
  float t = __builtin_amdgcn_fmed3f(p0[0], p1[0], 3.0e38f);
  asm("v_max3_f32 %0, %0, %1, %2\n\tv_max3_f32 %0, %0, %3, %4\n\tv_max3_f32 %0, %0, %5, %6\n\tv_max3_f32 %0, %0, %7, %8\n\t"
      "v_max3_f32 %0, %0, %9, %10\n\tv_max3_f32 %0, %0, %11, %12\n\tv_max3_f32 %0, %0, %13, %14\n\tv_max3_f32 %0, %0, %15, %16"
      : "+v"(t) : "v"(p0[1]), "v"(p1[1]), "v"(p0[2]), "v"(p1[2]), "v"(p0[3]), "v"(p1[3]), "v"(p0[4]), "v"(p1[4]), "v"(p0[5]), "v"(p1[5]), "v"(p0[6]), "v"(p1[6]), "v"(p0[7]), "v"(p1[7]), "v"(p0[8]), "v"(p1[8]));
  asm("v_max3_f32 %0, %0, %1, %2\n\tv_max3_f32 %0, %0, %3, %4\n\tv_max3_f32 %0, %0, %5, %6\n\tv_max3_f32 %0, %0, %7, %8\n\t"
      "v_max3_f32 %0, %0, %9, %10\n\tv_max3_f32 %0, %0, %11, %12\n\tv_max3_f32 %0, %0, %13, %14"
      : "+v"(t) : "v"(p0[9]), "v"(p1[9]), "v"(p0[10]), "v"(p1[10]), "v"(p0[11]), "v"(p1[11]), "v"(p0[12]), "v"(p1[12]), "v"(p0[13]), "v"(p1[13]), "v"(p0[14]), "v"(p1[14]), "v"(p0[15]), "v"(p1[15]));
  return t;
}
constexpr float PXG = 128.0f / 65535.0f;
__device__ __forceinline__ void softmax_tile(f32x16& p0, f32x16& p1, f32x16& negm, float& m, float& l, f32x16& o0, f32x16& o1, bf16x8 (&pb)[2][2]) {
  const float tmax = half_swap_max(tile_max(p0, p1));
  if (__any(tmax > PXG * (127.0f + THR2))) {
    const float dm = fmaxf(tmax * (1.0f / PXG) - 127.0f, 0.f), alpha = __builtin_amdgcn_exp2f(-dm), dp = dm * PXG;
    m += dm; l *= alpha;
#pragma unroll
    for (int r = 0; r < 16; ++r) { o0[r] *= alpha; o1[r] *= alpha; p0[r] -= dp; p1[r] -= dp; negm[r] = PXG * (127.0f - m); }
  }
  typedef __bf16 bf2 __attribute__((ext_vector_type(2)));
  const bf2 one2 = __builtin_bit_cast(bf2, 0x3f803f80u);
  float s = 0.f;
#pragma unroll
  for (int ks = 0; ks < 2; ++ks) {
    unsigned a[4], c[4];
#pragma unroll
    for (int i = 0; i < 4; ++i) { a[i] = mk_pknorm(p0[8 * ks + 2 * i], p0[8 * ks + 2 * i + 1]); c[i] = mk_pknorm(p1[8 * ks + 2 * i], p1[8 * ks + 2 * i + 1]);
      s = __builtin_amdgcn_fdot2_f32_bf16(__builtin_bit_cast(bf2, a[i]), one2, s, false); s = __builtin_amdgcn_fdot2_f32_bf16(__builtin_bit_cast(bf2, c[i]), one2, s, false); }
    const u32x4 w0 = {a[0], a[1], a[2], a[3]}, w1 = {c[0], c[1], c[2], c[3]};
    pb[0][ks] = __builtin_bit_cast(bf16x8, w0); pb[1][ks] = __builtin_bit_cast(bf16x8, w1);
  }
  l += s;
}
__device__ __forceinline__ void pv_tile(const LAS uchar* vimg, const bf16x8 (&pb)[2][2], f32x16& o0, f32x16& o1, int lane) {
#pragma unroll
  for (int kb = 0; kb < 2; ++kb)
#pragma unroll
    for (int ks = 0; ks < 2; ++ks) {
      const bf16x8 v0 = *(const LAS bf16x8*)(vimg + ((((kb * 2 + 0) * 2 + ks) * 64) + lane) * 16);
      const bf16x8 v1 = *(const LAS bf16x8*)(vimg + ((((kb * 2 + 1) * 2 + ks) * 64) + lane) * 16);
      o0 = mfma(v0, pb[kb][ks], o0); o1 = mfma(v1, pb[kb][ks], o1);
    }
}
__device__ __forceinline__ void store_o(bf16_t* __restrict__ orow, f32x16& o0, f32x16& o1, float l, int hi) {
  const float inv = 1.0f / half_swap_sum(l);
#pragma unroll
  for (int g = 0; g < 4; ++g) {
    u32x2 w; w.x = pk2(o0[4 * g] * inv, o0[4 * g + 1] * inv); w.y = pk2(o0[4 * g + 2] * inv, o0[4 * g + 3] * inv); *(u32x2*)(orow + 8 * g + 4 * hi) = w;
    u32x2 z; z.x = pk2(o1[4 * g] * inv, o1[4 * g + 1] * inv); z.y = pk2(o1[4 * g + 2] * inv, o1[4 * g + 3] * inv); *(u32x2*)(orow + 32 + 8 * g + 4 * hi) = z;
  }
}

__device__ __forceinline__ void store_o_l(bf16_t* __restrict__ orow, f32x16& o0, f32x16& o1, float ltot, int hi) {
  const float inv = 1.0f / ltot;
#pragma unroll
  for (int g = 0; g < 4; ++g) {
    u32x2 w; w.x = pk2(o0[4 * g] * inv, o0[4 * g + 1] * inv); w.y = pk2(o0[4 * g + 2] * inv, o0[4 * g + 3] * inv); *(u32x2*)(orow + 8 * g + 4 * hi) = w;
    u32x2 z; z.x = pk2(o1[4 * g] * inv, o1[4 * g + 1] * inv); z.y = pk2(o1[4 * g + 2] * inv, o1[4 * g + 3] * inv); *(u32x2*)(orow + 32 + 8 * g + 4 * hi) = z;
  }
}
constexpr int SWA_LDS = 49152;
__device__ __forceinline__ void swa_unit(const KP& P, LAS uchar* lds_all, int u, bool prefetched) {
  LAS uchar* lds = lds_all + SWA_LDS;
  int lane_ = mk_lane(); asm volatile("" : "+v"(lane_)); const int lane = lane_ & 63, wave = P.wave, tid = wave * 64 + lane, r32 = lane & 31, hi = lane >> 5;
  uchar* ws = P.ws;
  const int n = u & 31, kvh = (u >> 5) & 1, b = u >> 6;
  const uchar* kvimg = ws + WS_KVA + (size_t)(b * 2 + kvh) * 64 * 16384;
  if (!prefetched) {
#pragma unroll 1
    for (int jt = 0; jt < 6; ++jt) { const int gt = 2 * n - 2 + jt; if (gt < 0 || gt >= 64) continue;
      const u32x4* src = (const u32x4*)(kvimg + (size_t)gt * 16384); LAS u32x4* dst = (LAS u32x4*)(lds + jt * 16384);
      const u32x4 v0 = src[tid], v1 = src[tid + 512]; dst[tid] = v0; dst[tid + 512] = v1; }
  }
  __syncthreads();
  const int rbq = wave & 3, jlo = rbq >> 1;
  bf16_t* O = (bf16_t*)(ws + WS_O);
#pragma unroll 1
  for (int hh = 0; hh < 2; ++hh) {
    const int head = kvh * 4 + 2 * (wave >> 2) + hh;
    const uchar* qimg = ws + WS_QA + ((size_t)(b * 8 + head) * 64 + 2 * n + (rbq >> 1)) * 8192;
    bf16x8 qf[4];
#pragma unroll
    for (int s = 0; s < 4; ++s) qf[s] = *(const bf16x8*)(qimg + ((((rbq & 1) * 4 + s) * 64) + lane) * 16);
    const float sink2 = P.in[10][head] * LOG2E;
    float m = sink2, l = hi ? 0.f : 1.f; f32x16 negm, o0 = {}, o1 = {};
#pragma unroll
    for (int r = 0; r < 16; ++r) negm[r] = PXG * (127.0f - sink2);
#pragma unroll 1
    for (int jt = jlo; jt < jlo + 5; ++jt) { const int gt = 2 * n - 2 + jt; if (gt < 0 || gt >= 64) continue;
      const LAS uchar* kimg = lds + jt * 16384;
      f32x16 p0 = negm, p1 = negm;
#pragma unroll
      for (int s = 0; s < 4; ++s) { const bf16x8 k0 = *(const LAS bf16x8*)(kimg + (((0 * 4 + s) * 64) + lane) * 16), k1 = *(const LAS bf16x8*)(kimg + (((1 * 4 + s) * 64) + lane) * 16);
        p0 = mfma(k0, qf[s], p0); p1 = mfma(k1, qf[s], p1); }
      if (jt == jlo || jt == jlo + 4) { const int base = 64 * jt - 32 * rbq - r32;
#pragma unroll
        for (int r = 0; r < 16; ++r) { const int d0 = base + crow(r, hi);
          p0[r] = ((unsigned)d0 <= 256u) ? p0[r] : -1e30f; p1[r] = ((unsigned)(d0 + 32) <= 256u) ? p1[r] : -1e30f; } }
      bf16x8 pb[2][2];
      softmax_tile(p0, p1, negm, m, l, o0, o1, pb);
      pv_tile(kimg + 8192, pb, o0, o1, lane);
    }
    store_o(O + (size_t)(b * SEQ + n * 128 + 32 * rbq + r32) * DM + head * 64, o0, o1, l, hi);
  }
  __syncthreads();
}

#define MK_LDS_RD(dst, vaddr, imm) asm volatile("ds_read_b128 %0, %1 offset:%2" : "=v"(dst) : "v"(vaddr), "i"(imm))
template <int N> __device__ __forceinline__ void lgkm_wait() { asm volatile("s_waitcnt lgkmcnt(%0)" :: "i"(N) : "memory"); __builtin_amdgcn_sched_barrier(0); }
__device__ __forceinline__ void pv_regs(const bf16x8 (&vf)[8], const bf16x8 (&pb)[2][2], f32x16& o0, f32x16& o1) {
#pragma unroll
  for (int kb = 0; kb < 2; ++kb)
#pragma unroll
    for (int ks = 0; ks < 2; ++ks) { o0 = mfma(vf[(kb * 2 + 0) * 2 + ks], pb[kb][ks], o0); o1 = mfma(vf[(kb * 2 + 1) * 2 + ks], pb[kb][ks], o1); }
}
__device__ __forceinline__ void mla_dma_step(const uchar* kvimg, LAS uchar* lds, int t, int wave, int lane) {
  const uchar* src = kvimg + (size_t)t * 24576 + wave * 3072 + lane * 16;
  LAS uchar* dst = lds + (t & 1) * 24576 + wave * 3072;
#pragma unroll
  for (int i = 0; i < 3; ++i) __builtin_amdgcn_global_load_lds((const unsigned*)(src + i * 1024), (LAS unsigned*)(dst + i * 1024), 16, 0, 0);
}
template <bool FIRST_POSSIBLE>
__device__ __forceinline__ float softmax_tile8(f32x16& p0, f32x16& p1, float& pad, int& qpad, f32x16& lacc, f32x16& o0, f32x16& o1, bool first, int hi, i32x4& pb0, i32x4& pb1) {
  float applied = 0.f;
  const float tmax_s = half_swap_max(tile_max(p0, p1));
  const bool fst = FIRST_POSSIBLE && first;
  if (fst || __any(tmax_s > 120.5f / 256.0f)) {
    const float tmax = tmax_s * 256.0f;
    const float want = fst ? tmax - 96.5f : fmaxf(tmax - 96.5f, 0.f);
    const float nt = pad - want;
    const int wa = __builtin_amdgcn_cvt_pk_fp8_f32(nt, 0.f, 0, false); const float fa = __builtin_amdgcn_cvt_f32_fp8(wa, 0);
    const int wb = __builtin_amdgcn_cvt_pk_fp8_f32(nt - fa, 0.f, 0, false); const float fb = __builtin_amdgcn_cvt_f32_fp8(wb, 0);
    const float pnew = fa + fb, dt = pad - pnew, dts = dt * (1.0f / 256.0f);
    const float alpha = fst ? 1.0f : __builtin_amdgcn_exp2f(-0.125f * dt);
    pad = pnew; applied = dts; qpad = hi ? 0 : ((wa & 0xff) | ((wb & 0xff) << 8));
#pragma unroll
    for (int r = 0; r < 16; ++r) { o0[r] *= alpha; o1[r] *= alpha; lacc[r] *= alpha; p0[r] -= dts; p1[r] -= dts; }
  }
#define MK_P8(P, R) __builtin_amdgcn_perm(mk_pknorm(P[(R) + 2], P[(R) + 3]), mk_pknorm(P[R], P[(R) + 1]), 0x07050301u)
  pb0.x = (int)MK_P8(p0, 0); pb0.y = (int)MK_P8(p0, 4); pb0.z = (int)MK_P8(p0, 8); pb0.w = (int)MK_P8(p0, 12);
  pb1.x = (int)MK_P8(p1, 0); pb1.y = (int)MK_P8(p1, 4); pb1.z = (int)MK_P8(p1, 8); pb1.w = (int)MK_P8(p1, 12);
#undef MK_P8
  return applied;
}
constexpr int N_PACK_JOBS = 3 * 8192;
struct PackJob { const float* p; int ldw; u32x4* dst; float scale; };
__device__ __forceinline__ PackJob pack_job(const KP& P, int f, int lane) {
  const int which = f >> 13, ff = f & 8191, r = lane & 31, h = lane >> 5, e = ff >> 8; PackJob j;
  if (which < 2) { const int nb = (ff >> 5) & 7, s = ff & 31; j.ldw = 256; j.scale = WGU_SCALE;
    j.p = P.in[19 + which] + (size_t)e * DM * 256 + (size_t)(32 * s + 16 * h) * 256 + 32 * nb + r; j.dst = (u32x4*)(P.ws + (which ? WS_WU : WS_WG)) + (size_t)ff * 64 + lane; }
  else { const int nb = (ff >> 3) & 31, s = ff & 7; j.ldw = DM; j.scale = WD_SCALE;
    j.p = P.in[21] + (size_t)e * 256 * DM + (size_t)(32 * s + 16 * h) * DM + 32 * nb + r; j.dst = (u32x4*)(P.ws + WS_WD) + (size_t)ff * 64 + lane; }
  return j;
}
__device__ __forceinline__ u32x4 pack_cvt(const float (&v)[16], float sc) {
  u32x4 w; w.x = pk4_fp8(v[0] * sc, v[1] * sc, v[2] * sc, v[3] * sc); w.y = pk4_fp8(v[4] * sc, v[5] * sc, v[6] * sc, v[7] * sc);
  w.z = pk4_fp8(v[8] * sc, v[9] * sc, v[10] * sc, v[11] * sc); w.w = pk4_fp8(v[12] * sc, v[13] * sc, v[14] * sc, v[15] * sc); return w;
}
__device__ __forceinline__ void mla_unit(const KP& P, LAS uchar* lds, int b, int head, int qblk, int& pk_k, int swa_u) {
  int lane_ = mk_lane(); asm volatile("" : "+v"(lane_)); const int lane = lane_ & 63, wave = P.wave, r32 = lane & 31, hi = lane >> 5;
  uchar* ws = P.ws;
  const uchar* kvimg = ws + WS_KVB + (size_t)(b * 8 + head) * 64 * 12288;
  const uchar* qimg = ws + WS_QB + ((size_t)(b * 8 + head) * 64 + qblk * 4 + (wave >> 1)) * 8192 + (wave & 1) * 4096 + lane * 16;
  const int gw = blockIdx.x * NWAVE + wave, NGW = gridDim.x * NWAVE;
  const i32x4 q00 = *(const i32x4*)(qimg), q01 = *(const i32x4*)(qimg + 1024), q10 = *(const i32x4*)(qimg + 2048);
  float pad = 56.5f; int qpad = hi ? 0 : 0x3066;
  f32x16 o0 = {}, o1 = {}, lacc = {};
  i32x8 ones8 = {0x38383838, 0x38383838, 0x38383838, 0x38383838, 0x38383838, 0x38383838, 0x38383838, 0x38383838};
  asm volatile("" : "+v"(ones8));
  mla_dma_step(kvimg, lds, 0, wave, lane);
#pragma unroll 1
  for (int t = 0; t < 32; ++t) {
    asm volatile("s_waitcnt vmcnt(0)" ::: "memory");
    __syncthreads();
    if (t + 1 < 32 && !(P.variant & 4)) mla_dma_step(kvimg, lds, t + 1, wave, lane);
    if (P.variant & 8) continue;
    u32x4 bandv = {}; int band_off = -1;
    if (swa_u >= 0 && t >= 20) { const int c = (wave * 64 + lane) + 512 * (t - 20), jt = c >> 10, gt = 2 * (swa_u & 31) - 2 + jt;
      if (gt >= 0 && gt < 64) { band_off = c * 16; bandv = *(const u32x4*)(ws + WS_KVA + ((size_t)((swa_u >> 6) * 2 + ((swa_u >> 5) & 1)) * 64 + gt) * 16384 + (c & 1023) * 16); } }
    const int pf = gw + pk_k * NGW; const bool do_pack = pf < N_PACK_JOBS;
    float pv[16]; u32x4* pdst = nullptr; float psc = 0.f;
    if (do_pack) { const PackJob j = pack_job(P, pf, lane); pdst = j.dst; psc = j.scale;
#pragma unroll
      for (int q = 0; q < 16; ++q) pv[q] = __builtin_nontemporal_load(j.p + (size_t)q * j.ldw); }
    f32x16 a0, a1, b0, b1; i32x4 pb0, pb1;
    { const unsigned va = (unsigned)(unsigned long)(lds + (t & 1) * 24576) + lane * 16;
#define MK_KOFF(j) (((j) >> 2) * 12288 + (((j) >> 1) & 1) * 4096 + ((j) & 1) * 2048)
      i32x4 kf[4][2];
#define MK_KRD(j) { MK_LDS_RD(kf[(j) & 3][0], va, MK_KOFF(j)); MK_LDS_RD(kf[(j) & 3][1], va, MK_KOFF(j) + 1024); }
      MK_KRD(0) MK_KRD(1) MK_KRD(2) MK_KRD(3)
      const i32x4 q11 = {qpad, 0, 0, 0};
#define MK_QK_STEP(j, ACC, NW) { lgkm_wait<NW>(); ACC = ((j) & 1) ? mfma_mx_q(kf[(j) & 3][0], kf[(j) & 3][1], q10, q11, ACC) : mfma_mx_q(kf[(j) & 3][0], kf[(j) & 3][1], q00, q01, f32x16{}); if ((j) + 4 < 8) MK_KRD(((j) + 4) & 7) }
      MK_QK_STEP(0, a0, 6) MK_QK_STEP(1, a0, 6) MK_QK_STEP(2, a1, 6) MK_QK_STEP(3, a1, 6) MK_QK_STEP(4, b0, 6) MK_QK_STEP(5, b0, 4) MK_QK_STEP(6, b1, 2) MK_QK_STEP(7, b1, 0)
#undef MK_QK_STEP
#undef MK_KRD
#undef MK_KOFF
      i32x4 vf[4];
#define MK_VRD(tile) { MK_LDS_RD(vf[0], va, (tile) * 12288 + 8192); MK_LDS_RD(vf[1], va, (tile) * 12288 + 8192 + 1024); MK_LDS_RD(vf[2], va, (tile) * 12288 + 8192 + 2048); MK_LDS_RD(vf[3], va, (tile) * 12288 + 8192 + 3072); }
      MK_VRD(0)
      const float dA = softmax_tile8<true>(a0, a1, pad, qpad, lacc, o0, o1, t == 0, hi, pb0, pb1);
      lacc = mfma_mx8(ones8, __builtin_shufflevector(pb0, pb1, 0, 1, 2, 3, 4, 5, 6, 7), lacc);
      lgkm_wait<0>();
      o0 = mfma_mx(vf[0], vf[1], pb0, pb1, o0); o1 = mfma_mx(vf[2], vf[3], pb0, pb1, o1);
      MK_VRD(1)
#undef MK_VRD
      if (__any(dA != 0.f)) {
#pragma unroll
        for (int r = 0; r < 16; ++r) { b0[r] -= dA; b1[r] -= dA; }
      }
      (void)softmax_tile8<false>(b0, b1, pad, qpad, lacc, o0, o1, false, hi, pb0, pb1);
      lacc = mfma_mx8(ones8, __builtin_shufflevector(pb0, pb1, 0, 1, 2, 3, 4, 5, 6, 7), lacc);
      lgkm_wait<0>();
      o0 = mfma_mx(vf[0], vf[1], pb0, pb1, o0); o1 = mfma_mx(vf[2], vf[3], pb0, pb1, o1);
    }
    if (do_pack) { *pdst = pack_cvt(pv, psc); ++pk_k; }
    if (band_off >= 0) *(LAS u32x4*)(lds + SWA_LDS + band_off) = bandv;
  }
  if (!(P.variant & 12)) store_o_l((bf16_t*)(ws + WS_O) + (size_t)(b * SEQ + qblk * 256 + 32 * wave + r32) * DM + 512 + head * 64, o0, o1, lacc[0], hi);
  __syncthreads();
}
__device__ __forceinline__ void phase2(const KP& P, LAS uchar* lds) {
  const int bid = blockIdx.x;
  int pk_k = 0;
  const bool pref = gridDim.x == 256 && !(P.variant & 3);
  if (!(P.variant & 2)) for (int i = bid; i < 512; i += gridDim.x) {
    const int rr = i >> 8, ii = i & 255, xcd = ii & 7, local = ii >> 3, pair = xcd * 4 + rr * 2 + (local >> 4), qblk = local & 15;
    mla_unit(P, lds, pair >> 3, pair & 7, qblk, pk_k, (pref && i >= 256) ? bid : -1);
  }
  if (!(P.variant & 1)) for (int u = bid; u < 256; u += gridDim.x) swa_unit(P, lds, u, pref);
  { const int lane = mk_lane(), wave = P.wave, gw = bid * NWAVE + wave, NGW = gridDim.x * NWAVE;
    for (int f = gw + pk_k * NGW; f < N_PACK_JOBS; f += NGW) { const PackJob j = pack_job(P, f, lane); float v[16];
#pragma unroll
      for (int q = 0; q < 16; ++q) v[q] = j.p[(size_t)q * j.ldw];
      *j.dst = pack_cvt(v, j.scale); } }
}
__device__ __forceinline__ void phase3_tile(const KP& P, LAS uchar* lds, const int tile) {
  int lane_ = mk_lane(); asm volatile("" : "+v"(lane_)); const int lane = lane_ & 63, wave = P.wave, tid = wave * 64 + lane, r32 = lane & 31, hi = lane >> 5;
  uchar* ws = P.ws;
  const int t0 = tile * 64, b = t0 / SEQ;
  const float* __restrict__ x = P.in[0]; const float* __restrict__ mod = (const float*)(ws + WS_MOD) + b * (NMOD * DM);
  LAS float* ssq = (LAS float*)(lds + LDS_MISC + 64);
  LAS int* selE = (LAS int*)(lds + LDS_MISC + 1024);
  LAS float* selW = (LAS float*)(lds + LDS_MISC + 1536);
  LAS int* selP = (LAS int*)(lds + LDS_MISC + 2048);
  LAS int* cntl = (LAS int*)(lds + LDS_MISC + 2560);
  LAS int* basel = (LAS int*)(lds + LDS_MISC + 2688);
  LAS float* logit = (LAS float*)(lds + LDS_MISC + 8192);
  if (tid < 64) ssq[tid] = 0.f;
  if (tid < 32) cntl[tid] = 0;
  {
    const bf16_t* O = (const bf16_t*)(ws + WS_O);
    float ga[8], gb[8];
#pragma unroll
    for (int j = 0; j < 8; ++j) { ga[j] = P.in[11][8 * lane + j]; gb[j] = P.in[12][8 * lane + j]; }
#pragma unroll
    for (int hf = 0; hf < 2; ++hf) {
      u32x4 va[4], vb[4];
#pragma unroll
      for (int rr = 0; rr < 4; ++rr) { const u32x4* src = (const u32x4*)(O + (size_t)(t0 + wave * 8 + hf * 4 + rr) * DM); va[rr] = __builtin_nontemporal_load(src + lane); vb[rr] = __builtin_nontemporal_load(src + lane + 64); }
#pragma unroll
      for (int rr = 0; rr < 4; ++rr) {
        const int row = wave * 8 + hf * 4 + rr; float fa[8], fb[8], sa = 0.f, sb = 0.f;
#pragma unroll
        for (int q = 0; q < 4; ++q) { fa[2 * q] = __uint_as_float(va[rr][q] << 16); fa[2 * q + 1] = __uint_as_float(va[rr][q] & 0xffff0000u);
          fb[2 * q] = __uint_as_float(vb[rr][q] << 16); fb[2 * q + 1] = __uint_as_float(vb[rr][q] & 0xffff0000u); }
#pragma unroll
        for (int j = 0; j < 8; ++j) { sa += fa[j] * fa[j]; sb += fb[j] * fb[j]; }
        sa = wave_sum(sa); sb = wave_sum(sb);
        const float ra = rsqrtf(sa * (1.0f / 512.0f) + EPS), rb_ = rsqrtf(sb * (1.0f / 512.0f) + EPS);
        u32x4 wa, wb;
#pragma unroll
        for (int q = 0; q < 4; ++q) { wa[q] = pk2(fa[2 * q] * ra * ga[2 * q], fa[2 * q + 1] * ra * ga[2 * q + 1]); wb[q] = pk2(fb[2 * q] * rb_ * gb[2 * q], fb[2 * q + 1] * rb_ * gb[2 * q + 1]); }
        *(LAS u32x4*)(lds + a_off(row, 16 * lane, 2048)) = wa; *(LAS u32x4*)(lds + a_off(row, 16 * (lane + 64), 2048)) = wb;
      }
    }
  }
  __syncthreads();
  f32x16 acc[4][2]; acc_zero<4>(acc);
  { const bf16x8* wp[4];
#pragma unroll
    for (int i = 0; i < 4; ++i) wp[i] = (const bf16x8*)(ws + WS_WOUT) + (size_t)((4 * wave + i) * 64) * 64 + lane;
    gemm_tile<4, 64, false, 5>(acc, lds, 2048, wp, lane); }
  if (P.variant & 2) { asm volatile("" :: "v"(acc[0][0][0]), "v"(acc[1][1][3]), "v"(acc[2][0][7]), "v"(acc[3][1][15])); return; }
  bf16_t* X1 = (bf16_t*)(ws + WS_X1); const unsigned short* XB = (const unsigned short*)(ws + WS_XB);
  float gt[4];
#pragma unroll
  for (int i = 0; i < 4; ++i) gt[i] = mod[2 * DM + 128 * wave + 32 * i + r32];
#pragma unroll
  for (int rb = 0; rb < 2; ++rb) {
    float xr[16][4];
#pragma unroll
    for (int reg = 0; reg < 16; ++reg) { const size_t off = (size_t)(t0 + 32 * rb + crow(reg, hi)) * DM + 128 * wave + r32;
#pragma unroll
      for (int i = 0; i < 4; ++i) xr[reg][i] = __uint_as_float((unsigned)__builtin_nontemporal_load(XB + off + 32 * i) << 16); }
#pragma unroll
    for (int reg = 0; reg < 16; ++reg) { const int row = 32 * rb + crow(reg, hi); const size_t off = (size_t)(t0 + row) * DM + 128 * wave + r32; float ss = 0.f;
#pragma unroll
      for (int i = 0; i < 4; ++i) { const float v = xr[reg][i] + gt[i] * acc[i][rb][reg]; acc[i][rb][reg] = v; st_wt(X1 + off + 32 * i, (bf16_t)(pk2(v, 0.f) & 0xffffu)); ss += v * v; }
#pragma unroll
      for (int o = 16; o; o >>= 1) ss += __shfl_xor(ss, o);
      if (r32 == 0) lds_fadd(&ssq[row], ss); }
  }
  __syncthreads();
  { float a2[4], s2[4];
#pragma unroll
    for (int i = 0; i < 4; ++i) { const int col = 128 * wave + 32 * i + r32; a2[i] = P.in[14][col] * (1.0f + mod[4 * DM + col]); s2[i] = mod[3 * DM + col]; }
#pragma unroll
    for (int rb = 0; rb < 2; ++rb)
#pragma unroll
      for (int reg = 0; reg < 16; ++reg) { const int row = 32 * rb + crow(reg, hi); const float rs = rsqrtf(ssq[row] * (1.0f / DM) + EPS);
#pragma unroll
        for (int i = 0; i < 4; ++i) { const float v = acc[i][rb][reg] * rs * a2[i] + s2[i]; const int col = 128 * wave + 32 * i + r32;
          *(LAS bf16_t*)(lds + a_off(row, 2 * col, 2048)) = (bf16_t)(pk2(v, v) & 0xffffu); } }
  }
  __syncthreads();
  if (P.variant & 1) return;
  if (wave < 4) {
    f32x16 ar[1][2]; acc_zero<1>(ar);
    const bf16x8* wp[1]; wp[0] = (const bf16x8*)(ws + WS_WR) + (size_t)((wave >> 1) * 64) * 64 + lane;
    gemm_tile<1, 64, false>(ar, lds, 2048, wp, lane);
    const int rb = wave & 1, col = 32 * (wave >> 1) + r32;
#pragma unroll
    for (int reg = 0; reg < 16; ++reg) { const float v = rb ? ar[0][1][reg] : ar[0][0][reg]; logit[(32 * rb + crow(reg, hi)) * 64 + col] = v; }
  }
  { uchar* H2 = ws + WS_H2;
#pragma unroll
    for (int rr = 0; rr < 8; ++rr) { const int row = wave * 8 + rr;
      const u32x4 v0 = *(const LAS u32x4*)(lds + a_off(row, 16 * lane, 2048)), v1 = *(const LAS u32x4*)(lds + a_off(row, 16 * (lane + 64), 2048));
      u32x2 w0, w1;
      w0.x = pk4_fp8(__uint_as_float(v0.x << 16) * H2_SCALE, __uint_as_float(v0.x & 0xffff0000u) * H2_SCALE, __uint_as_float(v0.y << 16) * H2_SCALE, __uint_as_float(v0.y & 0xffff0000u) * H2_SCALE);
      w0.y = pk4_fp8(__uint_as_float(v0.z << 16) * H2_SCALE, __uint_as_float(v0.z & 0xffff0000u) * H2_SCALE, __uint_as_float(v0.w << 16) * H2_SCALE, __uint_as_float(v0.w & 0xffff0000u) * H2_SCALE);
      w1.x = pk4_fp8(__uint_as_float(v1.x << 16) * H2_SCALE, __uint_as_float(v1.x & 0xffff0000u) * H2_SCALE, __uint_as_float(v1.y << 16) * H2_SCALE, __uint_as_float(v1.y & 0xffff0000u) * H2_SCALE);
      w1.y = pk4_fp8(__uint_as_float(v1.z << 16) * H2_SCALE, __uint_as_float(v1.z & 0xffff0000u) * H2_SCALE, __uint_as_float(v1.w << 16) * H2_SCALE, __uint_as_float(v1.w & 0xffff0000u) * H2_SCALE);
      u32x2* dst = (u32x2*)(H2 + (size_t)(t0 + row) * DM); dst[lane] = w0; dst[lane + 64] = w1; } }
  __syncthreads();
  if (tid < 64) {
    const float* lg = (const float*)0; (void)lg;
    float gl[4];
#pragma unroll
    for (int i = 0; i < 4; ++i) gl[i] = logit[tid * 64 + i] + P.in[16][i];
    int gi = 0; float gm = gl[0];
#pragma unroll
    for (int i = 1; i < 4; ++i) if (gl[i] > gm) { gm = gl[i]; gi = i; }
    float gs = 0.f;
#pragma unroll
    for (int i = 0; i < 4; ++i) gs += __expf(gl[i] - gm);
    const float gw = 1.0f / gs;
    float el[8];
#pragma unroll
    for (int i = 0; i < 8; ++i) el[i] = logit[tid * 64 + 4 + gi * 8 + i] + P.in[18][gi * 8 + i];
    int i1 = 0; float m1 = el[0];
#pragma unroll
    for (int i = 1; i < 8; ++i) if (el[i] > m1) { m1 = el[i]; i1 = i; }
    int i2 = (i1 + 1) & 7; float m2 = el[i2];
#pragma unroll
    for (int i = 0; i < 8; ++i) if (i != i1 && el[i] > m2) { m2 = el[i]; i2 = i; }
    const float p2 = __expf(m2 - m1), w1 = 1.0f / (1.0f + p2), w2 = p2 * w1;
    const int e1 = gi * 8 + i1, e2 = gi * 8 + i2;
    selE[2 * tid] = e1; selE[2 * tid + 1] = e2; selW[2 * tid] = gw * w1; selW[2 * tid + 1] = gw * w2;
    selP[2 * tid] = __hip_atomic_fetch_add(&cntl[e1], 1, __ATOMIC_RELAXED, __HIP_MEMORY_SCOPE_WORKGROUP);
    selP[2 * tid + 1] = __hip_atomic_fetch_add(&cntl[e2], 1, __ATOMIC_RELAXED, __HIP_MEMORY_SCOPE_WORKGROUP);
  }
  __syncthreads();
  if (tid < 32) { const int c = cntl[tid]; basel[tid] = c ? atomicAdd((int*)(ws + WS_CNT) + tid, c) : 0; }
  __syncthreads();
  if (tid < 128) { const int e = selE[tid], pos = basel[e] + selP[tid];
    ((int*)(ws + WS_LIST))[(size_t)e * 16384 + pos] = (t0 + (tid >> 1)) * 2 + (tid & 1);
    ((float*)(ws + WS_WT))[(size_t)(t0 + (tid >> 1)) * 2 + (tid & 1)] = selW[tid]; }
  __syncthreads();
}

constexpr int P4_ROWS = 144, P4_NRB = 5, P4_MISC = P4_ROWS * 1024;
__device__ __forceinline__ void phase4(const KP& P, LAS uchar* lds) {
  int lane_ = mk_lane(); asm volatile("" : "+v"(lane_)); const int lane = lane_ & 63, wave = P.wave, tid = wave * 64 + lane, r32 = lane & 31, hi = lane >> 5;
  uchar* ws = P.ws;
  LAS int* rinfo = (LAS int*)(lds + P4_MISC + 1024);
  LAS float* rwt = (LAS float*)(lds + P4_MISC + 2048);
  LAS int* ustart = (LAS int*)(lds + P4_MISC + 3072);
  const int* cnt = (const int*)(ws + WS_CNT);
  if (tid == 0) { int acc_ = 0; for (int e = 0; e < 32; ++e) { ustart[e] = acc_; acc_ += (cnt[e] + P4_ROWS - 1) / P4_ROWS; } ustart[32] = acc_; }
  __syncthreads();
  const int total = ustart[32];
  const uchar* H2 = ws + WS_H2; bf16_t* Y = (bf16_t*)(ws + WS_Y);
#pragma unroll 1
  for (int u = blockIdx.x; u < total; u += gridDim.x) {
    int e = 0;
#pragma unroll 1
    for (int k = 1; k < 32; ++k) if (ustart[k] <= u) e = k;
    const int ne = cnt[e], ke = ustart[e + 1] - ustart[e], q = (ne + ke - 1) / ke, j = u - ustart[e], base = j * q, len = min(q, ne - base), nrb = (len + 31) >> 5;
    if (tid < 160) { int info = -1; float w = 0.f;
      if (tid < len) { info = ((const int*)(ws + WS_LIST))[(size_t)e * 16384 + base + tid]; w = ((const float*)(ws + WS_WT))[info]; }
      rinfo[tid] = info; rwt[tid] = w; }
    __syncthreads();
#pragma unroll
    for (int hf = 0; hf < 2; ++hf) {
      u32x4 v[9];
#pragma unroll
      for (int rr = 0; rr < 9; ++rr) { const int info = rinfo[wave * 18 + hf * 9 + rr]; const int tok = info < 0 ? 0 : (info >> 1); v[rr] = ((const u32x4*)(H2 + (size_t)tok * DM))[lane]; }
#pragma unroll
      for (int rr = 0; rr < 9; ++rr) *(LAS u32x4*)(lds + a_off(wave * 18 + hf * 9 + rr, 16 * lane, 1024)) = v[rr];
    }
    __syncthreads();
    f32x16 ag[2][P4_NRB];
#pragma unroll
    for (int i = 0; i < 2; ++i)
#pragma unroll
      for (int rb = 0; rb < P4_NRB; ++rb) ag[i][rb] = f32x16{};
    { const l64x2* wp[2];
      wp[0] = (const l64x2*)(ws + WS_WG) + (size_t)((e * 8 + wave) * 32) * 64 + lane;
      wp[1] = (const l64x2*)(ws + WS_WU) + (size_t)((e * 8 + wave) * 32) * 64 + lane;
      if (!(P.variant & 2)) gemm_tile_f8<2, 32, true, 1, false, P4_NRB>(ag, lds, 1024, wp, lane, nrb); }
    __syncthreads();
    { constexpr float S1 = 1.0f / (H2_SCALE * WGU_SCALE);
#pragma unroll
      for (int rb = 0; rb < P4_NRB; ++rb) if (rb < nrb) { const int rr = 32 * rb + r32; const float w = rwt[rr] * HID_SCALE;
#pragma unroll
        for (int g = 0; g < 4; ++g) { float hv[4];
#pragma unroll
          for (int i = 0; i < 4; ++i) { const float gg = ag[0][rb][4 * g + i] * S1, uu = ag[1][rb][4 * g + i] * S1; hv[i] = gg / (1.0f + __expf(-gg)) * uu * w; }
          *(LAS unsigned*)(lds + a_off(rr, 32 * wave + 8 * g + 4 * hi, 256)) = pk4_fp8(hv[0], hv[1], hv[2], hv[3]); } } }
    __syncthreads();
#pragma unroll 1
    for (int pass = (P.variant & 1) ? 2 : 0; pass < 2; ++pass) {
      f32x16 ad[2][P4_NRB];
#pragma unroll
      for (int i = 0; i < 2; ++i)
#pragma unroll
        for (int rb = 0; rb < P4_NRB; ++rb) ad[i][rb] = f32x16{};
      const l64x2* wp[2];
#pragma unroll
      for (int i = 0; i < 2; ++i) wp[i] = (const l64x2*)(ws + WS_WD) + (size_t)((e * 32 + 4 * wave + 2 * pass + i) * 8) * 64 + lane;
      gemm_tile_f8<2, 8, false, 1, false, P4_NRB>(ad, lds, 256, wp, lane, nrb);
      constexpr float S2 = 1.0f / (HID_SCALE * WD_SCALE);
#pragma unroll
      for (int rb = 0; rb < P4_NRB; ++rb) if (rb < nrb) {
#pragma unroll
        for (int reg = 0; reg < 16; ++reg) { const int info = rinfo[32 * rb + crow(reg, hi)];
          if (info >= 0) { bf16_t* yp = Y + (size_t)info * DM + 128 * wave + 64 * pass + r32;
            st_wt(yp, (bf16_t)(pk2(ad[0][rb][reg] * S2, 0.f) & 0xffffu)); st_wt(yp + 32, (bf16_t)(pk2(ad[1][rb][reg] * S2, 0.f) & 0xffffu)); } } }
    }
    __syncthreads();
  }
}

__device__ __forceinline__ void phase5(const KP& P) {
  int lane_ = mk_lane(); asm volatile("" : "+v"(lane_)); const int lane = lane_ & 63, wave = P.wave;
  uchar* ws = P.ws;
  const bf16_t* Y = (const bf16_t*)(ws + WS_Y);
  const bf16_t* X1 = (const bf16_t*)(ws + WS_X1); float* OUT = P.out;
  f32x4 gf[4];
#pragma unroll
  for (int i = 0; i < 4; ++i) gf[i] = *(const f32x4*)(P.in[22] + 4 * (lane + 64 * i));
  constexpr int RPI = 4;
  const int nwv = gridDim.x * NWAVE, wv = blockIdx.x * NWAVE + wave;
#pragma unroll 1
  for (int t0 = wv * RPI; t0 < T; t0 += nwv * RPI) {
    u32x2 xv[RPI][4]; u32x2 ya[RPI][4], yb[RPI][4];
#pragma unroll
    for (int r = 0; r < RPI; ++r)
#pragma unroll
      for (int i = 0; i < 4; ++i) { const int k = 4 * (lane + 64 * i); const size_t t = t0 + r;
        xv[r][i] = __builtin_nontemporal_load((const u32x2*)(X1 + t * DM + k)); ya[r][i] = __builtin_nontemporal_load((const u32x2*)(Y + (2 * t) * DM + k)); yb[r][i] = __builtin_nontemporal_load((const u32x2*)(Y + (2 * t + 1) * DM + k)); }
    const int b = t0 / SEQ; const float* gt2 = (const float*)(ws + WS_MOD) + b * (NMOD * DM) + 5 * DM;
    f32x4 g2v[4];
#pragma unroll
    for (int i = 0; i < 4; ++i) g2v[i] = *(const f32x4*)(gt2 + 4 * (lane + 64 * i));
#pragma unroll
    for (int r = 0; r < RPI; ++r) {
      f32x4 v[4]; float ss = 0.f;
#pragma unroll
      for (int i = 0; i < 4; ++i) { const u32x2 y0 = ya[r][i], y1 = yb[r][i]; f32x4 ys;
        ys[0] = __uint_as_float(y0.x << 16) + __uint_as_float(y1.x << 16); ys[1] = __uint_as_float(y0.x & 0xffff0000u) + __uint_as_float(y1.x & 0xffff0000u);
        ys[2] = __uint_as_float(y0.y << 16) + __uint_as_float(y1.y << 16); ys[3] = __uint_as_float(y0.y & 0xffff0000u) + __uint_as_float(y1.y & 0xffff0000u);
        f32x4 xf; xf[0] = __uint_as_float(xv[r][i].x << 16); xf[1] = __uint_as_float(xv[r][i].x & 0xffff0000u); xf[2] = __uint_as_float(xv[r][i].y << 16); xf[3] = __uint_as_float(xv[r][i].y & 0xffff0000u);
        v[i] = xf + g2v[i] * ys; ss += v[i][0] * v[i][0] + v[i][1] * v[i][1] + v[i][2] * v[i][2] + v[i][3] * v[i][3]; }
      ss = wave_sum(ss); const float rs = rsqrtf(ss * (1.0f / DM) + EPS);
#pragma unroll
      for (int i = 0; i < 4; ++i) __builtin_nontemporal_store(v[i] * rs * gf[i], (f32x4*)(OUT + (size_t)(t0 + r) * DM + 4 * (lane + 64 * i)));
    }
  }
}
__global__ void __launch_bounds__(NTHR, 2) mk_fwd(const Params P0) {
  extern __shared__ __attribute__((aligned(16))) uchar lds_raw[];
  LAS uchar* lds = (LAS uchar*)lds_raw;
  KP P; P.in = P0.in; P.out = P0.out; P.ws = P0.ws; P.ph_lo = P0.ph_lo; P.ph_hi = P0.ph_hi; P.variant = P0.variant; P.wave = __builtin_amdgcn_readfirstlane((int)(threadIdx.x >> 6));
  const int bid = blockIdx.x, G = gridDim.x;
  const int lo = P.ph_lo, hi = P.ph_hi;
  volatile LAS unsigned* bst = (volatile LAS unsigned*)(lds + LDS_BYTES - 16);
  if (threadIdx.x < 4) bst[threadIdx.x] = 0u;
  __syncthreads();
  XcdBarrier bar; bar.bar = (unsigned*)(P.ws + WS_CTL); bar.x = 0; bar.st = bst;
  if (hi - lo > 1) bar = xcd_barrier_post((unsigned*)(P.ws + WS_CTL), bst, P.wave == 0 && mk_lane() == 0);
#define IN(k) (lo <= (k) && (k) < hi)
#define BOTH(k) (IN(k) && IN((k) + 1))
  if (IN(0)) { phase0(P, lds); if (BOTH(0)) xcd_barrier(bar, P.wave == 0 && mk_lane() == 0); }
  if (IN(1)) { if (bid < T / 64) phase1_tile(P, lds, bid); if (BOTH(1)) xcd_barrier(bar, P.wave == 0 && mk_lane() == 0); }
  if (IN(2)) { phase2(P, lds); if (BOTH(2)) xcd_barrier(bar, P.wave == 0 && mk_lane() == 0); }
  if (IN(3)) { if (bid < T / 64) phase3_tile(P, lds, bid); if (BOTH(3)) xcd_barrier(bar, P.wave == 0 && mk_lane() == 0); }
  if (IN(4)) { phase4(P, lds); if (BOTH(4)) xcd_barrier(bar, P.wave == 0 && mk_lane() == 0); }
  if (IN(5)) phase5(P);
#undef IN
#undef BOTH
}

extern "C" void kernel_launch(void* const* d_in, const int* in_sizes, int n_in, void* d_out, int out_size, void* d_ws, size_t ws_size, hipStream_t stream) {
  static int ready = 0;
  if (!ready) {
    if (n_in != 23 || out_size != T * DM || ws_size < WS_END) { fprintf(stderr, "kernel_launch: unexpected shapes (n_in %d out %d ws %zu need %zu)\n", n_in, out_size, ws_size, (size_t)WS_END); return; }
    if (hipFuncSetAttribute((const void*)mk_fwd, hipFuncAttributeMaxDynamicSharedMemorySize, LDS_BYTES) != hipSuccess) { fprintf(stderr, "kernel_launch: hipFuncSetAttribute failed\n"); return; }
    ready = 1;
  }
  uchar* ws = (uchar*)d_ws;
  if (hipMemsetAsync(ws + WS_CTL, 0, 32768, stream) != hipSuccess) { fprintf(stderr, "kernel_launch: hipMemsetAsync failed\n"); return; }
  Params p{};
  for (int i = 0; i < 23; ++i) p.in[i] = (const float*)d_in[i];
  p.out = (float*)d_out; p.ws = ws; p.ph_lo = 0; p.ph_hi = 6; p.variant = 0; p.pad = 0;
  hipLaunchKernelGGL(mk_fwd, dim3(T / 64), dim3(NTHR), LDS_BYTES, stream, p);
}
```

```cpp
#include <hip/hip_runtime.h>
#include <cstdio>
#include <cstdint>
constexpr int DM = 1024, NB = 4, SEQ = 4096, T = NB * SEQ;
constexpr int INW = 1120, NMOD = 6;
constexpr float EPS = 1e-6f;
#define LAS __attribute__((address_space(3)))
typedef unsigned short bf16_t;
typedef short bf16x8 __attribute__((ext_vector_type(8)));
typedef float f32x16 __attribute__((ext_vector_type(16)));
typedef float f32x4 __attribute__((ext_vector_type(4)));
typedef unsigned u32x4 __attribute__((ext_vector_type(4)));
typedef unsigned u32x2 __attribute__((ext_vector_type(2)));
typedef unsigned char uchar;

constexpr int NTHR = 512, NWAVE = 8;
constexpr int LDS_A = 0, LDS_MISC = 131072, LDS_BYTES = 163840;
constexpr float LOG2E = 1.4426950408889634f;
constexpr float QSCALE_A = 0.125f * LOG2E * (128.0f / 65535.0f);
constexpr float QSCALE_B = 0.10206207261596575f * LOG2E;
constexpr float THR2 = 10.f;
constexpr float WIN_SCALE = 64.f, WIN_DESCALE = 1.0f / 64.f;
constexpr float H2_SCALE = 8.f, WGU_SCALE = 64.f, WD_SCALE = 32.f, HID_SCALE = 8.f;

constexpr size_t WS_CTL   = 0;
constexpr size_t WS_CNT   = 16384;
constexpr size_t WS_MOD   = 32768;
constexpr size_t WS_TABA  = WS_MOD + 98304;
constexpr size_t WS_TABB  = WS_TABA + 4096 * 32 * 8;
constexpr size_t WS_WIN   = WS_TABB + 4096 * 16 * 8;
constexpr size_t WS_WUQ   = WS_WIN + 35 * 64 * 1024;
constexpr size_t WS_WUKV  = WS_WUQ + 24 * 12 * 1024;
constexpr size_t WS_WOUT  = WS_WUKV + 32 * 8 * 1024;
constexpr size_t WS_WR    = WS_WOUT + 32 * 64 * 1024;
constexpr size_t WS_WG    = WS_WR + 2 * 64 * 1024;
constexpr size_t WS_WU    = WS_WG + (size_t)32 * 8 * 32 * 1024;
constexpr size_t WS_WD    = WS_WU + (size_t)32 * 8 * 32 * 1024;
constexpr size_t WS_LIST  = WS_WD + (size_t)32 * 32 * 8 * 1024;
constexpr size_t WS_WT    = WS_LIST + (size_t)32 * 16384 * 4;
constexpr size_t WS_QA    = WS_WT + (size_t)T * 2 * 4;
constexpr size_t WS_KVA   = WS_QA + (size_t)NB * 8 * 64 * 8192;
constexpr size_t WS_QB    = WS_KVA + (size_t)NB * 2 * 64 * 16384;
constexpr size_t WS_KVB   = WS_QB + (size_t)NB * 8 * 64 * 12288;
constexpr size_t WS_O     = WS_KVB + (size_t)NB * 8 * 64 * 20480;
constexpr size_t WS_H2    = WS_O + (size_t)T * DM * 2;
constexpr size_t WS_X1    = WS_H2 + (size_t)T * DM * 2;
constexpr size_t WS_XB    = WS_X1 + (size_t)T * DM * 2;
constexpr size_t WS_END   = WS_XB + (size_t)T * DM * 2;
constexpr size_t WS_Y     = WS_QA;
static_assert((size_t)T * 2 * DM * 2 <= WS_O - WS_QA, "Y overlay");

struct Params { const float* in[23]; float* out; unsigned char* ws; int ph_lo, ph_hi, variant, pad; };
struct KP { const float* const* in; float* out; unsigned char* ws; int ph_lo, ph_hi, wave, variant; };
__device__ __forceinline__ int mk_lane() { return (int)__builtin_amdgcn_mbcnt_hi(~0u, __builtin_amdgcn_mbcnt_lo(~0u, 0u)); }

__device__ __forceinline__ unsigned pk2(float lo, float hi) { unsigned r; asm("v_cvt_pk_bf16_f32 %0, %1, %2" : "=v"(r) : "v"(lo), "v"(hi)); return r; }
__device__ __forceinline__ float bf2f(unsigned short v) { return __uint_as_float((unsigned)v << 16); }
__host__ __device__ __forceinline__ constexpr int crow(int r, int hi) { return (r & 3) + 8 * (r >> 2) + 4 * hi; }
__device__ __forceinline__ f32x16 mfma(bf16x8 a, bf16x8 b, f32x16 c) { return __builtin_amdgcn_mfma_f32_32x32x16_bf16(a, b, c, 0, 0, 0); }
__device__ __forceinline__ float wave_sum(float v) {
#pragma unroll
  for (int o = 32; o; o >>= 1) v += __shfl_xor(v, o);
  return v;
}
__device__ __forceinline__ float half_swap_max(float x) { auto rr = __builtin_amdgcn_permlane32_swap(__float_as_uint(x), __float_as_uint(x), false, false);
  float m; asm("v_max_f32 %0, %1, %2" : "=v"(m) : "v"(rr[0]), "v"(rr[1])); return m; }
__device__ __forceinline__ float half_swap_sum(float x) { auto rr = __builtin_amdgcn_permlane32_swap(__float_as_uint(x), __float_as_uint(x), false, false); return __uint_as_float(rr[0]) + __uint_as_float(rr[1]); }
template <typename TT> __device__ __forceinline__ void st_wt(TT* p, TT v) { __hip_atomic_store(p, v, __ATOMIC_RELAXED, __HIP_MEMORY_SCOPE_AGENT); }
__device__ __forceinline__ void st_wt8(void* p, u32x2 v) { st_wt((unsigned long long*)p, __builtin_bit_cast(unsigned long long, v)); }
__device__ __forceinline__ void st_wt16(void* p, u32x4 v) { st_wt8(p, u32x2{v.x, v.y}); st_wt8((uchar*)p + 8, u32x2{v.z, v.w}); }
__host__ __device__ __forceinline__ constexpr int a_off(int row, int kbyte, int pitch) { return row * pitch + (kbyte ^ ((row & 15) << 4)); }
__host__ __device__ __forceinline__ constexpr int img_qk(int rr, int d, int NS) { return ((((rr >> 5) * NS + (d >> 4)) * 64) + ((d >> 3) & 1) * 32 + (rr & 31)) * 16 + (d & 7) * 2; }
__host__ __device__ __forceinline__ constexpr int img_v(int kk, int d) {
  const int kb = kk >> 5, k32 = kk & 31, s = k32 >> 4, k16 = k32 & 15, h = (k16 >> 2) & 1, j = ((k16 >> 3) << 2) | (k16 & 3), db = d >> 5, r = d & 31;
  return (((((kb * 2 + db) * 2 + s) * 64) + h * 32 + r) * 8 + j) * 2;
}

#define XB_TMO      128
#define XB_XCNT(j)  (256  + 64 * (j))
#define XB_XSUB(j)  (1280 + 64 * (j))
#define XB_XGEN(j)  (2304 + 64 * (j))
#define XB_TOP      3328
#define XB_TOPGEN   3392
#define XCD_BAR_WORDS 3456
#define XB_SPIN_CAP (1u << 20)
__device__ __forceinline__ unsigned xb_ld(unsigned* p)              { return __hip_atomic_load(p, __ATOMIC_RELAXED, __HIP_MEMORY_SCOPE_AGENT); }
__device__ __forceinline__ unsigned xb_add(unsigned* p, unsigned v) { return __hip_atomic_fetch_add(p, v, __ATOMIC_RELAXED, __HIP_MEMORY_SCOPE_AGENT); }
__device__ __forceinline__ unsigned xb_xcc_id() { return (unsigned)__builtin_amdgcn_s_getreg((3 << 11) | 20) & 0xFu; }
#define XB_SPIN(cond, bar) do { unsigned _sp = 0; while (cond) { __builtin_amdgcn_s_sleep(1); \
    if ((++_sp & 255u) == 0u) { if (xb_ld(&(bar)[XB_TMO])) break; if (_sp > XB_SPIN_CAP) { atomicAdd(&(bar)[XB_TMO], 1u); break; } } } } while (0)
struct XcdBarrier { unsigned* bar; unsigned x; volatile LAS unsigned* st; };
__device__ __forceinline__ XcdBarrier xcd_barrier_post(unsigned* bar, volatile LAS unsigned* st, bool leader) {
  XcdBarrier b; b.bar = bar; b.x = xb_xcc_id(); b.st = st;
  if (leader) (void)xb_add(&bar[XB_XCNT(b.x)], 1u);
  return b;
}
__device__ __forceinline__ void xcd_barrier_complete(unsigned* bar, unsigned x, unsigned& nloc, unsigned& nx) {
  const unsigned G = gridDim.x * gridDim.y * gridDim.z;
  unsigned sum, cnt, mine, sp = 0u;
  for (;;) {
    sum = 0u; cnt = 0u; mine = 0u;
#pragma unroll
    for (unsigned j = 0; j < 16; ++j) { const unsigned c = xb_ld(&bar[XB_XCNT(j)]); sum += c; cnt += (c > 0u) ? 1u : 0u; mine = (j == x) ? c : mine; }
    if (sum == G) break;
    __builtin_amdgcn_s_sleep(1);
    if ((++sp & 255u) == 0u) { if (xb_ld(&bar[XB_TMO])) break; if (sp > XB_SPIN_CAP) { atomicAdd(&bar[XB_TMO], 1u); break; } }
  }
  nloc = mine > 0u ? mine : 1u; nx = cnt > 0u ? cnt : 1u;
}
__device__ __forceinline__ void xcd_barrier(const XcdBarrier& b, bool leader) {
  asm volatile("s_waitcnt vmcnt(0)" ::: "memory");
  __syncthreads();
  if (leader) {
    unsigned* bar = b.bar;
    __builtin_amdgcn_s_waitcnt(0);
    unsigned nloc = b.st[0], nx = b.st[1];
    if (nloc == 0u) { xcd_barrier_complete(bar, b.x, nloc, nx); b.st[0] = nloc; b.st[1] = nx; }
    const unsigned old = xb_add(&bar[XB_XSUB(b.x)], 1u);
    const unsigned gen = old / nloc;
    if (old + 1u == (gen + 1u) * nloc) {
      __builtin_amdgcn_fence(__ATOMIC_RELEASE, "agent");
      asm volatile("s_waitcnt vmcnt(0)" ::: "memory");
      const unsigned og = xb_add(&bar[XB_TOP], 1u);
      const unsigned tg = og / nx;
      if (og + 1u == (tg + 1u) * nx) xb_add(&bar[XB_TOPGEN], 1u);
      else XB_SPIN(xb_ld(&bar[XB_TOPGEN]) == tg, bar);
      __builtin_amdgcn_fence(__ATOMIC_ACQUIRE, "agent");
      xb_add(&bar[XB_XGEN(b.x)], 1u);
      asm volatile("s_waitcnt vmcnt(0)" ::: "memory");
    } else {
      XB_SPIN(xb_ld(&bar[XB_XGEN(b.x)]) == gen, bar);
      __builtin_amdgcn_fence(__ATOMIC_ACQUIRE, "agent");
      asm volatile("s_waitcnt vmcnt(0)" ::: "memory");
    }
  }
  __syncthreads();
}

template <int NBLK, int NS, bool TR, int D = (NBLK >= 3 ? 4 : 8)>
__device__ __forceinline__ void gemm_tile(f32x16 (&acc)[NBLK][2], const LAS uchar* A, const int pitch, const bf16x8* const (&wp)[NBLK], const int lane) {
  constexpr int NSM = (NS / D) * D;
  const int r = lane & 31, h = lane >> 5;
  const LAS uchar* a0p = A + r * pitch; const LAS uchar* a1p = A + (32 + r) * pitch;
  const int swz = (lane & 15) << 4, kb0 = 16 * h;
  bf16x8 ring[D][NBLK];
#pragma unroll
  for (int d = 0; d < D; ++d)
#pragma unroll
    for (int i = 0; i < NBLK; ++i) ring[d][i] = wp[i][d * 64];
#pragma unroll 1
  for (int s0 = 0; s0 < NSM; s0 += D) {
#pragma unroll
    for (int d = 0; d < D; ++d) {
      const int s = s0 + d;
      const int ko = ((s * 32) + kb0) ^ swz; const bf16x8 fa0 = *(const LAS bf16x8*)(a0p + ko), fa1 = *(const LAS bf16x8*)(a1p + ko);
#pragma unroll
      for (int i = 0; i < NBLK; ++i) {
        if (TR) { acc[i][0] = mfma(ring[d][i], fa0, acc[i][0]); acc[i][1] = mfma(ring[d][i], fa1, acc[i][1]); }
        else    { acc[i][0] = mfma(fa0, ring[d][i], acc[i][0]); acc[i][1] = mfma(fa1, ring[d][i], acc[i][1]); }
      }
      if (s + D < NS) {
#pragma unroll
        for (int i = 0; i < NBLK; ++i) ring[d][i] = wp[i][(s + D) * 64];
      }
    }
  }
#pragma unroll
  for (int d = 0; d < NS - NSM; ++d) {
    const int s = NSM + d;
    const int ko = ((s * 32) + kb0) ^ swz; const bf16x8 fa0 = *(const LAS bf16x8*)(a0p + ko), fa1 = *(const LAS bf16x8*)(a1p + ko);
#pragma unroll
    for (int i = 0; i < NBLK; ++i) {
      if (TR) { acc[i][0] = mfma(ring[d][i], fa0, acc[i][0]); acc[i][1] = mfma(ring[d][i], fa1, acc[i][1]); }
      else    { acc[i][0] = mfma(fa0, ring[d][i], acc[i][0]); acc[i][1] = mfma(fa1, ring[d][i], acc[i][1]); }
    }
  }
}
typedef long l64x2 __attribute__((ext_vector_type(2)));
__device__ __forceinline__ f32x16 mfma8(long a, long b, f32x16 c) { return __builtin_amdgcn_mfma_f32_32x32x16_fp8_fp8(a, b, c, 0, 0, 0); }
__device__ __forceinline__ unsigned pk4_fp8(float a, float b, float c, float d) { int w = 0; w = __builtin_amdgcn_cvt_pk_fp8_f32(a, b, w, false); w = __builtin_amdgcn_cvt_pk_fp8_f32(c, d, w, true); return (unsigned)w; }
typedef int i32x8 __attribute__((ext_vector_type(8)));
typedef int i32x4 __attribute__((ext_vector_type(4)));
#ifndef MK_MX
#define MK_MX 1
#endif
__device__ __forceinline__ f32x16 mfma_mx(i32x4 a0, i32x4 a1, i32x4 b0, i32x4 b1, f32x16 c) {
  const i32x8 a = __builtin_shufflevector(a0, a1, 0, 1, 2, 3, 4, 5, 6, 7), b = __builtin_shufflevector(b0, b1, 0, 1, 2, 3, 4, 5, 6, 7);
  return __builtin_amdgcn_mfma_scale_f32_32x32x64_f8f6f4(a, b, c, 0, 0, 0, 0x7f7f7f7f, 0, 0x7f7f7f7f);
}
__device__ __forceinline__ f32x16 mfma_mx_q(i32x4 a0, i32x4 a1, i32x4 b0, i32x4 b1, f32x16 c) {
  const i32x8 a = __builtin_shufflevector(a0, a1, 0, 1, 2, 3, 4, 5, 6, 7), b = __builtin_shufflevector(b0, b1, 0, 1, 2, 3, 4, 5, 6, 7);
  return __builtin_amdgcn_mfma_scale_f32_32x32x64_f8f6f4(a, b, c, 0, 0, 0, 0x7f7f7f7f, 0, 0x77777777);
}
__device__ __forceinline__ unsigned mk_pknorm(float lo, float hi) { typedef unsigned short u16x2 __attribute__((ext_vector_type(2))); const u16x2 v = __builtin_amdgcn_cvt_pknorm_u16(lo, hi); return __builtin_bit_cast(unsigned, v); }
__device__ __forceinline__ f32x16 mfma_mx8(i32x8 a, i32x8 b, f32x16 c) { return __builtin_amdgcn_mfma_scale_f32_32x32x64_f8f6f4(a, b, c, 0, 0, 0, 0x7f7f7f7f, 0, 0x7f7f7f7f); }
__device__ __forceinline__ i32x8 ld_pair(const i32x4* p0, const i32x4* p1) { const i32x4 x = *p0, y = *p1; return __builtin_shufflevector(x, y, 0, 1, 2, 3, 4, 5, 6, 7); }
template <int NBLK, int NS, bool TR, int D, bool FULL, int NRB>
__device__ __forceinline__ void gemm_tile_f8(f32x16 (&acc)[NBLK][NRB], const LAS uchar* A, const int pitch, const l64x2* const (&wp)[NBLK], const int lane, const int nrb) {
  constexpr int NP = NS / 2;
  static_assert(NS % 2 == 0 && NP % D == 0, "NS even, NP % D");
  const int r = lane & 31, h = lane >> 5;
  const LAS uchar* ap = A + r * pitch;
  const int swz = (lane & 15) << 4, kb0 = 16 * h;
  i32x8 ring[D][NBLK];
#pragma unroll
  for (int d = 0; d < D; ++d)
#pragma unroll
    for (int i = 0; i < NBLK; ++i) ring[d][i] = ld_pair((const i32x4*)(wp[i] + (2 * d) * 64), (const i32x4*)(wp[i] + (2 * d + 1) * 64));
#pragma unroll 1
  for (int p0 = 0; p0 < NP; p0 += D) {
#pragma unroll
    for (int d = 0; d < D; ++d) {
      const int s = 2 * (p0 + d);
      const int ko0 = ((s * 32) + kb0) ^ swz, ko1 = (((s + 1) * 32) + kb0) ^ swz;
#pragma unroll
      for (int rb = 0; rb < NRB; ++rb) {
        if (FULL || rb < nrb) {
          const i32x4 f0 = *(const LAS i32x4*)(ap + rb * 32 * pitch + ko0), f1 = *(const LAS i32x4*)(ap + rb * 32 * pitch + ko1);
          const i32x8 fa = __builtin_shufflevector(f0, f1, 0, 1, 2, 3, 4, 5, 6, 7);
#pragma unroll
          for (int i = 0; i < NBLK; ++i) acc[i][rb] = TR ? mfma_mx8(ring[d][i], fa, acc[i][rb]) : mfma_mx8(fa, ring[d][i], acc[i][rb]);
        }
      }
      if (p0 + d + D < NP) {
#pragma unroll
        for (int i = 0; i < NBLK; ++i) ring[d][i] = ld_pair((const i32x4*)(wp[i] + (2 * (p0 + d + D)) * 64), (const i32x4*)(wp[i] + (2 * (p0 + d + D) + 1) * 64));
      }
    }
  }
}
template <int NSLOT, int NACC, int NS, bool TR, int D, int MAP>
__device__ __forceinline__ void gemm_slots_f8(f32x16 (&acc)[NACC][2], const LAS uchar* A, const int pitch, const l64x2* const (&wp)[NSLOT], const int lane) {
  constexpr int NP = NS / 2;
  static_assert(NS % 2 == 0 && NP % D == 0, "NS even, NP % D");
  const int r = lane & 31, h = lane >> 5;
  const LAS uchar* ap = A + r * pitch;
  const int swz = (lane & 15) << 4, kb0 = 16 * h;
  i32x8 ring[D][NSLOT];
#pragma unroll
  for (int d = 0; d < D; ++d)
#pragma unroll
    for (int i = 0; i < NSLOT; ++i) ring[d][i] = ld_pair((const i32x4*)(wp[i] + (2 * d) * 64), (const i32x4*)(wp[i] + (2 * d + 1) * 64));
#pragma unroll 1
  for (int p0 = 0; p0 < NP; p0 += D) {
#pragma unroll
    for (int d = 0; d < D; ++d) {
      const int s = 2 * (p0 + d);
      const int ko0 = ((s * 32) + kb0) ^ swz, ko1 = (((s + 1) * 32) + kb0) ^ swz;
#pragma unroll
      for (int rb = 0; rb < 2; ++rb) {
        const i32x4 f0 = *(const LAS i32x4*)(ap + rb * 32 * pitch + ko0), f1 = *(const LAS i32x4*)(ap + rb * 32 * pitch + ko1);
        const i32x8 fa = __builtin_shufflevector(f0, f1, 0, 1, 2, 3, 4, 5, 6, 7);
#pragma unroll
        for (int i = 0; i < NSLOT; ++i) { constexpr int dummy = 0; (void)dummy; const int ai = (MAP >> (4 * i)) & 15;
          acc[ai][rb] = TR ? mfma_mx8(ring[d][i], fa, acc[ai][rb]) : mfma_mx8(fa, ring[d][i], acc[ai][rb]); }
      }
      if (p0 + d + D < NP) {
#pragma unroll
        for (int i = 0; i < NSLOT; ++i) ring[d][i] = ld_pair((const i32x4*)(wp[i] + (2 * (p0 + d + D)) * 64), (const i32x4*)(wp[i] + (2 * (p0 + d + D) + 1) * 64));
      }
    }
  }
}
template <int NBLK> __device__ __forceinline__ void acc_zero(f32x16 (&acc)[NBLK][2]) {
#pragma unroll
  for (int i = 0; i < NBLK; ++i) { acc[i][0] = f32x16{}; acc[i][1] = f32x16{}; }
}

__device__ __forceinline__ void store_img_qk(uchar* img, const f32x16& v, int rr, int f0, int NS, int hi) {
#pragma unroll
  for (int g = 0; g < 4; ++g) { u32x2 w; w.x = pk2(v[4 * g], v[4 * g + 1]); w.y = pk2(v[4 * g + 2], v[4 * g + 3]);
    *(u32x2*)(img + img_qk(rr, f0 + 8 * g + 4 * hi, NS)) = w; }
}
__device__ __forceinline__ void store_img_v(uchar* img, const f32x16& v, int kb, int d, int hi) {
#pragma unroll
  for (int g = 0; g < 4; ++g) { u32x2 w; w.x = pk2(v[4 * g], v[4 * g + 1]); w.y = pk2(v[4 * g + 2], v[4 * g + 3]);
    *(u32x2*)(img + img_v(32 * kb + 8 * g + 4 * hi, d)) = w; }
}
__device__ __forceinline__ void pack_frag(const float* __restrict__ W, int ldw, int k0, int n0, const float* __restrict__ rowscale, u32x4* __restrict__ dst, int lane) {
  const int r = lane & 31, h = lane >> 5;
  const float* p = W + (size_t)(k0 + 8 * h) * ldw + n0 + r;
  float v[8];
#pragma unroll
  for (int j = 0; j < 8; ++j) v[j] = p[(size_t)j * ldw];
  if (rowscale) {
#pragma unroll
    for (int j = 0; j < 8; ++j) v[j] *= rowscale[k0 + 8 * h + j];
  }
  u32x4 w; w.x = pk2(v[0], v[1]); w.y = pk2(v[2], v[3]); w.z = pk2(v[4], v[5]); w.w = pk2(v[6], v[7]);
  dst[lane] = w;
}
__device__ __forceinline__ void pack_frag8(const float* __restrict__ W, int ldw, int k0, int n0, float scale, u32x4* __restrict__ dst, int lane) {
  const int r = lane & 31, h = lane >> 5;
  const float* p = W + (size_t)(k0 + 16 * h) * ldw + n0 + r;
  float v[16];
#pragma unroll
  for (int j = 0; j < 16; ++j) v[j] = p[(size_t)j * ldw] * scale;
  u32x4 w; w.x = pk4_fp8(v[0], v[1], v[2], v[3]); w.y = pk4_fp8(v[4], v[5], v[6], v[7]); w.z = pk4_fp8(v[8], v[9], v[10], v[11]); w.w = pk4_fp8(v[12], v[13], v[14], v[15]);
  dst[lane] = w;
}
__device__ __forceinline__ void pack_frag8_lo(const float* __restrict__ W, int ldw, int k0, int n0, float scale, u32x4* __restrict__ dst, int lane) {
  const int r = lane & 31, h = lane >> 5;
  const float* p = W + (size_t)(k0 + 16 * h) * ldw + n0 + r;
  float v[16];
#pragma unroll
  for (int j = 0; j < 16; ++j) { const float x = p[(size_t)j * ldw] * scale; const int q = __builtin_amdgcn_cvt_pk_fp8_f32(x, 0.f, 0, false); v[j] = x - __builtin_amdgcn_cvt_f32_fp8(q, 0); }
  u32x4 w; w.x = pk4_fp8(v[0], v[1], v[2], v[3]); w.y = pk4_fp8(v[4], v[5], v[6], v[7]); w.z = pk4_fp8(v[8], v[9], v[10], v[11]); w.w = pk4_fp8(v[12], v[13], v[14], v[15]);
  dst[lane] = w;
}
__device__ __forceinline__ void phase0(const KP& P, LAS uchar* lds) {
  int lane_ = mk_lane(); asm volatile("" : "+v"(lane_)); const int lane = lane_ & 63, wave = P.wave, tid = wave * 64 + lane, bid = blockIdx.x, G = gridDim.x;
  uchar* ws = P.ws;
  if (bid == 0 && tid < 64) ((int*)(ws + WS_CNT))[tid] = 0;
  for (int idx = bid * NTHR + tid; idx < SEQ * 48; idx += G * NTHR) {
    int pos, i, half; float2* dst;
    if (idx < SEQ * 32) { pos = idx >> 5; i = idx & 31; half = 32; dst = (float2*)(ws + WS_TABA) + idx; }
    else { const int i2 = idx - SEQ * 32; pos = i2 >> 4; i = i2 & 15; half = 16; dst = (float2*)(ws + WS_TABB) + i2; }
    const float inv = 1.0f / powf(10000.0f, (float)(2 * i) / (float)(2 * half));
    const float ang = (float)pos * inv;
    *dst = make_float2(cosf(ang), sinf(ang));
  }
  if (bid < 192) {
    const float* c = P.in[1]; const float* w_ada = P.in[2]; const float* b_ada = P.in[3];
    LAS float* sl = (LAS float*)lds; LAS float* part = (LAS float*)(lds + 16384);
    for (int i = tid; i < NB * DM; i += NTHR) { const float v = c[i]; sl[i] = v / (1.f + __expf(-v)); }
    __syncthreads();
    const int n0 = bid * 32, rowl = lane >> 3, c4 = lane & 7;
    f32x4 a0 = {0, 0, 0, 0}, a1 = a0, a2 = a0, a3 = a0;
#pragma unroll 4
    for (int it = 0; it < 16; ++it) {
      const int k = wave * 128 + it * 8 + rowl;
      const f32x4 wv = *(const f32x4*)(w_ada + (size_t)k * (NMOD * DM) + n0 + 4 * c4);
      a0 += wv * sl[k]; a1 += wv * sl[DM + k]; a2 += wv * sl[2 * DM + k]; a3 += wv * sl[3 * DM + k];
    }
#pragma unroll
    for (int e = 0; e < 4; ++e) {
#pragma unroll
      for (int o = 8; o < 64; o <<= 1) { a0[e] += __shfl_xor(a0[e], o); a1[e] += __shfl_xor(a1[e], o); a2[e] += __shfl_xor(a2[e], o); a3[e] += __shfl_xor(a3[e], o); }
    }
    if (rowl == 0) {
#pragma unroll
      for (int e = 0; e < 4; ++e) { part[(wave * 4 + 0) * 32 + 4 * c4 + e] = a0[e]; part[(wave * 4 + 1) * 32 + 4 * c4 + e] = a1[e]; part[(wave * 4 + 2) * 32 + 4 * c4 + e] = a2[e]; part[(wave * 4 + 3) * 32 + 4 * c4 + e] = a3[e]; }
    }
    __syncthreads();
    if (tid < 128) { const int bb = tid >> 5, col = tid & 31; float s = b_ada[n0 + col];
#pragma unroll
      for (int w = 0; w < 8; ++w) s += part[(w * 4 + bb) * 32 + col];
      ((float*)(ws + WS_MOD))[bb * (NMOD * DM) + n0 + col] = s; }
  }
  const int gw = bid * NWAVE + wave, NGW = G * NWAVE;
  for (int f = gw; f < 43 * 32; f += NGW) { const int slot = f >> 5, s = f & 31;
    if (slot < 35) pack_frag8(P.in[5], INW, 32 * s, 32 * slot, WIN_SCALE, (u32x4*)(ws + WS_WIN) + (size_t)f * 64, lane);
    else { const int blk = slot < 39 ? 20 + (slot - 35) : 30 + (slot - 39); pack_frag8_lo(P.in[5], INW, 32 * s, 32 * blk, WIN_SCALE, (u32x4*)(ws + WS_WIN) + (size_t)f * 64, lane); } }
  for (int f = gw; f < 32 * 64; f += NGW) pack_frag(P.in[13], DM, 16 * (f & 63), 32 * (f >> 6), nullptr, (u32x4*)(ws + WS_WOUT) + (size_t)f * 64, lane);
  for (int f = gw; f < 24 * 12; f += NGW) pack_frag(P.in[7], 768, 16 * (f % 12), 32 * (f / 12), P.in[6], (u32x4*)(ws + WS_WUQ) + (size_t)f * 64, lane);
  for (int f = gw; f < 32 * 8; f += NGW) pack_frag(P.in[9], 1024, 16 * (f & 7), 32 * (f >> 3), P.in[8], (u32x4*)(ws + WS_WUKV) + (size_t)f * 64, lane);
  for (int f = gw; f < 2 * 64; f += NGW) {
    const int nb = f >> 6, s = f & 63, r = lane & 31, h = lane >> 5, col = 32 * nb + r;
    float v[8];
#pragma unroll
    for (int j = 0; j < 8; ++j) { const int k = 16 * s + 8 * h + j; v[j] = col < 4 ? P.in[15][k * 4 + col] : (col < 36 ? P.in[17][k * 32 + col - 4] : 0.f); }
    u32x4 w; w.x = pk2(v[0], v[1]); w.y = pk2(v[2], v[3]); w.z = pk2(v[4], v[5]); w.w = pk2(v[6], v[7]);
    ((u32x4*)(ws + WS_WR) + (size_t)f * 64)[lane] = w;
  }
}

__device__ __forceinline__ void rope64(const f32x16& xa, const f32x16& xb, f32x16& ya, f32x16& yb, const float2* __restrict__ trow, int hi, float scale) {
#pragma unroll
  for (int g = 0; g < 4; ++g) {
    const f32x4 t0 = *(const f32x4*)(trow + 8 * g + 4 * hi), t1 = *(const f32x4*)(trow + 8 * g + 4 * hi + 2);
    const float cc[4] = {t0[0], t0[2], t1[0], t1[2]}, sn[4] = {t0[1], t0[3], t1[1], t1[3]};
#pragma unroll
    for (int i = 0; i < 4; ++i) { const int reg = 4 * g + i; ya[reg] = (xa[reg] * cc[i] - xb[reg] * sn[i]) * scale; yb[reg] = (xb[reg] * cc[i] + xa[reg] * sn[i]) * scale; }
  }
}
__device__ __forceinline__ void rope32(const f32x16& x, f32x16& y, const float2* __restrict__ trow, int hi, float scale) {
#pragma unroll
  for (int g = 0; g < 2; ++g) {
    const f32x4 t0 = *(const f32x4*)(trow + 8 * g + 4 * hi), t1 = *(const f32x4*)(trow + 8 * g + 4 * hi + 2);
    const float cc[4] = {t0[0], t0[2], t1[0], t1[2]}, sn[4] = {t0[1], t0[3], t1[1], t1[3]};
#pragma unroll
    for (int i = 0; i < 4; ++i) { const int reg = 4 * g + i; y[reg] = (x[reg] * cc[i] - x[reg + 8] * sn[i]) * scale; y[reg + 8] = (x[reg + 8] * cc[i] + x[reg] * sn[i]) * scale; }
  }
}
__device__ __forceinline__ float write_c_tile(LAS uchar* base, int pitch, const f32x16& vin, int rr, int f0, int hi) {
  const f32x16 v = vin * WIN_DESCALE;
  float ss = 0.f;
#pragma unroll
  for (int g = 0; g < 4; ++g) { u32x2 w; w.x = pk2(v[4 * g], v[4 * g + 1]); w.y = pk2(v[4 * g + 2], v[4 * g + 3]);
    *(LAS u32x2*)(base + a_off(rr, 2 * (f0 + 8 * g + 4 * hi), pitch)) = w;
    ss += v[4 * g] * v[4 * g] + v[4 * g + 1] * v[4 * g + 1] + v[4 * g + 2] * v[4 * g + 2] + v[4 * g + 3] * v[4 * g + 3]; }
  return ss;
}
__device__ __forceinline__ void store_img8_qk(uchar* img, const f32x16& v, int rb, int r32, int blk, int hi) {
#pragma unroll
  for (int g = 0; g < 4; ++g) { const unsigned w = pk4_fp8(v[4 * g], v[4 * g + 1], v[4 * g + 2], v[4 * g + 3]);
    const int off = blk < 2 ? rb * 4096 + (g >> 1) * 1024 + (blk * 32 + r32) * 16 + 8 * (g & 1) + 4 * hi : rb * 4096 + 2048 + ((g >> 1) * 32 + r32) * 16 + 8 * (g & 1) + 4 * hi;
    *(unsigned*)(img + off) = w; }
}
__device__ __forceinline__ void store_img8_v(uchar* img, const f32x16& v, int rb, int db, int r32, int hi) {
#pragma unroll
  for (int g = 0; g < 4; ++g) *(unsigned*)(img + db * 2048 + rb * 1024 + (hi * 32 + r32) * 16 + 4 * g) = pk4_fp8(v[4 * g], v[4 * g + 1], v[4 * g + 2], v[4 * g + 3]);
}
__device__ __forceinline__ void lds_fadd(LAS float* p, float v) { __hip_atomic_fetch_add(p, v, __ATOMIC_RELAXED, __HIP_MEMORY_SCOPE_WORKGROUP); }

__device__ __forceinline__ void phase1_tile(const KP& P, LAS uchar* lds, const int tile) {
  int lane_ = mk_lane(); asm volatile("" : "+v"(lane_)); const int lane = lane_ & 63, wave = P.wave, tid = wave * 64 + lane, r32 = lane & 31, hi = lane >> 5;
  uchar* ws = P.ws;
  const int t0 = tile * 64, b = t0 / SEQ, pos0 = t0 % SEQ, tb = pos0 >> 6;
  const float* __restrict__ x = P.in[0]; const float* __restrict__ mod = (const float*)(ws + WS_MOD) + b * (NMOD * DM); const float* __restrict__ g1 = P.in[4];
  LAS float* ssq = (LAS float*)(lds + LDS_MISC + 64);
  LAS uchar* krt = lds + LDS_MISC + 1024;
  const float2* tabA = (const float2*)(ws + WS_TABA); const float2* tabB = (const float2*)(ws + WS_TABB);
  if (tid < 128) ssq[tid] = 0.f;
  {
    f32x4 av[4], sv[4];
#pragma unroll
    for (int i = 0; i < 4; ++i) { const int k = 4 * (lane + 64 * i); const f32x4 g = *(const f32x4*)(g1 + k), sc = *(const f32x4*)(mod + DM + k); av[i] = g * (sc + 1.0f); sv[i] = *(const f32x4*)(mod + k); }
#pragma unroll
    for (int hf = 0; hf < 2; ++hf) {
      f32x4 xv[4][4];
#pragma unroll
      for (int rr = 0; rr < 4; ++rr)
#pragma unroll
        for (int i = 0; i < 4; ++i) xv[rr][i] = __builtin_nontemporal_load((const f32x4*)(x + (size_t)(t0 + wave * 8 + hf * 4 + rr) * DM + 4 * (lane + 64 * i)));
#pragma unroll
      for (int rr = 0; rr < 4; ++rr) {
        const int row = wave * 8 + hf * 4 + rr; float ss = 0.f;
#pragma unroll
        for (int i = 0; i < 4; ++i) { ss += xv[rr][i][0] * xv[rr][i][0] + xv[rr][i][1] * xv[rr][i][1] + xv[rr][i][2] * xv[rr][i][2] + xv[rr][i][3] * xv[rr][i][3];
          u32x2 xb; xb.x = pk2(xv[rr][i][0], xv[rr][i][1]); xb.y = pk2(xv[rr][i][2], xv[rr][i][3]);
          *(u32x2*)(ws + WS_XB + ((size_t)(t0 + row) * DM + 4 * (lane + 64 * i)) * 2) = xb; }
        ss = wave_sum(ss); const float rs = rsqrtf(ss * (1.0f / DM) + EPS);
#pragma unroll
        for (int i = 0; i < 4; ++i) { const f32x4 v = xv[rr][i] * rs * av[i] + sv[i];
          *(LAS unsigned*)(lds + a_off(row, 4 * (lane + 64 * i), 1024)) = pk4_fp8(v[0], v[1], v[2], v[3]); }
      }
    }
  }
  __syncthreads();
  const l64x2* WIN = (const l64x2*)(ws + WS_WIN);
#define WSLOT(slot) (WIN + (size_t)((slot) * 32) * 64 + lane)
  f32x16 acc[4][2]; acc_zero<4>(acc);
  f32x16 acc2[1][2]; acc_zero<1>(acc2);
  if (wave < 4) {
    { const l64x2* wp[4] = {WSLOT(4 * wave), WSLOT(4 * wave + 1), WSLOT(4 * wave + 2), WSLOT(4 * wave + 3)}; gemm_slots_f8<4, 4, 32, true, 1, 0x3210>(acc, lds, 1024, wp, lane); }
    if (wave < 3) { const l64x2* wp[1] = {WSLOT(wave == 0 ? 34 : 27 + wave)}; gemm_slots_f8<1, 1, 32, true, 2, 0x0>(acc2, lds, 1024, wp, lane); }
  } else if (wave == 4) {
    { const l64x2* wp[4] = {WSLOT(16), WSLOT(17), WSLOT(18), WSLOT(19)}; gemm_slots_f8<4, 4, 32, true, 1, 0x3210>(acc, lds, 1024, wp, lane); }
    { const l64x2* wp[2] = {WSLOT(33), WSLOT(42)}; gemm_slots_f8<2, 1, 32, true, 1, 0x00>(acc2, lds, 1024, wp, lane); }
  } else if (wave == 7) {
    { const l64x2* wp[4] = {WSLOT(30), WSLOT(39), WSLOT(31), WSLOT(40)}; gemm_slots_f8<4, 4, 32, true, 1, 0x1100>(acc, lds, 1024, wp, lane); }
    { const l64x2* wp[2] = {WSLOT(32), WSLOT(41)}; gemm_slots_f8<2, 4, 32, true, 1, 0x22>(acc, lds, 1024, wp, lane); }
  } else {
    const int kv = wave - 5;
    { const l64x2* wp[4] = {WSLOT(20 + 2 * kv), WSLOT(35 + 2 * kv), WSLOT(21 + 2 * kv), WSLOT(36 + 2 * kv)}; gemm_slots_f8<4, 4, 32, false, 1, 0x1100>(acc, lds, 1024, wp, lane); }
    { const l64x2* wp[2] = {WSLOT(24 + 2 * kv), WSLOT(25 + 2 * kv)}; gemm_slots_f8<2, 4, 32, true, 1, 0x32>(acc, lds, 1024, wp, lane); }
  }
#undef WSLOT
  int tid2_ = mk_lane(); asm volatile("" : "+v"(tid2_)); const int lane2 = tid2_ & 63;
#define lane lane2
  const int r32e = lane2 & 31, hie = lane2 >> 5;
#define r32 r32e
#define hi hie
  if (wave < 4) {
#pragma unroll
    for (int p = 0; p < 2; ++p) { uchar* img = ws + WS_QA + ((size_t)(b * 8 + 2 * wave + p) * 64 + tb) * 8192;
#pragma unroll
      for (int rb = 0; rb < 2; ++rb) { const int rr = 32 * rb + r32; f32x16 ya, yb; rope64(acc[2 * p][rb], acc[2 * p + 1][rb], ya, yb, tabA + (size_t)(pos0 + rr) * 32, hi, QSCALE_A * WIN_DESCALE);
        store_img_qk(img, ya, rr, 0, 4, hi); store_img_qk(img, yb, rr, 32, 4, hi); } }
    if (wave == 0) {
#pragma unroll
      for (int rb = 0; rb < 2; ++rb) { const int rr = 32 * rb + r32; f32x16 y; rope32(acc2[0][rb], y, tabB + (size_t)(pos0 + rr) * 16, hi, WIN_DESCALE);
#pragma unroll
        for (int g = 0; g < 4; ++g) { u32x2 w; w.x = pk2(y[4 * g], y[4 * g + 1]); w.y = pk2(y[4 * g + 2], y[4 * g + 3]); *(LAS u32x2*)(krt + rr * 64 + (8 * g + 4 * hi) * 2) = w; } }
    }
  } else if (wave == 4) {
#pragma unroll
    for (int p = 0; p < 2; ++p) { uchar* img = ws + WS_KVA + ((size_t)(b * 2 + p) * 64 + tb) * 16384;
#pragma unroll
      for (int rb = 0; rb < 2; ++rb) { const int rr = 32 * rb + r32; f32x16 ya, yb; rope64(acc[2 * p][rb], acc[2 * p + 1][rb], ya, yb, tabA + (size_t)(pos0 + rr) * 32, hi, WIN_DESCALE);
        store_img_qk(img, ya, rr, 0, 4, hi); store_img_qk(img, yb, rr, 32, 4, hi); } }
  } else if (wave == 5 || wave == 6) {
    uchar* img = ws + WS_KVA + ((size_t)(b * 2 + (wave - 5)) * 64 + tb) * 16384 + 8192;
#pragma unroll
    for (int i = 0; i < 2; ++i)
#pragma unroll
      for (int rb = 0; rb < 2; ++rb) { const f32x16 y = acc[i][rb] * WIN_DESCALE; store_img_v(img, y, rb, 32 * i + r32, hi); }
  }
  __syncthreads();
  if (wave != 0 && wave != 3) {
#pragma unroll
    for (int rb = 0; rb < 2; ++rb) { const int rr = 32 * rb + r32; float sq = 0.f, skv = 0.f;
      if (wave == 5 || wave == 6) { sq += write_c_tile(lds, 512, acc[2][rb], rr, 64 * (wave - 5), hi); sq += write_c_tile(lds, 512, acc[3][rb], rr, 64 * (wave - 5) + 32, hi); }
      else if (wave == 1 || wave == 2) sq += write_c_tile(lds, 512, acc2[0][rb], rr, 96 + 32 * wave, hi);
      else if (wave == 7) { skv += write_c_tile(lds + 32768, 256, acc[0][rb], rr, 0, hi); skv += write_c_tile(lds + 32768, 256, acc[1][rb], rr, 32, hi); skv += write_c_tile(lds + 32768, 256, acc[2][rb], rr, 64, hi); }
      else skv += write_c_tile(lds + 32768, 256, acc2[0][rb], rr, 96, hi);
      if (wave == 4 || wave == 7) lds_fadd(&ssq[64 + rr], skv); else lds_fadd(&ssq[rr], sq); }
  }
  __syncthreads();
  const int head = wave;
  uchar* imgQ = ws + WS_QB + ((size_t)(b * 8 + head) * 64 + tb) * 8192;
  uchar* imgKV = ws + WS_KVB + ((size_t)(b * 8 + head) * 64 + tb) * 12288;
  {
    f32x16 aq[3][2]; acc_zero<3>(aq);
    const bf16x8* wp[3];
#pragma unroll
    for (int i = 0; i < 3; ++i) wp[i] = (const bf16x8*)(ws + WS_WUQ) + (size_t)((3 * head + i) * 12) * 64 + lane;
    gemm_tile<3, 12, true>(aq, lds, 512, wp, lane);
#pragma unroll
    for (int rb = 0; rb < 2; ++rb) { const int rr = 32 * rb + r32; const float sc = rsqrtf(ssq[rr] * (1.0f / 192.0f) + EPS) * (8.0f * QSCALE_B);
      f32x16 y0 = aq[0][rb] * sc, y1 = aq[1][rb] * sc, y2; rope32(aq[2][rb], y2, tabB + (size_t)(pos0 + rr) * 16, hi, sc);
      store_img8_qk(imgQ, y0, rb, r32, 0, hi); store_img8_qk(imgQ, y1, rb, r32, 1, hi); store_img8_qk(imgQ, y2, rb, r32, 2, hi);
      *(u32x4*)(imgQ + rb * 4096 + 3072 + lane * 16) = u32x4{0u, 0u, 0u, 0u}; }
  }
  {
    f32x16 ak[2][2]; acc_zero<2>(ak);
    const bf16x8* wp[2];
#pragma unroll
    for (int i = 0; i < 2; ++i) wp[i] = (const bf16x8*)(ws + WS_WUKV) + (size_t)((4 * head + i) * 8) * 64 + lane;
    gemm_tile<2, 8, true>(ak, lds + 32768, 256, wp, lane);
#pragma unroll
    for (int rb = 0; rb < 2; ++rb) { const int rr = 32 * rb + r32; const float sc = rsqrtf(ssq[64 + rr] * (1.0f / 128.0f) + EPS);
      f32x16 y0 = ak[0][rb] * sc, y1 = ak[1][rb] * sc; store_img8_qk(imgKV, y0, rb, r32, 0, hi); store_img8_qk(imgKV, y1, rb, r32, 1, hi); }
#pragma unroll
    for (int rb = 0; rb < 2; ++rb) {
      const u32x4 c0 = *(const LAS u32x4*)(krt + (32 * rb + r32) * 64 + hi * 32), c1 = *(const LAS u32x4*)(krt + (32 * rb + r32) * 64 + hi * 32 + 16);
      u32x4 w;
      w.x = pk4_fp8(__uint_as_float(c0.x << 16), __uint_as_float(c0.x & 0xffff0000u), __uint_as_float(c0.y << 16), __uint_as_float(c0.y & 0xffff0000u));
      w.y = pk4_fp8(__uint_as_float(c0.z << 16), __uint_as_float(c0.z & 0xffff0000u), __uint_as_float(c0.w << 16), __uint_as_float(c0.w & 0xffff0000u));
      w.z = pk4_fp8(__uint_as_float(c1.x << 16), __uint_as_float(c1.x & 0xffff0000u), __uint_as_float(c1.y << 16), __uint_as_float(c1.y & 0xffff0000u));
      w.w = pk4_fp8(__uint_as_float(c1.z << 16), __uint_as_float(c1.z & 0xffff0000u), __uint_as_float(c1.w << 16), __uint_as_float(c1.w & 0xffff0000u));
      *(u32x4*)(imgKV + rb * 4096 + 2048 + lane * 16) = w;
      *(u32x4*)(imgKV + rb * 4096 + 3072 + lane * 16) = u32x4{hi ? 0u : 0x00003838u, 0u, 0u, 0u}; }
  }
  {
    f32x16 avv[2][2]; acc_zero<2>(avv);
    const bf16x8* wp[2];
#pragma unroll
    for (int i = 0; i < 2; ++i) wp[i] = (const bf16x8*)(ws + WS_WUKV) + (size_t)((4 * head + 2 + i) * 8) * 64 + lane;
    gemm_tile<2, 8, false>(avv, lds + 32768, 256, wp, lane);
#pragma unroll
    for (int rb = 0; rb < 2; ++rb) { f32x16 sc;
#pragma unroll
      for (int reg = 0; reg < 16; ++reg) sc[reg] = rsqrtf(ssq[64 + 32 * rb + crow(reg, hi)] * (1.0f / 128.0f) + EPS);
#pragma unroll
      for (int i = 0; i < 2; ++i) { f32x16 y = avv[i][rb] * sc; store_img8_v(imgKV + 8192, y, rb, i, r32, hi); } }
  }
  __syncthreads();
#undef lane
#undef r32
#undef hi
}
__device__ __forceinline__ float tile_max(const f32x16& p0, const f32x16& p1) {
  float t = __builtin_amdgcn_fmed3f(p0[0], p1[0], 3.0e38f);
  asm("v_max3_f32 %0, %0, %1, %2\n\tv_max3_f32 %0, %0, %3, %4\n\tv_max3_f32 %0, %0, %5, %6\n\tv_max3_f32 %0, %0, %7, %8\n\t"
      "v_max3_f32 %0, %0, %9, %10\n\tv_max3_f32 %0, %0, %11, %12\n\tv_max3_f32 %0, %0, %13, %14\n\tv_max3_f32 %0, %0, %15, %16"
      : "+v"(t) : "v"(p0[1]), "v"(p1[1]), "v"(p0[2]), "v"(p1[2]), "v"(p0[3]), "v"(p1[3]), "v"(p0[4]), "v"(p1[4]), "v"(p0[5]), "v"(p1[5]), "v"(p0[6]), "v"(p1[6]), "v"(p0[7]), "v"(p1[7]), "v"(p0[8]), "v"(p1[8]));
  asm("v_max3_f32 %0, %0, %1, %2\n\tv_max3_f32 %0, %0, %3, %4\n\tv_max3_f32 %0, %0, %5, %6\n\tv_max3_f32 %0, %0, %7, %8\n\t"
      "v_max3_f32 %0, %0, %9, %10\n\tv_max3_f32 %0, %0, %11, %12\n\tv_max3_f32 %0, %0, %13, %14"
      : "+v"(t) : "v"(p0[9]), "v"(p1[9]), "v"(p0[10]), "v"(p1[10]), "v"(p0[11]), "v"(p1[11]), "v"(p0[12]), "v"(p1[12]), "v"(p0[13]), "v"(p1[13]), "v"(p0[14]), "v"(p1[14]), "v"(p0[15]), "v"(p1[15]));
  return t;
}
constexpr float PXG = 128.0f / 65535.0f;
__device__ __forceinline__ void softmax_tile(f32x16& p0, f32x16& p1, f32x16& negm, float& m, float& l, f32x16& o0, f32x16& o1, bf16x8 (&pb)[2][2]) {
  const float tmax = half_swap_max(tile_max(p0, p1));
  if (__any(tmax > PXG * (127.0f + THR2))) {
    const float dm = fmaxf(tmax * (1.0f / PXG) - 127.0f, 0.f), alpha = __builtin_amdgcn_exp2f(-dm), dp = dm * PXG;
    m += dm; l *= alpha;
#pragma unroll
    for (int r = 0; r < 16; ++r) { o0[r] *= alpha; o1[r] *= alpha; p0[r] -= dp; p1[r] -= dp; negm[r] = PXG * (127.0f - m); }
  }
  typedef __bf16 bf2 __attribute__((ext_vector_type(2)));
  const bf2 one2 = __builtin_bit_cast(bf2, 0x3f803f80u);
  float s = 0.f;
#pragma unroll
  for (int ks = 0; ks < 2; ++ks) {
    unsigned a[4], c[4];
#pragma unroll
    for (int i = 0; i < 4; ++i) { a[i] = mk_pknorm(p0[8 * ks + 2 * i], p0[8 * ks + 2 * i + 1]); c[i] = mk_pknorm(p1[8 * ks + 2 * i], p1[8 * ks + 2 * i + 1]);
      s = __builtin_amdgcn_fdot2_f32_bf16(__builtin_bit_cast(bf2, a[i]), one2, s, false); s = __builtin_amdgcn_fdot2_f32_bf16(__builtin_bit_cast(bf2, c[i]), one2, s, false); }
    const u32x4 w0 = {a[0], a[1], a[2], a[3]}, w1 = {c[0], c[1], c[2], c[3]};
    pb[0][ks] = __builtin_bit_cast(bf16x8, w0); pb[1][ks] = __builtin_bit_cast(bf16x8, w1);
  }
  l += s;
}
__device__ __forceinline__ void pv_tile(const LAS uchar* vimg, const bf16x8 (&pb)[2][2], f32x16& o0, f32x16& o1, int lane) {
#pragma unroll
  for (int kb = 0; kb < 2; ++kb)
#pragma unroll
    for (int ks = 0; ks < 2; ++ks) {
      const bf16x8 v0 = *(const LAS bf16x8*)(vimg + ((((kb * 2 + 0) * 2 + ks) * 64) + lane) * 16);
      const bf16x8 v1 = *(const LAS bf16x8*)(vimg + ((((kb * 2 + 1) * 2 + ks) * 64) + lane) * 16);
      o0 = mfma(v0, pb[kb][ks], o0); o1 = mfma(v1, pb[kb][ks], o1);
    }
}
__device__ __forceinline__ void store_o(bf16_t* __restrict__ orow, f32x16& o0, f32x16& o1, float l, int hi) {
  const float inv = 1.0f / half_swap_sum(l);
#pragma unroll
  for (int g = 0; g < 4; ++g) {
    u32x2 w; w.x = pk2(o0[4 * g] * inv, o0[4 * g + 1] * inv); w.y = pk2(o0[4 * g + 2] * inv, o0[4 * g + 3] * inv); *(u32x2*)(orow + 8 * g + 4 * hi) = w;
    u32x2 z; z.x = pk2(o1[4 * g] * inv, o1[4 * g + 1] * inv); z.y = pk2(o1[4 * g + 2] * inv, o1[4 * g + 3] * inv); *(u32x2*)(orow + 32 + 8 * g + 4 * hi) = z;
  }
}

__device__ __forceinline__ void store_o_l(bf16_t* __restrict__ orow, f32x16& o0, f32x16& o1, float ltot, int hi) {
  const float inv = 1.0f / ltot;
#pragma unroll
  for (int g = 0; g < 4; ++g) {
    u32x2 w; w.x = pk2(o0[4 * g] * inv, o0[4 * g + 1] * inv); w.y = pk2(o0[4 * g + 2] * inv, o0[4 * g + 3] * inv); *(u32x2*)(orow + 8 * g + 4 * hi) = w;
    u32x2 z; z.x = pk2(o1[4 * g] * inv, o1[4 * g + 1] * inv); z.y = pk2(o1[4 * g + 2] * inv, o1[4 * g + 3] * inv); *(u32x2*)(orow + 32 + 8 * g + 4 * hi) = z;
  }
}
constexpr int SWA_LDS = 49152;
__device__ __forceinline__ void swa_unit(const KP& P, LAS uchar* lds_all, int u, bool prefetched) {
  LAS uchar* lds = lds_all + SWA_LDS;
  int lane_ = mk_lane(); asm volatile("" : "+v"(lane_)); const int lane = lane_ & 63, wave = P.wave, tid = wave * 64 + lane, r32 = lane & 31, hi = lane >> 5;
  uchar* ws = P.ws;
  const int n = u & 31, kvh = (u >> 5) & 1, b = u >> 6;
  const uchar* kvimg = ws + WS_KVA + (size_t)(b * 2 + kvh) * 64 * 16384;
  if (!prefetched) {
#pragma unroll 1
    for (int jt = 0; jt < 6; ++jt) { const int gt = 2 * n - 2 + jt; if (gt < 0 || gt >= 64) continue;
      const u32x4* src = (const u32x4*)(kvimg + (size_t)gt * 16384); LAS u32x4* dst = (LAS u32x4*)(lds + jt * 16384);
      const u32x4 v0 = src[tid], v1 = src[tid + 512]; dst[tid] = v0; dst[tid + 512] = v1; }
  }
  __syncthreads();
  const int rbq = wave & 3, jlo = rbq >> 1;
  bf16_t* O = (bf16_t*)(ws + WS_O);
#pragma unroll 1
  for (int hh = 0; hh < 2; ++hh) {
    const int head = kvh * 4 + 2 * (wave >> 2) + hh;
    const uchar* qimg = ws + WS_QA + ((size_t)(b * 8 + head) * 64 + 2 * n + (rbq >> 1)) * 8192;
    bf16x8 qf[4];
#pragma unroll
    for (int s = 0; s < 4; ++s) qf[s] = *(const bf16x8*)(qimg + ((((rbq & 1) * 4 + s) * 64) + lane) * 16);
    const float sink2 = P.in[10][head] * LOG2E;
    float m = sink2, l = hi ? 0.f : 1.f; f32x16 negm, o0 = {}, o1 = {};
#pragma unroll
    for (int r = 0; r < 16; ++r) negm[r] = PXG * (127.0f - sink2);
#pragma unroll 1
    for (int jt = jlo; jt < jlo + 5; ++jt) { const int gt = 2 * n - 2 + jt; if (gt < 0 || gt >= 64) continue;
      const LAS uchar* kimg = lds + jt * 16384;
      f32x16 p0 = negm, p1 = negm;
#pragma unroll
      for (int s = 0; s < 4; ++s) { const bf16x8 k0 = *(const LAS bf16x8*)(kimg + (((0 * 4 + s) * 64) + lane) * 16), k1 = *(const LAS bf16x8*)(kimg + (((1 * 4 + s) * 64) + lane) * 16);
        p0 = mfma(k0, qf[s], p0); p1 = mfma(k1, qf[s], p1); }
      if (jt == jlo || jt == jlo + 4) { const int base = 64 * jt - 32 * rbq - r32;
#pragma unroll
        for (int r = 0; r < 16; ++r) { const int d0 = base + crow(r, hi);
          p0[r] = ((unsigned)d0 <= 256u) ? p0[r] : -1e30f; p1[r] = ((unsigned)(d0 + 32) <= 256u) ? p1[r] : -1e30f; } }
      bf16x8 pb[2][2];
      softmax_tile(p0, p1, negm, m, l, o0, o1, pb);
      pv_tile(kimg + 8192, pb, o0, o1, lane);
    }
    store_o(O + (size_t)(b * SEQ + n * 128 + 32 * rbq + r32) * DM + head * 64, o0, o1, l, hi);
  }
  __syncthreads();
}

#define MK_LDS_RD(dst, vaddr, imm) asm volatile("ds_read_b128 %0, %1 offset:%2" : "=v"(dst) : "v"(vaddr), "i"(imm))
template <int N> __device__ __forceinline__ void lgkm_wait() { asm volatile("s_waitcnt lgkmcnt(%0)" :: "i"(N) : "memory"); __builtin_amdgcn_sched_barrier(0); }
__device__ __forceinline__ void pv_regs(const bf16x8 (&vf)[8], const bf16x8 (&pb)[2][2], f32x16& o0, f32x16& o1) {
#pragma unroll
  for (int kb = 0; kb < 2; ++kb)
#pragma unroll
    for (int ks = 0; ks < 2; ++ks) { o0 = mfma(vf[(kb * 2 + 0) * 2 + ks], pb[kb][ks], o0); o1 = mfma(vf[(kb * 2 + 1) * 2 + ks], pb[kb][ks], o1); }
}
__device__ __forceinline__ void mla_dma_step(const uchar* kvimg, LAS uchar* lds, int t, int wave, int lane) {
  const uchar* src = kvimg + (size_t)t * 24576 + wave * 3072 + lane * 16;
  LAS uchar* dst = lds + (t & 1) * 24576 + wave * 3072;
#pragma unroll
  for (int i = 0; i < 3; ++i) __builtin_amdgcn_global_load_lds((const unsigned*)(src + i * 1024), (LAS unsigned*)(dst + i * 1024), 16, 0, 0);
}
template <bool FIRST_POSSIBLE>
__device__ __forceinline__ float softmax_tile8(f32x16& p0, f32x16& p1, float& pad, int& qpad, f32x16& lacc, f32x16& o0, f32x16& o1, bool first, int hi, i32x4& pb0, i32x4& pb1) {
  float applied = 0.f;
  const float tmax_s = half_swap_max(tile_max(p0, p1));
  const bool fst = FIRST_POSSIBLE && first;
  if (fst || __any(tmax_s > 120.5f / 256.0f)) {
    const float tmax = tmax_s * 256.0f;
    const float want = fst ? tmax - 96.5f : fmaxf(tmax - 96.5f, 0.f);
    const float nt = pad - want;
    const int wa = __builtin_amdgcn_cvt_pk_fp8_f32(nt, 0.f, 0, false); const float fa = __builtin_amdgcn_cvt_f32_fp8(wa, 0);
    const int wb = __builtin_amdgcn_cvt_pk_fp8_f32(nt - fa, 0.f, 0, false); const float fb = __builtin_amdgcn_cvt_f32_fp8(wb, 0);
    const float pnew = fa + fb, dt = pad - pnew, dts = dt * (1.0f / 256.0f);
    const float alpha = fst ? 1.0f : __builtin_amdgcn_exp2f(-0.125f * dt);
    pad = pnew; applied = dts; qpad = hi ? 0 : ((wa & 0xff) | ((wb & 0xff) << 8));
#pragma unroll
    for (int r = 0; r < 16; ++r) { o0[r] *= alpha; o1[r] *= alpha; lacc[r] *= alpha; p0[r] -= dts; p1[r] -= dts; }
  }
#define MK_P8(P, R) __builtin_amdgcn_perm(mk_pknorm(P[(R) + 2], P[(R) + 3]), mk_pknorm(P[R], P[(R) + 1]), 0x07050301u)
  pb0.x = (int)MK_P8(p0, 0); pb0.y = (int)MK_P8(p0, 4); pb0.z = (int)MK_P8(p0, 8); pb0.w = (int)MK_P8(p0, 12);
  pb1.x = (int)MK_P8(p1, 0); pb1.y = (int)MK_P8(p1, 4); pb1.z = (int)MK_P8(p1, 8); pb1.w = (int)MK_P8(p1, 12);
#undef MK_P8
  return applied;
}
constexpr int N_PACK_JOBS = 3 * 8192;
struct PackJob { const float* p; int ldw; u32x4* dst; float scale; };
__device__ __forceinline__ PackJob pack_job(const KP& P, int f, int lane) {
  const int which = f >> 13, ff = f & 8191, r = lane & 31, h = lane >> 5, e = ff >> 8; PackJob j;
  if (which < 2) { const int nb = (ff >> 5) & 7, s = ff & 31; j.ldw = 256; j.scale = WGU_SCALE;
    j.p = P.in[19 + which] + (size_t)e * DM * 256 + (size_t)(32 * s + 16 * h) * 256 + 32 * nb + r; j.dst = (u32x4*)(P.ws + (which ? WS_WU : WS_WG)) + (size_t)ff * 64 + lane; }
  else { const int nb = (ff >> 3) & 31, s = ff & 7; j.ldw = DM; j.scale = WD_SCALE;
    j.p = P.in[21] + (size_t)e * 256 * DM + (size_t)(32 * s + 16 * h) * DM + 32 * nb + r; j.dst = (u32x4*)(P.ws + WS_WD) + (size_t)ff * 64 + lane; }
  return j;
}
__device__ __forceinline__ u32x4 pack_cvt(const float (&v)[16], float sc) {
  u32x4 w; w.x = pk4_fp8(v[0] * sc, v[1] * sc, v[2] * sc, v[3] * sc); w.y = pk4_fp8(v[4] * sc, v[5] * sc, v[6] * sc, v[7] * sc);
  w.z = pk4_fp8(v[8] * sc, v[9] * sc, v[10] * sc, v[11] * sc); w.w = pk4_fp8(v[12] * sc, v[13] * sc, v[14] * sc, v[15] * sc); return w;
}
__device__ __forceinline__ void mla_unit(const KP& P, LAS uchar* lds, int b, int head, int qblk, int& pk_k, int swa_u) {
  int lane_ = mk_lane(); asm volatile("" : "+v"(lane_)); const int lane = lane_ & 63, wave = P.wave, r32 = lane & 31, hi = lane >> 5;
  uchar* ws = P.ws;
  const uchar* kvimg = ws + WS_KVB + (size_t)(b * 8 + head) * 64 * 12288;
  const uchar* qimg = ws + WS_QB + ((size_t)(b * 8 + head) * 64 + qblk * 4 + (wave >> 1)) * 8192 + (wave & 1) * 4096 + lane * 16;
  const int gw = blockIdx.x * NWAVE + wave, NGW = gridDim.x * NWAVE;
  const i32x4 q00 = *(const i32x4*)(qimg), q01 = *(const i32x4*)(qimg + 1024), q10 = *(const i32x4*)(qimg + 2048);
  float pad = 56.5f; int qpad = hi ? 0 : 0x3066;
  f32x16 o0 = {}, o1 = {}, lacc = {};
  i32x8 ones8 = {0x38383838, 0x38383838, 0x38383838, 0x38383838, 0x38383838, 0x38383838, 0x38383838, 0x38383838};
  asm volatile("" : "+v"(ones8));
  mla_dma_step(kvimg, lds, 0, wave, lane);
#pragma unroll 1
  for (int t = 0; t < 32; ++t) {
    asm volatile("s_waitcnt vmcnt(0)" ::: "memory");
    __syncthreads();
    if (t + 1 < 32 && !(P.variant & 4)) mla_dma_step(kvimg, lds, t + 1, wave, lane);
    if (P.variant & 8) continue;
    u32x4 bandv = {}; int band_off = -1;
    if (swa_u >= 0 && t >= 20) { const int c = (wave * 64 + lane) + 512 * (t - 20), jt = c >> 10, gt = 2 * (swa_u & 31) - 2 + jt;
      if (gt >= 0 && gt < 64) { band_off = c * 16; bandv = *(const u32x4*)(ws + WS_KVA + ((size_t)((swa_u >> 6) * 2 + ((swa_u >> 5) & 1)) * 64 + gt) * 16384 + (c & 1023) * 16); } }
    const int pf = gw + pk_k * NGW; const bool do_pack = pf < N_PACK_JOBS;
    float pv[16]; u32x4* pdst = nullptr; float psc = 0.f;
    if (do_pack) { const PackJob j = pack_job(P, pf, lane); pdst = j.dst; psc = j.scale;
#pragma unroll
      for (int q = 0; q < 16; ++q) pv[q] = __builtin_nontemporal_load(j.p + (size_t)q * j.ldw); }
    f32x16 a0, a1, b0, b1; i32x4 pb0, pb1;
    { const unsigned va = (unsigned)(unsigned long)(lds + (t & 1) * 24576) + lane * 16;
#define MK_KOFF(j) (((j) >> 2) * 12288 + (((j) >> 1) & 1) * 4096 + ((j) & 1) * 2048)
      i32x4 kf[4][2];
#define MK_KRD(j) { MK_LDS_RD(kf[(j) & 3][0], va, MK_KOFF(j)); MK_LDS_RD(kf[(j) & 3][1], va, MK_KOFF(j) + 1024); }
      MK_KRD(0) MK_KRD(1) MK_KRD(2) MK_KRD(3)
      const i32x4 q11 = {qpad, 0, 0, 0};
#define MK_QK_STEP(j, ACC, NW) { lgkm_wait<NW>(); ACC = ((j) & 1) ? mfma_mx_q(kf[(j) & 3][0], kf[(j) & 3][1], q10, q11, ACC) : mfma_mx_q(kf[(j) & 3][0], kf[(j) & 3][1], q00, q01, f32x16{}); if ((j) + 4 < 8) MK_KRD(((j) + 4) & 7) }
      MK_QK_STEP(0, a0, 6) MK_QK_STEP(1, a0, 6) MK_QK_STEP(2, a1, 6) MK_QK_STEP(3, a1, 6) MK_QK_STEP(4, b0, 6) MK_QK_STEP(5, b0, 4) MK_QK_STEP(6, b1, 2) MK_QK_STEP(7, b1, 0)
#undef MK_QK_STEP
#undef MK_KRD
#undef MK_KOFF
      i32x4 vf[4];
#define MK_VRD(tile) { MK_LDS_RD(vf[0], va, (tile) * 12288 + 8192); MK_LDS_RD(vf[1], va, (tile) * 12288 + 8192 + 1024); MK_LDS_RD(vf[2], va, (tile) * 12288 + 8192 + 2048); MK_LDS_RD(vf[3], va, (tile) * 12288 + 8192 + 3072); }
      MK_VRD(0)
      const float dA = softmax_tile8<true>(a0, a1, pad, qpad, lacc, o0, o1, t == 0, hi, pb0, pb1);
      lacc = mfma_mx8(ones8, __builtin_shufflevector(pb0, pb1, 0, 1, 2, 3, 4, 5, 6, 7), lacc);
      lgkm_wait<0>();
      o0 = mfma_mx(vf[0], vf[1], pb0, pb1, o0); o1 = mfma_mx(vf[2], vf[3], pb0, pb1, o1);
      MK_VRD(1)
#undef MK_VRD
      if (__any(dA != 0.f)) {
#pragma unroll
        for (int r = 0; r < 16; ++r) { b0[r] -= dA; b1[r] -= dA; }
      }
      (void)softmax_tile8<false>(b0, b1, pad, qpad, lacc, o0, o1, false, hi, pb0, pb1);
      lacc = mfma_mx8(ones8, __builtin_shufflevector(pb0, pb1, 0, 1, 2, 3, 4, 5, 6, 7), lacc);
      lgkm_wait<0>();
      o0 = mfma_mx(vf[0], vf[1], pb0, pb1, o0); o1 = mfma_mx(vf[2], vf[3], pb0, pb1, o1);
    }
    if (do_pack) { *pdst = pack_cvt(pv, psc); ++pk_k; }
    if (band_off >= 0) *(LAS u32x4*)(lds + SWA_LDS + band_off) = bandv;
  }
  if (!(P.variant & 12)) store_o_l((bf16_t*)(ws + WS_O) + (size_t)(b * SEQ + qblk * 256 + 32 * wave + r32) * DM + 512 + head * 64, o0, o1, lacc[0], hi);
  __syncthreads();
}
__device__ __forceinline__ void phase2(const KP& P, LAS uchar* lds) {
  const int bid = blockIdx.x;
  int pk_k = 0;
  const bool pref = gridDim.x == 256 && !(P.variant & 3);
  if (!(P.variant & 2)) for (int i = bid; i < 512; i += gridDim.x) {
    const int rr = i >> 8, ii = i & 255, xcd = ii & 7, local = ii >> 3, pair = xcd * 4 + rr * 2 + (local >> 4), qblk = local & 15;
    mla_unit(P, lds, pair >> 3, pair & 7, qblk, pk_k, (pref && i >= 256) ? bid : -1);
  }
  if (!(P.variant & 1)) for (int u = bid; u < 256; u += gridDim.x) swa_unit(P, lds, u, pref);
  { const int lane = mk_lane(), wave = P.wave, gw = bid * NWAVE + wave, NGW = gridDim.x * NWAVE;
    for (int f = gw + pk_k * NGW; f < N_PACK_JOBS; f += NGW) { const PackJob j = pack_job(P, f, lane); float v[16];
#pragma unroll
      for (int q = 0; q < 16; ++q) v[q] = j.p[(size_t)q * j.ldw];
      *j.dst = pack_cvt(v, j.scale); } }
}
__device__ __forceinline__ void phase3_tile(const KP& P, LAS uchar* lds, const int tile) {
  int lane_ = mk_lane(); asm volatile("" : "+v"(lane_)); const int lane = lane_ & 63, wave = P.wave, tid = wave * 64 + lane, r32 = lane & 31, hi = lane >> 5;
  uchar* ws = P.ws;
  const int t0 = tile * 64, b = t0 / SEQ;
  const float* __restrict__ x = P.in[0]; const float* __restrict__ mod = (const float*)(ws + WS_MOD) + b * (NMOD * DM);
  LAS float* ssq = (LAS float*)(lds + LDS_MISC + 64);
  LAS int* selE = (LAS int*)(lds + LDS_MISC + 1024);
  LAS float* selW = (LAS float*)(lds + LDS_MISC + 1536);
  LAS int* selP = (LAS int*)(lds + LDS_MISC + 2048);
  LAS int* cntl = (LAS int*)(lds + LDS_MISC + 2560);
  LAS int* basel = (LAS int*)(lds + LDS_MISC + 2688);
  LAS float* logit = (LAS float*)(lds + LDS_MISC + 8192);
  if (tid < 64) ssq[tid] = 0.f;
  if (tid < 32) cntl[tid] = 0;
  {
    const bf16_t* O = (const bf16_t*)(ws + WS_O);
    float ga[8], gb[8];
#pragma unroll
    for (int j = 0; j < 8; ++j) { ga[j] = P.in[11][8 * lane + j]; gb[j] = P.in[12][8 * lane + j]; }
#pragma unroll
    for (int hf = 0; hf < 2; ++hf) {
      u32x4 va[4], vb[4];
#pragma unroll
      for (int rr = 0; rr < 4; ++rr) { const u32x4* src = (const u32x4*)(O + (size_t)(t0 + wave * 8 + hf * 4 + rr) * DM); va[rr] = __builtin_nontemporal_load(src + lane); vb[rr] = __builtin_nontemporal_load(src + lane + 64); }
#pragma unroll
      for (int rr = 0; rr < 4; ++rr) {
        const int row = wave * 8 + hf * 4 + rr; float fa[8], fb[8], sa = 0.f, sb = 0.f;
#pragma unroll
        for (int q = 0; q < 4; ++q) { fa[2 * q] = __uint_as_float(va[rr][q] << 16); fa[2 * q + 1] = __uint_as_float(va[rr][q] & 0xffff0000u);
          fb[2 * q] = __uint_as_float(vb[rr][q] << 16); fb[2 * q + 1] = __uint_as_float(vb[rr][q] & 0xffff0000u); }
#pragma unroll
        for (int j = 0; j < 8; ++j) { sa += fa[j] * fa[j]; sb += fb[j] * fb[j]; }
        sa = wave_sum(sa); sb = wave_sum(sb);
        const float ra = rsqrtf(sa * (1.0f / 512.0f) + EPS), rb_ = rsqrtf(sb * (1.0f / 512.0f) + EPS);
        u32x4 wa, wb;
#pragma unroll
        for (int q = 0; q < 4; ++q) { wa[q] = pk2(fa[2 * q] * ra * ga[2 * q], fa[2 * q + 1] * ra * ga[2 * q + 1]); wb[q] = pk2(fb[2 * q] * rb_ * gb[2 * q], fb[2 * q + 1] * rb_ * gb[2 * q + 1]); }
        *(LAS u32x4*)(lds + a_off(row, 16 * lane, 2048)) = wa; *(LAS u32x4*)(lds + a_off(row, 16 * (lane + 64), 2048)) = wb;
      }
    }
  }
  __syncthreads();
  f32x16 acc[4][2]; acc_zero<4>(acc);
  { const bf16x8* wp[4];
#pragma unroll
    for (int i = 0; i < 4; ++i) wp[i] = (const bf16x8*)(ws + WS_WOUT) + (size_t)((4 * wave + i) * 64) * 64 + lane;
    gemm_tile<4, 64, false, 5>(acc, lds, 2048, wp, lane); }
  if (P.variant & 2) { asm volatile("" :: "v"(acc[0][0][0]), "v"(acc[1][1][3]), "v"(acc[2][0][7]), "v"(acc[3][1][15])); return; }
  bf16_t* X1 = (bf16_t*)(ws + WS_X1); const unsigned short* XB = (const unsigned short*)(ws + WS_XB);
  float gt[4];
#pragma unroll
  for (int i = 0; i < 4; ++i) gt[i] = mod[2 * DM + 128 * wave + 32 * i + r32];
#pragma unroll
  for (int rb = 0; rb < 2; ++rb) {
    float xr[16][4];
#pragma unroll
    for (int reg = 0; reg < 16; ++reg) { const size_t off = (size_t)(t0 + 32 * rb + crow(reg, hi)) * DM + 128 * wave + r32;
#pragma unroll
      for (int i = 0; i < 4; ++i) xr[reg][i] = __uint_as_float((unsigned)__builtin_nontemporal_load(XB + off + 32 * i) << 16); }
#pragma unroll
    for (int reg = 0; reg < 16; ++reg) { const int row = 32 * rb + crow(reg, hi); const size_t off = (size_t)(t0 + row) * DM + 128 * wave + r32; float ss = 0.f;
#pragma unroll
      for (int i = 0; i < 4; ++i) { const float v = xr[reg][i] + gt[i] * acc[i][rb][reg]; acc[i][rb][reg] = v; st_wt(X1 + off + 32 * i, (bf16_t)(pk2(v, 0.f) & 0xffffu)); ss += v * v; }
#pragma unroll
      for (int o = 16; o; o >>= 1) ss += __shfl_xor(ss, o);
      if (r32 == 0) lds_fadd(&ssq[row], ss); }
  }
  __syncthreads();
  { float a2[4], s2[4];
#pragma unroll
    for (int i = 0; i < 4; ++i) { const int col = 128 * wave + 32 * i + r32; a2[i] = P.in[14][col] * (1.0f + mod[4 * DM + col]); s2[i] = mod[3 * DM + col]; }
#pragma unroll
    for (int rb = 0; rb < 2; ++rb)
#pragma unroll
      for (int reg = 0; reg < 16; ++reg) { const int row = 32 * rb + crow(reg, hi); const float rs = rsqrtf(ssq[row] * (1.0f / DM) + EPS);
#pragma unroll
        for (int i = 0; i < 4; ++i) { const float v = acc[i][rb][reg] * rs * a2[i] + s2[i]; const int col = 128 * wave + 32 * i + r32;
          *(LAS bf16_t*)(lds + a_off(row, 2 * col, 2048)) = (bf16_t)(pk2(v, v) & 0xffffu); } }
  }
  __syncthreads();
  if (P.variant & 1) return;
  if (wave < 4) {
    f32x16 ar[1][2]; acc_zero<1>(ar);
    const bf16x8* wp[1]; wp[0] = (const bf16x8*)(ws + WS_WR) + (size_t)((wave >> 1) * 64) * 64 + lane;
    gemm_tile<1, 64, false>(ar, lds, 2048, wp, lane);
    const int rb = wave & 1, col = 32 * (wave >> 1) + r32;
#pragma unroll
    for (int reg = 0; reg < 16; ++reg) { const float v = rb ? ar[0][1][reg] : ar[0][0][reg]; logit[(32 * rb + crow(reg, hi)) * 64 + col] = v; }
  }
  { uchar* H2 = ws + WS_H2;
#pragma unroll
    for (int rr = 0; rr < 8; ++rr) { const int row = wave * 8 + rr;
      const u32x4 v0 = *(const LAS u32x4*)(lds + a_off(row, 16 * lane, 2048)), v1 = *(const LAS u32x4*)(lds + a_off(row, 16 * (lane + 64), 2048));
      u32x2 w0, w1;
      w0.x = pk4_fp8(__uint_as_float(v0.x << 16) * H2_SCALE, __uint_as_float(v0.x & 0xffff0000u) * H2_SCALE, __uint_as_float(v0.y << 16) * H2_SCALE, __uint_as_float(v0.y & 0xffff0000u) * H2_SCALE);
      w0.y = pk4_fp8(__uint_as_float(v0.z << 16) * H2_SCALE, __uint_as_float(v0.z & 0xffff0000u) * H2_SCALE, __uint_as_float(v0.w << 16) * H2_SCALE, __uint_as_float(v0.w & 0xffff0000u) * H2_SCALE);
      w1.x = pk4_fp8(__uint_as_float(v1.x << 16) * H2_SCALE, __uint_as_float(v1.x & 0xffff0000u) * H2_SCALE, __uint_as_float(v1.y << 16) * H2_SCALE, __uint_as_float(v1.y & 0xffff0000u) * H2_SCALE);
      w1.y = pk4_fp8(__uint_as_float(v1.z << 16) * H2_SCALE, __uint_as_float(v1.z & 0xffff0000u) * H2_SCALE, __uint_as_float(v1.w << 16) * H2_SCALE, __uint_as_float(v1.w & 0xffff0000u) * H2_SCALE);
      u32x2* dst = (u32x2*)(H2 + (size_t)(t0 + row) * DM); dst[lane] = w0; dst[lane + 64] = w1; } }
  __syncthreads();
  if (tid < 64) {
    const float* lg = (const float*)0; (void)lg;
    float gl[4];
#pragma unroll
    for (int i = 0; i < 4; ++i) gl[i] = logit[tid * 64 + i] + P.in[16][i];
    int gi = 0; float gm = gl[0];
#pragma unroll
    for (int i = 1; i < 4; ++i) if (gl[i] > gm) { gm = gl[i]; gi = i; }
    float gs = 0.f;
#pragma unroll
    for (int i = 0; i < 4; ++i) gs += __expf(gl[i] - gm);
    const float gw = 1.0f / gs;
    float el[8];
#pragma unroll
    for (int i = 0; i < 8; ++i) el[i] = logit[tid * 64 + 4 + gi * 8 + i] + P.in[18][gi * 8 + i];
    int i1 = 0; float m1 = el[0];
#pragma unroll
    for (int i = 1; i < 8; ++i) if (el[i] > m1) { m1 = el[i]; i1 = i; }
    int i2 = (i1 + 1) & 7; float m2 = el[i2];
#pragma unroll
    for (int i = 0; i < 8; ++i) if (i != i1 && el[i] > m2) { m2 = el[i]; i2 = i; }
    const float p2 = __expf(m2 - m1), w1 = 1.0f / (1.0f + p2), w2 = p2 * w1;
    const int e1 = gi * 8 + i1, e2 = gi * 8 + i2;
    selE[2 * tid] = e1; selE[2 * tid + 1] = e2; selW[2 * tid] = gw * w1; selW[2 * tid + 1] = gw * w2;
    selP[2 * tid] = __hip_atomic_fetch_add(&cntl[e1], 1, __ATOMIC_RELAXED, __HIP_MEMORY_SCOPE_WORKGROUP);
    selP[2 * tid + 1] = __hip_atomic_fetch_add(&cntl[e2], 1, __ATOMIC_RELAXED, __HIP_MEMORY_SCOPE_WORKGROUP);
  }
  __syncthreads();
  if (tid < 32) { const int c = cntl[tid]; basel[tid] = c ? atomicAdd((int*)(ws + WS_CNT) + tid, c) : 0; }
  __syncthreads();
  if (tid < 128) { const int e = selE[tid], pos = basel[e] + selP[tid];
    ((int*)(ws + WS_LIST))[(size_t)e * 16384 + pos] = (t0 + (tid >> 1)) * 2 + (tid & 1);
    ((float*)(ws + WS_WT))[(size_t)(t0 + (tid >> 1)) * 2 + (tid & 1)] = selW[tid]; }
  __syncthreads();
}

constexpr int P4_ROWS = 144, P4_NRB = 5, P4_MISC = P4_ROWS * 1024;
__device__ __forceinline__ void phase4(const KP& P, LAS uchar* lds) {
  int lane_ = mk_lane(); asm volatile("" : "+v"(lane_)); const int lane = lane_ & 63, wave = P.wave, tid = wave * 64 + lane, r32 = lane & 31, hi = lane >> 5;
  uchar* ws = P.ws;
  LAS int* rinfo = (LAS int*)(lds + P4_MISC + 1024);
  LAS float* rwt = (LAS float*)(lds + P4_MISC + 2048);
  LAS int* ustart = (LAS int*)(lds + P4_MISC + 3072);
  const int* cnt = (const int*)(ws + WS_CNT);
  if (tid == 0) { int acc_ = 0; for (int e = 0; e < 32; ++e) { ustart[e] = acc_; acc_ += (cnt[e] + P4_ROWS - 1) / P4_ROWS; } ustart[32] = acc_; }
  __syncthreads();
  const int total = ustart[32];
  const uchar* H2 = ws + WS_H2; bf16_t* Y = (bf16_t*)(ws + WS_Y);
#pragma unroll 1
  for (int u0 = blockIdx.x; u0 < ((total + 255) & ~255); u0 += gridDim.x) {
    const int u = gridDim.x == 256 ? (u0 & ~255) + (u0 & 7) * 32 + ((u0 & 255) >> 3) : u0;
    if (u >= total) continue;
    int e = 0;
#pragma unroll 1
    for (int k = 1; k < 32; ++k) if (ustart[k] <= u) e = k;
    const int ne = cnt[e], ke = ustart[e + 1] - ustart[e], q = (ne + ke - 1) / ke, j = u - ustart[e], base = j * q, len = min(q, ne - base), nrb = (len + 31) >> 5;
    if (tid < 160) { int info = -1; float w = 0.f;
      if (tid < len) { info = ((const int*)(ws + WS_LIST))[(size_t)e * 16384 + base + tid]; w = ((const float*)(ws + WS_WT))[info]; }
      rinfo[tid] = info; rwt[tid] = w; }
    __syncthreads();
#pragma unroll
    for (int hf = 0; hf < 2; ++hf) {
      u32x4 v[9];
#pragma unroll
      for (int rr = 0; rr < 9; ++rr) { const int info = rinfo[wave * 18 + hf * 9 + rr]; const int tok = info < 0 ? 0 : (info >> 1); v[rr] = ((const u32x4*)(H2 + (size_t)tok * DM))[lane]; }
#pragma unroll
      for (int rr = 0; rr < 9; ++rr) *(LAS u32x4*)(lds + a_off(wave * 18 + hf * 9 + rr, 16 * lane, 1024)) = v[rr];
    }
    __syncthreads();
    f32x16 ag[2][P4_NRB];
#pragma unroll
    for (int i = 0; i < 2; ++i)
#pragma unroll
      for (int rb = 0; rb < P4_NRB; ++rb) ag[i][rb] = f32x16{};
    { const l64x2* wp[2];
      wp[0] = (const l64x2*)(ws + WS_WG) + (size_t)((e * 8 + wave) * 32) * 64 + lane;
      wp[1] = (const l64x2*)(ws + WS_WU) + (size_t)((e * 8 + wave) * 32) * 64 + lane;
      if (!(P.variant & 2)) gemm_tile_f8<2, 32, true, 1, false, P4_NRB>(ag, lds, 1024, wp, lane, nrb); }
    __syncthreads();
    { constexpr float S1 = 1.0f / (H2_SCALE * WGU_SCALE);
#pragma unroll
      for (int rb = 0; rb < P4_NRB; ++rb) if (rb < nrb) { const int rr = 32 * rb + r32; const float w = rwt[rr] * HID_SCALE;
#pragma unroll
        for (int g = 0; g < 4; ++g) { float hv[4];
#pragma unroll
          for (int i = 0; i < 4; ++i) { const float gg = ag[0][rb][4 * g + i] * S1, uu = ag[1][rb][4 * g + i] * S1; hv[i] = gg / (1.0f + __expf(-gg)) * uu * w; }
          *(LAS unsigned*)(lds + a_off(rr, 32 * wave + 8 * g + 4 * hi, 256)) = pk4_fp8(hv[0], hv[1], hv[2], hv[3]); } } }
    __syncthreads();
#pragma unroll 1
    for (int pass = (P.variant & 1) ? 2 : 0; pass < 2; ++pass) {
      f32x16 ad[2][P4_NRB];
#pragma unroll
      for (int i = 0; i < 2; ++i)
#pragma unroll
        for (int rb = 0; rb < P4_NRB; ++rb) ad[i][rb] = f32x16{};
      const l64x2* wp[2];
#pragma unroll
      for (int i = 0; i < 2; ++i) wp[i] = (const l64x2*)(ws + WS_WD) + (size_t)((e * 32 + 4 * wave + 2 * pass + i) * 8) * 64 + lane;
      gemm_tile_f8<2, 8, false, 1, false, P4_NRB>(ad, lds, 256, wp, lane, nrb);
      constexpr float S2 = 1.0f / (HID_SCALE * WD_SCALE);
#pragma unroll
      for (int rb = 0; rb < P4_NRB; ++rb) if (rb < nrb) {
#pragma unroll
        for (int reg = 0; reg < 16; ++reg) { const int info = rinfo[32 * rb + crow(reg, hi)];
          if (info >= 0) { bf16_t* yp = Y + (size_t)info * DM + 128 * wave + 64 * pass + r32;
            st_wt(yp, (bf16_t)(pk2(ad[0][rb][reg] * S2, 0.f) & 0xffffu)); st_wt(yp + 32, (bf16_t)(pk2(ad[1][rb][reg] * S2, 0.f) & 0xffffu)); } } }
    }
    __syncthreads();
  }
}

__device__ __forceinline__ void phase5(const KP& P) {
  int lane_ = mk_lane(); asm volatile("" : "+v"(lane_)); const int lane = lane_ & 63, wave = P.wave;
  uchar* ws = P.ws;
  const bf16_t* Y = (const bf16_t*)(ws + WS_Y);
  const bf16_t* X1 = (const bf16_t*)(ws + WS_X1); float* OUT = P.out;
  f32x4 gf[4];
#pragma unroll
  for (int i = 0; i < 4; ++i) gf[i] = *(const f32x4*)(P.in[22] + 4 * (lane + 64 * i));
  constexpr int RPI = 4;
  const int nwv = gridDim.x * NWAVE, wv = blockIdx.x * NWAVE + wave;
#pragma unroll 1
  for (int t0 = wv * RPI; t0 < T; t0 += nwv * RPI) {
    u32x2 xv[RPI][4]; u32x2 ya[RPI][4], yb[RPI][4];
#pragma unroll
    for (int r = 0; r < RPI; ++r)
#pragma unroll
      for (int i = 0; i < 4; ++i) { const int k = 4 * (lane + 64 * i); const size_t t = t0 + r;
        xv[r][i] = __builtin_nontemporal_load((const u32x2*)(X1 + t * DM + k)); ya[r][i] = __builtin_nontemporal_load((const u32x2*)(Y + (2 * t) * DM + k)); yb[r][i] = __builtin_nontemporal_load((const u32x2*)(Y + (2 * t + 1) * DM + k)); }
    const int b = t0 / SEQ; const float* gt2 = (const float*)(ws + WS_MOD) + b * (NMOD * DM) + 5 * DM;
    f32x4 g2v[4];
#pragma unroll
    for (int i = 0; i < 4; ++i) g2v[i] = *(const f32x4*)(gt2 + 4 * (lane + 64 * i));
#pragma unroll
    for (int r = 0; r < RPI; ++r) {
      f32x4 v[4]; float ss = 0.f;
#pragma unroll
      for (int i = 0; i < 4; ++i) { const u32x2 y0 = ya[r][i], y1 = yb[r][i]; f32x4 ys;
        ys[0] = __uint_as_float(y0.x << 16) + __uint_as_float(y1.x << 16); ys[1] = __uint_as_float(y0.x & 0xffff0000u) + __uint_as_float(y1.x & 0xffff0000u);
        ys[2] = __uint_as_float(y0.y << 16) + __uint_as_float(y1.y << 16); ys[3] = __uint_as_float(y0.y & 0xffff0000u) + __uint_as_float(y1.y & 0xffff0000u);
        f32x4 xf; xf[0] = __uint_as_float(xv[r][i].x << 16); xf[1] = __uint_as_float(xv[r][i].x & 0xffff0000u); xf[2] = __uint_as_float(xv[r][i].y << 16); xf[3] = __uint_as_float(xv[r][i].y & 0xffff0000u);
        v[i] = xf + g2v[i] * ys; ss += v[i][0] * v[i][0] + v[i][1] * v[i][1] + v[i][2] * v[i][2] + v[i][3] * v[i][3]; }
      ss = wave_sum(ss); const float rs = rsqrtf(ss * (1.0f / DM) + EPS);
#pragma unroll
      for (int i = 0; i < 4; ++i) __builtin_nontemporal_store(v[i] * rs * gf[i], (f32x4*)(OUT + (size_t)(t0 + r) * DM + 4 * (lane + 64 * i)));
    }
  }
}
__global__ void __launch_bounds__(NTHR, 2) mk_fwd(const Params P0) {
  extern __shared__ __attribute__((aligned(16))) uchar lds_raw[];
  LAS uchar* lds = (LAS uchar*)lds_raw;
  KP P; P.in = P0.in; P.out = P0.out; P.ws = P0.ws; P.ph_lo = P0.ph_lo; P.ph_hi = P0.ph_hi; P.variant = P0.variant; P.wave = __builtin_amdgcn_readfirstlane((int)(threadIdx.x >> 6));
  const int bid = blockIdx.x, G = gridDim.x;
  const int lo = P.ph_lo, hi = P.ph_hi;
  volatile LAS unsigned* bst = (volatile LAS unsigned*)(lds + LDS_BYTES - 16);
  if (threadIdx.x < 4) bst[threadIdx.x] = 0u;
  __syncthreads();
  XcdBarrier bar; bar.bar = (unsigned*)(P.ws + WS_CTL); bar.x = 0; bar.st = bst;
  if (hi - lo > 1) bar = xcd_barrier_post((unsigned*)(P.ws + WS_CTL), bst, P.wave == 0 && mk_lane() == 0);
#define IN(k) (lo <= (k) && (k) < hi)
#define BOTH(k) (IN(k) && IN((k) + 1))
  if (IN(0)) { phase0(P, lds); if (BOTH(0)) xcd_barrier(bar, P.wave == 0 && mk_lane() == 0); }
  if (IN(1)) { if (bid < T / 64) phase1_tile(P, lds, bid); if (BOTH(1)) xcd_barrier(bar, P.wave == 0 && mk_lane() == 0); }
  if (IN(2)) { phase2(P, lds); if (BOTH(2)) xcd_barrier(bar, P.wave == 0 && mk_lane() == 0); }
  if (IN(3)) { if (bid < T / 64) phase3_tile(P, lds, bid); if (BOTH(3)) xcd_barrier(bar, P.wave == 0 && mk_lane() == 0); }
  if (IN(4)) { phase4(P, lds); if (BOTH(4)) xcd_barrier(bar, P.wave == 0 && mk_lane() == 0); }
  if (IN(5)) phase5(P);
#undef IN
#undef BOTH
}

extern "C" void kernel_launch(void* const* d_in, const int* in_sizes, int n_in, void* d_out, int out_size, void* d_ws, size_t ws_size, hipStream_t stream) {
  static int ready = 0;
  if (!ready) {
    if (n_in != 23 || out_size != T * DM || ws_size < WS_END) { fprintf(stderr, "kernel_launch: unexpected shapes (n_in %d out %d ws %zu need %zu)\n", n_in, out_size, ws_size, (size_t)WS_END); return; }
    if (hipFuncSetAttribute((const void*)mk_fwd, hipFuncAttributeMaxDynamicSharedMemorySize, LDS_BYTES) != hipSuccess) { fprintf(stderr, "kernel_launch: hipFuncSetAttribute failed\n"); return; }
    ready = 1;
  }
  uchar* ws = (uchar*)d_ws;
  if (hipMemsetAsync(ws + WS_CTL, 0, 32768, stream) != hipSuccess) { fprintf(stderr, "kernel_launch: hipMemsetAsync failed\n"); return; }
  Params p{};
  for (int i = 0; i < 23; ++i) p.in[i] = (const float*)d_in[i];
  p.out = (float*)d_out; p.ws = ws; p.ph_lo = 0; p.ph_hi = 6; p.variant = 0; p.pad = 0;
  hipLaunchKernelGGL(mk_fwd, dim3(T / 64), dim3(NTHR), LDS_BYTES, stream, p);
}
```

```cpp
#include <hip/hip_runtime.h>
#include <cstdio>
#include <cstdint>
constexpr int DM = 1024, NB = 4, SEQ = 4096, T = NB * SEQ;
constexpr int INW = 1120, NMOD = 6;
constexpr float EPS = 1e-6f;
#define LAS __attribute__((address_space(3)))
typedef unsigned short bf16_t;
typedef short bf16x8 __attribute__((ext_vector_type(8)));
typedef float f32x16 __attribute__((ext_vector_type(16)));
typedef float f32x4 __attribute__((ext_vector_type(4)));
typedef unsigned u32x4 __attribute__((ext_vector_type(4)));
typedef unsigned u32x2 __attribute__((ext_vector_type(2)));
typedef unsigned char uchar;

constexpr int NTHR = 512, NWAVE = 8;
constexpr int LDS_A = 0, LDS_MISC = 131072, LDS_BYTES = 163840;
constexpr float LOG2E = 1.4426950408889634f;
constexpr float QSCALE_A = 0.125f * LOG2E * (128.0f / 65535.0f);
constexpr float QSCALE_B = 0.10206207261596575f * LOG2E;
constexpr float THR2 = 10.f;
constexpr float WIN_SCALE = 64.f, WIN_DESCALE = 1.0f / 64.f;
constexpr float H2_SCALE = 8.f, WGU_SCALE = 64.f, WD_SCALE = 32.f, HID_SCALE = 8.f;

constexpr size_t WS_CTL   = 0;
constexpr size_t WS_CNT   = 16384;
constexpr size_t WS_MOD   = 32768;
constexpr size_t WS_TABA  = WS_MOD + 98304;
constexpr size_t WS_TABB  = WS_TABA + 4096 * 32 * 8;
constexpr size_t WS_WIN   = WS_TABB + 4096 * 16 * 8;
constexpr size_t WS_WUQ   = WS_WIN + 35 * 64 * 1024;
constexpr size_t WS_WUKV  = WS_WUQ + 24 * 12 * 1024;
constexpr size_t WS_WOUT  = WS_WUKV + 32 * 8 * 1024;
constexpr size_t WS_WR    = WS_WOUT + 32 * 64 * 1024;
constexpr size_t WS_WG    = WS_WR + 2 * 64 * 1024;
constexpr size_t WS_WU    = WS_WG + (size_t)32 * 8 * 32 * 1024;
constexpr size_t WS_WD    = WS_WU + (size_t)32 * 8 * 32 * 1024;
constexpr size_t WS_LIST  = WS_WD + (size_t)32 * 32 * 8 * 1024;
constexpr size_t WS_WT    = WS_LIST + (size_t)32 * 16384 * 4;
constexpr size_t WS_QA    = WS_WT + (size_t)T * 2 * 4;
constexpr size_t WS_KVA   = WS_QA + (size_t)NB * 8 * 64 * 8192;
constexpr size_t WS_QB    = WS_KVA + (size_t)NB * 2 * 64 * 16384;
constexpr size_t WS_KVB   = WS_QB + (size_t)NB * 8 * 64 * 12288;
constexpr size_t WS_O     = WS_KVB + (size_t)NB * 8 * 64 * 20480;
constexpr size_t WS_H2    = WS_O + (size_t)T * DM * 2;
constexpr size_t WS_X1    = WS_H2 + (size_t)T * DM * 2;
constexpr size_t WS_XB    = WS_X1 + (size_t)T * DM * 2;
constexpr size_t WS_END   = WS_XB + (size_t)T * DM * 2;
constexpr size_t WS_Y     = WS_QA;
static_assert((size_t)T * 2 * DM * 2 <= WS_O - WS_QA, "Y overlay");

struct Params { const float* in[23]; float* out; unsigned char* ws; int ph_lo, ph_hi, variant, pad; };
struct KP { const float* const* in; float* out; unsigned char* ws; int ph_lo, ph_hi, wave, variant; };
__device__ __forceinline__ int mk_lane() { return (int)__builtin_amdgcn_mbcnt_hi(~0u, __builtin_amdgcn_mbcnt_lo(~0u, 0u)); }

__device__ __forceinline__ unsigned pk2(float lo, float hi) { unsigned r; asm("v_cvt_pk_bf16_f32 %0, %1, %2" : "=v"(r) : "v"(lo), "v"(hi)); return r; }
__device__ __forceinline__ float bf2f(unsigned short v) { return __uint_as_float((unsigned)v << 16); }
__host__ __device__ __forceinline__ constexpr int crow(int r, int hi) { return (r & 3) + 8 * (r >> 2) + 4 * hi; }
__device__ __forceinline__ f32x16 mfma(bf16x8 a, bf16x8 b, f32x16 c) { return __builtin_amdgcn_mfma_f32_32x32x16_bf16(a, b, c, 0, 0, 0); }
__device__ __forceinline__ float wave_sum(float v) {
#pragma unroll
  for (int o = 32; o; o >>= 1) v += __shfl_xor(v, o);
  return v;
}
__device__ __forceinline__ float half_swap_max(float x) { auto rr = __builtin_amdgcn_permlane32_swap(__float_as_uint(x), __float_as_uint(x), false, false);
  float m; asm("v_max_f32 %0, %1, %2" : "=v"(m) : "v"(rr[0]), "v"(rr[1])); return m; }
__device__ __forceinline__ float half_swap_sum(float x) { auto rr = __builtin_amdgcn_permlane32_swap(__float_as_uint(x), __float_as_uint(x), false, false); return __uint_as_float(rr[0]) + __uint_as_float(rr[1]); }
template <typename TT> __device__ __forceinline__ void st_wt(TT* p, TT v) { __hip_atomic_store(p, v, __ATOMIC_RELAXED, __HIP_MEMORY_SCOPE_AGENT); }
__device__ __forceinline__ void st_wt8(void* p, u32x2 v) { st_wt((unsigned long long*)p, __builtin_bit_cast(unsigned long long, v)); }
__device__ __forceinline__ void st_wt16(void* p, u32x4 v) { st_wt8(p, u32x2{v.x, v.y}); st_wt8((uchar*)p + 8, u32x2{v.z, v.w}); }
__host__ __device__ __forceinline__ constexpr int a_off(int row, int kbyte, int pitch) { return row * pitch + (kbyte ^ ((row & 15) << 4)); }
__host__ __device__ __forceinline__ constexpr int img_qk(int rr, int d, int NS) { return ((((rr >> 5) * NS + (d >> 4)) * 64) + ((d >> 3) & 1) * 32 + (rr & 31)) * 16 + (d & 7) * 2; }
__host__ __device__ __forceinline__ constexpr int img_v(int kk, int d) {
  const int kb = kk >> 5, k32 = kk & 31, s = k32 >> 4, k16 = k32 & 15, h = (k16 >> 2) & 1, j = ((k16 >> 3) << 2) | (k16 & 3), db = d >> 5, r = d & 31;
  return (((((kb * 2 + db) * 2 + s) * 64) + h * 32 + r) * 8 + j) * 2;
}

#define XB_TMO      128
#define XB_XCNT(j)  (256  + 64 * (j))
#define XB_XSUB(j)  (1280 + 64 * (j))
#define XB_XGEN(j)  (2304 + 64 * (j))
#define XB_TOP      3328
#define XB_TOPGEN   3392
#define XCD_BAR_WORDS 3456
#define XB_SPIN_CAP (1u << 20)
__device__ __forceinline__ unsigned xb_ld(unsigned* p)              { return __hip_atomic_load(p, __ATOMIC_RELAXED, __HIP_MEMORY_SCOPE_AGENT); }
__device__ __forceinline__ unsigned xb_add(unsigned* p, unsigned v) { return __hip_atomic_fetch_add(p, v, __ATOMIC_RELAXED, __HIP_MEMORY_SCOPE_AGENT); }
__device__ __forceinline__ unsigned xb_xcc_id() { return (unsigned)__builtin_amdgcn_s_getreg((3 << 11) | 20) & 0xFu; }
#define XB_SPIN(cond, bar) do { unsigned _sp = 0; while (cond) { __builtin_amdgcn_s_sleep(1); \
    if ((++_sp & 255u) == 0u) { if (xb_ld(&(bar)[XB_TMO])) break; if (_sp > XB_SPIN_CAP) { atomicAdd(&(bar)[XB_TMO], 1u); break; } } } } while (0)
struct XcdBarrier { unsigned* bar; unsigned x; volatile LAS unsigned* st; };
__device__ __forceinline__ XcdBarrier xcd_barrier_post(unsigned* bar, volatile LAS unsigned* st, bool leader) {
  XcdBarrier b; b.bar = bar; b.x = xb_xcc_id(); b.st = st;
  if (leader) (void)xb_add(&bar[XB_XCNT(b.x)], 1u);
  return b;
}
__device__ __forceinline__ void xcd_barrier_complete(unsigned* bar, unsigned x, unsigned& nloc, unsigned& nx) {
  const unsigned G = gridDim.x * gridDim.y * gridDim.z;
  unsigned sum, cnt, mine, sp = 0u;
  for (;;) {
    sum = 0u; cnt = 0u; mine = 0u;
#pragma unroll
    for (unsigned j = 0; j < 16; ++j) { const unsigned c = xb_ld(&bar[XB_XCNT(j)]); sum += c; cnt += (c > 0u) ? 1u : 0u; mine = (j == x) ? c : mine; }
    if (sum == G) break;
    __builtin_amdgcn_s_sleep(1);
    if ((++sp & 255u) == 0u) { if (xb_ld(&bar[XB_TMO])) break; if (sp > XB_SPIN_CAP) { atomicAdd(&bar[XB_TMO], 1u); break; } }
  }
  nloc = mine > 0u ? mine : 1u; nx = cnt > 0u ? cnt : 1u;
}
__device__ __forceinline__ void xcd_barrier(const XcdBarrier& b, bool leader) {
  asm volatile("s_waitcnt vmcnt(0)" ::: "memory");
  __syncthreads();
  if (leader) {
    unsigned* bar = b.bar;
    __builtin_amdgcn_s_waitcnt(0);
    unsigned nloc = b.st[0], nx = b.st[1];
    if (nloc == 0u) { xcd_barrier_complete(bar, b.x, nloc, nx); b.st[0] = nloc; b.st[1] = nx; }
    const unsigned old = xb_add(&bar[XB_XSUB(b.x)], 1u);
    const unsigned gen = old / nloc;
    if (old + 1u == (gen + 1u) * nloc) {
      __builtin_amdgcn_fence(__ATOMIC_RELEASE, "agent");
      asm volatile("s_waitcnt vmcnt(0)" ::: "memory");
      const unsigned og = xb_add(&bar[XB_TOP], 1u);
      const unsigned tg = og / nx;
      if (og + 1u == (tg + 1u) * nx) xb_add(&bar[XB_TOPGEN], 1u);
      else XB_SPIN(xb_ld(&bar[XB_TOPGEN]) == tg, bar);
      __builtin_amdgcn_fence(__ATOMIC_ACQUIRE, "agent");
      xb_add(&bar[XB_XGEN(b.x)], 1u);
      asm volatile("s_waitcnt vmcnt(0)" ::: "memory");
    } else {
      XB_SPIN(xb_ld(&bar[XB_XGEN(b.x)]) == gen, bar);
      __builtin_amdgcn_fence(__ATOMIC_ACQUIRE, "agent");
      asm volatile("s_waitcnt vmcnt(0)" ::: "memory");
    }
  }
  __syncthreads();
}

template <int NBLK, int NS, bool TR, int D = (NBLK >= 3 ? 4 : 8)>
__device__ __forceinline__ void gemm_tile(f32x16 (&acc)[NBLK][2], const LAS uchar* A, const int pitch, const bf16x8* const (&wp)[NBLK], const int lane) {
  constexpr int NSM = (NS / D) * D;
  const int r = lane & 31, h = lane >> 5;
  const LAS uchar* a0p = A + r * pitch; const LAS uchar* a1p = A + (32 + r) * pitch;
  const int swz = (lane & 15) << 4, kb0 = 16 * h;
  bf16x8 ring[D][NBLK];
#pragma unroll
  for (int d = 0; d < D; ++d)
#pragma unroll
    for (int i = 0; i < NBLK; ++i) ring[d][i] = wp[i][d * 64];
#pragma unroll 1
  for (int s0 = 0; s0 < NSM; s0 += D) {
#pragma unroll
    for (int d = 0; d < D; ++d) {
      const int s = s0 + d;
      const int ko = ((s * 32) + kb0) ^ swz; const bf16x8 fa0 = *(const LAS bf16x8*)(a0p + ko), fa1 = *(const LAS bf16x8*)(a1p + ko);
#pragma unroll
      for (int i = 0; i < NBLK; ++i) {
        if (TR) { acc[i][0] = mfma(ring[d][i], fa0, acc[i][0]); acc[i][1] = mfma(ring[d][i], fa1, acc[i][1]); }
        else    { acc[i][0] = mfma(fa0, ring[d][i], acc[i][0]); acc[i][1] = mfma(fa1, ring[d][i], acc[i][1]); }
      }
      if (s + D < NS) {
#pragma unroll
        for (int i = 0; i < NBLK; ++i) ring[d][i] = wp[i][(s + D) * 64];
      }
    }
  }
#pragma unroll
  for (int d = 0; d < NS - NSM; ++d) {
    const int s = NSM + d;
    const int ko = ((s * 32) + kb0) ^ swz; const bf16x8 fa0 = *(const LAS bf16x8*)(a0p + ko), fa1 = *(const LAS bf16x8*)(a1p + ko);
#pragma unroll
    for (int i = 0; i < NBLK; ++i) {
      if (TR) { acc[i][0] = mfma(ring[d][i], fa0, acc[i][0]); acc[i][1] = mfma(ring[d][i], fa1, acc[i][1]); }
      else    { acc[i][0] = mfma(fa0, ring[d][i], acc[i][0]); acc[i][1] = mfma(fa1, ring[d][i], acc[i][1]); }
    }
  }
}
typedef long l64x2 __attribute__((ext_vector_type(2)));
__device__ __forceinline__ f32x16 mfma8(long a, long b, f32x16 c) { return __builtin_amdgcn_mfma_f32_32x32x16_fp8_fp8(a, b, c, 0, 0, 0); }
__device__ __forceinline__ unsigned pk4_fp8(float a, float b, float c, float d) { int w = 0; w = __builtin_amdgcn_cvt_pk_fp8_f32(a, b, w, false); w = __builtin_amdgcn_cvt_pk_fp8_f32(c, d, w, true); return (unsigned)w; }
typedef int i32x8 __attribute__((ext_vector_type(8)));
typedef int i32x4 __attribute__((ext_vector_type(4)));
#ifndef MK_MX
#define MK_MX 1
#endif
__device__ __forceinline__ f32x16 mfma_mx(i32x4 a0, i32x4 a1, i32x4 b0, i32x4 b1, f32x16 c) {
  const i32x8 a = __builtin_shufflevector(a0, a1, 0, 1, 2, 3, 4, 5, 6, 7), b = __builtin_shufflevector(b0, b1, 0, 1, 2, 3, 4, 5, 6, 7);
  return __builtin_amdgcn_mfma_scale_f32_32x32x64_f8f6f4(a, b, c, 0, 0, 0, 0x7f7f7f7f, 0, 0x7f7f7f7f);
}
__device__ __forceinline__ f32x16 mfma_mx_q(i32x4 a0, i32x4 a1, i32x4 b0, i32x4 b1, f32x16 c) {
  const i32x8 a = __builtin_shufflevector(a0, a1, 0, 1, 2, 3, 4, 5, 6, 7), b = __builtin_shufflevector(b0, b1, 0, 1, 2, 3, 4, 5, 6, 7);
  return __builtin_amdgcn_mfma_scale_f32_32x32x64_f8f6f4(a, b, c, 0, 0, 0, 0x7f7f7f7f, 0, 0x77777777);
}
__device__ __forceinline__ unsigned mk_pknorm(float lo, float hi) { typedef unsigned short u16x2 __attribute__((ext_vector_type(2))); const u16x2 v = __builtin_amdgcn_cvt_pknorm_u16(lo, hi); return __builtin_bit_cast(unsigned, v); }
__device__ __forceinline__ f32x16 mfma_mx8(i32x8 a, i32x8 b, f32x16 c) { return __builtin_amdgcn_mfma_scale_f32_32x32x64_f8f6f4(a, b, c, 0, 0, 0, 0x7f7f7f7f, 0, 0x7f7f7f7f); }
__device__ __forceinline__ i32x8 ld_pair(const i32x4* p0, const i32x4* p1) { const i32x4 x = *p0, y = *p1; return __builtin_shufflevector(x, y, 0, 1, 2, 3, 4, 5, 6, 7); }
template <int NBLK, int NS, bool TR, int D, bool FULL, int NRB>
__device__ __forceinline__ void gemm_tile_f8(f32x16 (&acc)[NBLK][NRB], const LAS uchar* A, const int pitch, const l64x2* const (&wp)[NBLK], const int lane, const int nrb) {
  constexpr int NP = NS / 2;
  static_assert(NS % 2 == 0 && NP % D == 0, "NS even, NP % D");
  const int r = lane & 31, h = lane >> 5;
  const LAS uchar* ap = A + r * pitch;
  const int swz = (lane & 15) << 4, kb0 = 16 * h;
  i32x8 ring[D][NBLK];
#pragma unroll
  for (int d = 0; d < D; ++d)
#pragma unroll
    for (int i = 0; i < NBLK; ++i) ring[d][i] = ld_pair((const i32x4*)(wp[i] + (2 * d) * 64), (const i32x4*)(wp[i] + (2 * d + 1) * 64));
#pragma unroll 1
  for (int p0 = 0; p0 < NP; p0 += D) {
#pragma unroll
    for (int d = 0; d < D; ++d) {
      const int s = 2 * (p0 + d);
      const int ko0 = ((s * 32) + kb0) ^ swz, ko1 = (((s + 1) * 32) + kb0) ^ swz;
#pragma unroll
      for (int rb = 0; rb < NRB; ++rb) {
        if (FULL || rb < nrb) {
          const i32x4 f0 = *(const LAS i32x4*)(ap + rb * 32 * pitch + ko0), f1 = *(const LAS i32x4*)(ap + rb * 32 * pitch + ko1);
          const i32x8 fa = __builtin_shufflevector(f0, f1, 0, 1, 2, 3, 4, 5, 6, 7);
#pragma unroll
          for (int i = 0; i < NBLK; ++i) acc[i][rb] = TR ? mfma_mx8(ring[d][i], fa, acc[i][rb]) : mfma_mx8(fa, ring[d][i], acc[i][rb]);
        }
      }
      if (p0 + d + D < NP) {
#pragma unroll
        for (int i = 0; i < NBLK; ++i) ring[d][i] = ld_pair((const i32x4*)(wp[i] + (2 * (p0 + d + D)) * 64), (const i32x4*)(wp[i] + (2 * (p0 + d + D) + 1) * 64));
      }
    }
  }
}
template <int NSLOT, int NACC, int NS, bool TR, int D, int MAP>
__device__ __forceinline__ void gemm_slots_f8(f32x16 (&acc)[NACC][2], const LAS uchar* A, const int pitch, const l64x2* const (&wp)[NSLOT], const int lane) {
  constexpr int NP = NS / 2;
  static_assert(NS % 2 == 0 && NP % D == 0, "NS even, NP % D");
  const int r = lane & 31, h = lane >> 5;
  const LAS uchar* ap = A + r * pitch;
  const int swz = (lane & 15) << 4, kb0 = 16 * h;
  i32x8 ring[D][NSLOT];
#pragma unroll
  for (int d = 0; d < D; ++d)
#pragma unroll
    for (int i = 0; i < NSLOT; ++i) ring[d][i] = ld_pair((const i32x4*)(wp[i] + (2 * d) * 64), (const i32x4*)(wp[i] + (2 * d + 1) * 64));
#pragma unroll 1
  for (int p0 = 0; p0 < NP; p0 += D) {
#pragma unroll
    for (int d = 0; d < D; ++d) {
      const int s = 2 * (p0 + d);
      const int ko0 = ((s * 32) + kb0) ^ swz, ko1 = (((s + 1) * 32) + kb0) ^ swz;
#pragma unroll
      for (int rb = 0; rb < 2; ++rb) {
        const i32x4 f0 = *(const LAS i32x4*)(ap + rb * 32 * pitch + ko0), f1 = *(const LAS i32x4*)(ap + rb * 32 * pitch + ko1);
        const i32x8 fa = __builtin_shufflevector(f0, f1, 0, 1, 2, 3, 4, 5, 6, 7);
#pragma unroll
        for (int i = 0; i < NSLOT; ++i) { constexpr int dummy = 0; (void)dummy; const int ai = (MAP >> (4 * i)) & 15;
          acc[ai][rb] = TR ? mfma_mx8(ring[d][i], fa, acc[ai][rb]) : mfma_mx8(fa, ring[d][i], acc[ai][rb]); }
      }
      if (p0 + d + D < NP) {
#pragma unroll
        for (int i = 0; i < NSLOT; ++i) ring[d][i] = ld_pair((const i32x4*)(wp[i] + (2 * (p0 + d + D)) * 64), (const i32x4*)(wp[i] + (2 * (p0 + d + D) + 1) * 64));
      }
    }
  }
}
template <int NBLK> __device__ __forceinline__ void acc_zero(f32x16 (&acc)[NBLK][2]) {
#pragma unroll
  for (int i = 0; i < NBLK; ++i) { acc[i][0] = f32x16{}; acc[i][1] = f32x16{}; }
}

__device__ __forceinline__ void store_img_qk(uchar* img, const f32x16& v, int rr, int f0, int NS, int hi) {
#pragma unroll
  for (int g = 0; g < 4; ++g) { u32x2 w; w.x = pk2(v[4 * g], v[4 * g + 1]); w.y = pk2(v[4 * g + 2], v[4 * g + 3]);
    *(u32x2*)(img + img_qk(rr, f0 + 8 * g + 4 * hi, NS)) = w; }
}
__device__ __forceinline__ void store_img_v(uchar* img, const f32x16& v, int kb, int d, int hi) {
#pragma unroll
  for (int g = 0; g < 4; ++g) { u32x2 w; w.x = pk2(v[4 * g], v[4 * g + 1]); w.y = pk2(v[4 * g + 2], v[4 * g + 3]);
    *(u32x2*)(img + img_v(32 * kb + 8 * g + 4 * hi, d)) = w; }
}
__device__ __forceinline__ void pack_frag(const float* __restrict__ W, int ldw, int k0, int n0, const float* __restrict__ rowscale, u32x4* __restrict__ dst, int lane) {
  const int r = lane & 31, h = lane >> 5;
  const float* p = W + (size_t)(k0 + 8 * h) * ldw + n0 + r;
  float v[8];
#pragma unroll
  for (int j = 0; j < 8; ++j) v[j] = __builtin_nontemporal_load(p + (size_t)j * ldw);
  if (rowscale) {
#pragma unroll
    for (int j = 0; j < 8; ++j) v[j] *= rowscale[k0 + 8 * h + j];
  }
  u32x4 w; w.x = pk2(v[0], v[1]); w.y = pk2(v[2], v[3]); w.z = pk2(v[4], v[5]); w.w = pk2(v[6], v[7]);
  dst[lane] = w;
}
__device__ __forceinline__ void pack_frag8(const float* __restrict__ W, int ldw, int k0, int n0, float scale, u32x4* __restrict__ dst, int lane) {
  const int r = lane & 31, h = lane >> 5;
  const float* p = W + (size_t)(k0 + 16 * h) * ldw + n0 + r;
  float v[16];
#pragma unroll
  for (int j = 0; j < 16; ++j) v[j] = __builtin_nontemporal_load(p + (size_t)j * ldw) * scale;
  u32x4 w; w.x = pk4_fp8(v[0], v[1], v[2], v[3]); w.y = pk4_fp8(v[4], v[5], v[6], v[7]); w.z = pk4_fp8(v[8], v[9], v[10], v[11]); w.w = pk4_fp8(v[12], v[13], v[14], v[15]);
  dst[lane] = w;
}
__device__ __forceinline__ void pack_frag8_lo(const float* __restrict__ W, int ldw, int k0, int n0, float scale, u32x4* __restrict__ dst, int lane) {
  const int r = lane & 31, h = lane >> 5;
  const float* p = W + (size_t)(k0 + 16 * h) * ldw + n0 + r;
  float v[16];
#pragma unroll
  for (int j = 0; j < 16; ++j) { const float x = __builtin_nontemporal_load(p + (size_t)j * ldw) * scale; const int q = __builtin_amdgcn_cvt_pk_fp8_f32(x, 0.f, 0, false); v[j] = x - __builtin_amdgcn_cvt_f32_fp8(q, 0); }
  u32x4 w; w.x = pk4_fp8(v[0], v[1], v[2], v[3]); w.y = pk4_fp8(v[4], v[5], v[6], v[7]); w.z = pk4_fp8(v[8], v[9], v[10], v[11]); w.w = pk4_fp8(v[12], v[13], v[14], v[15]);
  dst[lane] = w;
}
__device__ __forceinline__ void phase0(const KP& P, LAS uchar* lds) {
  int lane_ = mk_lane(); asm volatile("" : "+v"(lane_)); const int lane = lane_ & 63, wave = P.wave, tid = wave * 64 + lane, bid = blockIdx.x, G = gridDim.x;
  uchar* ws = P.ws;
  if (bid == 0 && tid < 64) ((int*)(ws + WS_CNT))[tid] = 0;
  for (int idx = bid * NTHR + tid; idx < SEQ * 48; idx += G * NTHR) {
    int pos, i, half; float2* dst;
    if (idx < SEQ * 32) { pos = idx >> 5; i = idx & 31; half = 32; dst = (float2*)(ws + WS_TABA) + idx; }
    else { const int i2 = idx - SEQ * 32; pos = i2 >> 4; i = i2 & 15; half = 16; dst = (float2*)(ws + WS_TABB) + i2; }
    const float inv = 1.0f / powf(10000.0f, (float)(2 * i) / (float)(2 * half));
    const float ang = (float)pos * inv;
    *dst = make_float2(cosf(ang), sinf(ang));
  }
  if (bid < 192) {
    const float* c = P.in[1]; const float* w_ada = P.in[2]; const float* b_ada = P.in[3];
    LAS float* sl = (LAS float*)lds; LAS float* part = (LAS float*)(lds + 16384);
    for (int i = tid; i < NB * DM; i += NTHR) { const float v = c[i]; sl[i] = v / (1.f + __expf(-v)); }
    __syncthreads();
    const int n0 = bid * 32, rowl = lane >> 3, c4 = lane & 7;
    f32x4 a0 = {0, 0, 0, 0}, a1 = a0, a2 = a0, a3 = a0;
#pragma unroll 4
    for (int it = 0; it < 16; ++it) {
      const int k = wave * 128 + it * 8 + rowl;
      const f32x4 wv = __builtin_nontemporal_load((const f32x4*)(w_ada + (size_t)k * (NMOD * DM) + n0 + 4 * c4));
      a0 += wv * sl[k]; a1 += wv * sl[DM + k]; a2 += wv * sl[2 * DM + k]; a3 += wv * sl[3 * DM + k];
    }
#pragma unroll
    for (int e = 0; e < 4; ++e) {
#pragma unroll
      for (int o = 8; o < 64; o <<= 1) { a0[e] += __shfl_xor(a0[e], o); a1[e] += __shfl_xor(a1[e], o); a2[e] += __shfl_xor(a2[e], o); a3[e] += __shfl_xor(a3[e], o); }
    }
    if (rowl == 0) {
#pragma unroll
      for (int e = 0; e < 4; ++e) { part[(wave * 4 + 0) * 32 + 4 * c4 + e] = a0[e]; part[(wave * 4 + 1) * 32 + 4 * c4 + e] = a1[e]; part[(wave * 4 + 2) * 32 + 4 * c4 + e] = a2[e]; part[(wave * 4 + 3) * 32 + 4 * c4 + e] = a3[e]; }
    }
    __syncthreads();
    if (tid < 128) { const int bb = tid >> 5, col = tid & 31; float s = b_ada[n0 + col];
#pragma unroll
      for (int w = 0; w < 8; ++w) s += part[(w * 4 + bb) * 32 + col];
      ((float*)(ws + WS_MOD))[bb * (NMOD * DM) + n0 + col] = s; }
  }
  const int gw = bid * NWAVE + wave, NGW = G * NWAVE;
  for (int f = gw; f < 43 * 32; f += NGW) { const int slot = f >> 5, s = f & 31;
    if (slot < 35) pack_frag8(P.in[5], INW, 32 * s, 32 * slot, WIN_SCALE, (u32x4*)(ws + WS_WIN) + (size_t)f * 64, lane);
    else { const int blk = slot < 39 ? 20 + (slot - 35) : 30 + (slot - 39); pack_frag8_lo(P.in[5], INW, 32 * s, 32 * blk, WIN_SCALE, (u32x4*)(ws + WS_WIN) + (size_t)f * 64, lane); } }
  for (int f = gw; f < 32 * 64; f += NGW) pack_frag(P.in[13], DM, 16 * (f & 63), 32 * (f >> 6), nullptr, (u32x4*)(ws + WS_WOUT) + (size_t)f * 64, lane);
  for (int f = gw; f < 24 * 12; f += NGW) pack_frag(P.in[7], 768, 16 * (f % 12), 32 * (f / 12), P.in[6], (u32x4*)(ws + WS_WUQ) + (size_t)f * 64, lane);
  for (int f = gw; f < 32 * 8; f += NGW) pack_frag(P.in[9], 1024, 16 * (f & 7), 32 * (f >> 3), P.in[8], (u32x4*)(ws + WS_WUKV) + (size_t)f * 64, lane);
  for (int f = gw; f < 2 * 64; f += NGW) {
    const int nb = f >> 6, s = f & 63, r = lane & 31, h = lane >> 5, col = 32 * nb + r;
    float v[8];
#pragma unroll
    for (int j = 0; j < 8; ++j) { const int k = 16 * s + 8 * h + j; v[j] = col < 4 ? P.in[15][k * 4 + col] : (col < 36 ? P.in[17][k * 32 + col - 4] : 0.f); }
    u32x4 w; w.x = pk2(v[0], v[1]); w.y = pk2(v[2], v[3]); w.z = pk2(v[4], v[5]); w.w = pk2(v[6], v[7]);
    ((u32x4*)(ws + WS_WR) + (size_t)f * 64)[lane] = w;
  }
}

__device__ __forceinline__ void rope64(const f32x16& xa, const f32x16& xb, f32x16& ya, f32x16& yb, const float2* __restrict__ trow, int hi, float scale) {
#pragma unroll
  for (int g = 0; g < 4; ++g) {
    const f32x4 t0 = *(const f32x4*)(trow + 8 * g + 4 * hi), t1 = *(const f32x4*)(trow + 8 * g + 4 * hi + 2);
    const float cc[4] = {t0[0], t0[2], t1[0], t1[2]}, sn[4] = {t0[1], t0[3], t1[1], t1[3]};
#pragma unroll
    for (int i = 0; i < 4; ++i) { const int reg = 4 * g + i; ya[reg] = (xa[reg] * cc[i] - xb[reg] * sn[i]) * scale; yb[reg] = (xb[reg] * cc[i] + xa[reg] * sn[i]) * scale; }
  }
}
__device__ __forceinline__ void rope32(const f32x16& x, f32x16& y, const float2* __restrict__ trow, int hi, float scale) {
#pragma unroll
  for (int g = 0; g < 2; ++g) {
    const f32x4 t0 = *(const f32x4*)(trow + 8 * g + 4 * hi), t1 = *(const f32x4*)(trow + 8 * g + 4 * hi + 2);
    const float cc[4] = {t0[0], t0[2], t1[0], t1[2]}, sn[4] = {t0[1], t0[3], t1[1], t1[3]};
#pragma unroll
    for (int i = 0; i < 4; ++i) { const int reg = 4 * g + i; y[reg] = (x[reg] * cc[i] - x[reg + 8] * sn[i]) * scale; y[reg + 8] = (x[reg + 8] * cc[i] + x[reg] * sn[i]) * scale; }
  }
}
__device__ __forceinline__ float write_c_tile(LAS uchar* base, int pitch, const f32x16& vin, int rr, int f0, int hi) {
  const f32x16 v = vin * WIN_DESCALE;
  float ss = 0.f;
#pragma unroll
  for (int g = 0; g < 4; ++g) { u32x2 w; w.x = pk2(v[4 * g], v[4 * g + 1]); w.y = pk2(v[4 * g + 2], v[4 * g + 3]);
    *(LAS u32x2*)(base + a_off(rr, 2 * (f0 + 8 * g + 4 * hi), pitch)) = w;
    ss += v[4 * g] * v[4 * g] + v[4 * g + 1] * v[4 * g + 1] + v[4 * g + 2] * v[4 * g + 2] + v[4 * g + 3] * v[4 * g + 3]; }
  return ss;
}
__device__ __forceinline__ void store_img8_qk(uchar* img, const f32x16& v, int rb, int r32, int blk, int hi) {
#pragma unroll
  for (int g = 0; g < 4; ++g) { const unsigned w = pk4_fp8(v[4 * g], v[4 * g + 1], v[4 * g + 2], v[4 * g + 3]);
    const int off = blk < 2 ? rb * 4096 + (g >> 1) * 1024 + (blk * 32 + r32) * 16 + 8 * (g & 1) + 4 * hi : rb * 4096 + 2048 + ((g >> 1) * 32 + r32) * 16 + 8 * (g & 1) + 4 * hi;
    *(unsigned*)(img + off) = w; }
}
__device__ __forceinline__ void store_img8_v(uchar* img, const f32x16& v, int rb, int db, int r32, int hi) {
#pragma unroll
  for (int g = 0; g < 4; ++g) *(unsigned*)(img + db * 2048 + rb * 1024 + (hi * 32 + r32) * 16 + 4 * g) = pk4_fp8(v[4 * g], v[4 * g + 1], v[4 * g + 2], v[4 * g + 3]);
}
__device__ __forceinline__ void lds_fadd(LAS float* p, float v) { __hip_atomic_fetch_add(p, v, __ATOMIC_RELAXED, __HIP_MEMORY_SCOPE_WORKGROUP); }

__device__ __forceinline__ void phase1_tile(const KP& P, LAS uchar* lds, const int tile) {
  int lane_ = mk_lane(); asm volatile("" : "+v"(lane_)); const int lane = lane_ & 63, wave = P.wave, tid = wave * 64 + lane, r32 = lane & 31, hi = lane >> 5;
  uchar* ws = P.ws;
  const int t0 = tile * 64, b = t0 / SEQ, pos0 = t0 % SEQ, tb = pos0 >> 6;
  const float* __restrict__ x = P.in[0]; const float* __restrict__ mod = (const float*)(ws + WS_MOD) + b * (NMOD * DM); const float* __restrict__ g1 = P.in[4];
  LAS float* ssq = (LAS float*)(lds + LDS_MISC + 64);
  LAS uchar* krt = lds + LDS_MISC + 1024;
  const float2* tabA = (const float2*)(ws + WS_TABA); const float2* tabB = (const float2*)(ws + WS_TABB);
  if (tid < 128) ssq[tid] = 0.f;
  {
    f32x4 av[4], sv[4];
#pragma unroll
    for (int i = 0; i < 4; ++i) { const int k = 4 * (lane + 64 * i); const f32x4 g = *(const f32x4*)(g1 + k), sc = *(const f32x4*)(mod + DM + k); av[i] = g * (sc + 1.0f); sv[i] = *(const f32x4*)(mod + k); }
#pragma unroll
    for (int hf = 0; hf < 2; ++hf) {
      f32x4 xv[4][4];
#pragma unroll
      for (int rr = 0; rr < 4; ++rr)
#pragma unroll
        for (int i = 0; i < 4; ++i) xv[rr][i] = __builtin_nontemporal_load((const f32x4*)(x + (size_t)(t0 + wave * 8 + hf * 4 + rr) * DM + 4 * (lane + 64 * i)));
#pragma unroll
      for (int rr = 0; rr < 4; ++rr) {
        const int row = wave * 8 + hf * 4 + rr; float ss = 0.f;
#pragma unroll
        for (int i = 0; i < 4; ++i) { ss += xv[rr][i][0] * xv[rr][i][0] + xv[rr][i][1] * xv[rr][i][1] + xv[rr][i][2] * xv[rr][i][2] + xv[rr][i][3] * xv[rr][i][3];
          u32x2 xb; xb.x = pk2(xv[rr][i][0], xv[rr][i][1]); xb.y = pk2(xv[rr][i][2], xv[rr][i][3]);
          *(u32x2*)(ws + WS_XB + ((size_t)(t0 + row) * DM + 4 * (lane + 64 * i)) * 2) = xb; }
        ss = wave_sum(ss); const float rs = rsqrtf(ss * (1.0f / DM) + EPS);
#pragma unroll
        for (int i = 0; i < 4; ++i) { const f32x4 v = xv[rr][i] * rs * av[i] + sv[i];
          *(LAS unsigned*)(lds + a_off(row, 4 * (lane + 64 * i), 1024)) = pk4_fp8(v[0], v[1], v[2], v[3]); }
      }
    }
  }
  __syncthreads();
  const l64x2* WIN = (const l64x2*)(ws + WS_WIN);
#define WSLOT(slot) (WIN + (size_t)((slot) * 32) * 64 + lane)
  f32x16 acc[4][2]; acc_zero<4>(acc);
  f32x16 acc2[1][2]; acc_zero<1>(acc2);
  if (wave < 4) {
    { const l64x2* wp[4] = {WSLOT(4 * wave), WSLOT(4 * wave + 1), WSLOT(4 * wave + 2), WSLOT(4 * wave + 3)}; gemm_slots_f8<4, 4, 32, true, 1, 0x3210>(acc, lds, 1024, wp, lane); }
    if (wave < 3) { const l64x2* wp[1] = {WSLOT(wave == 0 ? 34 : 27 + wave)}; gemm_slots_f8<1, 1, 32, true, 2, 0x0>(acc2, lds, 1024, wp, lane); }
  } else if (wave == 4) {
    { const l64x2* wp[4] = {WSLOT(16), WSLOT(17), WSLOT(18), WSLOT(19)}; gemm_slots_f8<4, 4, 32, true, 1, 0x3210>(acc, lds, 1024, wp, lane); }
    { const l64x2* wp[2] = {WSLOT(33), WSLOT(42)}; gemm_slots_f8<2, 1, 32, true, 1, 0x00>(acc2, lds, 1024, wp, lane); }
  } else if (wave == 7) {
    { const l64x2* wp[4] = {WSLOT(30), WSLOT(39), WSLOT(31), WSLOT(40)}; gemm_slots_f8<4, 4, 32, true, 1, 0x1100>(acc, lds, 1024, wp, lane); }
    { const l64x2* wp[2] = {WSLOT(32), WSLOT(41)}; gemm_slots_f8<2, 4, 32, true, 1, 0x22>(acc, lds, 1024, wp, lane); }
  } else {
    const int kv = wave - 5;
    { const l64x2* wp[4] = {WSLOT(20 + 2 * kv), WSLOT(35 + 2 * kv), WSLOT(21 + 2 * kv), WSLOT(36 + 2 * kv)}; gemm_slots_f8<4, 4, 32, false, 1, 0x1100>(acc, lds, 1024, wp, lane); }
    { const l64x2* wp[2] = {WSLOT(24 + 2 * kv), WSLOT(25 + 2 * kv)}; gemm_slots_f8<2, 4, 32, true, 1, 0x32>(acc, lds, 1024, wp, lane); }
  }
#undef WSLOT
  int tid2_ = mk_lane(); asm volatile("" : "+v"(tid2_)); const int lane2 = tid2_ & 63;
#define lane lane2
  const int r32e = lane2 & 31, hie = lane2 >> 5;
#define r32 r32e
#define hi hie
  if (wave < 4) {
#pragma unroll
    for (int p = 0; p < 2; ++p) { uchar* img = ws + WS_QA + ((size_t)(b * 8 + 2 * wave + p) * 64 + tb) * 8192;
#pragma unroll
      for (int rb = 0; rb < 2; ++rb) { const int rr = 32 * rb + r32; f32x16 ya, yb; rope64(acc[2 * p][rb], acc[2 * p + 1][rb], ya, yb, tabA + (size_t)(pos0 + rr) * 32, hi, QSCALE_A * WIN_DESCALE);
        store_img_qk(img, ya, rr, 0, 4, hi); store_img_qk(img, yb, rr, 32, 4, hi); } }
    if (wave == 0) {
#pragma unroll
      for (int rb = 0; rb < 2; ++rb) { const int rr = 32 * rb + r32; f32x16 y; rope32(acc2[0][rb], y, tabB + (size_t)(pos0 + rr) * 16, hi, WIN_DESCALE);
#pragma unroll
        for (int g = 0; g < 4; ++g) { u32x2 w; w.x = pk2(y[4 * g], y[4 * g + 1]); w.y = pk2(y[4 * g + 2], y[4 * g + 3]); *(LAS u32x2*)(krt + rr * 64 + (8 * g + 4 * hi) * 2) = w; } }
    }
  } else if (wave == 4) {
#pragma unroll
    for (int p = 0; p < 2; ++p) { uchar* img = ws + WS_KVA + ((size_t)(b * 2 + p) * 64 + tb) * 16384;
#pragma unroll
      for (int rb = 0; rb < 2; ++rb) { const int rr = 32 * rb + r32; f32x16 ya, yb; rope64(acc[2 * p][rb], acc[2 * p + 1][rb], ya, yb, tabA + (size_t)(pos0 + rr) * 32, hi, WIN_DESCALE);
        store_img_qk(img, ya, rr, 0, 4, hi); store_img_qk(img, yb, rr, 32, 4, hi); } }
  } else if (wave == 5 || wave == 6) {
    uchar* img = ws + WS_KVA + ((size_t)(b * 2 + (wave - 5)) * 64 + tb) * 16384 + 8192;
#pragma unroll
    for (int i = 0; i < 2; ++i)
#pragma unroll
      for (int rb = 0; rb < 2; ++rb) { const f32x16 y = acc[i][rb] * WIN_DESCALE; store_img_v(img, y, rb, 32 * i + r32, hi); }
  }
  __syncthreads();
  if (wave != 0 && wave != 3) {
#pragma unroll
    for (int rb = 0; rb < 2; ++rb) { const int rr = 32 * rb + r32; float sq = 0.f, skv = 0.f;
      if (wave == 5 || wave == 6) { sq += write_c_tile(lds, 512, acc[2][rb], rr, 64 * (wave - 5), hi); sq += write_c_tile(lds, 512, acc[3][rb], rr, 64 * (wave - 5) + 32, hi); }
      else if (wave == 1 || wave == 2) sq += write_c_tile(lds, 512, acc2[0][rb], rr, 96 + 32 * wave, hi);
      else if (wave == 7) { skv += write_c_tile(lds + 32768, 256, acc[0][rb], rr, 0, hi); skv += write_c_tile(lds + 32768, 256, acc[1][rb], rr, 32, hi); skv += write_c_tile(lds + 32768, 256, acc[2][rb], rr, 64, hi); }
      else skv += write_c_tile(lds + 32768, 256, acc2[0][rb], rr, 96, hi);
      if (wave == 4 || wave == 7) lds_fadd(&ssq[64 + rr], skv); else lds_fadd(&ssq[rr], sq); }
  }
  __syncthreads();
  const int head = wave;
  uchar* imgQ = ws + WS_QB + ((size_t)(b * 8 + head) * 64 + tb) * 8192;
  uchar* imgKV = ws + WS_KVB + ((size_t)(b * 8 + head) * 64 + tb) * 12288;
  {
    f32x16 aq[3][2]; acc_zero<3>(aq);
    const bf16x8* wp[3];
#pragma unroll
    for (int i = 0; i < 3; ++i) wp[i] = (const bf16x8*)(ws + WS_WUQ) + (size_t)((3 * head + i) * 12) * 64 + lane;
    gemm_tile<3, 12, true>(aq, lds, 512, wp, lane);
#pragma unroll
    for (int rb = 0; rb < 2; ++rb) { const int rr = 32 * rb + r32; const float sc = rsqrtf(ssq[rr] * (1.0f / 192.0f) + EPS) * (8.0f * QSCALE_B);
      f32x16 y0 = aq[0][rb] * sc, y1 = aq[1][rb] * sc, y2; rope32(aq[2][rb], y2, tabB + (size_t)(pos0 + rr) * 16, hi, sc);
      store_img8_qk(imgQ, y0, rb, r32, 0, hi); store_img8_qk(imgQ, y1, rb, r32, 1, hi); store_img8_qk(imgQ, y2, rb, r32, 2, hi);
      *(u32x4*)(imgQ + rb * 4096 + 3072 + lane * 16) = u32x4{0u, 0u, 0u, 0u}; }
  }
  {
    f32x16 ak[2][2]; acc_zero<2>(ak);
    const bf16x8* wp[2];
#pragma unroll
    for (int i = 0; i < 2; ++i) wp[i] = (const bf16x8*)(ws + WS_WUKV) + (size_t)((4 * head + i) * 8) * 64 + lane;
    gemm_tile<2, 8, true>(ak, lds + 32768, 256, wp, lane);
#pragma unroll
    for (int rb = 0; rb < 2; ++rb) { const int rr = 32 * rb + r32; const float sc = rsqrtf(ssq[64 + rr] * (1.0f / 128.0f) + EPS);
      f32x16 y0 = ak[0][rb] * sc, y1 = ak[1][rb] * sc; store_img8_qk(imgKV, y0, rb, r32, 0, hi); store_img8_qk(imgKV, y1, rb, r32, 1, hi); }
#pragma unroll
    for (int rb = 0; rb < 2; ++rb) {
      const u32x4 c0 = *(const LAS u32x4*)(krt + (32 * rb + r32) * 64 + hi * 32), c1 = *(const LAS u32x4*)(krt + (32 * rb + r32) * 64 + hi * 32 + 16);
      u32x4 w;
      w.x = pk4_fp8(__uint_as_float(c0.x << 16), __uint_as_float(c0.x & 0xffff0000u), __uint_as_float(c0.y << 16), __uint_as_float(c0.y & 0xffff0000u));
      w.y = pk4_fp8(__uint_as_float(c0.z << 16), __uint_as_float(c0.z & 0xffff0000u), __uint_as_float(c0.w << 16), __uint_as_float(c0.w & 0xffff0000u));
      w.z = pk4_fp8(__uint_as_float(c1.x << 16), __uint_as_float(c1.x & 0xffff0000u), __uint_as_float(c1.y << 16), __uint_as_float(c1.y & 0xffff0000u));
      w.w = pk4_fp8(__uint_as_float(c1.z << 16), __uint_as_float(c1.z & 0xffff0000u), __uint_as_float(c1.w << 16), __uint_as_float(c1.w & 0xffff0000u));
      *(u32x4*)(imgKV + rb * 4096 + 2048 + lane * 16) = w;
      *(u32x4*)(imgKV + rb * 4096 + 3072 + lane * 16) = u32x4{hi ? 0u : 0x00003838u, 0u, 0u, 0u}; }
  }
  {
    f32x16 avv[2][2]; acc_zero<2>(avv);
    const bf16x8* wp[2];
#pragma unroll
    for (int i = 0; i < 2; ++i) wp[i] = (const bf16x8*)(ws + WS_WUKV) + (size_t)((4 * head + 2 + i) * 8) * 64 + lane;
    gemm_tile<2, 8, false>(avv, lds + 32768, 256, wp, lane);
#pragma unroll
    for (int rb = 0; rb < 2; ++rb) { f32x16 sc;
#pragma unroll
      for (int reg = 0; reg < 16; ++reg) sc[reg] = rsqrtf(ssq[64 + 32 * rb + crow(reg, hi)] * (1.0f / 128.0f) + EPS);
#pragma unroll
      for (int i = 0; i < 2; ++i) { f32x16 y = avv[i][rb] * sc; store_img8_v(imgKV + 8192, y, rb, i, r32, hi); } }
  }
  __syncthreads();
#undef lane
#undef r32
#undef hi
}
__device__ __forceinline__ float tile_max(const f32x16& p0, const f32x16& p1) {
  float t = __builtin_amdgcn_fmed3f(p0[0], p1[0], 3.0e38f);
  asm("v_max3_f32 %0, %0, %1, %2\n\tv_max3_f32 %0, %0, %3, %4\n\tv_max3_f32 %0, %0, %5, %6\n\tv_max3_f32 %0, %0, %7, %8\n\t"
      "v_max3_f32 %0, %0, %9, %10\n\tv_max3_f32 %0, %0, %11, %12\n\tv_max3_f32 %0, %0, %13, %14\n\tv_max3_f32 %0, %0, %15, %16"
      : "+v"(t) : "v"(p0[1]), "v"(p1[1]), "v"(p0[2]), "v"(p1[2]), "v"(p0[3]), "v"(p1[3]), "v"(p0[4]), "v"(p1[4]), "v"(p0[5]), "v"(p1[5]), "v"(p0[6]), "v"(p1[6]), "v"(p0[7]), "v"(p1[7]), "v"(p0[8]), "v"(p1[8]));
  asm("v_max3_f32 %0, %0, %1, %2\n\tv_max3_f32 %0, %0, %3, %4\n\tv_max3_f32 %0, %0, %5, %6\n\tv_max3_f32 %0, %0, %7, %8\n\t"
      "v_max3_f32 %0, %0, %9, %10\n\tv_max3_f32 %0, %0, %11, %12\n\tv_max3_f32 %0, %0, %13, %14"
      : "+v"(t) : "v"(p0[9]), "v"(p1[9]), "v"(p0[10]), "v"(p1[10]), "v"(p0[11]), "v"(p1[11]), "v"(p0[12]), "v"(p1[12]), "v"(p0[13]), "v"(p1[13]), "v"(p0[14]), "v"(p1[14]), "v"(p0[15]), "v"(p1[15]));
  return t;
}
constexpr float PXG = 128.0f / 65535.0f;
__device__ __forceinline__ void softmax_tile(f32x16& p0, f32x16& p1, f32x16& negm, float& m, float& l, f32x16& o0, f32x16& o1, bf16x8 (&pb)[2][2]) {
  const float tmax = half_swap_max(tile_max(p0, p1));
  if (__any(tmax > PXG * (127.0f + THR2))) {
    const float dm = fmaxf(tmax * (1.0f / PXG) - 127.0f, 0.f), alpha = __builtin_amdgcn_exp2f(-dm), dp = dm * PXG;
    m += dm; l *= alpha;
#pragma unroll
    for (int r = 0; r < 16; ++r) { o0[r] *= alpha; o1[r] *= alpha; p0[r] -= dp; p1[r] -= dp; negm[r] = PXG * (127.0f - m); }
  }
  typedef __bf16 bf2 __attribute__((ext_vector_type(2)));
  const bf2 one2 = __builtin_bit_cast(bf2, 0x3f803f80u);
  float s = 0.f;
#pragma unroll
  for (int ks = 0; ks < 2; ++ks) {
    unsigned a[4], c[4];
#pragma unroll
    for (int i = 0; i < 4; ++i) { a[i] = mk_pknorm(p0[8 * ks + 2 * i], p0[8 * ks + 2 * i + 1]); c[i] = mk_pknorm(p1[8 * ks + 2 * i], p1[8 * ks + 2 * i + 1]);
      s = __builtin_amdgcn_fdot2_f32_bf16(__builtin_bit_cast(bf2, a[i]), one2, s, false); s = __builtin_amdgcn_fdot2_f32_bf16(__builtin_bit_cast(bf2, c[i]), one2, s, false); }
    const u32x4 w0 = {a[0], a[1], a[2], a[3]}, w1 = {c[0], c[1], c[2], c[3]};
    pb[0][ks] = __builtin_bit_cast(bf16x8, w0); pb[1][ks] = __builtin_bit_cast(bf16x8, w1);
  }
  l += s;
}
__device__ __forceinline__ void pv_tile(const LAS uchar* vimg, const bf16x8 (&pb)[2][2], f32x16& o0, f32x16& o1, int lane) {
#pragma unroll
  for (int kb = 0; kb < 2; ++kb)
#pragma unroll
    for (int ks = 0; ks < 2; ++ks) {
      const bf16x8 v0 = *(const LAS bf16x8*)(vimg + ((((kb * 2 + 0) * 2 + ks) * 64) + lane) * 16);
      const bf16x8 v1 = *(const LAS bf16x8*)(vimg + ((((kb * 2 + 1) * 2 + ks) * 64) + lane) * 16);
      o0 = mfma(v0, pb[kb][ks], o0); o1 = mfma(v1, pb[kb][ks], o1);
    }
}
__device__ __forceinline__ void store_o(bf16_t* __restrict__ orow, f32x16& o0, f32x16& o1, float l, int hi) {
  const float inv = 1.0f / half_swap_sum(l);
#pragma unroll
  for (int g = 0; g < 4; ++g) {
    u32x2 w; w.x = pk2(o0[4 * g] * inv, o0[4 * g + 1] * inv); w.y = pk2(o0[4 * g + 2] * inv, o0[4 * g + 3] * inv); *(u32x2*)(orow + 8 * g + 4 * hi) = w;
    u32x2 z; z.x = pk2(o1[4 * g] * inv, o1[4 * g + 1] * inv); z.y = pk2(o1[4 * g + 2] * inv, o1[4 * g + 3] * inv); *(u32x2*)(orow + 32 + 8 * g + 4 * hi) = z;
  }
}

__device__ __forceinline__ void store_o_l(bf16_t* __restrict__ orow, f32x16& o0, f32x16& o1, float ltot, int hi) {
  const float inv = 1.0f / ltot;
#pragma unroll
  for (int g = 0; g < 4; ++g) {
    u32x2 w; w.x = pk2(o0[4 * g] * inv, o0[4 * g + 1] * inv); w.y = pk2(o0[4 * g + 2] * inv, o0[4 * g + 3] * inv); *(u32x2*)(orow + 8 * g + 4 * hi) = w;
    u32x2 z; z.x = pk2(o1[4 * g] * inv, o1[4 * g + 1] * inv); z.y = pk2(o1[4 * g + 2] * inv, o1[4 * g + 3] * inv); *(u32x2*)(orow + 32 + 8 * g + 4 * hi) = z;
  }
}
constexpr int SWA_LDS = 49152;
__device__ __forceinline__ void swa_unit(const KP& P, LAS uchar* lds_all, int u, bool prefetched) {
  LAS uchar* lds = lds_all + SWA_LDS;
  int lane_ = mk_lane(); asm volatile("" : "+v"(lane_)); const int lane = lane_ & 63, wave = P.wave, tid = wave * 64 + lane, r32 = lane & 31, hi = lane >> 5;
  uchar* ws = P.ws;
  const int n = u & 31, kvh = (u >> 5) & 1, b = u >> 6;
  const uchar* kvimg = ws + WS_KVA + (size_t)(b * 2 + kvh) * 64 * 16384;
  if (!prefetched) {
#pragma unroll 1
    for (int jt = 0; jt < 6; ++jt) { const int gt = 2 * n - 2 + jt; if (gt < 0 || gt >= 64) continue;
      const u32x4* src = (const u32x4*)(kvimg + (size_t)gt * 16384); LAS u32x4* dst = (LAS u32x4*)(lds + jt * 16384);
      const u32x4 v0 = src[tid], v1 = src[tid + 512]; dst[tid] = v0; dst[tid + 512] = v1; }
  }
  __syncthreads();
  const int rbq = wave & 3, jlo = rbq >> 1;
  bf16_t* O = (bf16_t*)(ws + WS_O);
#pragma unroll 1
  for (int hh = 0; hh < 2; ++hh) {
    const int head = kvh * 4 + 2 * (wave >> 2) + hh;
    const uchar* qimg = ws + WS_QA + ((size_t)(b * 8 + head) * 64 + 2 * n + (rbq >> 1)) * 8192;
    bf16x8 qf[4];
#pragma unroll
    for (int s = 0; s < 4; ++s) qf[s] = *(const bf16x8*)(qimg + ((((rbq & 1) * 4 + s) * 64) + lane) * 16);
    const float sink2 = P.in[10][head] * LOG2E;
    float m = sink2, l = hi ? 0.f : 1.f; f32x16 negm, o0 = {}, o1 = {};
#pragma unroll
    for (int r = 0; r < 16; ++r) negm[r] = PXG * (127.0f - sink2);
#pragma unroll 1
    for (int jt = jlo; jt < jlo + 5; ++jt) { const int gt = 2 * n - 2 + jt; if (gt < 0 || gt >= 64) continue;
      const LAS uchar* kimg = lds + jt * 16384;
      f32x16 p0 = negm, p1 = negm;
#pragma unroll
      for (int s = 0; s < 4; ++s) { const bf16x8 k0 = *(const LAS bf16x8*)(kimg + (((0 * 4 + s) * 64) + lane) * 16), k1 = *(const LAS bf16x8*)(kimg + (((1 * 4 + s) * 64) + lane) * 16);
        p0 = mfma(k0, qf[s], p0); p1 = mfma(k1, qf[s], p1); }
      if (jt == jlo || jt == jlo + 4) { const int base = 64 * jt - 32 * rbq - r32;
#pragma unroll
        for (int r = 0; r < 16; ++r) { const int d0 = base + crow(r, hi);
          p0[r] = ((unsigned)d0 <= 256u) ? p0[r] : -1e30f; p1[r] = ((unsigned)(d0 + 32) <= 256u) ? p1[r] : -1e30f; } }
      bf16x8 pb[2][2];
      softmax_tile(p0, p1, negm, m, l, o0, o1, pb);
      pv_tile(kimg + 8192, pb, o0, o1, lane);
    }
    store_o(O + (size_t)(b * SEQ + n * 128 + 32 * rbq + r32) * DM + head * 64, o0, o1, l, hi);
  }
  __syncthreads();
}

#define MK_LDS_RD(dst, vaddr, imm) asm volatile("ds_read_b128 %0, %1 offset:%2" : "=v"(dst) : "v"(vaddr), "i"(imm))
template <int N> __device__ __forceinline__ void lgkm_wait() { asm volatile("s_waitcnt lgkmcnt(%0)" :: "i"(N) : "memory"); __builtin_amdgcn_sched_barrier(0); }
__device__ __forceinline__ void pv_regs(const bf16x8 (&vf)[8], const bf16x8 (&pb)[2][2], f32x16& o0, f32x16& o1) {
#pragma unroll
  for (int kb = 0; kb < 2; ++kb)
#pragma unroll
    for (int ks = 0; ks < 2; ++ks) { o0 = mfma(vf[(kb * 2 + 0) * 2 + ks], pb[kb][ks], o0); o1 = mfma(vf[(kb * 2 + 1) * 2 + ks], pb[kb][ks], o1); }
}
__device__ __forceinline__ void mla_dma_step(const uchar* kvimg, LAS uchar* lds, int t, int wave, int lane) {
  const uchar* src = kvimg + (size_t)t * 24576 + wave * 3072 + lane * 16;
  LAS uchar* dst = lds + (t & 1) * 24576 + wave * 3072;
#pragma unroll
  for (int i = 0; i < 3; ++i) __builtin_amdgcn_global_load_lds((const unsigned*)(src + i * 1024), (LAS unsigned*)(dst + i * 1024), 16, 0, 0);
}
template <bool FIRST_POSSIBLE>
__device__ __forceinline__ float softmax_tile8(f32x16& p0, f32x16& p1, float& pad, int& qpad, f32x16& lacc, f32x16& o0, f32x16& o1, bool first, int hi, i32x4& pb0, i32x4& pb1) {
  float applied = 0.f;
  const float tmax_s = half_swap_max(tile_max(p0, p1));
  const bool fst = FIRST_POSSIBLE && first;
  if (fst || __any(tmax_s > 120.5f / 256.0f)) {
    const float tmax = tmax_s * 256.0f;
    const float want = fst ? tmax - 96.5f : fmaxf(tmax - 96.5f, 0.f);
    const float nt = pad - want;
    const int wa = __builtin_amdgcn_cvt_pk_fp8_f32(nt, 0.f, 0, false); const float fa = __builtin_amdgcn_cvt_f32_fp8(wa, 0);
    const int wb = __builtin_amdgcn_cvt_pk_fp8_f32(nt - fa, 0.f, 0, false); const float fb = __builtin_amdgcn_cvt_f32_fp8(wb, 0);
    const float pnew = fa + fb, dt = pad - pnew, dts = dt * (1.0f / 256.0f);
    const float alpha = fst ? 1.0f : __builtin_amdgcn_exp2f(-0.125f * dt);
    pad = pnew; applied = dts; qpad = hi ? 0 : ((wa & 0xff) | ((wb & 0xff) << 8));
#pragma unroll
    for (int r = 0; r < 16; ++r) { o0[r] *= alpha; o1[r] *= alpha; lacc[r] *= alpha; p0[r] -= dts; p1[r] -= dts; }
  }
#define MK_P8(P, R) __builtin_amdgcn_perm(mk_pknorm(P[(R) + 2], P[(R) + 3]), mk_pknorm(P[R], P[(R) + 1]), 0x07050301u)
  pb0.x = (int)MK_P8(p0, 0); pb0.y = (int)MK_P8(p0, 4); pb0.z = (int)MK_P8(p0, 8); pb0.w = (int)MK_P8(p0, 12);
  pb1.x = (int)MK_P8(p1, 0); pb1.y = (int)MK_P8(p1, 4); pb1.z = (int)MK_P8(p1, 8); pb1.w = (int)MK_P8(p1, 12);
#undef MK_P8
  return applied;
}
constexpr int N_PACK_JOBS = 3 * 8192;
struct PackJob { const float* p; int ldw; u32x4* dst; float scale; };
__device__ __forceinline__ PackJob pack_job(const KP& P, int f, int lane) {
  const int which = f >> 13, ff = f & 8191, r = lane & 31, h = lane >> 5, e = ff >> 8; PackJob j;
  if (which < 2) { const int nb = (ff >> 5) & 7, s = ff & 31; j.ldw = 256; j.scale = WGU_SCALE;
    j.p = P.in[19 + which] + (size_t)e * DM * 256 + (size_t)(32 * s + 16 * h) * 256 + 32 * nb + r; j.dst = (u32x4*)(P.ws + (which ? WS_WU : WS_WG)) + (size_t)ff * 64 + lane; }
  else { const int nb = (ff >> 3) & 31, s = ff & 7; j.ldw = DM; j.scale = WD_SCALE;
    j.p = P.in[21] + (size_t)e * 256 * DM + (size_t)(32 * s + 16 * h) * DM + 32 * nb + r; j.dst = (u32x4*)(P.ws + WS_WD) + (size_t)ff * 64 + lane; }
  return j;
}
__device__ __forceinline__ u32x4 pack_cvt(const float (&v)[16], float sc) {
  u32x4 w; w.x = pk4_fp8(v[0] * sc, v[1] * sc, v[2] * sc, v[3] * sc); w.y = pk4_fp8(v[4] * sc, v[5] * sc, v[6] * sc, v[7] * sc);
  w.z = pk4_fp8(v[8] * sc, v[9] * sc, v[10] * sc, v[11] * sc); w.w = pk4_fp8(v[12] * sc, v[13] * sc, v[14] * sc, v[15] * sc); return w;
}
__device__ __forceinline__ void mla_unit(const KP& P, LAS uchar* lds, int b, int head, int qblk, int& pk_k, int swa_u) {
  int lane_ = mk_lane(); asm volatile("" : "+v"(lane_)); const int lane = lane_ & 63, wave = P.wave, r32 = lane & 31, hi = lane >> 5;
  uchar* ws = P.ws;
  const uchar* kvimg = ws + WS_KVB + (size_t)(b * 8 + head) * 64 * 12288;
  const uchar* qimg = ws + WS_QB + ((size_t)(b * 8 + head) * 64 + qblk * 4 + (wave >> 1)) * 8192 + (wave & 1) * 4096 + lane * 16;
  const int gw = blockIdx.x * NWAVE + wave, NGW = gridDim.x * NWAVE;
  const i32x4 q00 = *(const i32x4*)(qimg), q01 = *(const i32x4*)(qimg + 1024), q10 = *(const i32x4*)(qimg + 2048);
  float pad = 56.5f; int qpad = hi ? 0 : 0x3066;
  f32x16 o0 = {}, o1 = {}, lacc = {};
  i32x8 ones8 = {0x38383838, 0x38383838, 0x38383838, 0x38383838, 0x38383838, 0x38383838, 0x38383838, 0x38383838};
  asm volatile("" : "+v"(ones8));
  mla_dma_step(kvimg, lds, 0, wave, lane);
#pragma unroll 1
  for (int t = 0; t < 32; ++t) {
    asm volatile("s_waitcnt vmcnt(0)" ::: "memory");
    __syncthreads();
    if (t + 1 < 32 && !(P.variant & 4)) mla_dma_step(kvimg, lds, t + 1, wave, lane);
    if (P.variant & 8) continue;
    u32x4 bandv = {}; int band_off = -1;
    if (swa_u >= 0 && t >= 20) { const int c = (wave * 64 + lane) + 512 * (t - 20), jt = c >> 10, gt = 2 * (swa_u & 31) - 2 + jt;
      if (gt >= 0 && gt < 64) { band_off = c * 16; bandv = *(const u32x4*)(ws + WS_KVA + ((size_t)((swa_u >> 6) * 2 + ((swa_u >> 5) & 1)) * 64 + gt) * 16384 + (c & 1023) * 16); } }
    const int pf = gw + pk_k * NGW; const bool do_pack = pf < N_PACK_JOBS;
    float pv[16]; u32x4* pdst = nullptr; float psc = 0.f;
    if (do_pack) { const PackJob j = pack_job(P, pf, lane); pdst = j.dst; psc = j.scale;
#pragma unroll
      for (int q = 0; q < 16; ++q) pv[q] = __builtin_nontemporal_load(j.p + (size_t)q * j.ldw); }
    f32x16 a0, a1, b0, b1; i32x4 pb0, pb1;
    { const unsigned va = (unsigned)(unsigned long)(lds + (t & 1) * 24576) + lane * 16;
#define MK_KOFF(j) (((j) >> 2) * 12288 + (((j) >> 1) & 1) * 4096 + ((j) & 1) * 2048)
      i32x4 kf[4][2];
#define MK_KRD(j) { MK_LDS_RD(kf[(j) & 3][0], va, MK_KOFF(j)); MK_LDS_RD(kf[(j) & 3][1], va, MK_KOFF(j) + 1024); }
      MK_KRD(0) MK_KRD(1) MK_KRD(2) MK_KRD(3)
      const i32x4 q11 = {qpad, 0, 0, 0};
#define MK_QK_STEP(j, ACC, NW) { lgkm_wait<NW>(); ACC = ((j) & 1) ? mfma_mx_q(kf[(j) & 3][0], kf[(j) & 3][1], q10, q11, ACC) : mfma_mx_q(kf[(j) & 3][0], kf[(j) & 3][1], q00, q01, f32x16{}); if ((j) + 4 < 8) MK_KRD(((j) + 4) & 7) }
      MK_QK_STEP(0, a0, 6) MK_QK_STEP(1, a0, 6) MK_QK_STEP(2, a1, 6) MK_QK_STEP(3, a1, 6) MK_QK_STEP(4, b0, 6) MK_QK_STEP(5, b0, 4) MK_QK_STEP(6, b1, 2) MK_QK_STEP(7, b1, 0)
#undef MK_QK_STEP
#undef MK_KRD
#undef MK_KOFF
      i32x4 vf[4];
#define MK_VRD(tile) { MK_LDS_RD(vf[0], va, (tile) * 12288 + 8192); MK_LDS_RD(vf[1], va, (tile) * 12288 + 8192 + 1024); MK_LDS_RD(vf[2], va, (tile) * 12288 + 8192 + 2048); MK_LDS_RD(vf[3], va, (tile) * 12288 + 8192 + 3072); }
      MK_VRD(0)
      const float dA = softmax_tile8<true>(a0, a1, pad, qpad, lacc, o0, o1, t == 0, hi, pb0, pb1);
      lacc = mfma_mx8(ones8, __builtin_shufflevector(pb0, pb1, 0, 1, 2, 3, 4, 5, 6, 7), lacc);
      lgkm_wait<0>();
      o0 = mfma_mx(vf[0], vf[1], pb0, pb1, o0); o1 = mfma_mx(vf[2], vf[3], pb0, pb1, o1);
      MK_VRD(1)
#undef MK_VRD
      if (__any(dA != 0.f)) {
#pragma unroll
        for (int r = 0; r < 16; ++r) { b0[r] -= dA; b1[r] -= dA; }
      }
      (void)softmax_tile8<false>(b0, b1, pad, qpad, lacc, o0, o1, false, hi, pb0, pb1);
      lacc = mfma_mx8(ones8, __builtin_shufflevector(pb0, pb1, 0, 1, 2, 3, 4, 5, 6, 7), lacc);
      lgkm_wait<0>();
      o0 = mfma_mx(vf[0], vf[1], pb0, pb1, o0); o1 = mfma_mx(vf[2], vf[3], pb0, pb1, o1);
    }
    if (do_pack) { *pdst = pack_cvt(pv, psc); ++pk_k; }
    if (band_off >= 0) *(LAS u32x4*)(lds + SWA_LDS + band_off) = bandv;
  }
  if (!(P.variant & 12)) store_o_l((bf16_t*)(ws + WS_O) + (size_t)(b * SEQ + qblk * 256 + 32 * wave + r32) * DM + 512 + head * 64, o0, o1, lacc[0], hi);
  __syncthreads();
}
__device__ __forceinline__ void phase2(const KP& P, LAS uchar* lds) {
  const int bid = blockIdx.x;
  int pk_k = 0;
  const bool pref = gridDim.x == 256 && !(P.variant & 3);
  if (!(P.variant & 2)) for (int i = bid; i < 512; i += gridDim.x) {
    const int rr = i >> 8, ii = i & 255, xcd = ii & 7, local = ii >> 3, pair = xcd * 4 + rr * 2 + (local >> 4), qblk = local & 15;
    mla_unit(P, lds, pair >> 3, pair & 7, qblk, pk_k, (pref && i >= 256) ? bid : -1);
  }
  if (!(P.variant & 1)) for (int u = bid; u < 256; u += gridDim.x) swa_unit(P, lds, u, pref);
  { const int lane = mk_lane(), wave = P.wave, gw = bid * NWAVE + wave, NGW = gridDim.x * NWAVE;
    for (int f = gw + pk_k * NGW; f < N_PACK_JOBS; f += NGW) { const PackJob j = pack_job(P, f, lane); float v[16];
#pragma unroll
      for (int q = 0; q < 16; ++q) v[q] = j.p[(size_t)q * j.ldw];
      *j.dst = pack_cvt(v, j.scale); } }
}
__device__ __forceinline__ void phase3_tile(const KP& P, LAS uchar* lds, const int tile) {
  int lane_ = mk_lane(); asm volatile("" : "+v"(lane_)); const int lane = lane_ & 63, wave = P.wave, tid = wave * 64 + lane, r32 = lane & 31, hi = lane >> 5;
  uchar* ws = P.ws;
  const int t0 = tile * 64, b = t0 / SEQ;
  const float* __restrict__ x = P.in[0]; const float* __restrict__ mod = (const float*)(ws + WS_MOD) + b * (NMOD * DM);
  LAS float* ssq = (LAS float*)(lds + LDS_MISC + 64);
  LAS int* selE = (LAS int*)(lds + LDS_MISC + 1024);
  LAS float* selW = (LAS float*)(lds + LDS_MISC + 1536);
  LAS int* selP = (LAS int*)(lds + LDS_MISC + 2048);
  LAS int* cntl = (LAS int*)(lds + LDS_MISC + 2560);
  LAS int* basel = (LAS int*)(lds + LDS_MISC + 2688);
  LAS float* logit = (LAS float*)(lds + LDS_MISC + 8192);
  if (tid < 64) ssq[tid] = 0.f;
  if (tid < 32) cntl[tid] = 0;
  {
    const bf16_t* O = (const bf16_t*)(ws + WS_O);
    float ga[8], gb[8];
#pragma unroll
    for (int j = 0; j < 8; ++j) { ga[j] = P.in[11][8 * lane + j]; gb[j] = P.in[12][8 * lane + j]; }
#pragma unroll
    for (int hf = 0; hf < 2; ++hf) {
      u32x4 va[4], vb[4];
#pragma unroll
      for (int rr = 0; rr < 4; ++rr) { const u32x4* src = (const u32x4*)(O + (size_t)(t0 + wave * 8 + hf * 4 + rr) * DM); va[rr] = __builtin_nontemporal_load(src + lane); vb[rr] = __builtin_nontemporal_load(src + lane + 64); }
#pragma unroll
      for (int rr = 0; rr < 4; ++rr) {
        const int row = wave * 8 + hf * 4 + rr; float fa[8], fb[8], sa = 0.f, sb = 0.f;
#pragma unroll
        for (int q = 0; q < 4; ++q) { fa[2 * q] = __uint_as_float(va[rr][q] << 16); fa[2 * q + 1] = __uint_as_float(va[rr][q] & 0xffff0000u);
          fb[2 * q] = __uint_as_float(vb[rr][q] << 16); fb[2 * q + 1] = __uint_as_float(vb[rr][q] & 0xffff0000u); }
#pragma unroll
        for (int j = 0; j < 8; ++j) { sa += fa[j] * fa[j]; sb += fb[j] * fb[j]; }
        sa = wave_sum(sa); sb = wave_sum(sb);
        const float ra = rsqrtf(sa * (1.0f / 512.0f) + EPS), rb_ = rsqrtf(sb * (1.0f / 512.0f) + EPS);
        u32x4 wa, wb;
#pragma unroll
        for (int q = 0; q < 4; ++q) { wa[q] = pk2(fa[2 * q] * ra * ga[2 * q], fa[2 * q + 1] * ra * ga[2 * q + 1]); wb[q] = pk2(fb[2 * q] * rb_ * gb[2 * q], fb[2 * q + 1] * rb_ * gb[2 * q + 1]); }
        *(LAS u32x4*)(lds + a_off(row, 16 * lane, 2048)) = wa; *(LAS u32x4*)(lds + a_off(row, 16 * (lane + 64), 2048)) = wb;
      }
    }
  }
  __syncthreads();
  f32x16 acc[4][2]; acc_zero<4>(acc);
  { const bf16x8* wp[4];
#pragma unroll
    for (int i = 0; i < 4; ++i) wp[i] = (const bf16x8*)(ws + WS_WOUT) + (size_t)((4 * wave + i) * 64) * 64 + lane;
    gemm_tile<4, 64, false, 5>(acc, lds, 2048, wp, lane); }
  if (P.variant & 2) { asm volatile("" :: "v"(acc[0][0][0]), "v"(acc[1][1][3]), "v"(acc[2][0][7]), "v"(acc[3][1][15])); return; }
  bf16_t* X1 = (bf16_t*)(ws + WS_X1); const unsigned short* XB = (const unsigned short*)(ws + WS_XB);
  float gt[4];
#pragma unroll
  for (int i = 0; i < 4; ++i) gt[i] = mod[2 * DM + 128 * wave + 32 * i + r32];
#pragma unroll
  for (int rb = 0; rb < 2; ++rb) {
    float xr[16][4];
#pragma unroll
    for (int reg = 0; reg < 16; ++reg) { const size_t off = (size_t)(t0 + 32 * rb + crow(reg, hi)) * DM + 128 * wave + r32;
#pragma unroll
      for (int i = 0; i < 4; ++i) xr[reg][i] = __uint_as_float((unsigned)__builtin_nontemporal_load(XB + off + 32 * i) << 16); }
#pragma unroll
    for (int reg = 0; reg < 16; ++reg) { const int row = 32 * rb + crow(reg, hi); const size_t off = (size_t)(t0 + row) * DM + 128 * wave + r32; float ss = 0.f;
#pragma unroll
      for (int i = 0; i < 4; ++i) { const float v = xr[reg][i] + gt[i] * acc[i][rb][reg]; acc[i][rb][reg] = v; st_wt(X1 + off + 32 * i, (bf16_t)(pk2(v, 0.f) & 0xffffu)); ss += v * v; }
#pragma unroll
      for (int o = 16; o; o >>= 1) ss += __shfl_xor(ss, o);
      if (r32 == 0) lds_fadd(&ssq[row], ss); }
  }
  __syncthreads();
  { float a2[4], s2[4];
#pragma unroll
    for (int i = 0; i < 4; ++i) { const int col = 128 * wave + 32 * i + r32; a2[i] = P.in[14][col] * (1.0f + mod[4 * DM + col]); s2[i] = mod[3 * DM + col]; }
#pragma unroll
    for (int rb = 0; rb < 2; ++rb)
#pragma unroll
      for (int reg = 0; reg < 16; ++reg) { const int row = 32 * rb + crow(reg, hi); const float rs = rsqrtf(ssq[row] * (1.0f / DM) + EPS);
#pragma unroll
        for (int i = 0; i < 4; ++i) { const float v = acc[i][rb][reg] * rs * a2[i] + s2[i]; const int col = 128 * wave + 32 * i + r32;
          *(LAS bf16_t*)(lds + a_off(row, 2 * col, 2048)) = (bf16_t)(pk2(v, v) & 0xffffu); } }
  }
  __syncthreads();
  if (P.variant & 1) return;
  if (wave < 4) {
    f32x16 ar[1][2]; acc_zero<1>(ar);
    const bf16x8* wp[1]; wp[0] = (const bf16x8*)(ws + WS_WR) + (size_t)((wave >> 1) * 64) * 64 + lane;
    gemm_tile<1, 64, false>(ar, lds, 2048, wp, lane);
    const int rb = wave & 1, col = 32 * (wave >> 1) + r32;
#pragma unroll
    for (int reg = 0; reg < 16; ++reg) { const float v = rb ? ar[0][1][reg] : ar[0][0][reg]; logit[(32 * rb + crow(reg, hi)) * 64 + col] = v; }
  }
  { uchar* H2 = ws + WS_H2;
#pragma unroll
    for (int rr = 0; rr < 8; ++rr) { const int row = wave * 8 + rr;
      const u32x4 v0 = *(const LAS u32x4*)(lds + a_off(row, 16 * lane, 2048)), v1 = *(const LAS u32x4*)(lds + a_off(row, 16 * (lane + 64), 2048));
      u32x2 w0, w1;
      w0.x = pk4_fp8(__uint_as_float(v0.x << 16) * H2_SCALE, __uint_as_float(v0.x & 0xffff0000u) * H2_SCALE, __uint_as_float(v0.y << 16) * H2_SCALE, __uint_as_float(v0.y & 0xffff0000u) * H2_SCALE);
      w0.y = pk4_fp8(__uint_as_float(v0.z << 16) * H2_SCALE, __uint_as_float(v0.z & 0xffff0000u) * H2_SCALE, __uint_as_float(v0.w << 16) * H2_SCALE, __uint_as_float(v0.w & 0xffff0000u) * H2_SCALE);
      w1.x = pk4_fp8(__uint_as_float(v1.x << 16) * H2_SCALE, __uint_as_float(v1.x & 0xffff0000u) * H2_SCALE, __uint_as_float(v1.y << 16) * H2_SCALE, __uint_as_float(v1.y & 0xffff0000u) * H2_SCALE);
      w1.y = pk4_fp8(__uint_as_float(v1.z << 16) * H2_SCALE, __uint_as_float(v1.z & 0xffff0000u) * H2_SCALE, __uint_as_float(v1.w << 16) * H2_SCALE, __uint_as_float(v1.w & 0xffff0000u) * H2_SCALE);
      u32x2* dst = (u32x2*)(H2 + (size_t)(t0 + row) * DM); dst[lane] = w0; dst[lane + 64] = w1; } }
  __syncthreads();
  if (tid < 64) {
    const float* lg = (const float*)0; (void)lg;
    float gl[4];
#pragma unroll
    for (int i = 0; i < 4; ++i) gl[i] = logit[tid * 64 + i] + P.in[16][i];
    int gi = 0; float gm = gl[0];
#pragma unroll
    for (int i = 1; i < 4; ++i) if (gl[i] > gm) { gm = gl[i]; gi = i; }
    float gs = 0.f;
#pragma unroll
    for (int i = 0; i < 4; ++i) gs += __expf(gl[i] - gm);
    const float gw = 1.0f / gs;
    float el[8];
#pragma unroll
    for (int i = 0; i < 8; ++i) el[i] = logit[tid * 64 + 4 + gi * 8 + i] + P.in[18][gi * 8 + i];
    int i1 = 0; float m1 = el[0];
#pragma unroll
    for (int i = 1; i < 8; ++i) if (el[i] > m1) { m1 = el[i]; i1 = i; }
    int i2 = (i1 + 1) & 7; float m2 = el[i2];
#pragma unroll
    for (int i = 0; i < 8; ++i) if (i != i1 && el[i] > m2) { m2 = el[i]; i2 = i; }
    const float p2 = __expf(m2 - m1), w1 = 1.0f / (1.0f + p2), w2 = p2 * w1;
    const int e1 = gi * 8 + i1, e2 = gi * 8 + i2;
    selE[2 * tid] = e1; selE[2 * tid + 1] = e2; selW[2 * tid] = gw * w1; selW[2 * tid + 1] = gw * w2;
    selP[2 * tid] = __hip_atomic_fetch_add(&cntl[e1], 1, __ATOMIC_RELAXED, __HIP_MEMORY_SCOPE_WORKGROUP);
    selP[2 * tid + 1] = __hip_atomic_fetch_add(&cntl[e2], 1, __ATOMIC_RELAXED, __HIP_MEMORY_SCOPE_WORKGROUP);
  }
  __syncthreads();
  if (tid < 32) { const int c = cntl[tid]; basel[tid] = c ? atomicAdd((int*)(ws + WS_CNT) + tid, c) : 0; }
  __syncthreads();
  if (tid < 128) { const int e = selE[tid], pos = basel[e] + selP[tid];
    ((int*)(ws + WS_LIST))[(size_t)e * 16384 + pos] = (t0 + (tid >> 1)) * 2 + (tid & 1);
    ((float*)(ws + WS_WT))[(size_t)(t0 + (tid >> 1)) * 2 + (tid & 1)] = selW[tid]; }
  __syncthreads();
}

constexpr int P4_ROWS = 144, P4_NRB = 5, P4_MISC = P4_ROWS * 1024;
__device__ __forceinline__ void phase4(const KP& P, LAS uchar* lds) {
  int lane_ = mk_lane(); asm volatile("" : "+v"(lane_)); const int lane = lane_ & 63, wave = P.wave, tid = wave * 64 + lane, r32 = lane & 31, hi = lane >> 5;
  uchar* ws = P.ws;
  LAS int* rinfo = (LAS int*)(lds + P4_MISC + 1024);
  LAS float* rwt = (LAS float*)(lds + P4_MISC + 2048);
  LAS int* ustart = (LAS int*)(lds + P4_MISC + 3072);
  const int* cnt = (const int*)(ws + WS_CNT);
  if (tid == 0) { int acc_ = 0; for (int e = 0; e < 32; ++e) { ustart[e] = acc_; acc_ += (cnt[e] + P4_ROWS - 1) / P4_ROWS; } ustart[32] = acc_; }
  __syncthreads();
  const int total = ustart[32];
  const uchar* H2 = ws + WS_H2; bf16_t* Y = (bf16_t*)(ws + WS_Y);
#pragma unroll 1
  for (int u0 = blockIdx.x; u0 < ((total + 255) & ~255); u0 += gridDim.x) {
    const int u = gridDim.x == 256 ? (u0 & ~255) + (u0 & 7) * 32 + ((u0 & 255) >> 3) : u0;
    if (u >= total) continue;
    int e = 0;
#pragma unroll 1
    for (int k = 1; k < 32; ++k) if (ustart[k] <= u) e = k;
    const int ne = cnt[e], ke = ustart[e + 1] - ustart[e], q = (ne + ke - 1) / ke, j = u - ustart[e], base = j * q, len = min(q, ne - base), nrb = (len + 31) >> 5;
    if (tid < 160) { int info = -1; float w = 0.f;
      if (tid < len) { info = ((const int*)(ws + WS_LIST))[(size_t)e * 16384 + base + tid]; w = ((const float*)(ws + WS_WT))[info]; }
      rinfo[tid] = info; rwt[tid] = w; }
    __syncthreads();
#pragma unroll
    for (int hf = 0; hf < 2; ++hf) {
      u32x4 v[9];
#pragma unroll
      for (int rr = 0; rr < 9; ++rr) { const int info = rinfo[wave * 18 + hf * 9 + rr]; const int tok = info < 0 ? 0 : (info >> 1); v[rr] = ((const u32x4*)(H2 + (size_t)tok * DM))[lane]; }
#pragma unroll
      for (int rr = 0; rr < 9; ++rr) *(LAS u32x4*)(lds + a_off(wave * 18 + hf * 9 + rr, 16 * lane, 1024)) = v[rr];
    }
    __syncthreads();
    f32x16 ag[2][P4_NRB];
#pragma unroll
    for (int i = 0; i < 2; ++i)
#pragma unroll
      for (int rb = 0; rb < P4_NRB; ++rb) ag[i][rb] = f32x16{};
    { const l64x2* wp[2];
      wp[0] = (const l64x2*)(ws + WS_WG) + (size_t)((e * 8 + wave) * 32) * 64 + lane;
      wp[1] = (const l64x2*)(ws + WS_WU) + (size_t)((e * 8 + wave) * 32) * 64 + lane;
      if (!(P.variant & 2)) gemm_tile_f8<2, 32, true, 1, false, P4_NRB>(ag, lds, 1024, wp, lane, nrb); }
    __syncthreads();
    { constexpr float S1 = 1.0f / (H2_SCALE * WGU_SCALE);
#pragma unroll
      for (int rb = 0; rb < P4_NRB; ++rb) if (rb < nrb) { const int rr = 32 * rb + r32; const float w = rwt[rr] * HID_SCALE;
#pragma unroll
        for (int g = 0; g < 4; ++g) { float hv[4];
#pragma unroll
          for (int i = 0; i < 4; ++i) { const float gg = ag[0][rb][4 * g + i] * S1, uu = ag[1][rb][4 * g + i] * S1; hv[i] = gg / (1.0f + __expf(-gg)) * uu * w; }
          *(LAS unsigned*)(lds + a_off(rr, 32 * wave + 8 * g + 4 * hi, 256)) = pk4_fp8(hv[0], hv[1], hv[2], hv[3]); } } }
    __syncthreads();
#pragma unroll 1
    for (int pass = (P.variant & 1) ? 2 : 0; pass < 2; ++pass) {
      f32x16 ad[2][P4_NRB];
#pragma unroll
      for (int i = 0; i < 2; ++i)
#pragma unroll
        for (int rb = 0; rb < P4_NRB; ++rb) ad[i][rb] = f32x16{};
      const l64x2* wp[2];
#pragma unroll
      for (int i = 0; i < 2; ++i) wp[i] = (const l64x2*)(ws + WS_WD) + (size_t)((e * 32 + 4 * wave + 2 * pass + i) * 8) * 64 + lane;
      gemm_tile_f8<2, 8, false, 1, false, P4_NRB>(ad, lds, 256, wp, lane, nrb);
      constexpr float S2 = 1.0f / (HID_SCALE * WD_SCALE);
#pragma unroll
      for (int rb = 0; rb < P4_NRB; ++rb) if (rb < nrb) {
#pragma unroll
        for (int reg = 0; reg < 16; ++reg) { const int info = rinfo[32 * rb + crow(reg, hi)];
          if (info >= 0) { bf16_t* yp = Y + (size_t)info * DM + 128 * wave + 64 * pass + r32;
            st_wt(yp, (bf16_t)(pk2(ad[0][rb][reg] * S2, 0.f) & 0xffffu)); st_wt(yp + 32, (bf16_t)(pk2(ad[1][rb][reg] * S2, 0.f) & 0xffffu)); } } }
    }
    __syncthreads();
  }
}

__device__ __forceinline__ void phase5(const KP& P) {
  int lane_ = mk_lane(); asm volatile("" : "+v"(lane_)); const int lane = lane_ & 63, wave = P.wave;
  uchar* ws = P.ws;
  const bf16_t* Y = (const bf16_t*)(ws + WS_Y);
  const bf16_t* X1 = (const bf16_t*)(ws + WS_X1); float* OUT = P.out;
  f32x4 gf[4];
#pragma unroll
  for (int i = 0; i < 4; ++i) gf[i] = *(const f32x4*)(P.in[22] + 4 * (lane + 64 * i));
  constexpr int RPI = 4;
  const int nwv = gridDim.x * NWAVE, wv = blockIdx.x * NWAVE + wave;
#pragma unroll 1
  for (int t0 = wv * RPI; t0 < T; t0 += nwv * RPI) {
    u32x2 xv[RPI][4]; u32x2 ya[RPI][4], yb[RPI][4];
#pragma unroll
    for (int r = 0; r < RPI; ++r)
#pragma unroll
      for (int i = 0; i < 4; ++i) { const int k = 4 * (lane + 64 * i); const size_t t = t0 + r;
        xv[r][i] = __builtin_nontemporal_load((const u32x2*)(X1 + t * DM + k)); ya[r][i] = __builtin_nontemporal_load((const u32x2*)(Y + (2 * t) * DM + k)); yb[r][i] = __builtin_nontemporal_load((const u32x2*)(Y + (2 * t + 1) * DM + k)); }
    const int b = t0 / SEQ; const float* gt2 = (const float*)(ws + WS_MOD) + b * (NMOD * DM) + 5 * DM;
    f32x4 g2v[4];
#pragma unroll
    for (int i = 0; i < 4; ++i) g2v[i] = *(const f32x4*)(gt2 + 4 * (lane + 64 * i));
#pragma unroll
    for (int r = 0; r < RPI; ++r) {
      f32x4 v[4]; float ss = 0.f;
#pragma unroll
      for (int i = 0; i < 4; ++i) { const u32x2 y0 = ya[r][i], y1 = yb[r][i]; f32x4 ys;
        ys[0] = __uint_as_float(y0.x << 16) + __uint_as_float(y1.x << 16); ys[1] = __uint_as_float(y0.x & 0xffff0000u) + __uint_as_float(y1.x & 0xffff0000u);
        ys[2] = __uint_as_float(y0.y << 16) + __uint_as_float(y1.y << 16); ys[3] = __uint_as_float(y0.y & 0xffff0000u) + __uint_as_float(y1.y & 0xffff0000u);
        f32x4 xf; xf[0] = __uint_as_float(xv[r][i].x << 16); xf[1] = __uint_as_float(xv[r][i].x & 0xffff0000u); xf[2] = __uint_as_float(xv[r][i].y << 16); xf[3] = __uint_as_float(xv[r][i].y & 0xffff0000u);
        v[i] = xf + g2v[i] * ys; ss += v[i][0] * v[i][0] + v[i][1] * v[i][1] + v[i][2] * v[i][2] + v[i][3] * v[i][3]; }
      ss = wave_sum(ss); const float rs = rsqrtf(ss * (1.0f / DM) + EPS);
#pragma unroll
      for (int i = 0; i < 4; ++i) __builtin_nontemporal_store(v[i] * rs * gf[i], (f32x4*)(OUT + (size_t)(t0 + r) * DM + 4 * (lane + 64 * i)));
    }
  }
}
__global__ void __launch_bounds__(NTHR, 2) mk_fwd(const Params P0) {
  extern __shared__ __attribute__((aligned(16))) uchar lds_raw[];
  LAS uchar* lds = (LAS uchar*)lds_raw;
  KP P; P.in = P0.in; P.out = P0.out; P.ws = P0.ws; P.ph_lo = P0.ph_lo; P.ph_hi = P0.ph_hi; P.variant = P0.variant; P.wave = __builtin_amdgcn_readfirstlane((int)(threadIdx.x >> 6));
  const int bid = blockIdx.x, G = gridDim.x;
  const int lo = P.ph_lo, hi = P.ph_hi;
  volatile LAS unsigned* bst = (volatile LAS unsigned*)(lds + LDS_BYTES - 16);
  if (threadIdx.x < 4) bst[threadIdx.x] = 0u;
  __syncthreads();
  XcdBarrier bar; bar.bar = (unsigned*)(P.ws + WS_CTL); bar.x = 0; bar.st = bst;
  if (hi - lo > 1) bar = xcd_barrier_post((unsigned*)(P.ws + WS_CTL), bst, P.wave == 0 && mk_lane() == 0);
#define IN(k) (lo <= (k) && (k) < hi)
#define BOTH(k) (IN(k) && IN((k) + 1))
  if (IN(0)) { phase0(P, lds); if (BOTH(0)) xcd_barrier(bar, P.wave == 0 && mk_lane() == 0); }
  if (IN(1)) { if (bid < T / 64) phase1_tile(P, lds, bid); if (BOTH(1)) xcd_barrier(bar, P.wave == 0 && mk_lane() == 0); }
  if (IN(2)) { phase2(P, lds); if (BOTH(2)) xcd_barrier(bar, P.wave == 0 && mk_lane() == 0); }
  if (IN(3)) { if (bid < T / 64) phase3_tile(P, lds, bid); if (BOTH(3)) xcd_barrier(bar, P.wave == 0 && mk_lane() == 0); }
  if (IN(4)) { phase4(P, lds); if (BOTH(4)) xcd_barrier(bar, P.wave == 0 && mk_lane() == 0); }
  if (IN(5)) phase5(P);
#undef IN
#undef BOTH
}

extern "C" void kernel_launch(void* const* d_in, const int* in_sizes, int n_in, void* d_out, int out_size, void* d_ws, size_t ws_size, hipStream_t stream) {
  static int ready = 0;
  if (!ready) {
    if (n_in != 23 || out_size != T * DM || ws_size < WS_END) { fprintf(stderr, "kernel_launch: unexpected shapes (n_in %d out %d ws %zu need %zu)\n", n_in, out_size, ws_size, (size_t)WS_END); return; }
    if (hipFuncSetAttribute((const void*)mk_fwd, hipFuncAttributeMaxDynamicSharedMemorySize, LDS_BYTES) != hipSuccess) { fprintf(stderr, "kernel_launch: hipFuncSetAttribute failed\n"); return; }
    ready = 1;
  }
  uchar* ws = (uchar*)d_ws;
  if (hipMemsetAsync(ws + WS_CTL, 0, 32768, stream) != hipSuccess) { fprintf(stderr, "kernel_launch: hipMemsetAsync failed\n"); return; }
  Params p{};
  for (int i = 0; i < 23; ++i) p.in[i] = (const float*)d_in[i];
  p.out = (float*)d_out; p.ws = ws; p.ph_lo = 0; p.ph_hi = 6; p.variant = 0; p.pad = 0;
  hipLaunchKernelGGL(mk_fwd, dim3(T / 64), dim3(NTHR), LDS_BYTES, stream, p);
}
```

```cpp
#include <hip/hip_runtime.h>
#include <cstdio>
#include <cstdint>
constexpr int DM = 1024, NB = 4, SEQ = 4096, T = NB * SEQ;
constexpr int INW = 1120, NMOD = 6;
constexpr float EPS = 1e-6f;
#define LAS __attribute__((address_space(3)))
typedef unsigned short bf16_t;
typedef short bf16x8 __attribute__((ext_vector_type(8)));
typedef float f32x16 __attribute__((ext_vector_type(16)));
typedef float f32x4 __attribute__((ext_vector_type(4)));
typedef unsigned u32x4 __attribute__((ext_vector_type(4)));
typedef unsigned u32x2 __attribute__((ext_vector_type(2)));
typedef unsigned char uchar;

constexpr int NTHR = 512, NWAVE = 8;
constexpr int LDS_A = 0, LDS_MISC = 131072, LDS_BYTES = 163840;
constexpr float LOG2E = 1.4426950408889634f;
constexpr float QSCALE_A = 0.125f * LOG2E * (128.0f / 65535.0f);
constexpr float QSCALE_B = 0.10206207261596575f * LOG2E;
constexpr float THR2 = 10.f;
constexpr float WIN_SCALE = 64.f, WIN_DESCALE = 1.0f / 64.f;
constexpr float H2_SCALE = 8.f, WGU_SCALE = 64.f, WD_SCALE = 32.f, HID_SCALE = 8.f, Y_SCALE = 16.f;

constexpr size_t WS_CTL   = 0;
constexpr size_t WS_CNT   = 16384;
constexpr size_t WS_MOD   = 32768;
constexpr size_t WS_TABA  = WS_MOD + 98304;
constexpr size_t WS_TABB  = WS_TABA + 4096 * 32 * 8;
constexpr size_t WS_WIN   = WS_TABB + 4096 * 16 * 8;
constexpr size_t WS_WUQ   = WS_WIN + 35 * 64 * 1024;
constexpr size_t WS_WUKV  = WS_WUQ + 24 * 12 * 1024;
constexpr size_t WS_WOUT  = WS_WUKV + 32 * 8 * 1024;
constexpr size_t WS_WR    = WS_WOUT + 32 * 64 * 1024;
constexpr size_t WS_WG    = WS_WR + 2 * 64 * 1024;
constexpr size_t WS_WU    = WS_WG + (size_t)32 * 8 * 32 * 1024;
constexpr size_t WS_WD    = WS_WU + (size_t)32 * 8 * 32 * 1024;
constexpr size_t WS_LIST  = WS_WD + (size_t)32 * 32 * 8 * 1024;
constexpr size_t WS_WT    = WS_LIST + (size_t)32 * 16384 * 4;
constexpr size_t WS_QA    = WS_WT + (size_t)T * 2 * 4;
constexpr size_t WS_KVA   = WS_QA + (size_t)NB * 8 * 64 * 8192;
constexpr size_t WS_QB    = WS_KVA + (size_t)NB * 2 * 64 * 16384;
constexpr size_t WS_KVB   = WS_QB + (size_t)NB * 8 * 64 * 12288;
constexpr size_t WS_O     = WS_KVB + (size_t)NB * 8 * 64 * 20480;
constexpr size_t WS_H2    = WS_O + (size_t)T * DM * 2;
constexpr size_t WS_X1    = WS_H2 + (size_t)T * DM * 2;
constexpr size_t WS_XB    = WS_X1 + (size_t)T * DM * 2;
constexpr size_t WS_END   = WS_XB + (size_t)T * DM * 2;
constexpr size_t WS_Y     = WS_QA;
static_assert((size_t)T * 2 * DM * 2 <= WS_O - WS_QA, "Y overlay");

struct Params { const float* in[23]; float* out; unsigned char* ws; int ph_lo, ph_hi, variant, pad; };
struct KP { const float* const* in; float* out; unsigned char* ws; int ph_lo, ph_hi, wave, variant; };
__device__ __forceinline__ int mk_lane() { return (int)__builtin_amdgcn_mbcnt_hi(~0u, __builtin_amdgcn_mbcnt_lo(~0u, 0u)); }

__device__ __forceinline__ unsigned pk2(float lo, float hi) { unsigned r; asm("v_cvt_pk_bf16_f32 %0, %1, %2" : "=v"(r) : "v"(lo), "v"(hi)); return r; }
__device__ __forceinline__ float bf2f(unsigned short v) { return __uint_as_float((unsigned)v << 16); }
__host__ __device__ __forceinline__ constexpr int crow(int r, int hi) { return (r & 3) + 8 * (r >> 2) + 4 * hi; }
__device__ __forceinline__ f32x16 mfma(bf16x8 a, bf16x8 b, f32x16 c) { return __builtin_amdgcn_mfma_f32_32x32x16_bf16(a, b, c, 0, 0, 0); }
__device__ __forceinline__ float wave_sum(float v) {
#pragma unroll
  for (int o = 32; o; o >>= 1) v += __shfl_xor(v, o);
  return v;
}
__device__ __forceinline__ float half_swap_max(float x) { auto rr = __builtin_amdgcn_permlane32_swap(__float_as_uint(x), __float_as_uint(x), false, false);
  float m; asm("v_max_f32 %0, %1, %2" : "=v"(m) : "v"(rr[0]), "v"(rr[1])); return m; }
__device__ __forceinline__ float half_swap_sum(float x) { auto rr = __builtin_amdgcn_permlane32_swap(__float_as_uint(x), __float_as_uint(x), false, false); return __uint_as_float(rr[0]) + __uint_as_float(rr[1]); }
template <typename TT> __device__ __forceinline__ void st_wt(TT* p, TT v) { __hip_atomic_store(p, v, __ATOMIC_RELAXED, __HIP_MEMORY_SCOPE_AGENT); }
__device__ __forceinline__ void st_wt8(void* p, u32x2 v) { st_wt((unsigned long long*)p, __builtin_bit_cast(unsigned long long, v)); }
__device__ __forceinline__ void st_wt16(void* p, u32x4 v) { st_wt8(p, u32x2{v.x, v.y}); st_wt8((uchar*)p + 8, u32x2{v.z, v.w}); }
__host__ __device__ __forceinline__ constexpr int a_off(int row, int kbyte, int pitch) { return row * pitch + (kbyte ^ ((row & 15) << 4)); }
__host__ __device__ __forceinline__ constexpr int img_qk(int rr, int d, int NS) { return ((((rr >> 5) * NS + (d >> 4)) * 64) + ((d >> 3) & 1) * 32 + (rr & 31)) * 16 + (d & 7) * 2; }
__host__ __device__ __forceinline__ constexpr int img_v(int kk, int d) {
  const int kb = kk >> 5, k32 = kk & 31, s = k32 >> 4, k16 = k32 & 15, h = (k16 >> 2) & 1, j = ((k16 >> 3) << 2) | (k16 & 3), db = d >> 5, r = d & 31;
  return (((((kb * 2 + db) * 2 + s) * 64) + h * 32 + r) * 8 + j) * 2;
}

#define XB_TMO      128
#define XB_XCNT(j)  (256  + 64 * (j))
#define XB_XSUB(j)  (1280 + 64 * (j))
#define XB_XGEN(j)  (2304 + 64 * (j))
#define XB_TOP      3328
#define XB_TOPGEN   3392
#define XCD_BAR_WORDS 3456
#define XB_SPIN_CAP (1u << 20)
__device__ __forceinline__ unsigned xb_ld(unsigned* p)              { return __hip_atomic_load(p, __ATOMIC_RELAXED, __HIP_MEMORY_SCOPE_AGENT); }
__device__ __forceinline__ unsigned xb_add(unsigned* p, unsigned v) { return __hip_atomic_fetch_add(p, v, __ATOMIC_RELAXED, __HIP_MEMORY_SCOPE_AGENT); }
__device__ __forceinline__ unsigned xb_xcc_id() { return (unsigned)__builtin_amdgcn_s_getreg((3 << 11) | 20) & 0xFu; }
#define XB_SPIN(cond, bar) do { unsigned _sp = 0; while (cond) { __builtin_amdgcn_s_sleep(1); \
    if ((++_sp & 255u) == 0u) { if (xb_ld(&(bar)[XB_TMO])) break; if (_sp > XB_SPIN_CAP) { atomicAdd(&(bar)[XB_TMO], 1u); break; } } } } while (0)
struct XcdBarrier { unsigned* bar; unsigned x; volatile LAS unsigned* st; };
__device__ __forceinline__ XcdBarrier xcd_barrier_post(unsigned* bar, volatile LAS unsigned* st, bool leader) {
  XcdBarrier b; b.bar = bar; b.x = xb_xcc_id(); b.st = st;
  if (leader) (void)xb_add(&bar[XB_XCNT(b.x)], 1u);
  return b;
}
__device__ __forceinline__ void xcd_barrier_complete(unsigned* bar, unsigned x, unsigned& nloc, unsigned& nx) {
  const unsigned G = gridDim.x * gridDim.y * gridDim.z;
  unsigned sum, cnt, mine, sp = 0u;
  for (;;) {
    sum = 0u; cnt = 0u; mine = 0u;
#pragma unroll
    for (unsigned j = 0; j < 16; ++j) { const unsigned c = xb_ld(&bar[XB_XCNT(j)]); sum += c; cnt += (c > 0u) ? 1u : 0u; mine = (j == x) ? c : mine; }
    if (sum == G) break;
    __builtin_amdgcn_s_sleep(1);
    if ((++sp & 255u) == 0u) { if (xb_ld(&bar[XB_TMO])) break; if (sp > XB_SPIN_CAP) { atomicAdd(&bar[XB_TMO], 1u); break; } }
  }
  nloc = mine > 0u ? mine : 1u; nx = cnt > 0u ? cnt : 1u;
}
__device__ __forceinline__ void xcd_barrier(const XcdBarrier& b, bool leader) {
  asm volatile("s_waitcnt vmcnt(0)" ::: "memory");
  __syncthreads();
  if (leader) {
    unsigned* bar = b.bar;
    __builtin_amdgcn_s_waitcnt(0);
    unsigned nloc = b.st[0], nx = b.st[1];
    if (nloc == 0u) { xcd_barrier_complete(bar, b.x, nloc, nx); b.st[0] = nloc; b.st[1] = nx; }
    const unsigned old = xb_add(&bar[XB_XSUB(b.x)], 1u);
    const unsigned gen = old / nloc;
    if (old + 1u == (gen + 1u) * nloc) {
      __builtin_amdgcn_fence(__ATOMIC_RELEASE, "agent");
      asm volatile("s_waitcnt vmcnt(0)" ::: "memory");
      const unsigned og = xb_add(&bar[XB_TOP], 1u);
      const unsigned tg = og / nx;
      if (og + 1u == (tg + 1u) * nx) xb_add(&bar[XB_TOPGEN], 1u);
      else XB_SPIN(xb_ld(&bar[XB_TOPGEN]) == tg, bar);
      __builtin_amdgcn_fence(__ATOMIC_ACQUIRE, "agent");
      xb_add(&bar[XB_XGEN(b.x)], 1u);
      asm volatile("s_waitcnt vmcnt(0)" ::: "memory");
    } else {
      XB_SPIN(xb_ld(&bar[XB_XGEN(b.x)]) == gen, bar);
      __builtin_amdgcn_fence(__ATOMIC_ACQUIRE, "agent");
      asm volatile("s_waitcnt vmcnt(0)" ::: "memory");
    }
  }
  __syncthreads();
}

template <int NBLK, int NS, bool TR, int D = (NBLK >= 3 ? 4 : 8)>
__device__ __forceinline__ void gemm_tile(f32x16 (&acc)[NBLK][2], const LAS uchar* A, const int pitch, const bf16x8* const (&wp)[NBLK], const int lane) {
  constexpr int NSM = (NS / D) * D;
  const int r = lane & 31, h = lane >> 5;
  const LAS uchar* a0p = A + r * pitch; const LAS uchar* a1p = A + (32 + r) * pitch;
  const int swz = (lane & 15) << 4, kb0 = 16 * h;
  bf16x8 ring[D][NBLK];
#pragma unroll
  for (int d = 0; d < D; ++d)
#pragma unroll
    for (int i = 0; i < NBLK; ++i) ring[d][i] = wp[i][d * 64];
  bf16x8 fa0 = *(const LAS bf16x8*)(a0p + (kb0 ^ swz)), fa1 = *(const LAS bf16x8*)(a1p + (kb0 ^ swz));
#pragma unroll 1
  for (int s0 = 0; s0 < NSM; s0 += D) {
#pragma unroll
    for (int d = 0; d < D; ++d) {
      const int s = s0 + d;
      const int kn = ((((s + 1 < NS) ? s + 1 : s) * 32) + kb0) ^ swz; const bf16x8 na0 = *(const LAS bf16x8*)(a0p + kn), na1 = *(const LAS bf16x8*)(a1p + kn);
#pragma unroll
      for (int i = 0; i < NBLK; ++i) {
        if (TR) { acc[i][0] = mfma(ring[d][i], fa0, acc[i][0]); acc[i][1] = mfma(ring[d][i], fa1, acc[i][1]); }
        else    { acc[i][0] = mfma(fa0, ring[d][i], acc[i][0]); acc[i][1] = mfma(fa1, ring[d][i], acc[i][1]); }
      }
      if (s + D < NS) {
#pragma unroll
        for (int i = 0; i < NBLK; ++i) ring[d][i] = wp[i][(s + D) * 64];
      }
      fa0 = na0; fa1 = na1;
      __builtin_amdgcn_sched_barrier(0);
    }
  }
#pragma unroll
  for (int d = 0; d < NS - NSM; ++d) {
    const int s = NSM + d;
    const int kn = ((((s + 1 < NS) ? s + 1 : s) * 32) + kb0) ^ swz; const bf16x8 na0 = *(const LAS bf16x8*)(a0p + kn), na1 = *(const LAS bf16x8*)(a1p + kn);
#pragma unroll
    for (int i = 0; i < NBLK; ++i) {
      if (TR) { acc[i][0] = mfma(ring[d][i], fa0, acc[i][0]); acc[i][1] = mfma(ring[d][i], fa1, acc[i][1]); }
      else    { acc[i][0] = mfma(fa0, ring[d][i], acc[i][0]); acc[i][1] = mfma(fa1, ring[d][i], acc[i][1]); }
    }
    fa0 = na0; fa1 = na1;
  }
}
typedef long l64x2 __attribute__((ext_vector_type(2)));
typedef float f32x2 __attribute__((ext_vector_type(2)));
__device__ __forceinline__ f32x16 mfma8(long a, long b, f32x16 c) { return __builtin_amdgcn_mfma_f32_32x32x16_fp8_fp8(a, b, c, 0, 0, 0); }
__device__ __forceinline__ unsigned pk4_fp8(float a, float b, float c, float d) { int w = 0; w = __builtin_amdgcn_cvt_pk_fp8_f32(a, b, w, false); w = __builtin_amdgcn_cvt_pk_fp8_f32(c, d, w, true); return (unsigned)w; }
typedef int i32x8 __attribute__((ext_vector_type(8)));
typedef int i32x4 __attribute__((ext_vector_type(4)));
#ifndef MK_MX
#define MK_MX 1
#endif
__device__ __forceinline__ f32x16 mfma_mx(i32x4 a0, i32x4 a1, i32x4 b0, i32x4 b1, f32x16 c) {
  const i32x8 a = __builtin_shufflevector(a0, a1, 0, 1, 2, 3, 4, 5, 6, 7), b = __builtin_shufflevector(b0, b1, 0, 1, 2, 3, 4, 5, 6, 7);
  return __builtin_amdgcn_mfma_scale_f32_32x32x64_f8f6f4(a, b, c, 0, 0, 0, 0x7f7f7f7f, 0, 0x7f7f7f7f);
}
__device__ __forceinline__ f32x16 mfma_mx_q(i32x4 a0, i32x4 a1, i32x4 b0, i32x4 b1, f32x16 c) {
  const i32x8 a = __builtin_shufflevector(a0, a1, 0, 1, 2, 3, 4, 5, 6, 7), b = __builtin_shufflevector(b0, b1, 0, 1, 2, 3, 4, 5, 6, 7);
  return __builtin_amdgcn_mfma_scale_f32_32x32x64_f8f6f4(a, b, c, 0, 0, 0, 0x7f7f7f7f, 0, 0x77777777);
}
__device__ __forceinline__ unsigned mk_pknorm(float lo, float hi) { typedef unsigned short u16x2 __attribute__((ext_vector_type(2))); const u16x2 v = __builtin_amdgcn_cvt_pknorm_u16(lo, hi); return __builtin_bit_cast(unsigned, v); }
__device__ __forceinline__ f32x16 mfma_mx8(i32x8 a, i32x8 b, f32x16 c) { return __builtin_amdgcn_mfma_scale_f32_32x32x64_f8f6f4(a, b, c, 0, 0, 0, 0x7f7f7f7f, 0, 0x7f7f7f7f); }
__device__ __forceinline__ i32x8 ld_pair(const i32x4* p0, const i32x4* p1) { const i32x4 x = *p0, y = *p1; return __builtin_shufflevector(x, y, 0, 1, 2, 3, 4, 5, 6, 7); }
template <int NBLK, int NS, bool TR, int D, bool FULL, int NRB>
__device__ __forceinline__ void gemm_tile_f8(f32x16 (&acc)[NBLK][NRB], const LAS uchar* A, const int pitch, const l64x2* const (&wp)[NBLK], const int lane, const int nrb) {
  constexpr int NP = NS / 2;
  static_assert(NS % 2 == 0 && NP % D == 0, "NS even, NP % D");
  const int r = lane & 31, h = lane >> 5;
  const LAS uchar* ap = A + r * pitch;
  const int swz = (lane & 15) << 4, kb0 = 16 * h;
  i32x8 ring[D][NBLK];
#pragma unroll
  for (int d = 0; d < D; ++d)
#pragma unroll
    for (int i = 0; i < NBLK; ++i) ring[d][i] = ld_pair((const i32x4*)(wp[i] + (2 * d) * 64), (const i32x4*)(wp[i] + (2 * d + 1) * 64));
#pragma unroll 1
  for (int p0 = 0; p0 < NP; p0 += D) {
#pragma unroll
    for (int d = 0; d < D; ++d) {
      const int s = 2 * (p0 + d);
      const int ko0 = ((s * 32) + kb0) ^ swz, ko1 = (((s + 1) * 32) + kb0) ^ swz;
#pragma unroll
      for (int rb = 0; rb < NRB; ++rb) {
        if (FULL || rb < nrb) {
          const i32x4 f0 = *(const LAS i32x4*)(ap + rb * 32 * pitch + ko0), f1 = *(const LAS i32x4*)(ap + rb * 32 * pitch + ko1);
          const i32x8 fa = __builtin_shufflevector(f0, f1, 0, 1, 2, 3, 4, 5, 6, 7);
#pragma unroll
          for (int i = 0; i < NBLK; ++i) acc[i][rb] = TR ? mfma_mx8(ring[d][i], fa, acc[i][rb]) : mfma_mx8(fa, ring[d][i], acc[i][rb]);
        }
      }
      if (p0 + d + D < NP) {
#pragma unroll
        for (int i = 0; i < NBLK; ++i) ring[d][i] = ld_pair((const i32x4*)(wp[i] + (2 * (p0 + d + D)) * 64), (const i32x4*)(wp[i] + (2 * (p0 + d + D) + 1) * 64));
      }
    }
  }
}
template <int NSLOT, int NACC, int NS, bool TR, int D, int MAP>
__device__ __forceinline__ void gemm_slots_f8(f32x16 (&acc)[NACC][2], const LAS uchar* A, const int pitch, const l64x2* const (&wp)[NSLOT], const int lane) {
  constexpr int NP = NS / 2;
  static_assert(NS % 2 == 0 && NP % D == 0, "NS even, NP % D");
  const int r = lane & 31, h = lane >> 5;
  const LAS uchar* ap = A + r * pitch;
  const int swz = (lane & 15) << 4, kb0 = 16 * h;
  i32x8 ring[D][NSLOT];
#pragma unroll
  for (int d = 0; d < D; ++d)
#pragma unroll
    for (int i = 0; i < NSLOT; ++i) ring[d][i] = ld_pair((const i32x4*)(wp[i] + (2 * d) * 64), (const i32x4*)(wp[i] + (2 * d + 1) * 64));
#pragma unroll 1
  for (int p0 = 0; p0 < NP; p0 += D) {
#pragma unroll
    for (int d = 0; d < D; ++d) {
      const int s = 2 * (p0 + d);
      const int ko0 = ((s * 32) + kb0) ^ swz, ko1 = (((s + 1) * 32) + kb0) ^ swz;
#pragma unroll
      for (int rb = 0; rb < 2; ++rb) {
        const i32x4 f0 = *(const LAS i32x4*)(ap + rb * 32 * pitch + ko0), f1 = *(const LAS i32x4*)(ap + rb * 32 * pitch + ko1);
        const i32x8 fa = __builtin_shufflevector(f0, f1, 0, 1, 2, 3, 4, 5, 6, 7);
#pragma unroll
        for (int i = 0; i < NSLOT; ++i) { constexpr int dummy = 0; (void)dummy; const int ai = (MAP >> (4 * i)) & 15;
          acc[ai][rb] = TR ? mfma_mx8(ring[d][i], fa, acc[ai][rb]) : mfma_mx8(fa, ring[d][i], acc[ai][rb]); }
      }
      if (p0 + d + D < NP) {
#pragma unroll
        for (int i = 0; i < NSLOT; ++i) ring[d][i] = ld_pair((const i32x4*)(wp[i] + (2 * (p0 + d + D)) * 64), (const i32x4*)(wp[i] + (2 * (p0 + d + D) + 1) * 64));
      }
    }
  }
}
template <int NBLK> __device__ __forceinline__ void acc_zero(f32x16 (&acc)[NBLK][2]) {
#pragma unroll
  for (int i = 0; i < NBLK; ++i) { acc[i][0] = f32x16{}; acc[i][1] = f32x16{}; }
}

__device__ __forceinline__ void swap32(unsigned& a, unsigned& b) { const auto r = __builtin_amdgcn_permlane32_swap(a, b, false, false); a = r[0]; b = r[1]; }
__device__ __forceinline__ void store_img_qk(uchar* img, const f32x16& v, int rr, int f0, int NS, int hi) {
  unsigned wx[4], wy[4];
#pragma unroll
  for (int g = 0; g < 4; ++g) { wx[g] = pk2(v[4 * g], v[4 * g + 1]); wy[g] = pk2(v[4 * g + 2], v[4 * g + 3]); }
  swap32(wx[0], wx[2]); swap32(wy[0], wy[2]); swap32(wx[1], wx[3]); swap32(wy[1], wy[3]);
#pragma unroll
  for (int gq = 0; gq < 2; ++gq) *(u32x4*)(img + img_qk(rr, f0 + 8 * (gq + 2 * hi), NS)) = u32x4{wx[gq], wy[gq], wx[2 + gq], wy[2 + gq]};
}
__device__ __forceinline__ void store_img_v(uchar* img, const f32x16& v, int kb, int d, int hi) {
#pragma unroll
  for (int gp = 0; gp < 2; ++gp) {
    u32x4 w; w.x = pk2(v[8 * gp], v[8 * gp + 1]); w.y = pk2(v[8 * gp + 2], v[8 * gp + 3]); w.z = pk2(v[8 * gp + 4], v[8 * gp + 5]); w.w = pk2(v[8 * gp + 6], v[8 * gp + 7]);
    *(u32x4*)(img + img_v(32 * kb + 16 * gp + 4 * hi, d)) = w; }
}
template <int CS = 1>
__device__ __forceinline__ void pack_frag(const float* __restrict__ W, int ldw, int k0, int n0, const float* __restrict__ rowscale, u32x4* __restrict__ dst, int lane) {
  const int r = lane & 31, h = lane >> 5;
  const float* p = W + (size_t)(k0 + 8 * h) * ldw + n0 + CS * r;
  float v[8];
#pragma unroll
  for (int j = 0; j < 8; ++j) v[j] = CS == 1 ? __builtin_nontemporal_load(p + (size_t)j * ldw) : p[(size_t)j * ldw];
  if (rowscale) {
#pragma unroll
    for (int j = 0; j < 8; ++j) v[j] *= rowscale[k0 + 8 * h + j];
  }
  u32x4 w; w.x = pk2(v[0], v[1]); w.y = pk2(v[2], v[3]); w.z = pk2(v[4], v[5]); w.w = pk2(v[6], v[7]);
  dst[lane] = w;
}
__device__ __forceinline__ void pack_frag8(const float* __restrict__ W, int ldw, int k0, int n0, float scale, u32x4* __restrict__ dst, int lane) {
  const int r = lane & 31, h = lane >> 5;
  const float* p = W + (size_t)(k0 + 16 * h) * ldw + n0 + r;
  float v[16];
#pragma unroll
  for (int j = 0; j < 16; ++j) v[j] = __builtin_nontemporal_load(p + (size_t)j * ldw) * scale;
  u32x4 w; w.x = pk4_fp8(v[0], v[1], v[2], v[3]); w.y = pk4_fp8(v[4], v[5], v[6], v[7]); w.z = pk4_fp8(v[8], v[9], v[10], v[11]); w.w = pk4_fp8(v[12], v[13], v[14], v[15]);
  dst[lane] = w;
}
__device__ __forceinline__ void pack_frag8_lo(const float* __restrict__ W, int ldw, int k0, int n0, float scale, u32x4* __restrict__ dst, int lane) {
  const int r = lane & 31, h = lane >> 5;
  const float* p = W + (size_t)(k0 + 16 * h) * ldw + n0 + r;
  float v[16];
#pragma unroll
  for (int j = 0; j < 16; ++j) { const float x = __builtin_nontemporal_load(p + (size_t)j * ldw) * scale; const int q = __builtin_amdgcn_cvt_pk_fp8_f32(x, 0.f, 0, false); v[j] = x - __builtin_amdgcn_cvt_f32_fp8(q, 0); }
  u32x4 w; w.x = pk4_fp8(v[0], v[1], v[2], v[3]); w.y = pk4_fp8(v[4], v[5], v[6], v[7]); w.z = pk4_fp8(v[8], v[9], v[10], v[11]); w.w = pk4_fp8(v[12], v[13], v[14], v[15]);
  dst[lane] = w;
}
__device__ __forceinline__ void phase0(const KP& P, LAS uchar* lds) {
  int lane_ = mk_lane(); asm volatile("" : "+v"(lane_)); const int lane = lane_ & 63, wave = P.wave, tid = wave * 64 + lane, bid = blockIdx.x, G = gridDim.x;
  uchar* ws = P.ws;
  if (bid == 0 && tid < 64) ((int*)(ws + WS_CNT))[tid] = 0;
  for (int idx = bid * NTHR + tid; idx < SEQ * 48; idx += G * NTHR) {
    int pos, i, half; float2* dst;
    if (idx < SEQ * 32) { pos = idx >> 5; i = idx & 31; half = 32; dst = (float2*)(ws + WS_TABA) + idx; }
    else { const int i2 = idx - SEQ * 32; pos = i2 >> 4; i = i2 & 15; half = 16; dst = (float2*)(ws + WS_TABB) + i2; }
    const float inv = __builtin_amdgcn_exp2f(-13.287712379549449f * (float)i / (float)half);
    float rev = (float)pos * inv * 0.15915494309189535f; rev -= floorf(rev);
    *dst = make_float2(__builtin_amdgcn_cosf(rev), __builtin_amdgcn_sinf(rev));
  }
  if (bid < 192) {
    const float* c = P.in[1]; const float* w_ada = P.in[2]; const float* b_ada = P.in[3];
    LAS float* sl = (LAS float*)lds; LAS float* part = (LAS float*)(lds + 16384);
    for (int i = tid; i < NB * DM; i += NTHR) { const float v = c[i]; sl[i] = v / (1.f + __expf(-v)); }
    __syncthreads();
    const int n0 = bid * 32, rowl = lane >> 3, c4 = lane & 7;
    f32x4 a0 = {0, 0, 0, 0}, a1 = a0, a2 = a0, a3 = a0;
#pragma unroll 4
    for (int it = 0; it < 16; ++it) {
      const int k = wave * 128 + it * 8 + rowl;
      const f32x4 wv = __builtin_nontemporal_load((const f32x4*)(w_ada + (size_t)k * (NMOD * DM) + n0 + 4 * c4));
      a0 += wv * sl[k]; a1 += wv * sl[DM + k]; a2 += wv * sl[2 * DM + k]; a3 += wv * sl[3 * DM + k];
    }
#pragma unroll
    for (int e = 0; e < 4; ++e) {
#pragma unroll
      for (int o = 8; o < 64; o <<= 1) { a0[e] += __shfl_xor(a0[e], o); a1[e] += __shfl_xor(a1[e], o); a2[e] += __shfl_xor(a2[e], o); a3[e] += __shfl_xor(a3[e], o); }
    }
    if (rowl == 0) {
#pragma unroll
      for (int e = 0; e < 4; ++e) { part[(wave * 4 + 0) * 32 + 4 * c4 + e] = a0[e]; part[(wave * 4 + 1) * 32 + 4 * c4 + e] = a1[e]; part[(wave * 4 + 2) * 32 + 4 * c4 + e] = a2[e]; part[(wave * 4 + 3) * 32 + 4 * c4 + e] = a3[e]; }
    }
    __syncthreads();
    if (tid < 128) { const int bb = tid >> 5, col = tid & 31; float s = b_ada[n0 + col];
#pragma unroll
      for (int w = 0; w < 8; ++w) s += part[(w * 4 + bb) * 32 + col];
      ((float*)(ws + WS_MOD))[bb * (NMOD * DM) + n0 + col] = s; }
  }
  const int gw = bid * NWAVE + wave, NGW = G * NWAVE;
  const int B1 = 43 * 32, B2 = B1 + 32 * 64, B3 = B2 + 24 * 12, B4 = B3 + 32 * 8, B5 = B4 + 2 * 64;
#pragma unroll 1
  for (int j = gw; j < B5; j += NGW) {
    if (j < B1) { const int f = j, slot = f >> 5, s = f & 31;
      if (slot < 35) pack_frag8(P.in[5], INW, 32 * s, 32 * slot, WIN_SCALE, (u32x4*)(ws + WS_WIN) + (size_t)f * 64, lane);
      else { const int blk = slot < 39 ? 20 + (slot - 35) : 30 + (slot - 39); pack_frag8_lo(P.in[5], INW, 32 * s, 32 * blk, WIN_SCALE, (u32x4*)(ws + WS_WIN) + (size_t)f * 64, lane); } }
    else if (j < B2) { const int f = j - B1; pack_frag<4>(P.in[13], DM, 16 * (f & 63), 128 * (f >> 8) + ((f >> 6) & 3), nullptr, (u32x4*)(ws + WS_WOUT) + (size_t)f * 64, lane); }
    else if (j < B3) { const int f = j - B2; pack_frag(P.in[7], 768, 16 * (f % 12), 32 * (f / 12), P.in[6], (u32x4*)(ws + WS_WUQ) + (size_t)f * 64, lane); }
    else if (j < B4) { const int f = j - B3; pack_frag(P.in[9], 1024, 16 * (f & 7), 32 * (f >> 3), P.in[8], (u32x4*)(ws + WS_WUKV) + (size_t)f * 64, lane); }
    else { const int f = j - B4;
    const int nb = f >> 6, s = f & 63, r = lane & 31, h = lane >> 5, col = 32 * nb + r;
    float v[8];
#pragma unroll
    for (int j = 0; j < 8; ++j) { const int k = 16 * s + 8 * h + j; v[j] = col < 4 ? P.in[15][k * 4 + col] : (col < 36 ? P.in[17][k * 32 + col - 4] : 0.f); }
    u32x4 w; w.x = pk2(v[0], v[1]); w.y = pk2(v[2], v[3]); w.z = pk2(v[4], v[5]); w.w = pk2(v[6], v[7]);
    ((u32x4*)(ws + WS_WR) + (size_t)f * 64)[lane] = w; }
  }
}

__device__ __forceinline__ void rope64(const f32x16& xa, const f32x16& xb, f32x16& ya, f32x16& yb, const float2* __restrict__ trow, int hi, float scale) {
#pragma unroll
  for (int g = 0; g < 4; ++g) {
    const f32x4 t0 = *(const f32x4*)(trow + 8 * g + 4 * hi), t1 = *(const f32x4*)(trow + 8 * g + 4 * hi + 2);
    const float cc[4] = {t0[0], t0[2], t1[0], t1[2]}, sn[4] = {t0[1], t0[3], t1[1], t1[3]};
#pragma unroll
    for (int i = 0; i < 4; ++i) { const int reg = 4 * g + i; ya[reg] = (xa[reg] * cc[i] - xb[reg] * sn[i]) * scale; yb[reg] = (xb[reg] * cc[i] + xa[reg] * sn[i]) * scale; }
  }
}
__device__ __forceinline__ void rope32(const f32x16& x, f32x16& y, const float2* __restrict__ trow, int hi, float scale) {
#pragma unroll
  for (int g = 0; g < 2; ++g) {
    const f32x4 t0 = *(const f32x4*)(trow + 8 * g + 4 * hi), t1 = *(const f32x4*)(trow + 8 * g + 4 * hi + 2);
    const float cc[4] = {t0[0], t0[2], t1[0], t1[2]}, sn[4] = {t0[1], t0[3], t1[1], t1[3]};
#pragma unroll
    for (int i = 0; i < 4; ++i) { const int reg = 4 * g + i; y[reg] = (x[reg] * cc[i] - x[reg + 8] * sn[i]) * scale; y[reg + 8] = (x[reg + 8] * cc[i] + x[reg] * sn[i]) * scale; }
  }
}
__device__ __forceinline__ float write_c_tile(LAS uchar* base, int pitch, const f32x16& vin, int rr, int f0, int hi) {
  const f32x16 v = vin * WIN_DESCALE;
  float ss = 0.f;
#pragma unroll
  for (int g = 0; g < 4; ++g) { u32x2 w; w.x = pk2(v[4 * g], v[4 * g + 1]); w.y = pk2(v[4 * g + 2], v[4 * g + 3]);
    *(LAS u32x2*)(base + a_off(rr, 2 * (f0 + 8 * g + 4 * hi), pitch)) = w;
    ss += v[4 * g] * v[4 * g] + v[4 * g + 1] * v[4 * g + 1] + v[4 * g + 2] * v[4 * g + 2] + v[4 * g + 3] * v[4 * g + 3]; }
  return ss;
}
__device__ __forceinline__ void store_img8_qk(uchar* img, const f32x16& v, int rb, int r32, int blk, int hi) {
  unsigned w[4];
#pragma unroll
  for (int g = 0; g < 4; ++g) w[g] = pk4_fp8(v[4 * g], v[4 * g + 1], v[4 * g + 2], v[4 * g + 3]);
  swap32(w[0], w[2]); swap32(w[1], w[3]);
  const int off = blk < 2 ? rb * 4096 + hi * 1024 + (blk * 32 + r32) * 16 : rb * 4096 + 2048 + (hi * 32 + r32) * 16;
  *(u32x4*)(img + off) = u32x4{w[0], w[2], w[1], w[3]};
}
__device__ __forceinline__ void store_img8_v(uchar* img, const f32x16& v, int rb, int db, int r32, int hi) {
  *(u32x4*)(img + db * 2048 + rb * 1024 + (hi * 32 + r32) * 16) = u32x4{pk4_fp8(v[0], v[1], v[2], v[3]), pk4_fp8(v[4], v[5], v[6], v[7]), pk4_fp8(v[8], v[9], v[10], v[11]), pk4_fp8(v[12], v[13], v[14], v[15])};
}
__device__ __forceinline__ void lds_fadd(LAS float* p, float v) { __hip_atomic_fetch_add(p, v, __ATOMIC_RELAXED, __HIP_MEMORY_SCOPE_WORKGROUP); }

__device__ __forceinline__ void phase1_tile(const KP& P, LAS uchar* lds, const int tile) {
  int lane_ = mk_lane(); asm volatile("" : "+v"(lane_)); const int lane = lane_ & 63, wave = P.wave, tid = wave * 64 + lane, r32 = lane & 31, hi = lane >> 5;
  uchar* ws = P.ws;
  const int t0 = tile * 64, b = t0 / SEQ, pos0 = t0 % SEQ, tb = pos0 >> 6;
  const float* __restrict__ x = P.in[0]; const float* __restrict__ mod = (const float*)(ws + WS_MOD) + b * (NMOD * DM); const float* __restrict__ g1 = P.in[4];
  LAS float* ssl = (LAS float*)(lds + LDS_MISC + 8192);
#define SSQ_Q(rr) ((ssl[(rr)] + ssl[64 + (rr)]) + (ssl[128 + (rr)] + ssl[192 + (rr)]))
#define SSQ_KV(rr) (ssl[256 + (rr)] + ssl[320 + (rr)])
  LAS uchar* krt = lds + LDS_MISC + 1024;
  const float2* tabA = (const float2*)(ws + WS_TABA); const float2* tabB = (const float2*)(ws + WS_TABB);
  {
    f32x4 av[4], sv[4];
#pragma unroll
    for (int i = 0; i < 4; ++i) { const int k = 4 * (lane + 64 * i); const f32x4 g = *(const f32x4*)(g1 + k), sc = *(const f32x4*)(mod + DM + k); av[i] = g * (sc + 1.0f); sv[i] = *(const f32x4*)(mod + k); }
#pragma unroll
    for (int hf = 0; hf < 2; ++hf) {
      f32x4 xv[4][4];
#pragma unroll
      for (int rr = 0; rr < 4; ++rr)
#pragma unroll
        for (int i = 0; i < 4; ++i) xv[rr][i] = __builtin_nontemporal_load((const f32x4*)(x + (size_t)(t0 + wave * 8 + hf * 4 + rr) * DM + 4 * (lane + 64 * i)));
#pragma unroll
      for (int rr = 0; rr < 4; ++rr) {
        const int row = wave * 8 + hf * 4 + rr; float ss = 0.f;
#pragma unroll
        for (int i = 0; i < 4; ++i) { ss += xv[rr][i][0] * xv[rr][i][0] + xv[rr][i][1] * xv[rr][i][1] + xv[rr][i][2] * xv[rr][i][2] + xv[rr][i][3] * xv[rr][i][3];
          u32x2 xb; xb.x = pk2(xv[rr][i][0], xv[rr][i][1]); xb.y = pk2(xv[rr][i][2], xv[rr][i][3]);
          *(u32x2*)(ws + WS_XB + ((size_t)(t0 + row) * DM + 4 * (lane + 64 * i)) * 2) = xb; }
        ss = wave_sum(ss); const float rs = rsqrtf(ss * (1.0f / DM) + EPS);
#pragma unroll
        for (int i = 0; i < 4; ++i) { const f32x4 v = xv[rr][i] * rs * av[i] + sv[i];
          *(LAS unsigned*)(lds + a_off(row, 4 * (lane + 64 * i), 1024)) = pk4_fp8(v[0], v[1], v[2], v[3]); }
      }
    }
  }
  __syncthreads();
  const l64x2* WIN = (const l64x2*)(ws + WS_WIN);
#define WSLOT(slot) (WIN + (size_t)((slot) * 32) * 64 + lane)
  f32x16 acc[4][2]; acc_zero<4>(acc);
  f32x16 acc2[1][2]; acc_zero<1>(acc2);
  if (wave < 4) {
    { const l64x2* wp[4] = {WSLOT(4 * wave), WSLOT(4 * wave + 1), WSLOT(4 * wave + 2), WSLOT(4 * wave + 3)}; gemm_slots_f8<4, 4, 32, true, 1, 0x3210>(acc, lds, 1024, wp, lane); }
    if (wave < 3) { const l64x2* wp[1] = {WSLOT(wave == 0 ? 34 : 27 + wave)}; gemm_slots_f8<1, 1, 32, true, 2, 0x0>(acc2, lds, 1024, wp, lane); }
  } else if (wave == 4) {
    { const l64x2* wp[4] = {WSLOT(16), WSLOT(17), WSLOT(18), WSLOT(19)}; gemm_slots_f8<4, 4, 32, true, 1, 0x3210>(acc, lds, 1024, wp, lane); }
    { const l64x2* wp[2] = {WSLOT(33), WSLOT(42)}; gemm_slots_f8<2, 1, 32, true, 1, 0x00>(acc2, lds, 1024, wp, lane); }
  } else if (wave == 7) {
    { const l64x2* wp[4] = {WSLOT(30), WSLOT(39), WSLOT(31), WSLOT(40)}; gemm_slots_f8<4, 4, 32, true, 1, 0x1100>(acc, lds, 1024, wp, lane); }
    { const l64x2* wp[2] = {WSLOT(32), WSLOT(41)}; gemm_slots_f8<2, 4, 32, true, 1, 0x22>(acc, lds, 1024, wp, lane); }
  } else {
    const int kv = wave - 5;
    { const l64x2* wp[4] = {WSLOT(20 + 2 * kv), WSLOT(35 + 2 * kv), WSLOT(21 + 2 * kv), WSLOT(36 + 2 * kv)}; gemm_slots_f8<4, 4, 32, false, 1, 0x1100>(acc, lds, 1024, wp, lane); }
    { const l64x2* wp[2] = {WSLOT(24 + 2 * kv), WSLOT(25 + 2 * kv)}; gemm_slots_f8<2, 4, 32, true, 1, 0x32>(acc, lds, 1024, wp, lane); }
  }
#undef WSLOT
  int tid2_ = mk_lane(); asm volatile("" : "+v"(tid2_)); const int lane2 = tid2_ & 63;
#define lane lane2
  const int r32e = lane2 & 31, hie = lane2 >> 5;
#define r32 r32e
#define hi hie
  if (wave < 4) {
#pragma unroll
    for (int p = 0; p < 2; ++p) { uchar* img = ws + WS_QA + ((size_t)(b * 8 + 2 * wave + p) * 64 + tb) * 8192;
#pragma unroll
      for (int rb = 0; rb < 2; ++rb) { const int rr = 32 * rb + r32; f32x16 ya, yb; rope64(acc[2 * p][rb], acc[2 * p + 1][rb], ya, yb, tabA + (size_t)(pos0 + rr) * 32, hi, QSCALE_A * WIN_DESCALE);
        store_img_qk(img, ya, rr, 0, 4, hi); store_img_qk(img, yb, rr, 32, 4, hi); } }
    if (wave == 0) {
#pragma unroll
      for (int rb = 0; rb < 2; ++rb) { const int rr = 32 * rb + r32; f32x16 y; rope32(acc2[0][rb], y, tabB + (size_t)(pos0 + rr) * 16, hi, WIN_DESCALE);
#pragma unroll
        for (int g = 0; g < 4; ++g) { u32x2 w; w.x = pk2(y[4 * g], y[4 * g + 1]); w.y = pk2(y[4 * g + 2], y[4 * g + 3]); *(LAS u32x2*)(krt + rr * 64 + (8 * g + 4 * hi) * 2) = w; } }
    }
  } else if (wave == 4) {
#pragma unroll
    for (int p = 0; p < 2; ++p) { uchar* img = ws + WS_KVA + ((size_t)(b * 2 + p) * 64 + tb) * 16384;
#pragma unroll
      for (int rb = 0; rb < 2; ++rb) { const int rr = 32 * rb + r32; f32x16 ya, yb; rope64(acc[2 * p][rb], acc[2 * p + 1][rb], ya, yb, tabA + (size_t)(pos0 + rr) * 32, hi, WIN_DESCALE);
        store_img_qk(img, ya, rr, 0, 4, hi); store_img_qk(img, yb, rr, 32, 4, hi); } }
  } else if (wave == 5 || wave == 6) {
    uchar* img = ws + WS_KVA + ((size_t)(b * 2 + (wave - 5)) * 64 + tb) * 16384 + 8192;
#pragma unroll
    for (int i = 0; i < 2; ++i)
#pragma unroll
      for (int rb = 0; rb < 2; ++rb) { const f32x16 y = acc[i][rb] * WIN_DESCALE; store_img_v(img, y, rb, 32 * i + r32, hi); }
  }
  __syncthreads();
  if (wave != 0 && wave != 3) {
#pragma unroll
    for (int rb = 0; rb < 2; ++rb) { const int rr = 32 * rb + r32; float sq = 0.f, skv = 0.f;
      if (wave == 5 || wave == 6) { sq += write_c_tile(lds, 512, acc[2][rb], rr, 64 * (wave - 5), hi); sq += write_c_tile(lds, 512, acc[3][rb], rr, 64 * (wave - 5) + 32, hi); }
      else if (wave == 1 || wave == 2) sq += write_c_tile(lds, 512, acc2[0][rb], rr, 96 + 32 * wave, hi);
      else if (wave == 7) { skv += write_c_tile(lds + 32768, 256, acc[0][rb], rr, 0, hi); skv += write_c_tile(lds + 32768, 256, acc[1][rb], rr, 32, hi); skv += write_c_tile(lds + 32768, 256, acc[2][rb], rr, 64, hi); }
      else skv += write_c_tile(lds + 32768, 256, acc2[0][rb], rr, 96, hi);
      const float tot = half_swap_sum((wave == 4 || wave == 7) ? skv : sq);
      const int slot = wave == 1 ? 0 : wave == 2 ? 1 : wave == 5 ? 2 : wave == 6 ? 3 : wave == 4 ? 4 : 5;
      if (hi == 0) ssl[slot * 64 + rr] = tot; }
  }
  __syncthreads();
  const int head = wave;
  uchar* imgQ = ws + WS_QB + ((size_t)(b * 8 + head) * 64 + tb) * 8192;
  uchar* imgKV = ws + WS_KVB + ((size_t)(b * 8 + head) * 64 + tb) * 12288;
  {
    f32x16 aq[3][2]; acc_zero<3>(aq);
    const bf16x8* wp[3];
#pragma unroll
    for (int i = 0; i < 3; ++i) wp[i] = (const bf16x8*)(ws + WS_WUQ) + (size_t)((3 * head + i) * 12) * 64 + lane;
    gemm_tile<3, 12, true>(aq, lds, 512, wp, lane);
#pragma unroll
    for (int rb = 0; rb < 2; ++rb) { const int rr = 32 * rb + r32; const float sc = rsqrtf(SSQ_Q(rr) * (1.0f / 192.0f) + EPS) * (8.0f * QSCALE_B);
      f32x16 y0 = aq[0][rb] * sc, y1 = aq[1][rb] * sc, y2; rope32(aq[2][rb], y2, tabB + (size_t)(pos0 + rr) * 16, hi, sc);
      store_img8_qk(imgQ, y0, rb, r32, 0, hi); store_img8_qk(imgQ, y1, rb, r32, 1, hi); store_img8_qk(imgQ, y2, rb, r32, 2, hi);
      *(u32x4*)(imgQ + rb * 4096 + 3072 + lane * 16) = u32x4{0u, 0u, 0u, 0u}; }
  }
  {
    f32x16 ak[2][2]; acc_zero<2>(ak);
    const bf16x8* wp[2];
#pragma unroll
    for (int i = 0; i < 2; ++i) wp[i] = (const bf16x8*)(ws + WS_WUKV) + (size_t)((4 * head + i) * 8) * 64 + lane;
    gemm_tile<2, 8, true>(ak, lds + 32768, 256, wp, lane);
#pragma unroll
    for (int rb = 0; rb < 2; ++rb) { const int rr = 32 * rb + r32; const float sc = rsqrtf(SSQ_KV(rr) * (1.0f / 128.0f) + EPS);
      f32x16 y0 = ak[0][rb] * sc, y1 = ak[1][rb] * sc; store_img8_qk(imgKV, y0, rb, r32, 0, hi); store_img8_qk(imgKV, y1, rb, r32, 1, hi); }
#pragma unroll
    for (int rb = 0; rb < 2; ++rb) {
      const u32x4 c0 = *(const LAS u32x4*)(krt + (32 * rb + r32) * 64 + hi * 32), c1 = *(const LAS u32x4*)(krt + (32 * rb + r32) * 64 + hi * 32 + 16);
      u32x4 w;
      w.x = pk4_fp8(__uint_as_float(c0.x << 16), __uint_as_float(c0.x & 0xffff0000u), __uint_as_float(c0.y << 16), __uint_as_float(c0.y & 0xffff0000u));
      w.y = pk4_fp8(__uint_as_float(c0.z << 16), __uint_as_float(c0.z & 0xffff0000u), __uint_as_float(c0.w << 16), __uint_as_float(c0.w & 0xffff0000u));
      w.z = pk4_fp8(__uint_as_float(c1.x << 16), __uint_as_float(c1.x & 0xffff0000u), __uint_as_float(c1.y << 16), __uint_as_float(c1.y & 0xffff0000u));
      w.w = pk4_fp8(__uint_as_float(c1.z << 16), __uint_as_float(c1.z & 0xffff0000u), __uint_as_float(c1.w << 16), __uint_as_float(c1.w & 0xffff0000u));
      *(u32x4*)(imgKV + rb * 4096 + 2048 + lane * 16) = w;
      *(u32x4*)(imgKV + rb * 4096 + 3072 + lane * 16) = u32x4{hi ? 0u : 0x00003838u, 0u, 0u, 0u}; }
  }
  {
    f32x16 avv[2][2]; acc_zero<2>(avv);
    const bf16x8* wp[2];
#pragma unroll
    for (int i = 0; i < 2; ++i) wp[i] = (const bf16x8*)(ws + WS_WUKV) + (size_t)((4 * head + 2 + i) * 8) * 64 + lane;
    gemm_tile<2, 8, false>(avv, lds + 32768, 256, wp, lane);
#pragma unroll
    for (int rb = 0; rb < 2; ++rb) { f32x16 sc;
#pragma unroll
      for (int reg = 0; reg < 16; ++reg) sc[reg] = rsqrtf(SSQ_KV(32 * rb + crow(reg, hi)) * (1.0f / 128.0f) + EPS);
#pragma unroll
      for (int i = 0; i < 2; ++i) { f32x16 y = avv[i][rb] * sc; store_img8_v(imgKV + 8192, y, rb, i, r32, hi); } }
  }
  __syncthreads();
#undef lane
#undef r32
#undef hi
#undef SSQ_Q
#undef SSQ_KV
}
__device__ __forceinline__ float tile_max(const f32x16& p0, const f32x16& p1) {
  float t = __builtin_amdgcn_fmed3f(p0[0], p1[0], 3.0e38f);
  asm("v_max3_f32 %0, %0, %1, %2\n\tv_max3_f32 %0, %0, %3, %4\n\tv_max3_f32 %0, %0, %5, %6\n\tv_max3_f32 %0, %0, %7, %8\n\t"
      "v_max3_f32 %0, %0, %9, %10\n\tv_max3_f32 %0, %0, %11, %12\n\tv_max3_f32 %0, %0, %13, %14\n\tv_max3_f32 %0, %0, %15, %16"
      : "+v"(t) : "v"(p0[1]), "v"(p1[1]), "v"(p0[2]), "v"(p1[2]), "v"(p0[3]), "v"(p1[3]), "v"(p0[4]), "v"(p1[4]), "v"(p0[5]), "v"(p1[5]), "v"(p0[6]), "v"(p1[6]), "v"(p0[7]), "v"(p1[7]), "v"(p0[8]), "v"(p1[8]));
  asm("v_max3_f32 %0, %0, %1, %2\n\tv_max3_f32 %0, %0, %3, %4\n\tv_max3_f32 %0, %0, %5, %6\n\tv_max3_f32 %0, %0, %7, %8\n\t"
      "v_max3_f32 %0, %0, %9, %10\n\tv_max3_f32 %0, %0, %11, %12\n\tv_max3_f32 %0, %0, %13, %14"
      : "+v"(t) : "v"(p0[9]), "v"(p1[9]), "v"(p0[10]), "v"(p1[10]), "v"(p0[11]), "v"(p1[11]), "v"(p0[12]), "v"(p1[12]), "v"(p0[13]), "v"(p1[13]), "v"(p0[14]), "v"(p1[14]), "v"(p0[15]), "v"(p1[15]));
  return t;
}
constexpr float PXG = 128.0f / 65535.0f;
__device__ __forceinline__ void softmax_tile(f32x16& p0, f32x16& p1, f32x16& negm, float& m, float& l, f32x16& o0, f32x16& o1, bf16x8 (&pb)[2][2]) {
  const float tmax = half_swap_max(tile_max(p0, p1));
  if (__any(tmax > PXG * (127.0f + THR2))) {
    const float dm = fmaxf(tmax * (1.0f / PXG) - 127.0f, 0.f), alpha = __builtin_amdgcn_exp2f(-dm), dp = dm * PXG;
    m += dm; l *= alpha;
#pragma unroll
    for (int r = 0; r < 16; ++r) { o0[r] *= alpha; o1[r] *= alpha; p0[r] -= dp; p1[r] -= dp; negm[r] = PXG * (127.0f - m); }
  }
  typedef __bf16 bf2 __attribute__((ext_vector_type(2)));
  const bf2 one2 = __builtin_bit_cast(bf2, 0x3f803f80u);
  float s = 0.f;
#pragma unroll
  for (int ks = 0; ks < 2; ++ks) {
    unsigned a[4], c[4];
#pragma unroll
    for (int i = 0; i < 4; ++i) { a[i] = mk_pknorm(p0[8 * ks + 2 * i], p0[8 * ks + 2 * i + 1]); c[i] = mk_pknorm(p1[8 * ks + 2 * i], p1[8 * ks + 2 * i + 1]);
      s = __builtin_amdgcn_fdot2_f32_bf16(__builtin_bit_cast(bf2, a[i]), one2, s, false); s = __builtin_amdgcn_fdot2_f32_bf16(__builtin_bit_cast(bf2, c[i]), one2, s, false); }
    const u32x4 w0 = {a[0], a[1], a[2], a[3]}, w1 = {c[0], c[1], c[2], c[3]};
    pb[0][ks] = __builtin_bit_cast(bf16x8, w0); pb[1][ks] = __builtin_bit_cast(bf16x8, w1);
  }
  l += s;
}
__device__ __forceinline__ void pv_tile(const LAS uchar* vimg, const bf16x8 (&pb)[2][2], f32x16& o0, f32x16& o1, int lane) {
#pragma unroll
  for (int kb = 0; kb < 2; ++kb)
#pragma unroll
    for (int ks = 0; ks < 2; ++ks) {
      const bf16x8 v0 = *(const LAS bf16x8*)(vimg + ((((kb * 2 + 0) * 2 + ks) * 64) + lane) * 16);
      const bf16x8 v1 = *(const LAS bf16x8*)(vimg + ((((kb * 2 + 1) * 2 + ks) * 64) + lane) * 16);
      o0 = mfma(v0, pb[kb][ks], o0); o1 = mfma(v1, pb[kb][ks], o1);
    }
}
__device__ __forceinline__ void store_o(bf16_t* __restrict__ orow, f32x16& o0, f32x16& o1, float l, int hi) {
  const float inv = 1.0f / half_swap_sum(l);
#pragma unroll
  for (int g = 0; g < 4; ++g) {
    u32x2 w; w.x = pk2(o0[4 * g] * inv, o0[4 * g + 1] * inv); w.y = pk2(o0[4 * g + 2] * inv, o0[4 * g + 3] * inv); *(u32x2*)(orow + 8 * g + 4 * hi) = w;
    u32x2 z; z.x = pk2(o1[4 * g] * inv, o1[4 * g + 1] * inv); z.y = pk2(o1[4 * g + 2] * inv, o1[4 * g + 3] * inv); *(u32x2*)(orow + 32 + 8 * g + 4 * hi) = z;
  }
}

__device__ __forceinline__ void store_o_l(bf16_t* __restrict__ orow, f32x16& o0, f32x16& o1, float ltot, int hi) {
  const float inv = 1.0f / ltot;
#pragma unroll
  for (int g = 0; g < 4; ++g) {
    u32x2 w; w.x = pk2(o0[4 * g] * inv, o0[4 * g + 1] * inv); w.y = pk2(o0[4 * g + 2] * inv, o0[4 * g + 3] * inv); *(u32x2*)(orow + 8 * g + 4 * hi) = w;
    u32x2 z; z.x = pk2(o1[4 * g] * inv, o1[4 * g + 1] * inv); z.y = pk2(o1[4 * g + 2] * inv, o1[4 * g + 3] * inv); *(u32x2*)(orow + 32 + 8 * g + 4 * hi) = z;
  }
}
constexpr int SWA_LDS = 49152;
__device__ __forceinline__ void swa_unit(const KP& P, LAS uchar* lds_all, int u, bool prefetched) {
  LAS uchar* lds = lds_all + SWA_LDS;
  int lane_ = mk_lane(); asm volatile("" : "+v"(lane_)); const int lane = lane_ & 63, wave = P.wave, tid = wave * 64 + lane, r32 = lane & 31, hi = lane >> 5;
  uchar* ws = P.ws;
  const int n = u & 31, kvh = (u >> 5) & 1, b = u >> 6;
  const uchar* kvimg = ws + WS_KVA + (size_t)(b * 2 + kvh) * 64 * 16384;
  if (!prefetched) {
#pragma unroll 1
    for (int jt = 0; jt < 6; ++jt) { const int gt = 2 * n - 2 + jt; if (gt < 0 || gt >= 64) continue;
      const u32x4* src = (const u32x4*)(kvimg + (size_t)gt * 16384); LAS u32x4* dst = (LAS u32x4*)(lds + jt * 16384);
      const u32x4 v0 = src[tid], v1 = src[tid + 512]; dst[tid] = v0; dst[tid + 512] = v1; }
  }
  __syncthreads();
  const int rbq = wave & 3, jlo = rbq >> 1;
  bf16_t* O = (bf16_t*)(ws + WS_O);
  bf16x8 qall[2][4];
#pragma unroll
  for (int hh = 0; hh < 2; ++hh) { const uchar* qimg = ws + WS_QA + ((size_t)(b * 8 + kvh * 4 + 2 * (wave >> 2) + hh) * 64 + 2 * n + (rbq >> 1)) * 8192;
#pragma unroll
    for (int s = 0; s < 4; ++s) qall[hh][s] = *(const bf16x8*)(qimg + ((((rbq & 1) * 4 + s) * 64) + lane) * 16); }
#pragma unroll
  for (int hh = 0; hh < 2; ++hh) {
    const int head = kvh * 4 + 2 * (wave >> 2) + hh;
    bf16x8 qf[4];
#pragma unroll
    for (int s = 0; s < 4; ++s) qf[s] = qall[hh][s];
    const float sink2 = P.in[10][head] * LOG2E;
    float m = sink2, l = hi ? 0.f : 1.f; f32x16 negm, o0 = {}, o1 = {};
#pragma unroll
    for (int r = 0; r < 16; ++r) negm[r] = PXG * (127.0f - sink2);
#pragma unroll 1
    for (int jt = jlo; jt < jlo + 5; ++jt) { const int gt = 2 * n - 2 + jt; if (gt < 0 || gt >= 64) continue;
      const LAS uchar* kimg = lds + jt * 16384;
      f32x16 p0 = negm, p1 = negm;
#pragma unroll
      for (int s = 0; s < 4; ++s) { const bf16x8 k0 = *(const LAS bf16x8*)(kimg + (((0 * 4 + s) * 64) + lane) * 16), k1 = *(const LAS bf16x8*)(kimg + (((1 * 4 + s) * 64) + lane) * 16);
        p0 = mfma(k0, qf[s], p0); p1 = mfma(k1, qf[s], p1); }
      if (jt == jlo || jt == jlo + 4) { const int base = 64 * jt - 32 * rbq - r32;
#pragma unroll
        for (int r = 0; r < 16; ++r) { const int d0 = base + crow(r, hi);
          p0[r] = ((unsigned)d0 <= 256u) ? p0[r] : -1e30f; p1[r] = ((unsigned)(d0 + 32) <= 256u) ? p1[r] : -1e30f; } }
      bf16x8 pb[2][2];
      softmax_tile(p0, p1, negm, m, l, o0, o1, pb);
      pv_tile(kimg + 8192, pb, o0, o1, lane);
    }
    store_o(O + (size_t)(b * SEQ + n * 128 + 32 * rbq + r32) * DM + head * 64, o0, o1, l, hi);
  }
  __syncthreads();
}

#define MK_LDS_RD(dst, vaddr, imm) asm volatile("ds_read_b128 %0, %1 offset:%2" : "=v"(dst) : "v"(vaddr), "i"(imm))
template <int N> __device__ __forceinline__ void lgkm_wait() { asm volatile("s_waitcnt lgkmcnt(%0)" :: "i"(N) : "memory"); __builtin_amdgcn_sched_barrier(0); }
__device__ __forceinline__ void pv_regs(const bf16x8 (&vf)[8], const bf16x8 (&pb)[2][2], f32x16& o0, f32x16& o1) {
#pragma unroll
  for (int kb = 0; kb < 2; ++kb)
#pragma unroll
    for (int ks = 0; ks < 2; ++ks) { o0 = mfma(vf[(kb * 2 + 0) * 2 + ks], pb[kb][ks], o0); o1 = mfma(vf[(kb * 2 + 1) * 2 + ks], pb[kb][ks], o1); }
}
__device__ __forceinline__ void mla_dma_step(const uchar* kvimg, LAS uchar* lds, int t, int wave, int lane) {
  const uchar* src = kvimg + (size_t)t * 24576 + wave * 3072 + lane * 16;
  LAS uchar* dst = lds + (t & 1) * 24576 + wave * 3072;
#pragma unroll
  for (int i = 0; i < 3; ++i) __builtin_amdgcn_global_load_lds((const unsigned*)(src + i * 1024), (LAS unsigned*)(dst + i * 1024), 16, 0, 0);
}
template <bool FIRST_POSSIBLE>
__device__ __forceinline__ float softmax_tile8(f32x16& p0, f32x16& p1, float& pad, int& qpad, f32x16& lacc, f32x16& o0, f32x16& o1, bool first, int hi, i32x4& pb0, i32x4& pb1) {
  float applied = 0.f;
  const float tmax_s = half_swap_max(tile_max(p0, p1));
  const bool fst = FIRST_POSSIBLE && first;
  if (fst || __any(tmax_s > 120.5f / 256.0f)) {
    const float tmax = tmax_s * 256.0f;
    const float want = fst ? tmax - 96.5f : fmaxf(tmax - 96.5f, 0.f);
    const float nt = pad - want;
    const int wa = __builtin_amdgcn_cvt_pk_fp8_f32(nt, 0.f, 0, false); const float fa = __builtin_amdgcn_cvt_f32_fp8(wa, 0);
    const int wb = __builtin_amdgcn_cvt_pk_fp8_f32(nt - fa, 0.f, 0, false); const float fb = __builtin_amdgcn_cvt_f32_fp8(wb, 0);
    const float pnew = fa + fb, dt = pad - pnew, dts = dt * (1.0f / 256.0f);
    const float alpha = fst ? 1.0f : __builtin_amdgcn_exp2f(-0.125f * dt);
    pad = pnew; applied = dts; qpad = hi ? 0 : ((wa & 0xff) | ((wb & 0xff) << 8));
#pragma unroll
    for (int r = 0; r < 16; ++r) { o0[r] *= alpha; o1[r] *= alpha; lacc[r] *= alpha; p0[r] -= dts; p1[r] -= dts; }
  }
#define MK_P8(P, R) __builtin_amdgcn_perm(mk_pknorm(P[(R) + 2], P[(R) + 3]), mk_pknorm(P[R], P[(R) + 1]), 0x07050301u)
  pb0.x = (int)MK_P8(p0, 0); pb0.y = (int)MK_P8(p0, 4); pb0.z = (int)MK_P8(p0, 8); pb0.w = (int)MK_P8(p0, 12);
  pb1.x = (int)MK_P8(p1, 0); pb1.y = (int)MK_P8(p1, 4); pb1.z = (int)MK_P8(p1, 8); pb1.w = (int)MK_P8(p1, 12);
#undef MK_P8
  return applied;
}
constexpr int N_PACK_JOBS = 3 * 8192;
struct PackJob { const float* p; int ldw; u32x4* dst; float scale; };
__device__ __forceinline__ PackJob pack_job(const KP& P, int f, int lane) {
  const int which = f >> 13, ff = f & 8191, r = lane & 31, h = lane >> 5, e = ff >> 8; PackJob j;
  if (which < 2) { const int nb = (ff >> 5) & 7, s = ff & 31; j.ldw = 256; j.scale = WGU_SCALE;
    j.p = P.in[19 + which] + (size_t)e * DM * 256 + (size_t)(32 * s + 16 * h) * 256 + 32 * nb + r; j.dst = (u32x4*)(P.ws + (which ? WS_WU : WS_WG)) + (size_t)ff * 64 + lane; }
  else { const int nb = (ff >> 3) & 31, s = ff & 7; j.ldw = DM; j.scale = WD_SCALE;
    j.p = P.in[21] + (size_t)e * 256 * DM + (size_t)(32 * s + 16 * h) * DM + 32 * nb + r; j.dst = (u32x4*)(P.ws + WS_WD) + (size_t)ff * 64 + lane; }
  return j;
}
__device__ __forceinline__ u32x4 pack_cvt(const float (&v)[16], float sc) {
  u32x4 w; w.x = pk4_fp8(v[0] * sc, v[1] * sc, v[2] * sc, v[3] * sc); w.y = pk4_fp8(v[4] * sc, v[5] * sc, v[6] * sc, v[7] * sc);
  w.z = pk4_fp8(v[8] * sc, v[9] * sc, v[10] * sc, v[11] * sc); w.w = pk4_fp8(v[12] * sc, v[13] * sc, v[14] * sc, v[15] * sc); return w;
}
__device__ __forceinline__ void mla_unit(const KP& P, LAS uchar* lds, int b, int head, int qblk, int& pk_k, int swa_u) {
  int lane_ = mk_lane(); asm volatile("" : "+v"(lane_)); const int lane = lane_ & 63, wave = P.wave, r32 = lane & 31, hi = lane >> 5;
  uchar* ws = P.ws;
  const uchar* kvimg = ws + WS_KVB + (size_t)(b * 8 + head) * 64 * 12288;
  const uchar* qimg = ws + WS_QB + ((size_t)(b * 8 + head) * 64 + qblk * 4 + (wave >> 1)) * 8192 + (wave & 1) * 4096 + lane * 16;
  const int gw = blockIdx.x * NWAVE + wave, NGW = gridDim.x * NWAVE;
  const i32x4 q00 = *(const i32x4*)(qimg), q01 = *(const i32x4*)(qimg + 1024), q10 = *(const i32x4*)(qimg + 2048);
  float pad = 56.5f; int qpad = hi ? 0 : 0x3066;
  f32x16 o0 = {}, o1 = {}, lacc = {};
  i32x8 ones8 = {0x38383838, 0x38383838, 0x38383838, 0x38383838, 0x38383838, 0x38383838, 0x38383838, 0x38383838};
  asm volatile("" : "+v"(ones8));
  mla_dma_step(kvimg, lds, 0, wave, lane);
#pragma unroll 1
  for (int t = 0; t < 32; ++t) {
    asm volatile("s_waitcnt vmcnt(0)" ::: "memory");
    __syncthreads();
    if (t + 1 < 32 && !(P.variant & 4)) mla_dma_step(kvimg, lds, t + 1, wave, lane);
    if (P.variant & 8) continue;
    u32x4 bandv = {}; int band_off = -1;
    if (swa_u >= 0 && t >= 20) { const int c = (wave * 64 + lane) + 512 * (t - 20), jt = c >> 10, gt = 2 * (swa_u & 31) - 2 + jt;
      if (gt >= 0 && gt < 64) { band_off = c * 16; bandv = *(const u32x4*)(ws + WS_KVA + ((size_t)((swa_u >> 6) * 2 + ((swa_u >> 5) & 1)) * 64 + gt) * 16384 + (c & 1023) * 16); } }
    const int pf = gw + pk_k * NGW; const bool do_pack = pf < N_PACK_JOBS;
    float pv[16]; u32x4* pdst = nullptr; float psc = 0.f;
    if (do_pack) { const PackJob j = pack_job(P, pf, lane); pdst = j.dst; psc = j.scale;
#pragma unroll
      for (int q = 0; q < 16; ++q) pv[q] = __builtin_nontemporal_load(j.p + (size_t)q * j.ldw); }
    f32x16 a0, a1, b0, b1; i32x4 pb0, pb1;
    { const unsigned va = (unsigned)(unsigned long)(lds + (t & 1) * 24576) + lane * 16;
#define MK_KOFF(j) (((j) >> 2) * 12288 + (((j) >> 1) & 1) * 4096 + ((j) & 1) * 2048)
      i32x4 kf[4][2];
#define MK_KRD(j) { MK_LDS_RD(kf[(j) & 3][0], va, MK_KOFF(j)); MK_LDS_RD(kf[(j) & 3][1], va, MK_KOFF(j) + 1024); }
      MK_KRD(0) MK_KRD(1) MK_KRD(2) MK_KRD(3)
      const i32x4 q11 = {qpad, 0, 0, 0};
#define MK_QK_STEP(j, ACC, NW) { lgkm_wait<NW>(); ACC = ((j) & 1) ? mfma_mx_q(kf[(j) & 3][0], kf[(j) & 3][1], q10, q11, ACC) : mfma_mx_q(kf[(j) & 3][0], kf[(j) & 3][1], q00, q01, f32x16{}); if ((j) + 4 < 8) MK_KRD(((j) + 4) & 7) }
      MK_QK_STEP(0, a0, 6) MK_QK_STEP(1, a0, 6) MK_QK_STEP(2, a1, 6) MK_QK_STEP(3, a1, 6) MK_QK_STEP(4, b0, 6) MK_QK_STEP(5, b0, 4) MK_QK_STEP(6, b1, 2) MK_QK_STEP(7, b1, 0)
#undef MK_QK_STEP
#undef MK_KRD
#undef MK_KOFF
      i32x4 vf[4];
#define MK_VRD(tile) { MK_LDS_RD(vf[0], va, (tile) * 12288 + 8192); MK_LDS_RD(vf[1], va, (tile) * 12288 + 8192 + 1024); MK_LDS_RD(vf[2], va, (tile) * 12288 + 8192 + 2048); MK_LDS_RD(vf[3], va, (tile) * 12288 + 8192 + 3072); }
      MK_VRD(0)
      const float dA = softmax_tile8<true>(a0, a1, pad, qpad, lacc, o0, o1, t == 0, hi, pb0, pb1);
      lacc = mfma_mx8(ones8, __builtin_shufflevector(pb0, pb1, 0, 1, 2, 3, 4, 5, 6, 7), lacc);
      lgkm_wait<0>();
      o0 = mfma_mx(vf[0], vf[1], pb0, pb1, o0); o1 = mfma_mx(vf[2], vf[3], pb0, pb1, o1);
      MK_VRD(1)
#undef MK_VRD
      if (__any(dA != 0.f)) {
#pragma unroll
        for (int r = 0; r < 16; ++r) { b0[r] -= dA; b1[r] -= dA; }
      }
      (void)softmax_tile8<false>(b0, b1, pad, qpad, lacc, o0, o1, false, hi, pb0, pb1);
      lacc = mfma_mx8(ones8, __builtin_shufflevector(pb0, pb1, 0, 1, 2, 3, 4, 5, 6, 7), lacc);
      lgkm_wait<0>();
      o0 = mfma_mx(vf[0], vf[1], pb0, pb1, o0); o1 = mfma_mx(vf[2], vf[3], pb0, pb1, o1);
    }
    if (do_pack) { *pdst = pack_cvt(pv, psc); ++pk_k; }
    if (band_off >= 0) *(LAS u32x4*)(lds + SWA_LDS + band_off) = bandv;
  }
  if (!(P.variant & 12)) store_o_l((bf16_t*)(ws + WS_O) + (size_t)(b * SEQ + qblk * 256 + 32 * wave + r32) * DM + 512 + head * 64, o0, o1, lacc[0], hi);
  __syncthreads();
}
__device__ __forceinline__ void phase2(const KP& P, LAS uchar* lds) {
  const int bid = blockIdx.x;
  int pk_k = 0;
  const bool pref = gridDim.x == 256 && !(P.variant & 3);
  if (!(P.variant & 2)) for (int i = bid; i < 512; i += gridDim.x) {
    const int rr = i >> 8, ii = i & 255, xcd = ii & 7, local = ii >> 3, pair = xcd * 4 + rr * 2 + (local >> 4), qblk = local & 15;
    mla_unit(P, lds, pair >> 3, pair & 7, qblk, pk_k, (pref && i >= 256) ? bid : -1);
  }
  if (!(P.variant & 1)) for (int u = bid; u < 256; u += gridDim.x) swa_unit(P, lds, u, pref);
  { const int lane = mk_lane(), wave = P.wave, gw = bid * NWAVE + wave, NGW = gridDim.x * NWAVE;
    for (int f = gw + pk_k * NGW; f < N_PACK_JOBS; f += NGW) { const PackJob j = pack_job(P, f, lane); float v[16];
#pragma unroll
      for (int q = 0; q < 16; ++q) v[q] = j.p[(size_t)q * j.ldw];
      *j.dst = pack_cvt(v, j.scale); } }
}
__device__ __forceinline__ void phase3_tile(const KP& P, LAS uchar* lds, const int tile) {
  int lane_ = mk_lane(); asm volatile("" : "+v"(lane_)); const int lane = lane_ & 63, wave = P.wave, tid = wave * 64 + lane, r32 = lane & 31, hi = lane >> 5;
  uchar* ws = P.ws;
  const int t0 = tile * 64, b = t0 / SEQ;
  const float* __restrict__ x = P.in[0]; const float* __restrict__ mod = (const float*)(ws + WS_MOD) + b * (NMOD * DM);
  LAS float* ssq = (LAS float*)(lds + LDS_MISC + 64);
  LAS float* ssl = (LAS float*)(lds + LDS_MISC + 4096);
  LAS int* selE = (LAS int*)(lds + LDS_MISC + 1024);
  LAS float* selW = (LAS float*)(lds + LDS_MISC + 1536);
  LAS int* selP = (LAS int*)(lds + LDS_MISC + 2048);
  LAS int* cntl = (LAS int*)(lds + LDS_MISC + 2560);
  LAS int* basel = (LAS int*)(lds + LDS_MISC + 2688);
  LAS float* logit = (LAS float*)(lds + LDS_MISC + 8192);
  if (tid < 64) ssq[tid] = 0.f;
  if (tid < 32) cntl[tid] = 0;
  LAS float* rbias = (LAS float*)(lds + LDS_MISC + 2816);
  if (tid < 32) rbias[tid] = P.in[18][tid]; else if (tid < 36) rbias[tid] = P.in[16][tid - 32];
  {
    const bf16_t* O = (const bf16_t*)(ws + WS_O);
    float ga[8], gb[8];
#pragma unroll
    for (int j = 0; j < 8; ++j) { ga[j] = P.in[11][8 * lane + j]; gb[j] = P.in[12][8 * lane + j]; }
#pragma unroll
    for (int hf = 0; hf < 2; ++hf) {
      u32x4 va[4], vb[4];
#pragma unroll
      for (int rr = 0; rr < 4; ++rr) { const u32x4* src = (const u32x4*)(O + (size_t)(t0 + wave * 8 + hf * 4 + rr) * DM); va[rr] = __builtin_nontemporal_load(src + lane); vb[rr] = __builtin_nontemporal_load(src + lane + 64); }
#pragma unroll
      for (int rr = 0; rr < 4; ++rr) {
        const int row = wave * 8 + hf * 4 + rr; float fa[8], fb[8], sa = 0.f, sb = 0.f;
#pragma unroll
        for (int q = 0; q < 4; ++q) { fa[2 * q] = __uint_as_float(va[rr][q] << 16); fa[2 * q + 1] = __uint_as_float(va[rr][q] & 0xffff0000u);
          fb[2 * q] = __uint_as_float(vb[rr][q] << 16); fb[2 * q + 1] = __uint_as_float(vb[rr][q] & 0xffff0000u); }
#pragma unroll
        for (int j = 0; j < 8; ++j) { sa += fa[j] * fa[j]; sb += fb[j] * fb[j]; }
        sa = wave_sum(sa); sb = wave_sum(sb);
        const float ra = rsqrtf(sa * (1.0f / 512.0f) + EPS), rb_ = rsqrtf(sb * (1.0f / 512.0f) + EPS);
        u32x4 wa, wb;
#pragma unroll
        for (int q = 0; q < 4; ++q) { wa[q] = pk2(fa[2 * q] * ra * ga[2 * q], fa[2 * q + 1] * ra * ga[2 * q + 1]); wb[q] = pk2(fb[2 * q] * rb_ * gb[2 * q], fb[2 * q + 1] * rb_ * gb[2 * q + 1]); }
        *(LAS u32x4*)(lds + a_off(row, 16 * lane, 2048)) = wa; *(LAS u32x4*)(lds + a_off(row, 16 * (lane + 64), 2048)) = wb;
      }
    }
  }
  __syncthreads();
  f32x16 acc[4][2]; acc_zero<4>(acc);
  { const bf16x8* wp[4];
#pragma unroll
    for (int i = 0; i < 4; ++i) wp[i] = (const bf16x8*)(ws + WS_WOUT) + (size_t)((4 * wave + i) * 64) * 64 + lane;
    gemm_tile<4, 64, false, 5>(acc, lds, 2048, wp, lane); }
  if (P.variant & 2) { asm volatile("" :: "v"(acc[0][0][0]), "v"(acc[1][1][3]), "v"(acc[2][0][7]), "v"(acc[3][1][15])); return; }
  bf16_t* X1 = (bf16_t*)(ws + WS_X1); const bf16_t* XB = (const bf16_t*)(ws + WS_XB);
  int le_ = mk_lane(); asm volatile("" : "+v"(le_));
  const int odd = le_ & 1, pr = (le_ >> 1) & 15, col8 = 128 * wave + 8 * pr, rowp = 16 * odd + 4 * ((le_ >> 5) & 1);
  const f32x4 gtl = *(const f32x4*)(mod + 2 * DM + col8), gth = *(const f32x4*)(mod + 2 * DM + col8 + 4);
#pragma unroll
  for (int rb = 0; rb < 2; ++rb) {
    u32x4 xr[8];
#pragma unroll
    for (int k = 0; k < 8; ++k) xr[k] = __builtin_nontemporal_load((const u32x4*)(XB + (size_t)(t0 + 32 * rb + rowp + (k & 3) + 8 * (k >> 2)) * DM + col8));
#pragma unroll
    for (int i = 0; i < 4; ++i)
#pragma unroll
      for (int k = 0; k < 8; ++k) { const float a = acc[i][rb][k], bq = acc[i][rb][8 + k];
        const float rcv = __int_as_float(__builtin_amdgcn_update_dpp(0, __float_as_int(odd ? a : bq), 0xB1, 0xF, 0xF, true));
        acc[i][rb][k] = odd ? rcv : a; acc[i][rb][8 + k] = odd ? bq : rcv; }
#pragma unroll
    for (int k = 0; k < 8; ++k) { const int row = 32 * rb + rowp + (k & 3) + 8 * (k >> 2);
      const float v0 = __uint_as_float(xr[k].x << 16) + gtl[0] * acc[0][rb][k], v1 = __uint_as_float(xr[k].x & 0xffff0000u) + gtl[1] * acc[1][rb][k];
      const float v2 = __uint_as_float(xr[k].y << 16) + gtl[2] * acc[2][rb][k], v3 = __uint_as_float(xr[k].y & 0xffff0000u) + gtl[3] * acc[3][rb][k];
      const float v4 = __uint_as_float(xr[k].z << 16) + gth[0] * acc[0][rb][8 + k], v5 = __uint_as_float(xr[k].z & 0xffff0000u) + gth[1] * acc[1][rb][8 + k];
      const float v6 = __uint_as_float(xr[k].w << 16) + gth[2] * acc[2][rb][8 + k], v7 = __uint_as_float(xr[k].w & 0xffff0000u) + gth[3] * acc[3][rb][8 + k];
      acc[0][rb][k] = v0; acc[1][rb][k] = v1; acc[2][rb][k] = v2; acc[3][rb][k] = v3; acc[0][rb][8 + k] = v4; acc[1][rb][8 + k] = v5; acc[2][rb][8 + k] = v6; acc[3][rb][8 + k] = v7;
      { const u32x4 wv = u32x4{pk2(v0, v1), pk2(v2, v3), pk2(v4, v5), pk2(v6, v7)}; bf16_t* dp = X1 + (size_t)(t0 + row) * DM + col8;
        asm volatile("global_store_dwordx4 %0, %1, off sc1" :: "v"(dp), "v"(wv) : "memory"); }
      float ss = v0 * v0 + v1 * v1 + v2 * v2 + v3 * v3 + v4 * v4 + v5 * v5 + v6 * v6 + v7 * v7;
#pragma unroll
      for (int o = 16; o > 1; o >>= 1) ss += __shfl_xor(ss, o);
      if (pr == 0) ssl[wave * 64 + row] = ss; }
    __builtin_amdgcn_sched_barrier(0);
  }
  const f32x4 g2l = *(const f32x4*)(P.in[14] + col8), g2h = *(const f32x4*)(P.in[14] + col8 + 4), sc2l = *(const f32x4*)(mod + 4 * DM + col8), sc2h = *(const f32x4*)(mod + 4 * DM + col8 + 4);
  const f32x4 s2l = *(const f32x4*)(mod + 3 * DM + col8), s2h = *(const f32x4*)(mod + 3 * DM + col8 + 4);
  __syncthreads();
  if (tid < 64) { float s = 0.f;
#pragma unroll
    for (int w = 0; w < 8; ++w) s += ssl[w * 64 + tid];
    ssq[tid] = s; }
  __syncthreads();
  { const f32x4 a2l = g2l * (sc2l + 1.0f), a2h = g2h * (sc2h + 1.0f);
#pragma unroll
    for (int rb = 0; rb < 2; ++rb)
#pragma unroll
      for (int k = 0; k < 8; ++k) { const int row = 32 * rb + rowp + (k & 3) + 8 * (k >> 2); const float rs = rsqrtf(ssq[row] * (1.0f / DM) + EPS);
        const float h0 = acc[0][rb][k] * rs * a2l[0] + s2l[0], h1 = acc[1][rb][k] * rs * a2l[1] + s2l[1], h2v = acc[2][rb][k] * rs * a2l[2] + s2l[2], h3 = acc[3][rb][k] * rs * a2l[3] + s2l[3];
        const float h4 = acc[0][rb][8 + k] * rs * a2h[0] + s2h[0], h5 = acc[1][rb][8 + k] * rs * a2h[1] + s2h[1], h6 = acc[2][rb][8 + k] * rs * a2h[2] + s2h[2], h7 = acc[3][rb][8 + k] * rs * a2h[3] + s2h[3];
        *(LAS u32x4*)(lds + a_off(row, 2 * col8, 2048)) = u32x4{pk2(h0, h1), pk2(h2v, h3), pk2(h4, h5), pk2(h6, h7)}; }
  }
  __syncthreads();
  if (P.variant & 1) return;
  { const int rb = wave & 1, cb = (wave >> 1) & 1, kh = wave >> 2, col = 32 * cb + r32;
    const bf16x8* wpr = (const bf16x8*)(ws + WS_WR) + (size_t)(cb * 64 + 32 * kh) * 64 + lane;
    const LAS uchar* apr = lds + (32 * rb + r32) * 2048; const int swz = (lane & 15) << 4, kb0 = 16 * hi;
    f32x16 ar0 = {}, ar1 = {};
    bf16x8 ring[8];
#pragma unroll
    for (int d = 0; d < 8; ++d) ring[d] = wpr[d * 64];
#pragma unroll 1
    for (int s0 = 0; s0 < 32; s0 += 8) {
#pragma unroll
      for (int d = 0; d < 8; ++d) { const int s = s0 + d; const bf16x8 fa = *(const LAS bf16x8*)(apr + ((((32 * kh + s) * 32) + kb0) ^ swz));
        if (d & 1) ar1 = mfma(fa, ring[d], ar1); else ar0 = mfma(fa, ring[d], ar0);
        if (s + 8 < 32) ring[d] = wpr[(s + 8) * 64]; }
    }
    if (kh == 0) {
#pragma unroll
      for (int reg = 0; reg < 16; ++reg) logit[(32 * rb + crow(reg, hi)) * 64 + col] = ar0[reg] + ar1[reg]; }
    __syncthreads();
    if (kh == 1) {
#pragma unroll
      for (int reg = 0; reg < 16; ++reg) logit[(32 * rb + crow(reg, hi)) * 64 + col] += ar0[reg] + ar1[reg]; }
  }
  __syncthreads();
  if (tid < 64) {
    const float* lg = (const float*)0; (void)lg;
    float gl[4];
#pragma unroll
    for (int i = 0; i < 4; ++i) gl[i] = logit[tid * 64 + i] + rbias[32 + i];
    int gi = 0; float gm = gl[0];
#pragma unroll
    for (int i = 1; i < 4; ++i) if (gl[i] > gm) { gm = gl[i]; gi = i; }
    float gs = 0.f;
#pragma unroll
    for (int i = 0; i < 4; ++i) gs += __expf(gl[i] - gm);
    const float gw = 1.0f / gs;
    float el[8];
#pragma unroll
    for (int i = 0; i < 8; ++i) el[i] = logit[tid * 64 + 4 + gi * 8 + i] + rbias[gi * 8 + i];
    int i1 = 0; float m1 = el[0];
#pragma unroll
    for (int i = 1; i < 8; ++i) if (el[i] > m1) { m1 = el[i]; i1 = i; }
    int i2 = (i1 + 1) & 7; float m2 = el[i2];
#pragma unroll
    for (int i = 0; i < 8; ++i) if (i != i1 && el[i] > m2) { m2 = el[i]; i2 = i; }
    const float p2 = __expf(m2 - m1), w1 = 1.0f / (1.0f + p2), w2 = p2 * w1;
    const int e1 = gi * 8 + i1, e2 = gi * 8 + i2;
    selE[2 * tid] = e1; selE[2 * tid + 1] = e2; selW[2 * tid] = gw * w1; selW[2 * tid + 1] = gw * w2;
    selP[2 * tid] = __hip_atomic_fetch_add(&cntl[e1], 1, __ATOMIC_RELAXED, __HIP_MEMORY_SCOPE_WORKGROUP);
    selP[2 * tid + 1] = __hip_atomic_fetch_add(&cntl[e2], 1, __ATOMIC_RELAXED, __HIP_MEMORY_SCOPE_WORKGROUP);
  }
  __syncthreads();
  int gbase = 0;
  if (tid < 32) { const int c = cntl[tid]; gbase = c ? atomicAdd((int*)(ws + WS_CNT) + tid, c) : 0; }
  { uchar* H2 = ws + WS_H2;
#pragma unroll
    for (int rr = 0; rr < 8; ++rr) { const int row = wave * 8 + rr;
      const u32x4 v0 = *(const LAS u32x4*)(lds + a_off(row, 32 * lane, 2048)), v1 = *(const LAS u32x4*)(lds + a_off(row, 32 * lane + 16, 2048));
      u32x2 w0, w1;
      w0.x = pk4_fp8(__uint_as_float(v0.x << 16) * H2_SCALE, __uint_as_float(v0.x & 0xffff0000u) * H2_SCALE, __uint_as_float(v0.y << 16) * H2_SCALE, __uint_as_float(v0.y & 0xffff0000u) * H2_SCALE);
      w0.y = pk4_fp8(__uint_as_float(v0.z << 16) * H2_SCALE, __uint_as_float(v0.z & 0xffff0000u) * H2_SCALE, __uint_as_float(v0.w << 16) * H2_SCALE, __uint_as_float(v0.w & 0xffff0000u) * H2_SCALE);
      w1.x = pk4_fp8(__uint_as_float(v1.x << 16) * H2_SCALE, __uint_as_float(v1.x & 0xffff0000u) * H2_SCALE, __uint_as_float(v1.y << 16) * H2_SCALE, __uint_as_float(v1.y & 0xffff0000u) * H2_SCALE);
      w1.y = pk4_fp8(__uint_as_float(v1.z << 16) * H2_SCALE, __uint_as_float(v1.z & 0xffff0000u) * H2_SCALE, __uint_as_float(v1.w << 16) * H2_SCALE, __uint_as_float(v1.w & 0xffff0000u) * H2_SCALE);
      ((u32x4*)(H2 + (size_t)(t0 + row) * DM))[lane] = u32x4{w0.x, w0.y, w1.x, w1.y}; } }
  if (tid < 32) basel[tid] = gbase;
  __syncthreads();
  if (tid < 128) { const int e = selE[tid], pos = basel[e] + selP[tid];
    ((int*)(ws + WS_LIST))[(size_t)e * 16384 + pos] = (t0 + (tid >> 1)) * 2 + (tid & 1);
    ((float*)(ws + WS_WT))[(size_t)(t0 + (tid >> 1)) * 2 + (tid & 1)] = selW[tid]; }
  __syncthreads();
}

constexpr int P4_ROWS = 144, P4_NRB = 5, P4_MISC = P4_ROWS * 1024;
__device__ __forceinline__ void phase4(const KP& P, LAS uchar* lds) {
  int lane_ = mk_lane(); asm volatile("" : "+v"(lane_)); const int lane = lane_ & 63, wave = P.wave, tid = wave * 64 + lane, r32 = lane & 31, hi = lane >> 5;
  uchar* ws = P.ws;
  LAS int* rinfo = (LAS int*)(lds + P4_MISC + 1024);
  LAS float* rwt = (LAS float*)(lds + P4_MISC + 2048);
  LAS int* ustart = (LAS int*)(lds + P4_MISC + 3072);
  const int* cnt = (const int*)(ws + WS_CNT);
  LAS int* cl = (LAS int*)(lds + P4_MISC + 3328);
  if (tid < 32) {
    const int c = cnt[tid]; cl[tid] = c; int s = (c + P4_ROWS - 1) / P4_ROWS;
#pragma unroll
    for (int o = 1; o < 32; o <<= 1) { const int n = __shfl_up(s, o); if (tid >= o) s += n; }
    ustart[tid + 1] = s; if (tid == 0) ustart[0] = 0; }
  __syncthreads();
  const int total = ustart[32];
  const uchar* H2 = ws + WS_H2; uchar* Y = ws + WS_Y;
#pragma unroll 1
  for (int u0 = blockIdx.x; u0 < ((total + 255) & ~255); u0 += gridDim.x) {
    const int u = gridDim.x == 256 ? (u0 & ~255) + (u0 & 7) * 32 + ((u0 & 255) >> 3) : u0;
    if (u >= total) continue;
    int lt_ = mk_lane(); asm volatile("" : "+v"(lt_)); const int lane = lt_ & 63, tid = wave * 64 + lane, r32 = lane & 31, hi = lane >> 5;
    const int e = __popcll(__ballot(lane < 32 && ustart[lane & 31] <= u)) - 1;
    const int ne = cl[e], ke = ustart[e + 1] - ustart[e], q = (ne + ke - 1) / ke, j = u - ustart[e], base = j * q, len = min(q, ne - base), nrb = (len + 31) >> 5;
    if (tid < 160) { int info = -1; float w = 0.f;
      if (tid < len) { info = ((const int*)(ws + WS_LIST))[(size_t)e * 16384 + base + tid]; w = ((const float*)(ws + WS_WT))[info]; }
      rinfo[tid] = info; rwt[tid] = w; }
    __syncthreads();
#pragma unroll
    for (int hf = 0; hf < 2; ++hf) {
      u32x4 v[9];
#pragma unroll
      for (int rr = 0; rr < 9; ++rr) { const int info = rinfo[wave * 18 + hf * 9 + rr]; const int tok = info < 0 ? 0 : (info >> 1); v[rr] = ((const u32x4*)(H2 + (size_t)tok * DM))[lane]; }
#pragma unroll
      for (int rr = 0; rr < 9; ++rr) *(LAS u32x4*)(lds + a_off(wave * 18 + hf * 9 + rr, 16 * lane, 1024)) = v[rr];
    }
    __syncthreads();
    f32x16 ag[2][P4_NRB];
#pragma unroll
    for (int i = 0; i < 2; ++i)
#pragma unroll
      for (int rb = 0; rb < P4_NRB; ++rb) ag[i][rb] = f32x16{};
    { const l64x2* wp[2];
      wp[0] = (const l64x2*)(ws + WS_WG) + (size_t)((e * 8 + wave) * 32) * 64 + lane;
      wp[1] = (const l64x2*)(ws + WS_WU) + (size_t)((e * 8 + wave) * 32) * 64 + lane;
      if (!(P.variant & 2)) gemm_tile_f8<2, 32, true, 1, false, P4_NRB>(ag, lds, 1024, wp, lane, nrb); }
    __syncthreads();
    { constexpr float S1 = 1.0f / (H2_SCALE * WGU_SCALE);
      int lh_ = mk_lane(); asm volatile("" : "+v"(lh_)); const int r32 = lh_ & 31, hi = (lh_ >> 5) & 1;
#pragma unroll
      for (int rb = 0; rb < P4_NRB; ++rb) if (rb < nrb) { const int rr = 32 * rb + r32; const float w = rwt[rr] * HID_SCALE;
#pragma unroll
        for (int g = 0; g < 4; ++g) { float hv[4];
#pragma unroll
          for (int i = 0; i < 4; ++i) { const float gg = ag[0][rb][4 * g + i] * S1, uu = ag[1][rb][4 * g + i] * S1; hv[i] = gg / (1.0f + __expf(-gg)) * uu * w; }
          *(LAS unsigned*)(lds + a_off(rr, 32 * wave + 8 * g + 4 * hi, 256)) = pk4_fp8(hv[0], hv[1], hv[2], hv[3]); } } }
    __syncthreads();
#pragma unroll 1
    for (int pass = (P.variant & 1) ? 2 : 0; pass < 2; ++pass) {
      f32x16 ad[2][P4_NRB];
#pragma unroll
      for (int i = 0; i < 2; ++i)
#pragma unroll
        for (int rb = 0; rb < P4_NRB; ++rb) ad[i][rb] = f32x16{};
      const l64x2* wp[2];
#pragma unroll
      for (int i = 0; i < 2; ++i) wp[i] = (const l64x2*)(ws + WS_WD) + (size_t)((e * 32 + 4 * wave + 2 * pass + i) * 8) * 64 + lane;
      gemm_tile_f8<2, 8, false, 1, false, P4_NRB>(ad, lds, 256, wp, lane, nrb);
      constexpr float S2 = Y_SCALE / (HID_SCALE * WD_SCALE);
      int le_ = mk_lane(); asm volatile("" : "+v"(le_));
      const int hi = (le_ >> 5) & 1, odd = le_ & 1, b1 = (le_ >> 1) & 1;
      const unsigned selA = odd ? 0x01050004u : 0x05010400u, selB = odd ? 0x03070206u : 0x07030602u;
      const unsigned selL = b1 ? 0x01000504u : 0x05040100u, selH = b1 ? 0x03020706u : 0x07060302u;
      const int b2 = (le_ >> 2) & 1, b3 = (le_ >> 3) & 1;
      const int cbase = 128 * wave + 64 * pass + (le_ & 16), rowoff = 16 * odd + 8 * b1 + 4 * hi + 2 * b2 + b3;
#pragma unroll
      for (int rb = 0; rb < P4_NRB; ++rb) if (rb < nrb) {
#pragma unroll
        for (int i = 0; i < 2; ++i) {
          unsigned q[4];
#pragma unroll
          for (int m = 0; m < 4; ++m) q[m] = pk4_fp8(__builtin_amdgcn_fmed3f(ad[i][rb][4 * m] * S2, -440.f, 440.f), __builtin_amdgcn_fmed3f(ad[i][rb][4 * m + 1] * S2, -440.f, 440.f),
                                                   __builtin_amdgcn_fmed3f(ad[i][rb][4 * m + 2] * S2, -440.f, 440.f), __builtin_amdgcn_fmed3f(ad[i][rb][4 * m + 3] * S2, -440.f, 440.f));
          unsigned T[2][2];
#pragma unroll
          for (int k = 0; k < 2; ++k) {
            const unsigned own = odd ? q[2 + k] : q[k], snd = odd ? q[k] : q[2 + k];
            const unsigned rcv = (unsigned)__builtin_amdgcn_update_dpp(0, (int)snd, 0xB1, 0xF, 0xF, true);
            T[k][0] = __builtin_amdgcn_perm(rcv, own, selA); T[k][1] = __builtin_amdgcn_perm(rcv, own, selB);
          }
          unsigned R[4];
#pragma unroll
          for (int x = 0; x < 2; ++x) {
            const unsigned own = b1 ? T[1][x] : T[0][x], snd = b1 ? T[0][x] : T[1][x];
            const unsigned rcv = (unsigned)__builtin_amdgcn_update_dpp(0, (int)snd, 0x4E, 0xF, 0xF, true);
            R[2 * x] = __builtin_amdgcn_perm(rcv, own, selL); R[2 * x + 1] = __builtin_amdgcn_perm(rcv, own, selH);
          }
          u32x2 O2[2];
#pragma unroll
          for (int z = 0; z < 2; ++z) {
            const unsigned own = b2 ? R[2 + z] : R[z], snd = b2 ? R[z] : R[2 + z];
            const unsigned rcv = (unsigned)__builtin_amdgcn_ds_swizzle((int)snd, 0x101F);
            O2[z] = u32x2{b2 ? rcv : own, b2 ? own : rcv};
          }
          const u32x2 own4 = b3 ? O2[1] : O2[0], snd4 = b3 ? O2[0] : O2[1];
          const u32x2 rcv4 = u32x2{(unsigned)__builtin_amdgcn_ds_swizzle((int)snd4.x, 0x201F), (unsigned)__builtin_amdgcn_ds_swizzle((int)snd4.y, 0x201F)};
          const u32x4 w16 = b3 ? u32x4{rcv4.x, rcv4.y, own4.x, own4.y} : u32x4{own4.x, own4.y, rcv4.x, rcv4.y};
          const int info = rinfo[32 * rb + rowoff];
          if (info >= 0) *(u32x4*)(Y + (size_t)info * DM + cbase + 32 * i) = w16;
        }
      }
    }
    __syncthreads();
  }
}

__device__ __forceinline__ void phase5(const KP& P) {
  int lane_ = mk_lane(); asm volatile("" : "+v"(lane_)); const int lane = lane_ & 63, wave = P.wave;
  uchar* ws = P.ws;
  const uchar* Y = ws + WS_Y;
  const bf16_t* X1 = (const bf16_t*)(ws + WS_X1); float* OUT = P.out;
  f32x4 gf[4];
#pragma unroll
  for (int i = 0; i < 4; ++i) gf[i] = *(const f32x4*)(P.in[22] + 4 * (lane + 64 * i));
  constexpr int RPI = 8;
  const int nwv = gridDim.x * NWAVE, wv = blockIdx.x * NWAVE + wave;
#pragma unroll 1
  for (int t0 = wv * RPI; t0 < T; t0 += nwv * RPI) {
    u32x2 xv[RPI][4]; unsigned ya[RPI][4], yb[RPI][4];
#pragma unroll
    for (int r = 0; r < RPI; ++r)
#pragma unroll
      for (int i = 0; i < 4; ++i) { const int k = 4 * (lane + 64 * i); const size_t t = t0 + r;
        xv[r][i] = __builtin_nontemporal_load((const u32x2*)(X1 + t * DM + k)); ya[r][i] = __builtin_nontemporal_load((const unsigned*)(Y + (2 * t) * DM + k)); yb[r][i] = __builtin_nontemporal_load((const unsigned*)(Y + (2 * t + 1) * DM + k)); }
    const int b = t0 / SEQ; const float* gt2 = (const float*)(ws + WS_MOD) + b * (NMOD * DM) + 5 * DM;
    f32x4 g2v[4];
#pragma unroll
    for (int i = 0; i < 4; ++i) g2v[i] = *(const f32x4*)(gt2 + 4 * (lane + 64 * i)) * (1.0f / Y_SCALE);
#pragma unroll
    for (int r = 0; r < RPI; ++r) {
      f32x4 v[4]; float ss = 0.f;
#pragma unroll
      for (int i = 0; i < 4; ++i) { const int y0 = (int)ya[r][i], y1 = (int)yb[r][i]; f32x4 ys;
        const f32x2 a01 = __builtin_amdgcn_cvt_pk_f32_fp8(y0, false), a23 = __builtin_amdgcn_cvt_pk_f32_fp8(y0, true), b01 = __builtin_amdgcn_cvt_pk_f32_fp8(y1, false), b23 = __builtin_amdgcn_cvt_pk_f32_fp8(y1, true);
        ys[0] = a01[0] + b01[0]; ys[1] = a01[1] + b01[1]; ys[2] = a23[0] + b23[0]; ys[3] = a23[1] + b23[1];
        f32x4 xf; xf[0] = __uint_as_float(xv[r][i].x << 16); xf[1] = __uint_as_float(xv[r][i].x & 0xffff0000u); xf[2] = __uint_as_float(xv[r][i].y << 16); xf[3] = __uint_as_float(xv[r][i].y & 0xffff0000u);
        v[i] = xf + g2v[i] * ys; ss += v[i][0] * v[i][0] + v[i][1] * v[i][1] + v[i][2] * v[i][2] + v[i][3] * v[i][3]; }
      ss = wave_sum(ss); const float rs = rsqrtf(ss * (1.0f / DM) + EPS);
#pragma unroll
      for (int i = 0; i < 4; ++i) __builtin_nontemporal_store(v[i] * rs * gf[i], (f32x4*)(OUT + (size_t)(t0 + r) * DM + 4 * (lane + 64 * i)));
    }
  }
}
__global__ void __launch_bounds__(NTHR, 2) mk_fwd(const Params P0) {
  extern __shared__ __attribute__((aligned(16))) uchar lds_raw[];
  LAS uchar* lds = (LAS uchar*)lds_raw;
  KP P; P.in = P0.in; P.out = P0.out; P.ws = P0.ws; P.ph_lo = P0.ph_lo; P.ph_hi = P0.ph_hi; P.variant = P0.variant; P.wave = __builtin_amdgcn_readfirstlane((int)(threadIdx.x >> 6));
  const int bid = blockIdx.x, G = gridDim.x;
  const int lo = P.ph_lo, hi = P.ph_hi;
  volatile LAS unsigned* bst = (volatile LAS unsigned*)(lds + LDS_BYTES - 16);
  if (threadIdx.x < 4) bst[threadIdx.x] = 0u;
  __syncthreads();
  XcdBarrier bar; bar.bar = (unsigned*)(P.ws + WS_CTL); bar.x = 0; bar.st = bst;
  if (hi - lo > 1) bar = xcd_barrier_post((unsigned*)(P.ws + WS_CTL), bst, P.wave == 0 && mk_lane() == 0);
#define IN(k) (lo <= (k) && (k) < hi)
#define BOTH(k) (IN(k) && IN((k) + 1))
  if (IN(0)) { phase0(P, lds); if (BOTH(0)) xcd_barrier(bar, P.wave == 0 && mk_lane() == 0); }
  if (IN(1)) { if (bid < T / 64) phase1_tile(P, lds, bid); if (BOTH(1)) xcd_barrier(bar, P.wave == 0 && mk_lane() == 0); }
  if (IN(2)) { phase2(P, lds); if (BOTH(2)) xcd_barrier(bar, P.wave == 0 && mk_lane() == 0); }
  if (IN(3)) { if (bid < T / 64) phase3_tile(P, lds, bid); if (BOTH(3)) xcd_barrier(bar, P.wave == 0 && mk_lane() == 0); }
  if (IN(4)) { phase4(P, lds); if (BOTH(4)) xcd_barrier(bar, P.wave == 0 && mk_lane() == 0); }
  if (IN(5)) phase5(P);
#undef IN
#undef BOTH
}

extern "C" void kernel_launch(void* const* d_in, const int* in_sizes, int n_in, void* d_out, int out_size, void* d_ws, size_t ws_size, hipStream_t stream) {
  static int mode = -1;
  if (mode < 0) {
    if (n_in != 23 || out_size != T * DM || ws_size < WS_END) { fprintf(stderr, "kernel_launch: unexpected shapes (n_in %d out %d ws %zu need %zu)\n", n_in, out_size, ws_size, (size_t)WS_END); return; }
    if (hipFuncSetAttribute((const void*)mk_fwd, hipFuncAttributeMaxDynamicSharedMemorySize, LDS_BYTES) != hipSuccess) { fprintf(stderr, "kernel_launch: hipFuncSetAttribute failed\n"); return; }
    int dev = 0, ncu = 0, per_cu = 0;
    if (hipGetDevice(&dev) != hipSuccess || hipDeviceGetAttribute(&ncu, hipDeviceAttributeMultiprocessorCount, dev) != hipSuccess ||
        hipOccupancyMaxActiveBlocksPerMultiprocessor(&per_cu, (const void*)mk_fwd, NTHR, LDS_BYTES) != hipSuccess) { ncu = 0; per_cu = 0; }
    mode = ((long)ncu * per_cu >= T / 64) ? 1 : 0;
  }
  uchar* ws = (uchar*)d_ws;
  if (hipMemsetAsync(ws + WS_CTL, 0, 32768, stream) != hipSuccess) { fprintf(stderr, "kernel_launch: hipMemsetAsync failed\n"); return; }
  Params p{};
  for (int i = 0; i < 23; ++i) p.in[i] = (const float*)d_in[i];
  p.out = (float*)d_out; p.ws = ws; p.ph_lo = 0; p.ph_hi = 6; p.variant = 0; p.pad = 0;
  if (mode == 1) hipLaunchKernelGGL(mk_fwd, dim3(T / 64), dim3(NTHR), LDS_BYTES, stream, p);
  else for (int k = 0; k < 6; ++k) { p.ph_lo = k; p.ph_hi = k + 1; hipLaunchKernelGGL(mk_fwd, dim3(T / 64), dim3(NTHR), LDS_BYTES, stream, p); }
}
```
